# Optimizing an MI355X kernel written in HIP

```python
import jax, jax.numpy as jnp
from jax import lax
import numpy as np

D_MODEL = 1024
BATCH = 4
SEQ = 4096
DEPTH = 2

MLSTM_HEADS = 4
MLSTM_QK_DIM = 128
MLSTM_V_DIM = 256
MLSTM_CHUNK = 64
CONV_K = 4
SB_HEADS = 16
SB_HEAD_DIM = D_MODEL // SB_HEADS
Q_BLOCK = 128
N_EXPERTS = 64
TOP_K = 8
N_GROUPS = 8
TOPK_GROUPS = 4
EXPERT_FF = 128
SHARED_FF = 256
ROUTED_SCALE = 2.5
EPS = 1e-6

MLSTM_QK = MLSTM_HEADS * MLSTM_QK_DIM
MLSTM_V = MLSTM_HEADS * MLSTM_V_DIM
SB_WIDTH = SB_HEADS * SB_HEAD_DIM
IN_WIDTH = 2 * MLSTM_QK + 2 * MLSTM_V + 2 * MLSTM_HEADS + 3 * SB_WIDTH + 2 * D_MODEL

kernel_name = 'hybrid_mlstm_stickbreak_moe'


def rms_norm(x, w):
    x32 = x.astype(jnp.float32)
    y = x32 * lax.rsqrt(jnp.mean(x32 * x32, axis=-1, keepdims=True) + EPS)
    return (y * w.astype(jnp.float32)).astype(x.dtype)


def modulate(h, shift, scale):
    return h * (1 + scale[:, None, :]) + shift[:, None, :]


def causal_depthwise_conv(u, w, b):
    k_taps = w.shape[0]
    s = u.shape[1]
    up = jnp.pad(u, ((0, 0), (k_taps - 1, 0), (0, 0)))
    out = b
    for j in range(k_taps):
        out = out + up[:, j:j + s, :] * w[j]
    return out


def _mlstm_chunk_step(carry, xs):
    C, n, m = carry
    q, k, v, ig, lf = xs
    L = q.shape[2]
    b = jnp.cumsum(lf, axis=-1)
    a = b[..., -1]
    causal = jnp.tril(jnp.ones((L, L), dtype=bool))
    dmat = jnp.where(causal, b[..., :, None] - b[..., None, :] + ig[..., None, :], -jnp.inf)
    inter = b + m[..., None]
    m_t = jnp.maximum(inter, jnp.max(dmat, axis=-1))
    w_intra = jnp.exp(dmat - m_t[..., None])
    w_inter = jnp.exp(inter - m_t)
    s = jnp.einsum('bhtd,bhsd->bhts', q, k) * w_intra
    num = jnp.einsum('bhts,bhsv->bhtv', s, v) + w_inter[..., None] * jnp.einsum('bhtd,bhdv->bhtv', q, C)
    den = jnp.sum(s, axis=-1) + w_inter * jnp.einsum('bhtd,bhd->bht', q, n)
    h = num / jnp.maximum(jnp.abs(den), jnp.exp(-m_t))[..., None]
    g = a[..., None] - b + ig
    m_new = jnp.maximum(a + m, jnp.max(g, axis=-1))
    wc = jnp.exp(g - m_new[..., None])
    decay = jnp.exp(a + m - m_new)
    C_new = decay[..., None, None] * C + jnp.einsum('bhsd,bhsv->bhdv', k * wc[..., None], v)
    n_new = decay[..., None] * n + jnp.einsum('bhs,bhsd->bhd', wc, k)
    return (C_new, n_new, m_new), h


def mlstm(q, k, v, i_pre, f_pre):
    bsz, s = q.shape[0], q.shape[1]
    nc = s // MLSTM_CHUNK

    def to_chunks(t):
        t = t.astype(jnp.float32).reshape((bsz, nc, MLSTM_CHUNK) + t.shape[2:])
        return jnp.moveaxis(jnp.moveaxis(t, 3, 2), 1, 0)

    xs = (to_chunks(q) * (MLSTM_QK_DIM ** -0.5), to_chunks(k), to_chunks(v),
          to_chunks(i_pre), to_chunks(jax.nn.log_sigmoid(f_pre.astype(jnp.float32))))
    init = (jnp.zeros((bsz, MLSTM_HEADS, MLSTM_QK_DIM, MLSTM_V_DIM), jnp.float32),
            jnp.zeros((bsz, MLSTM_HEADS, MLSTM_QK_DIM), jnp.float32),
            jnp.zeros((bsz, MLSTM_HEADS), jnp.float32))
    _, h = lax.scan(_mlstm_chunk_step, init, xs)
    h = jnp.moveaxis(jnp.moveaxis(h, 0, 1), 2, 3)
    return h.reshape(bsz, s, MLSTM_HEADS, MLSTM_V_DIM)


def stick_breaking_attention(q, k, v):
    s_len, dh = q.shape[2], q.shape[3]
    scale = dh ** -0.5
    outs = []
    for blk in range(s_len // Q_BLOCK):
        t0, t1 = blk * Q_BLOCK, (blk + 1) * Q_BLOCK
        qb = q[:, :, t0:t1].astype(jnp.float32)
        kp = k[:, :, :t1].astype(jnp.float32)
        vp = v[:, :, :t1].astype(jnp.float32)
        z = jnp.einsum('bhtd,bhsd->bhts', qb, kp) * scale
        mask = jnp.arange(t1)[None, :] < jnp.arange(t0, t1)[:, None]
        log_fail = jnp.where(mask, jax.nn.log_sigmoid(-z), 0.0)
        later = lax.cumsum(log_fail, axis=3, reverse=True) - log_fail
        att = jnp.where(mask, jnp.exp(jax.nn.log_sigmoid(z) + later), 0.0)
        outs.append(jnp.einsum('bhts,bhsd->bhtd', att, vp))
    return jnp.concatenate(outs, axis=2).astype(q.dtype)


def hybrid_mixer(h, w_in, conv_w, conv_b, m_igate_b, m_fgate_b, m_norm_w, w_proj_a, w_proj_b, w_out):
    bsz, s, _ = h.shape
    p = h @ w_in
    sizes = [2 * MLSTM_QK, MLSTM_V, MLSTM_V, MLSTM_HEADS, MLSTM_HEADS, SB_WIDTH, SB_WIDTH, SB_WIDTH, D_MODEL, D_MODEL]
    offs, acc = [], 0
    for sz in sizes[:-1]:
        acc += sz
        offs.append(acc)
    mqk, mv, mo, mi, mf, sq, sk, sv, ga, gb = jnp.split(p, offs, axis=-1)
    mqk = jax.nn.silu(causal_depthwise_conv(mqk, conv_w, conv_b))
    mq, mk = jnp.split(mqk, 2, axis=-1)
    hm = mlstm(mq.reshape(bsz, s, MLSTM_HEADS, MLSTM_QK_DIM),
               mk.reshape(bsz, s, MLSTM_HEADS, MLSTM_QK_DIM),
               mv.reshape(bsz, s, MLSTM_HEADS, MLSTM_V_DIM),
               mi + m_igate_b, mf + m_fgate_b)
    hm = hm * lax.rsqrt(jnp.mean(hm * hm, axis=-1, keepdims=True) + EPS)
    hm = (hm.reshape(bsz, s, MLSTM_V) * m_norm_w.astype(jnp.float32)).astype(h.dtype) * jax.nn.sigmoid(mo)
    to_heads = lambda t: t.reshape(bsz, s, SB_HEADS, SB_HEAD_DIM).transpose(0, 2, 1, 3)
    hs = stick_breaking_attention(to_heads(sq), to_heads(sk), to_heads(sv))
    hs = hs.transpose(0, 2, 1, 3).reshape(bsz, s, SB_WIDTH)
    y = jax.nn.sigmoid(ga) * (hm @ w_proj_a) + jax.nn.sigmoid(gb) * (hs @ w_proj_b)
    return y @ w_out


def moe_ffn(u, router_w, router_b, w_gate, w_up, w_down, sh_gate, sh_up, sh_down):
    bsz, s, d = u.shape
    t = u.reshape(-1, d)
    scores = jax.nn.sigmoid((t @ router_w).astype(jnp.float32))
    sel = scores + router_b.astype(jnp.float32)
    grp = sel.reshape(-1, N_GROUPS, N_EXPERTS // N_GROUPS)
    grp_score = jnp.sum(lax.top_k(grp, 2)[0], axis=-1)
    _, gidx = lax.top_k(grp_score, TOPK_GROUPS)
    gmask = jnp.sum(jax.nn.one_hot(gidx, N_GROUPS, dtype=jnp.float32), axis=-2)
    emask = jnp.repeat(gmask, N_EXPERTS // N_GROUPS, axis=-1) > 0
    _, eidx = lax.top_k(jnp.where(emask, sel, -jnp.inf), TOP_K)
    wts = jnp.take_along_axis(scores, eidx, axis=-1)
    wts = wts / jnp.sum(wts, axis=-1, keepdims=True) * ROUTED_SCALE
    gates = jnp.sum(jax.nn.one_hot(eidx, N_EXPERTS, dtype=jnp.float32) * wts[..., None], axis=-2).astype(u.dtype)
    hid = jax.nn.silu(jnp.einsum('nd,edf->nef', t, w_gate)) * jnp.einsum('nd,edf->nef', t, w_up)
    routed = jnp.einsum('nef,efd->nd', hid * gates[..., None], w_down)
    shared = (jax.nn.silu(t @ sh_gate) * (t @ sh_up)) @ sh_down
    return (routed + shared).reshape(bsz, s, d)


def setup_inputs(seed: int = 0) -> dict:
    key = jax.random.key(seed)
    ks = jax.random.split(key, 24)
    nrm = lambda k, shape, sc: jax.random.normal(k, shape, jnp.float32) * sc
    E, F, FS = N_EXPERTS, EXPERT_FF, SHARED_FF
    return {
        'x': nrm(ks[0], (BATCH, SEQ, D_MODEL), 1.0),
        'c': nrm(ks[1], (BATCH, D_MODEL), 1.0),
        'ada_w': nrm(ks[2], (DEPTH, D_MODEL, 6 * D_MODEL), 0.5 * D_MODEL ** -0.5),
        'ada_b': nrm(ks[3], (DEPTH, 6 * D_MODEL), 0.02),
        'norm1_w': 1.0 + nrm(ks[4], (DEPTH, D_MODEL), 0.05),
        'w_in': nrm(ks[5], (DEPTH, D_MODEL, IN_WIDTH), D_MODEL ** -0.5),
        'conv_w': nrm(ks[6], (DEPTH, CONV_K, 2 * MLSTM_QK), CONV_K ** -0.5),
        'conv_b': nrm(ks[7], (DEPTH, 2 * MLSTM_QK), 0.02),
        'm_igate_b': nrm(ks[8], (DEPTH, MLSTM_HEADS), 0.1),
        'm_fgate_b': 3.0 + nrm(ks[9], (DEPTH, MLSTM_HEADS), 0.5),
        'm_norm_w': 1.0 + nrm(ks[10], (DEPTH, MLSTM_V), 0.05),
        'w_proj_a': nrm(ks[11], (DEPTH, MLSTM_V, D_MODEL), MLSTM_V ** -0.5),
        'w_proj_b': nrm(ks[12], (DEPTH, SB_WIDTH, D_MODEL), SB_WIDTH ** -0.5),
        'w_out': nrm(ks[13], (DEPTH, D_MODEL, D_MODEL), D_MODEL ** -0.5),
        'norm2_w': 1.0 + nrm(ks[14], (DEPTH, D_MODEL), 0.05),
        'router_w': nrm(ks[15], (DEPTH, D_MODEL, E), D_MODEL ** -0.5),
        'router_b': nrm(ks[16], (DEPTH, E), 0.01),
        'w_gate': nrm(ks[17], (DEPTH, E, D_MODEL, F), D_MODEL ** -0.5),
        'w_up': nrm(ks[18], (DEPTH, E, D_MODEL, F), D_MODEL ** -0.5),
        'w_down': nrm(ks[19], (DEPTH, E, F, D_MODEL), F ** -0.5),
        'sh_gate': nrm(ks[20], (DEPTH, D_MODEL, FS), D_MODEL ** -0.5),
        'sh_up': nrm(ks[21], (DEPTH, D_MODEL, FS), D_MODEL ** -0.5),
        'sh_down': nrm(ks[22], (DEPTH, FS, D_MODEL), FS ** -0.5),
        'final_norm_w': 1.0 + nrm(ks[23], (D_MODEL,), 0.05),
    }


def reference(x, c, ada_w, ada_b, norm1_w, w_in, conv_w, conv_b, m_igate_b, m_fgate_b, m_norm_w,
              w_proj_a, w_proj_b, w_out, norm2_w, router_w, router_b, w_gate, w_up, w_down,
              sh_gate, sh_up, sh_down, final_norm_w):
    cond = jax.nn.silu(c)
    for l in range(DEPTH):
        mod = cond @ ada_w[l] + ada_b[l]
        sh1, sc1, g1, sh2, sc2, g2 = jnp.split(mod, 6, axis=-1)
        h = modulate(rms_norm(x, norm1_w[l]), sh1, sc1)
        mix = hybrid_mixer(h, w_in[l], conv_w[l], conv_b[l], m_igate_b[l], m_fgate_b[l], m_norm_w[l],
                           w_proj_a[l], w_proj_b[l], w_out[l])
        x = x + (g1[:, None, :] * mix).astype(x.dtype)
        h = modulate(rms_norm(x, norm2_w[l]), sh2, sc2)
        ffn = moe_ffn(h, router_w[l], router_b[l], w_gate[l], w_up[l], w_down[l], sh_gate[l], sh_up[l], sh_down[l])
        x = x + (g2[:, None, :] * ffn).astype(x.dtype)
    return rms_norm(x, final_norm_w)
```

```cpp
#include <hip/hip_runtime.h>
#include <cstdio>
#include <cstdint>
#include <cmath>
namespace pg8 {
#define PG8_LAS __attribute__((address_space(3)))
typedef unsigned short bf16_t;
typedef short bf16x8 __attribute__((ext_vector_type(8)));
typedef float f32x4 __attribute__((ext_vector_type(4)));
typedef unsigned u32x4 __attribute__((ext_vector_type(4)));
constexpr int BM = 256, BK = 64, HALF = 128, HTB = HALF * BK * 2  , STAGE_BYTES = 8 * HTB, NXCD = 8, WGM = 8;

__host__ __device__ __forceinline__ int lds_byte(int r, int c) { const int st = (r >> 4) * 2 + (c >> 5), rr = r & 15, cc = c & 31, ob = rr * 64 + cc * 2; return st * 1024 + (ob ^ (((ob >> 9) & 1) << 5)); }
__host__ __device__ __forceinline__ void stage_rc(int b, int& R, int& C) { const int st = b / 1024, sb = b % 1024, swz = sb ^ (((sb >> 9) & 1) << 5); R = (st >> 1) * 16 + swz / 64; C = (st & 1) * 32 + (swz % 64) / 2; }
__host__ __device__ __forceinline__ int perm32(int rho) { const int n = rho >> 4, i = rho & 15; return 8 * (i >> 2) + 4 * n + (i & 3); }

struct Unit { int pm, pn; };
struct Gemm { const bf16_t* A; const bf16_t* Bt; int K; int lda; };

struct StaticOrder {
    int nM, nN, nwg, G, c, wave;
    __device__ void init(int M, int N, int G_, int c_, int wave_) { nM = M / BM; nN = N / BM; nwg = nM * nN; G = G_; c = c_; wave = wave_; }
    __device__ bool next(int i, Unit& u) const {
        const long L = (long)i * G + c; if (L >= nwg) return false;
        int wgid = (int)L; { const int q = nwg / NXCD, r = nwg % NXCD, xcd = wgid % NXCD, off = wgid / NXCD; wgid = (xcd < r ? xcd * (q + 1) : r * (q + 1) + (xcd - r) * q) + off; }
        const int nig = WGM * nN, gid = wgid / nig, fm = gid * WGM, gsz = (nM - fm) < WGM ? (nM - fm) : WGM;
        u.pm = fm + ((wgid % nig) % gsz); u.pn = (wgid % nig) / gsz; return true;
    }
    __device__ __forceinline__ unsigned rowtok(int, int) const { return 0u; }
};

template <class Epi, class Sched, bool ALIGN_EPI, bool GATHER>
__device__ __forceinline__ void gemm_phase(PG8_LAS unsigned char* lds, const Gemm g, const Sched& S, const Epi& E) {
    int lane_; asm volatile("v_mbcnt_lo_u32_b32 %0, -1, 0\n\tv_mbcnt_hi_u32_b32 %0, -1, %0" : "=v"(lane_));
    const int wid = S.wave, lane = lane_, tid = wid * 64 + lane, wr = wid >> 2, wc = wid & 3, fr = lane & 15, fq = lane >> 4;
    int K_ = g.K, lda_ = g.lda; asm volatile("" : "+s"(K_), "+s"(lda_));
    const int K = K_, nt = K / BK, lda = lda_;
    unsigned vA[2][2], voffB[2];
#pragma unroll
    for (int i = 0; i < 2; ++i) { int R, C; stage_rc(tid * 16 + i * 8192, R, C); const int Rb = Epi::PERM ? ((R & ~31) + perm32(R & 31)) : R;
        voffB[i] = (unsigned)(Rb * K + C) * 2u;
#pragma unroll
        for (int h = 0; h < 2; ++h) vA[h][i] = (unsigned)(((GATHER ? h * HALF : 0) + R) * lda + C) * 2u; }
    const size_t kstep = (size_t)(BK * 2);
    const size_t hstepB = (size_t)HALF * K * 2, tstepB = 2 * hstepB;
    const size_t tstepA = (size_t)BM * lda * 2, hstepA = (size_t)HALF * lda * 2;
    const unsigned ldsw = (unsigned)wid * 1024u;
    const int aoff = lds_byte(wr * 64 + fr, fq * 8), boff = lds_byte(wc * 32 + fr, fq * 8);
#define PG8_SA(b, h) (((b) * 2 + (h)) * HTB)
#define PG8_SB(b, h) ((4 + (b) * 2 + (h)) * HTB)
#define PG8_STAGE(bufoff, gbase, voff) do { _Pragma("unroll") for (int _i = 0; _i < 2; ++_i) \
        __builtin_amdgcn_global_load_lds((const unsigned*)((const char*)(gbase) + (voff)[_i]), (PG8_LAS unsigned*)(lds + (bufoff) + ldsw + _i * 8192), 16, 0, 0); } while (0)
#define PG8_GATHER_SET(ui_, h) do { int l2_; asm volatile("v_mbcnt_lo_u32_b32 %0, -1, 0\n\tv_mbcnt_hi_u32_b32 %0, -1, %0" : "=v"(l2_)); const int tid2_ = wid * 64 + l2_; _Pragma("unroll") for (int _i = 0; _i < 2; ++_i) { int R_, C_; stage_rc(tid2_ * 16 + _i * 8192, R_, C_); vA[h][_i] = (S.rowtok((ui_), (h) * HALF + R_) * (unsigned)lda + (unsigned)C_) * 2u; } } while (0)
#define PG8_STAGE_A(bufoff, gbase, h, NX) do { _Pragma("unroll") for (int _i = 0; _i < 2; ++_i) { const unsigned _v = GATHER ? vA[h][_i] : vA[0][_i]; \
        __builtin_amdgcn_global_load_lds((const unsigned*)((const char*)(gbase) + (GATHER ? (size_t)0 : (size_t)(h) * hstepA) + _v), (PG8_LAS unsigned*)(lds + (bufoff) + ldsw + _i * 8192), 16, 0, 0); } } while (0)
#define PG8_LDA(dst, b, h) do { _Pragma("unroll") for (int m = 0; m < 4; ++m) _Pragma("unroll") for (int k = 0; k < 2; ++k) dst[m][k] = *(const PG8_LAS bf16x8*)(lds + PG8_SA(b, h) + aoff + m * 2048 + k * 1024); } while (0)
#define PG8_LDB(dst, b, h) do { _Pragma("unroll") for (int n = 0; n < 2; ++n) _Pragma("unroll") for (int k = 0; k < 2; ++k) dst[n][k] = *(const PG8_LAS bf16x8*)(lds + PG8_SB(b, h) + boff + n * 2048 + k * 1024); } while (0)
#define PG8_MMA(ai, bj, At, Bt) do { __builtin_amdgcn_s_setprio(1); _Pragma("unroll") for (int m = 0; m < 4; ++m) _Pragma("unroll") for (int n = 0; n < 2; ++n) _Pragma("unroll") for (int k = 0; k < 2; ++k) \
        acc[ai][bj][m][n] = __builtin_amdgcn_mfma_f32_16x16x32_bf16(Bt[n][k], At[m][k], acc[ai][bj][m][n], 0, 0, 0); __builtin_amdgcn_s_setprio(0); } while (0)
#define PG8_WAIT_V(n) asm volatile("s_waitcnt vmcnt(" #n ")" ::: "memory")
#define PG8_WAIT_L(n) asm volatile("s_waitcnt lgkmcnt(" #n ")" ::: "memory")
#define PG8_BAR __builtin_amdgcn_s_barrier()
#define PG8_SCHED __builtin_amdgcn_sched_barrier(0)
    Unit cur, nxt; int ui = 0;
    if (!S.next(0, cur)) return;
    if constexpr (GATHER) { PG8_GATHER_SET(0, 0); PG8_GATHER_SET(0, 1); }
    f32x4 acc[2][2][4][2];
#pragma unroll
    for (int a = 0; a < 2; ++a)
#pragma unroll
        for (int b = 0; b < 2; ++b)
#pragma unroll
            for (int m = 0; m < 4; ++m)
#pragma unroll
                for (int n = 0; n < 2; ++n) acc[a][b][m][n] = (f32x4){0.f, 0.f, 0.f, 0.f};
    bf16x8 At[4][2], B0[2][2], B1[2][2];
    const char* cA = (const char*)g.A + (GATHER ? (size_t)0 : (size_t)cur.pm * tstepA); const char* cB = (const char*)g.Bt + (size_t)cur.pn * tstepB;
    PG8_STAGE(PG8_SB(0, 0), cB, voffB); PG8_STAGE(PG8_SB(0, 1), cB + hstepB, voffB); PG8_STAGE_A(PG8_SA(0, 0), cA, 0, false); PG8_STAGE_A(PG8_SA(0, 1), cA, 1, false);
    if (wr == 1) PG8_BAR;
    PG8_WAIT_V(2); PG8_BAR;
    PG8_STAGE(PG8_SB(1, 0), cB + kstep, voffB); PG8_STAGE_A(PG8_SA(1, 0), cA + kstep, 0, false); PG8_STAGE(PG8_SB(1, 1), cB + hstepB + kstep, voffB);
    PG8_WAIT_V(6); PG8_BAR;
    for (;;) {
        const bool has_next = S.next(ui + 1, nxt);
        const char* nA = (has_next && !GATHER) ? (const char*)g.A + (size_t)nxt.pm * tstepA : (GATHER ? (const char*)g.A : cA);
        const char* nB = has_next ? (const char*)g.Bt + (size_t)nxt.pn * tstepB : cB;
        for (int t = 0; t < nt; t += 2) {
            const bool last = (t == nt - 2);
            const char* a1 = cA + (size_t)(t + 1) * kstep;
            const char* a2 = last ? nA : cA + (size_t)(t + 2) * kstep; const char* b2 = last ? nB : cB + (size_t)(t + 2) * kstep;
            const char* a3 = a2 + kstep; const char* b3 = b2 + kstep;
            if constexpr (GATHER) { if (last && has_next) PG8_GATHER_SET(ui + 1, 0); }
            PG8_LDB(B0, 0, 0); PG8_LDB(B1, 0, 1); PG8_SCHED; PG8_LDA(At, 0, 0); PG8_STAGE_A(PG8_SA(1, 1), a1, 1, false);
            if constexpr (GATHER) { if (last && has_next) PG8_GATHER_SET(ui + 1, 1); }
            PG8_WAIT_V(8); PG8_WAIT_L(0); PG8_BAR; PG8_MMA(0, 0, At, B0); PG8_MMA(0, 1, At, B1); PG8_BAR; PG8_SCHED;
            PG8_LDA(At, 0, 1); PG8_STAGE(PG8_SB(0, 0), b2, voffB); PG8_STAGE(PG8_SB(0, 1), b2 + hstepB, voffB); PG8_STAGE_A(PG8_SA(0, 0), a2, 0, last);
            PG8_WAIT_V(8); PG8_WAIT_L(0); PG8_BAR; PG8_MMA(1, 0, At, B0); PG8_MMA(1, 1, At, B1); PG8_BAR; PG8_SCHED;
            PG8_LDB(B0, 1, 0); PG8_LDB(B1, 1, 1); PG8_SCHED; PG8_LDA(At, 1, 0); PG8_STAGE_A(PG8_SA(0, 1), a2, 1, last);
            PG8_WAIT_V(8); PG8_WAIT_L(0); PG8_BAR; PG8_MMA(0, 0, At, B0); PG8_MMA(0, 1, At, B1); PG8_BAR; PG8_SCHED;
            PG8_LDA(At, 1, 1); PG8_STAGE(PG8_SB(1, 0), b3, voffB); PG8_STAGE(PG8_SB(1, 1), b3 + hstepB, voffB); PG8_STAGE_A(PG8_SA(1, 0), a3, 0, last);
            PG8_WAIT_V(8); PG8_WAIT_L(0); PG8_BAR; PG8_MMA(1, 0, At, B0); PG8_MMA(1, 1, At, B1); PG8_BAR; PG8_SCHED;
        }
        if constexpr (ALIGN_EPI) { if (wr == 0) PG8_BAR; }
        { Unit eu; eu.pm = __builtin_amdgcn_readfirstlane(cur.pm); eu.pn = __builtin_amdgcn_readfirstlane(cur.pn); int fr_ = fr, fq_ = fq; asm volatile("" : "+s"(eu.pm), "+s"(eu.pn), "+v"(fr_), "+v"(fq_));
          E(acc, eu, wr, wc, fr_, fq_); }
        if (!has_next) break;
#pragma unroll
        for (int a = 0; a < 2; ++a)
#pragma unroll
            for (int b = 0; b < 2; ++b)
#pragma unroll
                for (int m = 0; m < 4; ++m)
#pragma unroll
                    for (int n = 0; n < 2; ++n) acc[a][b][m][n] = (f32x4){0.f, 0.f, 0.f, 0.f};
        cur = nxt; cA = nA; cB = nB; ++ui;
        if constexpr (ALIGN_EPI) { if (wr == 1) PG8_BAR; }
    }
    PG8_WAIT_V(0);
    if constexpr (!ALIGN_EPI) { if (wr == 0) PG8_BAR; }
    PG8_BAR;
#undef PG8_SA
#undef PG8_SB
#undef PG8_STAGE
#undef PG8_STAGE_A
#undef PG8_GATHER_SET
#undef PG8_LDA
#undef PG8_LDB
#undef PG8_MMA
#undef PG8_WAIT_V
#undef PG8_WAIT_L
#undef PG8_BAR
#undef PG8_SCHED
}
}

constexpr int NTOK = 16384, DM = 1024, SEQ = 4096, NB = 4, NLAYER = 2;
constexpr int INW = 8200;
constexpr int C_MQK = 0, C_MV = 1024, C_MO = 2048, C_MI = 3072, C_MF = 3076, C_SQ = 3080, C_SK = 4104, C_SV = 5128, C_GA = 6152, C_GB = 7176;
constexpr int P6W = 6144;
constexpr int P_MQK = 0, P_MO = 1024, P_SQ = 2048, P_SK = 3072, P_GA = 4096, P_GB = 5120;
constexpr int NEXP = 64, EFF = 128, SFF = 256, TOPK = 8;
constexpr int MAXROWS = NTOK * TOPK + NEXP * 256;
constexpr int MAXTILES = MAXROWS / 256;
constexpr float EPS = 1e-6f;
constexpr float LOG2E = 1.4426950408889634f;

constexpr size_t MiB = 1u << 20;
constexpr size_t WS_CTL = 0, CTL_ZERO_BYTES = 3456 * 4;
constexpr size_t WS_MODP = 1 * MiB;
constexpr size_t WS_MODF = 4 * MiB;
constexpr size_t WS_GATES = WS_MODF + 256 * 1024;
constexpr size_t WS_TOPE = WS_GATES + 512 * 1024;
constexpr size_t WS_TOPW = WS_TOPE + 512 * 1024;
constexpr size_t WS_CNT = WS_TOPW + 512 * 1024;
constexpr size_t WS_STOK = WS_CNT + 64 * 1024;
constexpr size_t WS_SW = WS_STOK + 576 * 1024;
constexpr size_t WS_SDST = WS_SW + 576 * 1024;
constexpr size_t WS_TILEE = WS_SDST + 576 * 1024;
constexpr size_t WS_MISC_END = WS_TILEE + 4096;
static_assert(WS_MISC_END <= 8 * MiB, "misc region");
constexpr size_t WS_BIN = 8 * MiB;
constexpr size_t WS_AIN = WS_BIN + 12 * MiB;
constexpr size_t WS_BA = WS_AIN + 4 * MiB, WS_BB = WS_BA + 2 * MiB, WS_BO = WS_BB + 2 * MiB;
constexpr size_t WS_BGU = WS_BO + 2 * MiB;
constexpr size_t WS_BD = WS_BGU + 32 * MiB;
constexpr size_t WS_BSGU = WS_BD + 16 * MiB;
constexpr size_t WS_BSD = WS_BSGU + 1 * MiB;
constexpr size_t WS_W_END = WS_BSD + 1 * MiB;
constexpr size_t WS_R1 = 80 * MiB;
constexpr size_t WS_P6 = WS_R1, WS_VT = WS_R1 + 192 * MiB;
constexpr size_t WS_R2 = WS_R1 + 256 * MiB;
constexpr size_t WS_R3 = WS_R2 + 36 * MiB;
constexpr size_t WS_PT = WS_R3 + 8 * MiB;
constexpr size_t WS_END = WS_PT + 18 * MiB;
static_assert(WS_W_END <= WS_R1, "weights region");
constexpr int CW_BAR = 0;

constexpr int LDS_BYTES = 147456;
constexpr int LDS_MAIN = 131072;
constexpr int LDS_TAB = 131072;
constexpr int LDS_CTL = LDS_BYTES - 512;

#define GAS __attribute__((address_space(1)))
#define LAS __attribute__((address_space(3)))
typedef unsigned short bf16;
typedef unsigned v4u __attribute__((ext_vector_type(4)));
typedef unsigned v2u __attribute__((ext_vector_type(2)));
typedef float f32x4 __attribute__((ext_vector_type(4)));
typedef float f32x16 __attribute__((ext_vector_type(16)));
typedef short bf16x8 __attribute__((ext_vector_type(8)));
typedef short s16x4 __attribute__((ext_vector_type(4)));
typedef GAS unsigned gu32;
#define RLX_AGENT __ATOMIC_RELAXED, __HIP_MEMORY_SCOPE_AGENT
#define LDS_WAIT() asm volatile("s_waitcnt lgkmcnt(0)" ::: "memory")
typedef float f32x2_t __attribute__((ext_vector_type(2))); typedef __bf16 bf16x2_t __attribute__((ext_vector_type(2)));
__device__ __forceinline__ unsigned pk2(float lo, float hi) { f32x2_t v = {lo, hi}; bf16x2_t b = __builtin_convertvector(v, bf16x2_t); return __builtin_bit_cast(unsigned, b); }
__device__ __forceinline__ unsigned short f2bf(float f) { return (unsigned short)(pk2(f, 0.f) & 0xffffu); }
__device__ __forceinline__ float bflo(unsigned w) { return __uint_as_float(w << 16); }
__device__ __forceinline__ float bfhi(unsigned w) { return __uint_as_float(w & 0xffff0000u); }
__device__ __forceinline__ float bf2f(unsigned short h) { return __uint_as_float((unsigned)h << 16); }
__device__ __forceinline__ float sigmoidf_(float x) { return __builtin_amdgcn_rcpf(1.f + __builtin_amdgcn_exp2f(-x * LOG2E)); }
__device__ __forceinline__ int crow(int r, int hi) { return (r & 3) + 8 * (r >> 2) + 4 * hi; }
__device__ __forceinline__ int lane_now() { int l; asm volatile("v_mbcnt_lo_u32_b32 %0, -1, 0\n\tv_mbcnt_hi_u32_b32 %0, -1, %0" : "=v"(l)); return l; }
__device__ __forceinline__ float shfl_xor_l(float v, int d, int lane) { return __int_as_float(__builtin_amdgcn_ds_bpermute((lane ^ d) << 2, __float_as_int(v))); }
__device__ __forceinline__ float shfl_up_l(float v, int d, int lane) { return __int_as_float(__builtin_amdgcn_ds_bpermute(((lane - d) & 63) << 2, __float_as_int(v))); }
__device__ __forceinline__ float wave_sum(float v, int lane) {
#pragma unroll
    for (int o = 1; o < 64; o <<= 1) v += shfl_xor_l(v, o, lane);
    return v;
}

#define XB_TMO      128
#define XB_XCNT(j)  (256  + 64 * (j))
#define XB_XSUB(j)  (1280 + 64 * (j))
#define XB_XGEN(j)  (2304 + 64 * (j))
#define XB_TOP      3328
#define XB_TOPGEN   3392
#define XCD_BAR_WORDS 3456
#define XB_SPIN_CAP (1u << 18)
__device__ __forceinline__ unsigned xb_ld(unsigned* p)              { return __hip_atomic_load(p, __ATOMIC_RELAXED, __HIP_MEMORY_SCOPE_AGENT); }
__device__ __forceinline__ unsigned xb_add(unsigned* p, unsigned v) { return __hip_atomic_fetch_add(p, v, __ATOMIC_RELAXED, __HIP_MEMORY_SCOPE_AGENT); }
__device__ __forceinline__ unsigned xb_xcc_id() { return (unsigned)__builtin_amdgcn_s_getreg((3 << 11) | 20) & 0xFu; }
#define XB_SPIN(cond, bar) do { unsigned _sp = 0; while (cond) { __builtin_amdgcn_s_sleep(1); \
    if ((++_sp & 255u) == 0u) { if (xb_ld(&(bar)[XB_TMO])) break; if (_sp > XB_SPIN_CAP) { atomicAdd(&(bar)[XB_TMO], 1u); break; } } } } while (0)
struct XcdBarrier { unsigned* bar; unsigned x; volatile LAS unsigned* st; };
__device__ __forceinline__ XcdBarrier xcd_barrier_post(unsigned* bar, volatile LAS unsigned* st) {
    XcdBarrier b; b.bar = bar; b.x = xb_xcc_id(); b.st = st;
    if (threadIdx.x == 0) (void)xb_add(&bar[XB_XCNT(b.x)], 1u);
    return b;
}
__device__ __forceinline__ void xcd_barrier_complete(unsigned* bar, unsigned x, unsigned& nloc, unsigned& nx) {
    const unsigned G = gridDim.x * gridDim.y * gridDim.z;
    unsigned sum, cnt, mine, sp = 0u;
    for (;;) {
        sum = 0u; cnt = 0u; mine = 0u;
#pragma unroll
        for (unsigned j = 0; j < 16; ++j) { const unsigned c = xb_ld(&bar[XB_XCNT(j)]); sum += c; cnt += (c > 0u) ? 1u : 0u; mine = (j == x) ? c : mine; }
        if (sum == G) break;
        __builtin_amdgcn_s_sleep(1);
        if ((++sp & 255u) == 0u) { if (xb_ld(&bar[XB_TMO])) break; if (sp > XB_SPIN_CAP) { atomicAdd(&bar[XB_TMO], 1u); break; } }
    }
    nloc = mine > 0u ? mine : 1u; nx = cnt > 0u ? cnt : 1u;
}
__device__ __forceinline__ void xcd_barrier(const XcdBarrier& b) {
    asm volatile("s_waitcnt vmcnt(0)" ::: "memory");
    __syncthreads();
    if (threadIdx.x == 0) {
        unsigned* bar = b.bar;
        __builtin_amdgcn_s_waitcnt(0);
        unsigned nloc = b.st[0], nx = b.st[1];
        if (nloc == 0u) { xcd_barrier_complete(bar, b.x, nloc, nx); b.st[0] = nloc; b.st[1] = nx; }
        const unsigned old = xb_add(&bar[XB_XSUB(b.x)], 1u);
        const unsigned gen = old / nloc;
        if (old + 1u == (gen + 1u) * nloc) {
            __builtin_amdgcn_fence(__ATOMIC_RELEASE, "agent");
            asm volatile("s_waitcnt vmcnt(0)" ::: "memory");
            const unsigned og = xb_add(&bar[XB_TOP], 1u);
            const unsigned tg = og / nx;
            if (og + 1u == (tg + 1u) * nx) xb_add(&bar[XB_TOPGEN], 1u);
            else XB_SPIN(xb_ld(&bar[XB_TOPGEN]) == tg, bar);
            __builtin_amdgcn_fence(__ATOMIC_ACQUIRE, "agent");
            xb_add(&bar[XB_XGEN(b.x)], 1u);
            asm volatile("s_waitcnt vmcnt(0)" ::: "memory");
        } else {
            XB_SPIN(xb_ld(&bar[XB_XGEN(b.x)]) == gen, bar);
            __builtin_amdgcn_fence(__ATOMIC_ACQUIRE, "agent");
            asm volatile("s_waitcnt vmcnt(0)" ::: "memory");
        }
    }
    __syncthreads();
}

struct Frame {
    LAS unsigned char* lds;
    int tid, lane, wave, G, c;
    float* out; unsigned char* ws;
};
__device__ __forceinline__ unsigned char* wsp(const Frame& F, size_t off) { unsigned char* p = F.ws; asm volatile("" : "+s"(p)); return (unsigned char*)(GAS unsigned char*)(p + off); }
__device__ __forceinline__ float* outp(const Frame& F) { float* p = F.out; asm volatile("" : "+s"(p)); return (float*)(GAS float*)p; }
__device__ __forceinline__ const float* inp(const Frame& F, int i) {
    const LAS unsigned* p = (const LAS unsigned*)(F.lds + LDS_CTL + 64) + 2 * i;
    const unsigned lo = __builtin_amdgcn_readfirstlane(p[0]), hi = __builtin_amdgcn_readfirstlane(p[1]);
    return (const float*)(const GAS float*)(((unsigned long long)hi << 32) | lo);
}
enum { I_X = 0, I_C, I_ADAW, I_ADAB, I_N1W, I_WIN, I_CONVW, I_CONVB, I_IGB, I_FGB, I_MNW, I_WPA, I_WPB, I_WOUT, I_N2W, I_RW, I_RB, I_WG, I_WU, I_WD, I_SG, I_SU, I_SD, I_FNW };

#define EPI_LOOP_BEGIN \
    _Pragma("unroll") for (int ai = 0; ai < 2; ++ai) _Pragma("unroll") for (int m = 0; m < 4; ++m) { const int rl = ai * 128 + wr * 64 + m * 16 + fr; (void)rl; \
    _Pragma("unroll") for (int bj = 0; bj < 2; ++bj) { const int cl = bj * 128 + wc * 32 + 8 * fq; (void)cl; const pg8::f32x4 v0 = acc[ai][bj][m][0], v1 = acc[ai][bj][m][1];
#define EPI_LOOP_END } }

struct EpiPlain {
    static constexpr bool PERM = true;
    bf16* O; int ldc;
    __device__ __forceinline__ void operator()(const pg8::f32x4 (&acc)[2][2][4][2], const pg8::Unit& u, int wr, int wc, int fr, int fq) const {
        EPI_LOOP_BEGIN
            v4u w; w.x = pk2(v0[0], v0[1]); w.y = pk2(v0[2], v0[3]); w.z = pk2(v1[0], v1[1]); w.w = pk2(v1[2], v1[3]);
            *(GAS v4u*)(O + (size_t)(u.pm * 256 + rl) * ldc + u.pn * 256 + cl) = w;
        EPI_LOOP_END
    }
};
#define SG8(q_, v0_, v1_, o0_, o1_, OP) do { \
        o0_[0] = OP(sigmoidf_(bflo(q_.x)) * v0_[0], 0); o0_[1] = OP(sigmoidf_(bfhi(q_.x)) * v0_[1], 1); o0_[2] = OP(sigmoidf_(bflo(q_.y)) * v0_[2], 2); o0_[3] = OP(sigmoidf_(bfhi(q_.y)) * v0_[3], 3); \
        o1_[0] = OP(sigmoidf_(bflo(q_.z)) * v1_[0], 4); o1_[1] = OP(sigmoidf_(bfhi(q_.z)) * v1_[1], 5); o1_[2] = OP(sigmoidf_(bflo(q_.w)) * v1_[2], 6); o1_[3] = OP(sigmoidf_(bfhi(q_.w)) * v1_[3], 7); } while (0)
struct EpiGateT1 {
    static constexpr bool PERM = true;
    const bf16* Gt; int gld; bf16* T1;
    __device__ __forceinline__ void operator()(const pg8::f32x4 (&acc)[2][2][4][2], const pg8::Unit& u, int wr, int wc, int fr, int fq) const {
#pragma unroll
        for (int ai = 0; ai < 2; ++ai) {
            v4u gq[4][2];
#pragma unroll
            for (int m = 0; m < 4; ++m)
#pragma unroll
                for (int bj = 0; bj < 2; ++bj) { const size_t row = (size_t)(u.pm * 256 + ai * 128 + wr * 64 + m * 16 + fr); const int col = u.pn * 256 + bj * 128 + wc * 32 + 8 * fq; gq[m][bj] = *(const GAS v4u*)(Gt + row * gld + col); }
#pragma unroll
            for (int m = 0; m < 4; ++m)
#pragma unroll
                for (int bj = 0; bj < 2; ++bj) { const size_t row = (size_t)(u.pm * 256 + ai * 128 + wr * 64 + m * 16 + fr); const int col = u.pn * 256 + bj * 128 + wc * 32 + 8 * fq;
                    const pg8::f32x4 v0 = acc[ai][bj][m][0], v1 = acc[ai][bj][m][1]; f32x4 o0, o1;
#define OPN(x_, i_) (x_)
                    SG8(gq[m][bj], v0, v1, o0, o1, OPN);
#undef OPN
                    v4u tw; tw.x = pk2(o0[0], o0[1]); tw.y = pk2(o0[2], o0[3]); tw.z = pk2(o1[0], o1[1]); tw.w = pk2(o1[2], o1[3]);
                    *(GAS v4u*)(T1 + row * 1024 + col) = tw; }
        }
    }
};
struct EpiGateY {
    static constexpr bool PERM = true;
    const bf16* Gt; int gld; const bf16* T1; bf16* Y;
    __device__ __forceinline__ void operator()(const pg8::f32x4 (&acc)[2][2][4][2], const pg8::Unit& u, int wr, int wc, int fr, int fq) const {
#pragma unroll
        for (int ai = 0; ai < 2; ++ai) {
            v4u gq[4][2], tq[4][2];
#pragma unroll
            for (int m = 0; m < 4; ++m)
#pragma unroll
                for (int bj = 0; bj < 2; ++bj) { const size_t row = (size_t)(u.pm * 256 + ai * 128 + wr * 64 + m * 16 + fr); const int col = u.pn * 256 + bj * 128 + wc * 32 + 8 * fq;
                    gq[m][bj] = *(const GAS v4u*)(Gt + row * gld + col); tq[m][bj] = *(const GAS v4u*)(T1 + row * 1024 + col); }
#pragma unroll
            for (int m = 0; m < 4; ++m)
#pragma unroll
                for (int bj = 0; bj < 2; ++bj) { const size_t row = (size_t)(u.pm * 256 + ai * 128 + wr * 64 + m * 16 + fr); const int col = u.pn * 256 + bj * 128 + wc * 32 + 8 * fq;
                    const pg8::f32x4 v0 = acc[ai][bj][m][0], v1 = acc[ai][bj][m][1]; f32x4 o0, o1;
                    const v4u t4 = tq[m][bj]; const float tt[8] = {bflo(t4.x), bfhi(t4.x), bflo(t4.y), bfhi(t4.y), bflo(t4.z), bfhi(t4.z), bflo(t4.w), bfhi(t4.w)};
#define OPT(x_, i_) (tt[i_] + (x_))
                    SG8(gq[m][bj], v0, v1, o0, o1, OPT);
#undef OPT
                    v4u w; w.x = pk2(o0[0], o0[1]); w.y = pk2(o0[2], o0[3]); w.z = pk2(o1[0], o1[1]); w.w = pk2(o1[2], o1[3]);
                    *(GAS v4u*)(Y + row * 1024 + col) = w; }
        }
    }
};
#undef SG8
struct EpiRes {
    static constexpr bool PERM = true;
    const float* xin; float* out; const float* gv; int nostore;
    __device__ __forceinline__ void operator()(const pg8::f32x4 (&acc)[2][2][4][2], const pg8::Unit& u, int wr, int wc, int fr, int fq) const {
        const float* gb = gv + (size_t)(u.pm >> 4) * 6144;
        f32x4 g0[2], g1[2];
#pragma unroll
        for (int bj = 0; bj < 2; ++bj) { const int col = u.pn * 256 + bj * 128 + wc * 32 + 8 * fq; g0[bj] = *(const GAS f32x4*)(gb + col); g1[bj] = *(const GAS f32x4*)(gb + col + 4); }
#pragma unroll
        for (int ai = 0; ai < 2; ++ai)
#pragma unroll
            for (int mh = 0; mh < 2; ++mh) {
                f32x4 x0[2][2], x1[2][2];
#pragma unroll
                for (int mm = 0; mm < 2; ++mm)
#pragma unroll
                    for (int bj = 0; bj < 2; ++bj) { const size_t row = (size_t)(u.pm * 256 + ai * 128 + wr * 64 + (2 * mh + mm) * 16 + fr); const int col = u.pn * 256 + bj * 128 + wc * 32 + 8 * fq;
                        x0[mm][bj] = *(const GAS f32x4*)(xin + row * 1024 + col); x1[mm][bj] = *(const GAS f32x4*)(xin + row * 1024 + col + 4); }
#pragma unroll
                for (int mm = 0; mm < 2; ++mm)
#pragma unroll
                    for (int bj = 0; bj < 2; ++bj) { const int m = 2 * mh + mm; const size_t row = (size_t)(u.pm * 256 + ai * 128 + wr * 64 + m * 16 + fr); const int col = u.pn * 256 + bj * 128 + wc * 32 + 8 * fq;
                        const f32x4 r0 = x0[mm][bj] + g0[bj] * acc[ai][bj][m][0], r1 = x1[mm][bj] + g1[bj] * acc[ai][bj][m][1];
                        if (nostore) { asm volatile("" :: "v"(r0), "v"(r1)); } else { *(GAS f32x4*)(out + row * 1024 + col) = r0; *(GAS f32x4*)(out + row * 1024 + col + 4) = r1; } }
            }
    }
};
struct EpiHid {
    static constexpr bool PERM = true;
    bf16* O; int ldo; const LAS float* roww; int ubase; int ustride; int shared;
    __device__ __forceinline__ void operator()(const pg8::f32x4 (&acc)[2][2][4][2], const pg8::Unit& u, int wr, int wc, int fr, int fq) const {
#pragma unroll
        for (int ai = 0; ai < 2; ++ai)
#pragma unroll
            for (int m = 0; m < 4; ++m) {
                const int rl = ai * 128 + wr * 64 + m * 16 + fr; const size_t pos = (size_t)u.pm * 256 + rl;
                const float w = shared ? 1.f : roww[((u.pm - ubase) / ustride) * 256 + rl];
                const int col = (shared ? 128 * u.pn : 0) + wc * 32 + 8 * fq;
                float h[8];
#pragma unroll
                for (int n = 0; n < 2; ++n)
#pragma unroll
                    for (int j = 0; j < 4; ++j) { const float gt = acc[ai][0][m][n][j], up = acc[ai][1][m][n][j]; h[n * 4 + j] = gt * sigmoidf_(gt) * up * w; }
                v4u o; o.x = pk2(h[0], h[1]); o.y = pk2(h[2], h[3]); o.z = pk2(h[4], h[5]); o.w = pk2(h[6], h[7]);
                *(GAS v4u*)(O + pos * ldo + col) = o;
                asm volatile("" ::: "memory");
            }
    }
};
constexpr float YS_SCALE = 4.0f;
struct EpiScatter {
    static constexpr bool PERM = true;
    bf16* Y; const LAS unsigned* dst; int v; int G; int nostore;
    __device__ __forceinline__ void operator()(const pg8::f32x4 (&acc)[2][2][4][2], const pg8::Unit& u, int wr, int wc, int fr, int fq) const {
        const int q = u.pn & 3;
#pragma unroll
        for (int ai = 0; ai < 2; ++ai)
#pragma unroll
            for (int m = 0; m < 4; ++m) {
                const int rl = ai * 128 + wr * 64 + m * 16 + fr; const unsigned d = dst[((4 * u.pm + q - v) / G) * 256 + rl];
                if (nostore) { asm volatile("" :: "v"(acc[ai][0][m][0]), "v"(acc[ai][0][m][1]), "v"(acc[ai][1][m][0]), "v"(acc[ai][1][m][1])); } else if (d != 0xffffffffu) {
#pragma unroll
                    for (int bj = 0; bj < 2; ++bj) { const pg8::f32x4 v0 = acc[ai][bj][m][0] * YS_SCALE, v1 = acc[ai][bj][m][1] * YS_SCALE;
                        int w0 = 0, w1 = 0;
#define YS_CL(x_) __builtin_amdgcn_fmed3f((x_), -440.f, 440.f)
                        w0 = __builtin_amdgcn_cvt_pk_fp8_f32(YS_CL(v0[0]), YS_CL(v0[1]), w0, false); w0 = __builtin_amdgcn_cvt_pk_fp8_f32(YS_CL(v0[2]), YS_CL(v0[3]), w0, true);
                        w1 = __builtin_amdgcn_cvt_pk_fp8_f32(YS_CL(v1[0]), YS_CL(v1[1]), w1, false); w1 = __builtin_amdgcn_cvt_pk_fp8_f32(YS_CL(v1[2]), YS_CL(v1[3]), w1, true);
#undef YS_CL
                        v2u w; w.x = (unsigned)w0; w.y = (unsigned)w1;
                        *(GAS v2u*)((unsigned char*)Y + (size_t)d * 1024 + q * 256 + bj * 128 + wc * 32 + 8 * fq) = w; }
                }
            }
    }
};

struct TrDesc { const float* sp; bf16* dp; int ldw, ldt; float scale; };
__device__ __forceinline__ void tr_load(const TrDesc& d, float (&tv)[32]) {
    const GAS float* sp = (const GAS float*)d.sp;
#pragma unroll
    for (int i = 0; i < 32; ++i) tv[i] = sp[(size_t)(2 * i) * d.ldw];
}
__device__ __forceinline__ void tr_store(const TrDesc& d, const float (&tv)[32], LAS float* scr, int lane) {
#pragma unroll
    for (int i = 0; i < 32; ++i) { const int kk = 2 * i + (lane >> 5); scr[kk * 33 + (lane & 31)] = tv[i]; }
    LDS_WAIT();
    const int c = lane & 7; const float scale = d.scale;
#pragma unroll
    for (int j = 0; j < 4; ++j) { const int n = (lane >> 3) + 8 * j; const LAS float* s = scr + (8 * c) * 33 + n;
        v4u o; o.x = pk2(s[0 * 33] * scale, s[1 * 33] * scale); o.y = pk2(s[2 * 33] * scale, s[3 * 33] * scale); o.z = pk2(s[4 * 33] * scale, s[5 * 33] * scale); o.w = pk2(s[6 * 33] * scale, s[7 * 33] * scale);
        *(GAS v4u*)(d.dp + (size_t)n * d.ldt + 8 * c) = o; }
    LDS_WAIT();
}
constexpr int CW_N_IN = 8 * 512, CW_N_P = 3 * 512, CW_N_E = 4096, CW_N_S = 4 * 64, CW_N_SD = 128;
constexpr int CW_TOTAL = CW_N_IN + CW_N_P + 3 * CW_N_E + CW_N_S + CW_N_SD;
__device__ __forceinline__ TrDesc tr_decode(Frame& F, int l, int it) {
    const float* src; int ldw; bf16* dst; int ldt; int kb, nb; float sc = 1.f;
    int r = it;
    if (r < CW_N_IN) { const int job = r >> 9, rr = r & 511; kb = rr >> 5; nb = rr & 31;
        int col; bf16* BIN = (bf16*)wsp(F, WS_BIN); bf16* AIN = (bf16*)wsp(F, WS_AIN);
        switch (job) {
            case 0: col = C_MQK; dst = BIN; break;
            case 1: col = C_MO; dst = BIN + (size_t)1024 * 1024; break;
            case 2: col = C_SQ; dst = BIN + (size_t)2048 * 1024; sc = LOG2E * 0.125f; break;
            case 3: col = C_SK; dst = BIN + (size_t)3072 * 1024; break;
            case 4: col = C_GA; dst = BIN + (size_t)4096 * 1024; break;
            case 5: col = C_GB; dst = BIN + (size_t)5120 * 1024; break;
            case 6: col = C_MV; dst = AIN; break;
            default: col = C_SV; dst = AIN + (size_t)1024 * 1024; break;
        }
        src = inp(F, I_WIN) + (size_t)l * DM * INW + col; ldw = INW; ldt = 1024; }
    else if ((r -= CW_N_IN) < CW_N_P) { const int job = r >> 9, rr = r & 511; kb = rr >> 5; nb = rr & 31;
        src = inp(F, job == 0 ? I_WPA : (job == 1 ? I_WPB : I_WOUT)) + (size_t)l * DM * DM; ldw = 1024;
        dst = (bf16*)wsp(F, job == 0 ? WS_BA : (job == 1 ? WS_BB : WS_BO)); ldt = 1024; }
    else if ((r -= CW_N_P) < 2 * CW_N_E) { const int up = r >= CW_N_E; if (up) r -= CW_N_E; const int e = r >> 6, rr = r & 63; kb = rr >> 2; nb = rr & 3;
        src = inp(F, up ? I_WU : I_WG) + ((size_t)l * NEXP + e) * DM * EFF; ldw = EFF;
        dst = (bf16*)wsp(F, WS_BGU) + ((size_t)e * 256 + (up ? 128 : 0)) * 1024; ldt = 1024; }
    else if ((r -= 2 * CW_N_E) < CW_N_E) { const int e = r >> 6, rr = r & 63; kb = rr >> 5; nb = rr & 31;
        src = inp(F, I_WD) + ((size_t)l * NEXP + e) * EFF * DM; ldw = DM;
        dst = (bf16*)wsp(F, WS_BD) + (size_t)e * 1024 * 128; ldt = 128; }
    else if ((r -= CW_N_E) < CW_N_S) { const int job = r >> 6, rr = r & 63; kb = rr >> 2; nb = rr & 3;
        const int up = job >> 1, hi = job & 1;
        src = inp(F, up ? I_SU : I_SG) + (size_t)l * DM * SFF + hi * 128; ldw = SFF;
        dst = (bf16*)wsp(F, WS_BSGU) + (size_t)(hi * 256 + up * 128) * 1024; ldt = 1024; }
    else { r -= CW_N_S; kb = r >> 5; nb = r & 31;
        src = inp(F, I_SD) + (size_t)l * SFF * DM; ldw = DM; dst = (bf16*)wsp(F, WS_BSD); ldt = 256; }
    TrDesc d; const int k0 = 64 * kb, n0 = 32 * nb; const int ln = lane_now();
    d.sp = src + (size_t)(k0 + (ln >> 5)) * ldw + n0 + (ln & 31); d.dp = dst + (size_t)n0 * ldt + k0; d.ldw = ldw; d.ldt = ldt; d.scale = sc;
    return d;
}
__device__ __forceinline__ void conv_weights(Frame& F, int l) {
    LAS float* scr = (LAS float*)(F.lds + F.wave * 16384);
    int gw = F.c * 8 + F.wave; asm volatile("" : "+s"(gw)); const int NGW = F.G * 8;
    int it = gw;
    if (it >= CW_TOTAL) return;
    TrDesc dc = tr_decode(F, l, it); float tc[32]; tr_load(dc, tc);
    for (;;) {
        const int itn = it + NGW; const bool more = itn < CW_TOTAL;
        TrDesc dn = dc; float tn[32];
        if (more) { dn = tr_decode(F, l, itn); tr_load(dn, tn); }
        tr_store(dc, tc, scr, F.lane);
        if (!more) break;
        it = itn; dc = dn;
#pragma unroll
        for (int i = 0; i < 32; ++i) tc[i] = tn[i];
    }
}
__device__ __forceinline__ void mod_partials(Frame& F) {
    LAS float* sc = (LAS float*)(F.lds);
    for (int i = F.tid; i < 4096; i += 512) { const float v = inp(F, I_C)[i]; sc[i] = v / (1.f + __expf(-v)); }
    __syncthreads();
    float* MODP = (float*)wsp(F, WS_MODP);
    for (int it = F.c; it < 384; it += F.G) {
        const int l = it / 192, rem = it % 192, g = rem >> 4, kp = rem & 15, j = g * 512 + F.tid;
        const float* w = inp(F, I_ADAW) + ((size_t)l * DM + 64 * kp) * 6144 + j;
        float a0 = 0.f, a1 = 0.f, a2 = 0.f, a3 = 0.f;
#pragma unroll 16
        for (int k = 0; k < 64; ++k) { const float wv = w[(size_t)k * 6144]; const int kk = 64 * kp + k;
            a0 += sc[kk] * wv; a1 += sc[1024 + kk] * wv; a2 += sc[2048 + kk] * wv; a3 += sc[3072 + kk] * wv; }
        float* o = MODP + ((size_t)(kp * 2 + l) * 4) * 6144 + j;
        o[0] = a0; o[6144] = a1; o[2 * 6144] = a2; o[3 * 6144] = a3;
    }
    __syncthreads();
}
__device__ __forceinline__ float modv(const Frame& F, int l, int b, int j) {
    const float* MODP = (const float*)wsp(F, WS_MODP);
    float s = inp(F, I_ADAB)[l * 6144 + j];
#pragma unroll
    for (int kp = 0; kp < 16; ++kp) s += MODP[((size_t)(kp * 2 + l) * 4 + b) * 6144 + j];
    return s;
}

__device__ __forceinline__ void norm_emit(Frame& F, const float (&v)[2][8], const LAS float* cA, const LAS float* cB, const LAS float* Wg, const float gbias_lane  , bf16* xn_row, float* gate_row) {
    float ss = 0.f;
#pragma unroll
    for (int j = 0; j < 2; ++j)
#pragma unroll
        for (int i = 0; i < 8; ++i) ss += v[j][i] * v[j][i];
    ss = wave_sum(ss, F.lane);
    const float r = 1.0f / sqrtf(ss * (1.f / 1024.f) + EPS);
    float h[2][8];
#pragma unroll
    for (int j = 0; j < 2; ++j) { const int k = 8 * F.lane + 512 * j;
        const f32x4 a0 = *(const LAS f32x4*)(cA + k), a1 = *(const LAS f32x4*)(cA + k + 4), b0 = *(const LAS f32x4*)(cB + k), b1 = *(const LAS f32x4*)(cB + k + 4);
#pragma unroll
        for (int i = 0; i < 4; ++i) { h[j][i] = v[j][i] * r * a0[i] + b0[i]; h[j][4 + i] = v[j][4 + i] * r * a1[i] + b1[i]; }
        v4u o; o.x = pk2(h[j][0], h[j][1]); o.y = pk2(h[j][2], h[j][3]); o.z = pk2(h[j][4], h[j][5]); o.w = pk2(h[j][6], h[j][7]);
        *(GAS v4u*)(xn_row + k) = o; }
    float mine = 0.f;
#pragma unroll
    for (int g = 0; g < 8; ++g) { float p = 0.f;
#pragma unroll
        for (int j = 0; j < 2; ++j) { const int k = 8 * F.lane + 512 * j; const f32x4 w0 = *(const LAS f32x4*)(Wg + g * 1024 + k), w1 = *(const LAS f32x4*)(Wg + g * 1024 + k + 4);
#pragma unroll
            for (int i = 0; i < 4; ++i) { p += h[j][i] * w0[i]; p += h[j][4 + i] * w1[i]; } }
        p = wave_sum(p, F.lane);
        if (F.lane == g) mine = p; }
    if (F.lane < 8) { float z = mine + gbias_lane; if (F.lane >= 4) z = fminf(z, 0.f) - __logf(1.f + __expf(-fabsf(z))); gate_row[F.lane] = z; }
}
__device__ __forceinline__ void norm1_tables(Frame& F, int l, int b, bool from_modp) {
    LAS float* cA = (LAS float*)(F.lds + LDS_TAB); LAS float* cB = cA + 1024; LAS float* Wg = (LAS float*)(F.lds);
    const float* MODF = (const float*)wsp(F, WS_MODF) + (size_t)(l * 4 + b) * 6144;
    for (int k = F.tid; k < 1024; k += 512) {
        const float sh = from_modp ? modv(F, l, b, k) : MODF[k], sc = from_modp ? modv(F, l, b, 1024 + k) : MODF[1024 + k];
        cA[k] = inp(F, I_N1W)[l * 1024 + k] * (1.f + sc); cB[k] = sh; }
    const float* w_in = inp(F, I_WIN) + (size_t)l * DM * INW;
    for (int idx = F.tid; idx < 8192; idx += 512) { const int k = idx >> 3, g = idx & 7; Wg[g * 1024 + k] = w_in[(size_t)k * INW + C_MI + g]; }
}
__device__ __forceinline__ void phase_norm1_first(Frame& F) {
    float* MODF = (float*)wsp(F, WS_MODF);
    for (int idx = F.c * 512 + F.tid; idx < 2 * 4 * 6144; idx += F.G * 512) { const int l = idx / 24576, rem = idx % 24576, b = rem / 6144, j = rem % 6144; MODF[idx] = modv(F, l, b, j); }
    bf16* XN = (bf16*)wsp(F, WS_R2); float* GATES = (float*)wsp(F, WS_GATES);
    for (int vb = F.c; vb < 256; vb += F.G) {
        norm1_tables(F, 0, vb >> 6, true);
        __syncthreads();
        const float gbl = (F.lane < 4) ? inp(F, I_IGB)[F.lane] : (F.lane < 8 ? inp(F, I_FGB)[F.lane - 4] : 0.f);
        for (int i = 0; i < 8; ++i) {
            const int t = vb * 64 + F.wave * 8 + i; const float* xr = inp(F, I_X) + (size_t)t * 1024 + 8 * F.lane;
            float v[2][8];
#pragma unroll
            for (int j = 0; j < 2; ++j) { const f32x4 a = *(const GAS f32x4*)(xr + 512 * j), b2 = *(const GAS f32x4*)(xr + 512 * j + 4);
#pragma unroll
                for (int q = 0; q < 4; ++q) { v[j][q] = a[q]; v[j][4 + q] = b2[q]; } }
            norm_emit(F, v, (const LAS float*)(F.lds + LDS_TAB), (const LAS float*)(F.lds + LDS_TAB) + 1024, (const LAS float*)(F.lds), gbl, XN + (size_t)t * 1024, GATES + (size_t)t * 8);
        }
        __syncthreads();
    }
}

__device__ __forceinline__ void phase_conv(Frame& F, int l) {
    const bf16* P6 = (const bf16*)wsp(F, WS_P6); bf16* MQK = (bf16*)wsp(F, WS_R2);
    const int cg = F.tid & 127, tq = F.tid >> 7, ch = cg * 8;
    float w[4][8], bias[8];
#pragma unroll
    for (int j = 0; j < 4; ++j) { const float* p = inp(F, I_CONVW) + ((size_t)l * 4 + j) * 1024 + ch; const f32x4 a = *(const GAS f32x4*)p, b = *(const GAS f32x4*)(p + 4);
#pragma unroll
        for (int i = 0; i < 4; ++i) { w[j][i] = a[i]; w[j][4 + i] = b[i]; } }
    { const float* p = inp(F, I_CONVB) + (size_t)l * 1024 + ch; const f32x4 a = *(const GAS f32x4*)p, b = *(const GAS f32x4*)(p + 4);
#pragma unroll
      for (int i = 0; i < 4; ++i) { bias[i] = a[i]; bias[4 + i] = b[i]; } }
    const float osc = (ch < 512) ? 0.08838834764831845f : 1.0f;
    for (int vb = F.c; vb < 256; vb += F.G) {
        const int tbeg = vb * 64 + tq * 16;
        float u0[8], u1[8], u2[8];
#define CV_LOAD(dst, tt) do { const int t_ = (tt); if (t_ >= 0 && (t_ >> 12) == (tbeg >> 12)) { const v4u q = *(const GAS v4u*)(P6 + (size_t)t_ * P6W + ch); \
            dst[0] = bflo(q.x); dst[1] = bfhi(q.x); dst[2] = bflo(q.y); dst[3] = bfhi(q.y); dst[4] = bflo(q.z); dst[5] = bfhi(q.z); dst[6] = bflo(q.w); dst[7] = bfhi(q.w); } \
            else { _Pragma("unroll") for (int i_ = 0; i_ < 8; ++i_) dst[i_] = 0.f; } } while (0)
        CV_LOAD(u0, tbeg - 3); CV_LOAD(u1, tbeg - 2); CV_LOAD(u2, tbeg - 1);
        for (int tt = 0; tt < 16; ++tt) {
            const int t = tbeg + tt; float u3[8]; CV_LOAD(u3, t);
            float o[8];
#pragma unroll
            for (int i = 0; i < 8; ++i) { const float a = bias[i] + w[0][i] * u0[i] + w[1][i] * u1[i] + w[2][i] * u2[i] + w[3][i] * u3[i]; o[i] = a * sigmoidf_(a) * osc; }
            v4u q; q.x = pk2(o[0], o[1]); q.y = pk2(o[2], o[3]); q.z = pk2(o[4], o[5]); q.w = pk2(o[6], o[7]);
            *(GAS v4u*)(MQK + (size_t)t * 1024 + ch) = q;
#pragma unroll
            for (int i = 0; i < 8; ++i) { u0[i] = u1[i]; u1[i] = u2[i]; u2[i] = u3[i]; }
        }
#undef CV_LOAD
    }
}

constexpr float SB_EXIT = -80.0f;
constexpr int AT_NSLOT = 12, AT_SLOTB = 8192, AT_FLAGS = AT_NSLOT * AT_SLOTB;
__device__ __forceinline__ void at_dma(const void* gsrc, LAS unsigned char* ldst) { __builtin_amdgcn_global_load_lds((const GAS unsigned*)gsrc, (LAS unsigned*)ldst, 16, 0, 0); }
__device__ __forceinline__ void attn_unit(Frame& F, int b, int h, int qb, bool do_store) {
    bf16* P6 = (bf16*)wsp(F, WS_P6); const bf16* VT = (const bf16*)wsp(F, WS_VT);
    LAS unsigned char* L = F.lds;
    const int lane = F.lane, r32 = lane & 31, hh = lane >> 5, wid = F.wave;
    const int tb = b * SEQ, t0 = qb * 256 + wid * 32;
    const int D0 = 8 * qb, Dw = D0 + wid;
    const bf16* dsrc; int dtile_stride; int doff;
    if (wid < 4) { const int row = 8 * wid + (lane >> 3), pos = lane & 7; dsrc = P6 + (size_t)(tb + row) * P6W + P_SK + h * 64 + ((pos ^ (row & 7)) * 8); dtile_stride = 32 * P6W; doff = wid * 1024; }
    else { const int d = 16 * (wid - 4) + (lane >> 2), pos = lane & 3; dsrc = VT + (size_t)(1024 + h * 64 + d) * NTOK + tb + ((pos ^ ((d >> 2) & 3)) * 8); dtile_stride = 32; doff = 4096 + (wid - 4) * 1024; }
#define AT_DMA(T_) do { const int T__ = (T_); if (T__ >= 0) at_dma(dsrc + (size_t)T__ * dtile_stride, L + (T__ % AT_NSLOT) * AT_SLOTB + doff); } while (0)
    for (int T = D0 + 7; T >= D0 - 1; --T) AT_DMA(T);
    bf16x8 qf[4];
#pragma unroll
    for (int kk = 0; kk < 4; ++kk) qf[kk] = *(const GAS bf16x8*)(P6 + (size_t)(tb + t0 + r32) * P6W + P_SQ + h * 64 + 16 * kk + 8 * hh);
    f32x16 o0 = {}, o1 = {};
    float Rrun = 0.f;
    bool done = false;
    LAS unsigned* flags = (LAS unsigned*)(L + AT_FLAGS);
    asm volatile("s_waitcnt vmcnt(0)" ::: "memory");
    if (lane == 0) flags[wid] = 1u;
    __syncthreads();
    int koff[4], vlo[2][2], vhi[2][2];
#pragma unroll
    for (int kk = 0; kk < 4; ++kk) koff[kk] = r32 * 128 + (((2 * kk + hh) ^ (r32 & 7)) * 16);
#pragma unroll
    for (int dt = 0; dt < 2; ++dt)
#pragma unroll
        for (int s = 0; s < 2; ++s) { const int d = 32 * dt + r32, sw = (d >> 2) & 3; vlo[dt][s] = 4096 + d * 64 + (((2 * s) ^ sw) * 16) + 8 * hh; vhi[dt][s] = 4096 + d * 64 + (((2 * s + 1) ^ sw) * 16) + 8 * hh; }
    for (int j = 0; ; ++j) {
        const int T = Dw - j;
        const bool active = !done && T >= 0;
        AT_DMA(D0 - j - 2);
        if (active) {
            const LAS unsigned char* S = L + (T % AT_NSLOT) * AT_SLOTB;
            f32x16 p = {};
#pragma unroll
            for (int kk = 0; kk < 4; ++kk) { const bf16x8 kf = *(const LAS bf16x8*)(S + koff[kk]); p = __builtin_amdgcn_mfma_f32_32x32x16_bf16(kf, qf[kk], p, 0, 0, 0); }
            bf16x8 vf[2][2];
#pragma unroll
            for (int dt = 0; dt < 2; ++dt)
#pragma unroll
                for (int s = 0; s < 2; ++s) { const v2u lo = *(const LAS v2u*)(S + vlo[dt][s]), hi = *(const LAS v2u*)(S + vhi[dt][s]); v4u t; t.x = lo.x; t.y = lo.y; t.z = hi.x; t.w = hi.y; vf[dt][s] = __builtin_bit_cast(bf16x8, t); }
            const bool diag = (j == 0);
            float lf[16];
#pragma unroll
            for (int r = 0; r < 16; ++r) { const float z = p[r]; const float e = __builtin_amdgcn_exp2f(-fabsf(z)); const float lg = __builtin_amdgcn_logf(1.f + e);
                float v = -(fmaxf(z, 0.f) + lg); if (diag && crow(r, hh) >= r32) v = 0.f; lf[r] = v; }
            float own[4], pair[4];
#pragma unroll
            for (int g = 0; g < 4; ++g) { own[g] = (lf[4 * g] + lf[4 * g + 1]) + (lf[4 * g + 2] + lf[4 * g + 3]);
                auto rr = __builtin_amdgcn_permlane32_swap(__float_as_uint(own[g]), __float_as_uint(own[g]), false, false);
                pair[g] = __uint_as_float(rr[0]) + __uint_as_float(rr[1]); }
            float sfx[4]; sfx[3] = Rrun; sfx[2] = sfx[3] + pair[3]; sfx[1] = sfx[2] + pair[2]; sfx[0] = sfx[1] + pair[1];
            const float nh = hh ? 0.f : 1.f;
            float att[16];
#pragma unroll
            for (int g = 0; g < 4; ++g) { float run = sfx[g] + nh * (pair[g] - own[g]);
#pragma unroll
                for (int i = 3; i >= 0; --i) { const int r = 4 * g + i; run += lf[r]; float a = __builtin_amdgcn_exp2f(p[r] + run); if (diag && crow(r, hh) >= r32) a = 0.f; att[r] = a; } }
            Rrun = sfx[0] + pair[0];
            v4u pb0, pb1;
            pb0.x = pk2(att[0], att[1]); pb0.y = pk2(att[2], att[3]); pb0.z = pk2(att[4], att[5]); pb0.w = pk2(att[6], att[7]);
            pb1.x = pk2(att[8], att[9]); pb1.y = pk2(att[10], att[11]); pb1.z = pk2(att[12], att[13]); pb1.w = pk2(att[14], att[15]);
            const bf16x8 b0 = __builtin_bit_cast(bf16x8, pb0), b1 = __builtin_bit_cast(bf16x8, pb1);
            o0 = __builtin_amdgcn_mfma_f32_32x32x16_bf16(vf[0][0], b0, o0, 0, 0, 0); o0 = __builtin_amdgcn_mfma_f32_32x32x16_bf16(vf[0][1], b1, o0, 0, 0, 0);
            o1 = __builtin_amdgcn_mfma_f32_32x32x16_bf16(vf[1][0], b0, o1, 0, 0, 0); o1 = __builtin_amdgcn_mfma_f32_32x32x16_bf16(vf[1][1], b1, o1, 0, 0, 0);
            if (__all(Rrun < SB_EXIT)) done = true;
        }
        const bool more = !done && (Dw - (j + 1)) >= 0;
        if (lane == 0) flags[8 * ((j + 1) & 1) + wid] = more ? 1u : 0u;
        asm volatile("s_waitcnt vmcnt(0) lgkmcnt(0)" ::: "memory");
        __builtin_amdgcn_s_barrier();
        asm volatile("" ::: "memory");
        const LAS unsigned* fl = flags + 8 * ((j + 1) & 1);
        const unsigned any = fl[0] | fl[1] | fl[2] | fl[3] | fl[4] | fl[5] | fl[6] | fl[7];
        if (any == 0u) break;
    }
#undef AT_DMA
    if (do_store) {
        bf16* orow = P6 + (size_t)(tb + t0 + r32) * P6W + P_SQ + h * 64 + 4 * hh;
#pragma unroll
        for (int g = 0; g < 4; ++g) {
            v2u a; a.x = pk2(o0[4 * g], o0[4 * g + 1]); a.y = pk2(o0[4 * g + 2], o0[4 * g + 3]); *(GAS v2u*)(orow + 8 * g) = a;
            v2u c; c.x = pk2(o1[4 * g], o1[4 * g + 1]); c.y = pk2(o1[4 * g + 2], o1[4 * g + 3]); *(GAS v2u*)(orow + 32 + 8 * g) = c;
        }
    } else { asm volatile("" :: "v"(o0), "v"(o1)); }
    __syncthreads();
}
__device__ __forceinline__ void phase_attn(Frame& F, bool do_store) {
    const int v = (F.G % 8 == 0) ? (F.c % 8) * (F.G / 8) + F.c / 8 : F.c;
    for (int u = v; u < 1024; u += F.G) { const int bh = u >> 4, qb = u & 15; attn_unit(F, bh >> 4, bh & 15, qb, do_store); }
}

constexpr size_t MLS_U = 0, MLS_PM = 16 * 4096 * 4, MLS_BL = 2 * 16 * 4096 * 4, MLS_SUM = 3 * 16 * 4096 * 4;
__device__ __forceinline__ void phase_mlstm_scalars(Frame& F) {
    const float* GATES = (const float*)wsp(F, WS_GATES); unsigned char* R3 = wsp(F, WS_R3);
    const int lane = F.lane;
    for (int vb = F.c; vb < 256; vb += F.G) {
        if (F.wave != 0) continue;
        const int bh = vb >> 4, ch = vb & 15, b = bh >> 2, h = bh & 3, t0 = b * SEQ + 256 * ch;
        float carry_b = 0.f, carry_pm = -INFINITY;
#pragma unroll
        for (int sg = 0; sg < 4; ++sg) {
            const int tok = t0 + 64 * sg + lane;
            const float ig = *(const GAS float*)(GATES + (size_t)tok * 8 + h), lfv = *(const GAS float*)(GATES + (size_t)tok * 8 + 4 + h);
            float bc = lfv;
#pragma unroll
            for (int o = 1; o < 64; o <<= 1) { const float t = shfl_up_l(bc, o, lane); if (lane >= o) bc += t; }
            bc += carry_b;
            const float u = ig - bc;
            float pm = u;
#pragma unroll
            for (int o = 1; o < 64; o <<= 1) { const float t = shfl_up_l(pm, o, lane); if (lane >= o) pm = fmaxf(pm, t); }
            pm = fmaxf(pm, carry_pm);
            const size_t idx = (size_t)bh * 4096 + 256 * ch + 64 * sg + lane;
            *(GAS float*)(R3 + MLS_U + idx * 4) = u; *(GAS float*)(R3 + MLS_PM + idx * 4) = pm; *(GAS float*)(R3 + MLS_BL + idx * 4) = bc;
            carry_b = __int_as_float(__builtin_amdgcn_readlane(__float_as_int(bc), 63)); carry_pm = __int_as_float(__builtin_amdgcn_readlane(__float_as_int(pm), 63));
        }
        if (lane == 0) { *(GAS float*)(R3 + MLS_SUM + (size_t)(bh * 16 + ch) * 8) = carry_b; *(GAS float*)(R3 + MLS_SUM + (size_t)(bh * 16 + ch) * 8 + 4) = carry_pm; }
    }
}

constexpr int CVP_QS = 0, CVP_KS = 69632, CVP_U = 139264;
__device__ __forceinline__ void cvp_job(Frame& F, int l, int bh, int c) {
    LAS unsigned char* L = F.lds;
    const int b = bh >> 2, h = bh & 3, T0 = b * SEQ + 256 * c;
    const bf16* P6 = (const bf16*)wsp(F, WS_P6); const unsigned char* R3 = wsp(F, WS_R3);
    {
        const int cg = F.tid & 31, tr = F.tid >> 5, ch8 = 8 * cg;
        const int cq = (ch8 < 128) ? h * 128 + ch8 : 512 + h * 128 + (ch8 - 128);
        float w[4][8], bias[8];
#pragma unroll
        for (int j = 0; j < 4; ++j) { const float* p = inp(F, I_CONVW) + ((size_t)l * 4 + j) * 1024 + cq; const f32x4 a = *(const GAS f32x4*)p, bb = *(const GAS f32x4*)(p + 4);
#pragma unroll
            for (int i = 0; i < 4; ++i) { w[j][i] = a[i]; w[j][4 + i] = bb[i]; } }
        { const float* p = inp(F, I_CONVB) + (size_t)l * 1024 + cq; const f32x4 a = *(const GAS f32x4*)p, bb = *(const GAS f32x4*)(p + 4);
#pragma unroll
          for (int i = 0; i < 4; ++i) { bias[i] = a[i]; bias[4 + i] = bb[i]; } }
        const float osc = (ch8 < 128) ? 0.08838834764831845f : 1.0f;
        const int sbeg = 256 * c + 16 * tr;
        float u0[8], u1[8], u2[8];
#define CVP_LOAD(dst, ss) do { const int s_ = (ss); if (s_ >= 0) { const v4u q = *(const GAS v4u*)(P6 + (size_t)(b * SEQ + s_) * P6W + cq); \
            dst[0] = bflo(q.x); dst[1] = bfhi(q.x); dst[2] = bflo(q.y); dst[3] = bfhi(q.y); dst[4] = bflo(q.z); dst[5] = bfhi(q.z); dst[6] = bflo(q.w); dst[7] = bfhi(q.w); } \
            else { _Pragma("unroll") for (int i_ = 0; i_ < 8; ++i_) dst[i_] = 0.f; } } while (0)
        CVP_LOAD(u0, sbeg - 3); CVP_LOAD(u1, sbeg - 2); CVP_LOAD(u2, sbeg - 1);
        LAS unsigned char* tile = L + ((ch8 < 128) ? CVP_QS : CVP_KS) + ((ch8 & 127) * 2);
        for (int tt = 0; tt < 16; ++tt) {
            float u3[8]; CVP_LOAD(u3, sbeg + tt);
            float o[8];
#pragma unroll
            for (int i = 0; i < 8; ++i) { const float a = bias[i] + w[0][i] * u0[i] + w[1][i] * u1[i] + w[2][i] * u2[i] + w[3][i] * u3[i]; o[i] = a * sigmoidf_(a) * osc; }
            v4u q; q.x = pk2(o[0], o[1]); q.y = pk2(o[2], o[3]); q.z = pk2(o[4], o[5]); q.w = pk2(o[6], o[7]);
            *(LAS v4u*)(tile + (16 * tr + tt) * 272) = q;
#pragma unroll
            for (int i = 0; i < 8; ++i) { u0[i] = u1[i]; u1[i] = u2[i]; u2[i] = u3[i]; }
        }
#undef CVP_LOAD
        if (F.tid < 256) *(LAS float*)(L + CVP_U + F.tid * 4) = *(const GAS float*)(R3 + MLS_U + ((size_t)bh * 4096 + 256 * c + F.tid) * 4) * LOG2E;
    }
    __syncthreads();
    {
        const int lane = F.lane, wid = F.wave, r32 = lane & 31, hh = lane >> 5;
        const int qblk = (wid < 4) ? 7 - wid : wid - 4;
        float Mc = 0.f;
        for (int cc = 0; cc < c; ++cc) { const float a = *(const GAS float*)(R3 + MLS_SUM + (size_t)(bh * 16 + cc) * 8), pmx = *(const GAS float*)(R3 + MLS_SUM + (size_t)(bh * 16 + cc) * 8 + 4); Mc = a + fmaxf(Mc, pmx); }
        const float pmq = *(const GAS float*)(R3 + MLS_PM + ((size_t)bh * 4096 + 256 * c + 32 * qblk + r32) * 4);
        const float myMM2 = fmaxf(Mc, pmq) * LOG2E;
        bf16x8 qf[8];
#pragma unroll
        for (int kk = 0; kk < 8; ++kk) qf[kk] = *(const LAS bf16x8*)(L + CVP_QS + (32 * qblk + r32) * 272 + (16 * kk + 8 * hh) * 2);
        { unsigned char* QF = wsp(F, WS_R2) + (((size_t)(bh * 16 + c) * 8 + qblk) * 8) * 1024 + lane * 16;
#pragma unroll
          for (int kk = 0; kk < 8; ++kk) *(GAS bf16x8*)(QF + (size_t)kk * 1024) = qf[kk]; }
        unsigned char* PT = wsp(F, WS_PT) + ((size_t)(bh * 16 + c) * 36 + (qblk * (qblk + 1)) / 2) * 2048;
        const LAS float* U2 = (const LAS float*)(L + CVP_U);
        for (int kt = 0; kt <= qblk; ++kt) {
            f32x16 p = {};
#pragma unroll
            for (int kk = 0; kk < 8; ++kk) { const bf16x8 a = *(const LAS bf16x8*)(L + CVP_KS + (32 * kt + r32) * 272 + (16 * kk + 8 * hh) * 2); p = __builtin_amdgcn_mfma_f32_32x32x16_bf16(a, qf[kk], p, 0, 0, 0); }
            const bool diag = (kt == qblk);
            float pw[16];
#pragma unroll
            for (int g = 0; g < 4; ++g) { const f32x4 u2 = *(const LAS f32x4*)(U2 + 32 * kt + 8 * g + 4 * hh);
#pragma unroll
                for (int i = 0; i < 4; ++i) { const int r = 4 * g + i; float v = p[r] * __builtin_amdgcn_exp2f(u2[i] - myMM2); if (diag && (8 * g + 4 * hh + i) > r32) v = 0.f; pw[r] = v; } }
            v4u pb0, pb1;
            pb0.x = pk2(pw[0], pw[1]); pb0.y = pk2(pw[2], pw[3]); pb0.z = pk2(pw[4], pw[5]); pb0.w = pk2(pw[6], pw[7]);
            pb1.x = pk2(pw[8], pw[9]); pb1.y = pk2(pw[10], pw[11]); pb1.z = pk2(pw[12], pw[13]); pb1.w = pk2(pw[14], pw[15]);
            *(GAS v4u*)(PT + (size_t)kt * 2048 + lane * 16) = pb0; *(GAS v4u*)(PT + (size_t)kt * 2048 + 1024 + lane * 16) = pb1;
        }
        { const int dkt = wid & 3, kh = wid >> 2;
          unsigned char* KF = wsp(F, WS_R2) + 16 * MiB + (((size_t)(bh * 16 + c) * 8 + (dkt * 2 + kh)) * 8) * 1024 + lane * 16;
#pragma unroll
          for (int ks = 0; ks < 8; ++ks) { const int s0 = 128 * kh + 16 * ks + 8 * hh; bf16x8 bb;
#pragma unroll
              for (int j = 0; j < 8; ++j) bb[j] = *(const LAS short*)(L + CVP_KS + (s0 + j) * 272 + (32 * dkt + r32) * 2);
              *(GAS bf16x8*)(KF + (size_t)ks * 1024) = bb; } }
    }
    __syncthreads();
}
__device__ __forceinline__ void phase_cvp(Frame& F, int l) {
    const int v = (F.G % 8 == 0) ? (F.c % 8) * (F.G / 8) + F.c / 8 : F.c;
    for (int u = v; u < 256; u += F.G) cvp_job(F, l, u >> 4, u & 15);
}

constexpr int M2_KS = 0, M2_VT = 69632, M2_CT = 86528, M2_G = 95232, M2_U2 = 97280, M2_WC = 105472, M2_PART = 113664;
constexpr int M2_KP = 272, M2_VP = 528, M2_CP = 272;
__device__ __forceinline__ void mlstm_unit(Frame& F, int b, int h, int ds, int skip) {
    LAS unsigned char* L = F.lds;
    const int wid = F.wave;
    const int qblk = (wid < 4) ? 7 - wid : wid - 4;
    const int dkt = wid & 3, kh = wid >> 2;
#define M2_IDS() int lane_ = F.lane; asm volatile("" : "+v"(lane_)); const int lane = lane_, tid = wid * 64 + lane, r32 = lane & 31, hh = lane >> 5
    const bf16* VTg = (const bf16*)wsp(F, WS_VT);
    bf16* P6 = (bf16*)wsp(F, WS_P6);
    const int tb = b * SEQ, bh = b * 4 + h;
    { M2_IDS();
    for (int i = tid; i < 16 * 264; i += 512) { const int row = 16 + i / 264, col = i % 264; *(LAS bf16*)(L + M2_VT + row * M2_VP + col * 2) = (row == 16 && col < 256) ? (bf16)0x3F80 : (bf16)0; }
    for (int i = tid; i < 32 * 136; i += 512) *(LAS bf16*)(L + M2_CT + i * 2) = (bf16)0; }
    f32x16 st = {};
    float Mst = 0.f;
    v4u pv; float pu[4], ppm, pbl, psa, psm;
    bf16x8 qf[8];
    v4u kfr[8];
    v4u pbuf[8][2];
    const unsigned char* R3 = wsp(F, WS_R3);
#define M2_FETCH(cc) do { const int t0_ = tb + 256 * (cc); \
        { const int dvl_ = tid >> 5, seg_ = tid & 31; pv = *(const GAS v4u*)(VTg + (size_t)(h * 256 + ds * 16 + dvl_) * NTOK + t0_ + seg_ * 8); } \
        { const size_t ib_ = (size_t)bh * 4096 + 256 * (cc); \
          _Pragma("unroll") for (int i = 0; i < 4; ++i) pu[i] = *(const GAS float*)(R3 + MLS_U + (ib_ + 64 * i + lane) * 4); \
          ppm = *(const GAS float*)(R3 + MLS_PM + (ib_ + 32 * qblk + r32) * 4); pbl = *(const GAS float*)(R3 + MLS_BL + (ib_ + 32 * qblk + r32) * 4); \
          psa = *(const GAS float*)(R3 + MLS_SUM + (size_t)(bh * 16 + (cc)) * 8); psm = *(const GAS float*)(R3 + MLS_SUM + (size_t)(bh * 16 + (cc)) * 8 + 4); } } while (0)
#define M2_QFETCH(cc) do { const unsigned char* qf_ = wsp(F, WS_R2) + (((size_t)(bh * 16 + (cc)) * 8 + qblk) * 8) * 1024 + lane * 16; _Pragma("unroll") for (int kk = 0; kk < 8; ++kk) qf[kk] = *(const GAS bf16x8*)(qf_ + (size_t)kk * 1024); } while (0)
#define M2_KFETCH(cc) do { const unsigned char* kf_ = wsp(F, WS_R2) + 16 * MiB + (((size_t)(bh * 16 + (cc)) * 8 + (dkt * 2 + kh)) * 8) * 1024 + lane * 16; \
        _Pragma("unroll") for (int ks = 0; ks < 8; ++ks) kfr[ks] = *(const GAS v4u*)(kf_ + (size_t)ks * 1024); } while (0)
#define M2_PTQ(cc) (wsp(F, WS_PT) + ((size_t)(bh * 16 + (cc)) * 36 + (qblk * (qblk + 1)) / 2) * 2048 + lane * 16)
    { M2_IDS(); M2_FETCH(0); M2_QFETCH(0); M2_KFETCH(0);
      const unsigned char* pt_ = M2_PTQ(0);
#pragma unroll
      for (int kt = 0; kt < 8; ++kt) if (kt <= qblk) { pbuf[kt][0] = *(const GAS v4u*)(pt_ + (size_t)kt * 2048); pbuf[kt][1] = *(const GAS v4u*)(pt_ + (size_t)kt * 2048 + 1024); } }
    LAS float* WCw = (LAS float*)(L + M2_WC + wid * 1024);
    for (int c = 0; c < 16; ++c) {
        M2_IDS();
        const int t0 = tb + 256 * c;
        const bool more = (c + 1 < 16);
        { const int dvl_ = tid >> 5, seg_ = tid & 31; *(LAS v4u*)(L + M2_VT + dvl_ * M2_VP + seg_ * 16) = pv; }
        float cu[4]; const float cpm = ppm, cbl = pbl, csa = psa, csm = psm;
#pragma unroll
        for (int i = 0; i < 4; ++i) cu[i] = pu[i];
        if (more) M2_FETCH(c + 1);
        float myWIN, myEFLO, decay;
        {
            const float mml = fmaxf(Mst, csm);
#pragma unroll
            for (int i = 0; i < 4; ++i) WCw[64 * i + lane] = __expf(cu[i] - mml);
            const float mm = fmaxf(Mst, cpm);
            myWIN = __expf(Mst - mm); myEFLO = __expf(-(cbl + mm));
            decay = __expf(Mst - mml);
            Mst = csa + mml;
        }
        __syncthreads();
        f32x16 hT = {};
        if (!(skip & 4))
#pragma unroll
        for (int kk = 0; kk < 8; ++kk) { const bf16x8 a = *(const LAS bf16x8*)(L + M2_CT + r32 * M2_CP + (16 * kk + 8 * hh) * 2); hT = __builtin_amdgcn_mfma_f32_32x32x16_bf16(a, qf[kk], hT, 0, 0, 0); }
        if (more) M2_QFETCH(c + 1);
#pragma unroll
        for (int r = 0; r < 16; ++r) hT[r] *= myWIN;
        {
            const unsigned char* ptn = M2_PTQ(c + 1);
#pragma unroll
            for (int kt = 0; kt < 8; ++kt) if (kt <= qblk) {
#pragma unroll
                for (int s = 0; s < 2; ++s) if (!(skip & 1)) { const LAS unsigned char* vp = L + M2_VT + r32 * M2_VP + (32 * kt + 16 * s + 4 * hh) * 2;
                    const v2u lo = *(const LAS v2u*)vp, hi = *(const LAS v2u*)(vp + 16);
                    v4u t; t.x = lo.x; t.y = lo.y; t.z = hi.x; t.w = hi.y;
                    hT = __builtin_amdgcn_mfma_f32_32x32x16_bf16(__builtin_bit_cast(bf16x8, t), __builtin_bit_cast(bf16x8, pbuf[kt][s]), hT, 0, 0, 0); }
                if (more) { pbuf[kt][0] = *(const GAS v4u*)(ptn + (size_t)kt * 2048); pbuf[kt][1] = *(const GAS v4u*)(ptn + (size_t)kt * 2048 + 1024); }
            }
        }
        {
            const float dn = hT[8];
            auto rr = __builtin_amdgcn_permlane32_swap(__float_as_uint(dn), __float_as_uint(dn), false, false);
            const float den = __uint_as_float(rr[0]);
            const float inv = 1.0f / fmaxf(fabsf(den), myEFLO);
            bf16* orow = P6 + (size_t)(t0 + 32 * qblk + r32) * P6W + P_MQK + h * 256 + ds * 16 + 4 * hh;
            v2u o0, o1; o0.x = pk2(hT[0] * inv, hT[1] * inv); o0.y = pk2(hT[2] * inv, hT[3] * inv); o1.x = pk2(hT[4] * inv, hT[5] * inv); o1.y = pk2(hT[6] * inv, hT[7] * inv);
            if (!(skip & 8)) { *(GAS v2u*)orow = o0; *(GAS v2u*)(orow + 8) = o1; } else { asm volatile("" :: "v"(o0), "v"(o1)); }
        }
        f32x16 part = {};
#pragma unroll
        for (int ks = 0; ks < 8; ++ks) if (!(skip & 2)) {
            const int s0 = 128 * kh + 16 * ks + 8 * hh;
            const v4u raw = *(const LAS v4u*)(L + M2_VT + r32 * M2_VP + s0 * 2);
            const f32x4 w0 = *(const LAS f32x4*)(WCw + s0), w1 = *(const LAS f32x4*)(WCw + s0 + 4);
            v4u aw; aw.x = pk2(bflo(raw.x) * w0[0], bfhi(raw.x) * w0[1]); aw.y = pk2(bflo(raw.y) * w0[2], bfhi(raw.y) * w0[3]);
            aw.z = pk2(bflo(raw.z) * w1[0], bfhi(raw.z) * w1[1]); aw.w = pk2(bflo(raw.w) * w1[2], bfhi(raw.w) * w1[3]);
            part = __builtin_amdgcn_mfma_f32_32x32x16_bf16(__builtin_bit_cast(bf16x8, aw), __builtin_bit_cast(bf16x8, kfr[ks]), part, 0, 0, 0);
        }
        if (more) M2_KFETCH(c + 1);
        if (kh == 1) {
#pragma unroll
            for (int r = 0; r < 16; ++r) *(LAS float*)(L + M2_PART + dkt * 4096 + r * 256 + lane * 4) = part[r];
        }
        __syncthreads();
        if (kh == 0) {
#pragma unroll
            for (int r = 0; r < 16; ++r) { st[r] = st[r] * decay + part[r] + *(LAS float*)(L + M2_PART + dkt * 4096 + r * 256 + lane * 4);
                *(LAS bf16*)(L + M2_CT + crow(r, hh) * M2_CP + (32 * dkt + r32) * 2) = f2bf(st[r]); }
        }
    }
#undef M2_FETCH
#undef M2_QFETCH
#undef M2_KFETCH
#undef M2_PTQ
#undef M2_IDS
}
__device__ __forceinline__ void phase_mlstm(Frame& F, int skip) {
    const int v = (F.G % 8 == 0) ? (F.c % 8) * (F.G / 8) + F.c / 8 : F.c;
    for (int u = v; u < 256; u += F.G) { const int bh = u >> 4, ds = u & 15; mlstm_unit(F, bh >> 2, bh & 3, ds, skip); __syncthreads(); }
}

__device__ __forceinline__ void phase_hm_final(Frame& F, int l, bool do_store) {
    bf16* P6 = (bf16*)wsp(F, WS_P6);
    const float* mw = inp(F, I_MNW) + (size_t)l * 1024;
    for (int vb = F.c; vb < 256; vb += F.G) {
        for (int i = 0; i < 8; ++i) {
            const int t = vb * 64 + F.wave * 8 + i; bf16* row = P6 + (size_t)t * P6W;
#pragma unroll
            for (int j = 0; j < 4; ++j) {
                const int col = 256 * j + 4 * F.lane;
                const v2u hv = *(const GAS v2u*)(row + P_MQK + col), mo = *(const GAS v2u*)(row + P_MO + col);
                float x[4] = {bflo(hv.x), bfhi(hv.x), bflo(hv.y), bfhi(hv.y)};
                float ss = wave_sum(x[0] * x[0] + x[1] * x[1] + x[2] * x[2] + x[3] * x[3], F.lane);
                const float r = 1.0f / sqrtf(ss * (1.f / 256.f) + EPS);
                const f32x4 w = *(const GAS f32x4*)(mw + col);
                const float g[4] = {sigmoidf_(bflo(mo.x)), sigmoidf_(bfhi(mo.x)), sigmoidf_(bflo(mo.y)), sigmoidf_(bfhi(mo.y))};
                v2u o; o.x = pk2(x[0] * r * w[0] * g[0], x[1] * r * w[1] * g[1]); o.y = pk2(x[2] * r * w[2] * g[2], x[3] * r * w[3] * g[3]);
                if (do_store) *(GAS v2u*)(row + P_MQK + col) = o; else asm volatile("" :: "v"(o));
            }
        }
    }
}

#define N2_LD0(dst, k0) do { const GAS float* bq_ = bp + (size_t)(2 * (k0)) * 64; asm volatile("" : "+v"(bq_)); _Pragma("unroll") for (int q_ = 0; q_ < 32; ++q_) dst[q_] = bq_[(size_t)(2 * q_) * 64]; } while (0)
constexpr int N2_H2 = 0, N2_CA = 131328, N2_CB = N2_CA + 4096, N2_HIST = N2_CB + 4096;
__device__ __forceinline__ void phase_norm2_router(Frame& F, int l, int skip) {
    LAS unsigned char* L = F.lds;
    LAS float* H2 = (LAS float*)(L + N2_H2); LAS float* cA = (LAS float*)(L + N2_CA); LAS float* cB = (LAS float*)(L + N2_CB); LAS unsigned* hist = (LAS unsigned*)(L + N2_HIST);
    const int lane = F.lane, wid = F.wave, r32 = lane & 31, hh = lane >> 5;
    bf16* XN2 = (bf16*)wsp(F, WS_R1); int* TOPE = (int*)wsp(F, WS_TOPE); float* TOPW = (float*)wsp(F, WS_TOPW); unsigned* CNT = (unsigned*)wsp(F, WS_CNT);
    const float* Wr = inp(F, I_RW) + (size_t)l * 1024 * 64;
    const float rb = inp(F, I_RB)[l * 64 + lane];
    for (int vb = F.c; vb < 256; vb += F.G) {
        const int b = vb >> 6;
        const float* MODF = (const float*)wsp(F, WS_MODF) + (size_t)(l * 4 + b) * 6144;
        for (int k = F.tid; k < 1024; k += 512) { cA[k] = inp(F, I_N2W)[l * 1024 + k] * (1.f + MODF[4 * 1024 + k]); cB[k] = MODF[3 * 1024 + k]; }
        if (F.tid < 64) hist[F.tid] = 0u;
        const int eh = wid & 1, kq = wid >> 1;
        const GAS float* bp = (const GAS float*)(Wr + (size_t)(256 * kq + hh) * 64 + 32 * eh + r32);
        __syncthreads();
        for (int it = 0; it < 2; ++it) {
            const int T0 = vb * 64 + it * 32;
            float wA[32], wB[32];
            N2_LD0(wA, 0); N2_LD0(wB, 32);
            f32x4 xr4[4][2][2];
            if (!(skip & 4))
#pragma unroll
            for (int i = 0; i < 4; ++i) { const float* xr = outp(F) + (size_t)(T0 + wid * 4 + i) * 1024 + 8 * lane;
#pragma unroll
                for (int j = 0; j < 2; ++j) { xr4[i][j][0] = *(const GAS f32x4*)(xr + 512 * j); xr4[i][j][1] = *(const GAS f32x4*)(xr + 512 * j + 4); } }
#pragma unroll
            for (int i = 0; i < 4; ++i) if (!(skip & 4)) {
                const int tl = wid * 4 + i, t = T0 + tl;
                float v[2][8]; float ss = 0.f;
#pragma unroll
                for (int j = 0; j < 2; ++j) { const f32x4 a = xr4[i][j][0], c2 = xr4[i][j][1];
#pragma unroll
                    for (int q = 0; q < 4; ++q) { v[j][q] = a[q]; v[j][4 + q] = c2[q]; ss += a[q] * a[q] + c2[q] * c2[q]; } }
                ss = wave_sum(ss, F.lane);
                const float r = 1.0f / sqrtf(ss * (1.f / 1024.f) + EPS);
#pragma unroll
                for (int j = 0; j < 2; ++j) { const int k = 8 * lane + 512 * j; float h[8];
                    const f32x4 a0 = *(const LAS f32x4*)(cA + k), a1 = *(const LAS f32x4*)(cA + k + 4), b0 = *(const LAS f32x4*)(cB + k), b1 = *(const LAS f32x4*)(cB + k + 4);
                    LAS float* hp = H2 + tl * 1025 + k;
#pragma unroll
                    for (int q = 0; q < 4; ++q) { h[q] = v[j][q] * r * a0[q] + b0[q]; h[4 + q] = v[j][4 + q] * r * a1[q] + b1[q]; }
#pragma unroll
                    for (int q = 0; q < 8; ++q) hp[q] = h[q];
                    v4u o; o.x = pk2(h[0], h[1]); o.y = pk2(h[2], h[3]); o.z = pk2(h[4], h[5]); o.w = pk2(h[6], h[7]);
                    *(GAS v4u*)(XN2 + (size_t)t * 1024 + k) = o; }
            }
            __syncthreads();
            f32x16 acc = {};
            {
                const LAS float* ap = H2 + r32 * 1025 + 256 * kq + hh;
#define N2_LD(dst, k0) N2_LD0(dst, k0)
#define N2_MM(src, k0) do { _Pragma("unroll") for (int q_ = 0; q_ < 32; ++q_) { if ((q_ & 7) == 0) asm volatile("" ::: "memory"); acc = __builtin_amdgcn_mfma_f32_32x32x2f32(ap[2 * ((k0) + q_)], src[q_], acc, 0, 0, 0); } } while (0)
                if (!(skip & 1)) { N2_MM(wA, 0); N2_LD(wA, 64); N2_MM(wB, 32); N2_LD(wB, 96); N2_MM(wA, 64); N2_MM(wB, 96); }
            }
            __syncthreads();
            LAS float* PART = (LAS float*)(L);
#pragma unroll
            for (int r = 0; r < 16; ++r) PART[(kq * 32 + crow(r, hh)) * 64 + 32 * eh + r32] = acc[r];
            __syncthreads();
            if (!(skip & 2))
            {
                LAS float* rowb = (LAS float*)(L + 32768 + wid * 4096);
                int lane_t = F.lane; asm volatile("" : "+v"(lane_t)); const int lane = lane_t;
                const int g = lane >> 3;
                float score[4], sel[4], s2[4]; int rk[4]; bool chosen[4];
#pragma unroll
                for (int i = 0; i < 4; ++i) { const int tl = wid * 4 + i;
                    const float x = (PART[(0 * 32 + tl) * 64 + lane] + PART[(1 * 32 + tl) * 64 + lane]) + (PART[(2 * 32 + tl) * 64 + lane] + PART[(3 * 32 + tl) * 64 + lane]);
                    score[i] = 1.f / (1.f + expf(-x)); sel[i] = score[i] + rb; rowb[i * 256 + lane] = sel[i]; }
                LDS_WAIT();
#pragma unroll
                for (int i = 0; i < 4; ++i) { const LAS float* row = rowb + i * 256;
                    const f32x4 a = *(const LAS f32x4*)(row + 8 * g), c2 = *(const LAS f32x4*)(row + 8 * g + 4);
                    float m1 = fmaxf(a[0], a[1]), m2 = fminf(a[0], a[1]);
#define TK_INS(v_) do { const float v__ = (v_); m2 = fmaxf(m2, fminf(m1, v__)); m1 = fmaxf(m1, v__); } while (0)
                    TK_INS(a[2]); TK_INS(a[3]); TK_INS(c2[0]); TK_INS(c2[1]); TK_INS(c2[2]); TK_INS(c2[3]);
#undef TK_INS
                    if ((lane & 7) == 0) rowb[i * 256 + 64 + g] = m1 + m2; }
                LDS_WAIT();
#pragma unroll
                for (int i = 0; i < 4; ++i) { const LAS float* row = rowb + i * 256;
                    const f32x4 a = *(const LAS f32x4*)(row + 64), c2 = *(const LAS f32x4*)(row + 68);
                    const float gsv[8] = {a[0], a[1], a[2], a[3], c2[0], c2[1], c2[2], c2[3]};
                    float mine = 0.f;
#pragma unroll
                    for (int q = 0; q < 8; ++q) if (q == g) mine = gsv[q];
                    int gr = 0;
#pragma unroll
                    for (int q = 0; q < 8; ++q) gr += ((gsv[q] > mine) || (gsv[q] == mine && q < g)) ? 1 : 0;
                    s2[i] = (gr < 4) ? sel[i] : -INFINITY;
                    rowb[i * 256 + 72 + lane] = s2[i]; }
                LDS_WAIT();
#pragma unroll
                for (int i = 0; i < 4; ++i) { const LAS float* row = rowb + i * 256; int r_ = 0;
#pragma unroll
                    for (int q4 = 0; q4 < 16; ++q4) { const f32x4 a = *(const LAS f32x4*)(row + 72 + 4 * q4);
#pragma unroll
                        for (int e = 0; e < 4; ++e) { const int j = 4 * q4 + e; r_ += ((a[e] > s2[i]) || (a[e] == s2[i] && j < lane)) ? 1 : 0; } }
                    rk[i] = r_; chosen[i] = r_ < 8;
                    rowb[i * 256 + 136 + lane] = chosen[i] ? score[i] : 0.f; }
                LDS_WAIT();
#pragma unroll
                for (int i = 0; i < 4; ++i) { const LAS float* row = rowb + i * 256; const int t = T0 + wid * 4 + i;
                    float wsum = 0.f;
#pragma unroll
                    for (int q4 = 0; q4 < 16; ++q4) { const f32x4 a = *(const LAS f32x4*)(row + 136 + 4 * q4); wsum += (a[0] + a[1]) + (a[2] + a[3]); }
                    if (chosen[i]) { TOPE[(size_t)t * 8 + rk[i]] = lane; TOPW[(size_t)t * 8 + rk[i]] = score[i] / wsum * 2.5f; __hip_atomic_fetch_add(&hist[lane], 1u, __ATOMIC_RELAXED, __HIP_MEMORY_SCOPE_WORKGROUP); } }
                LDS_WAIT();
            }
            __syncthreads();
        }
        if (F.tid < 64) CNT[vb * 64 + F.tid] = hist[F.tid];
        __syncthreads();
    }
}

__device__ __forceinline__ void phase_scatter(Frame& F) {
    LAS unsigned* red = (LAS unsigned*)(F.lds);
    LAS unsigned* tot = red + 1024; LAS unsigned* padv = tot + 64; LAS unsigned* bef = padv + 64; LAS unsigned* base = bef + 64; LAS unsigned* selm = base + 64;
    const unsigned* CNT = (const unsigned*)wsp(F, WS_CNT); const int* TOPE = (const int*)wsp(F, WS_TOPE); const float* TOPW = (const float*)wsp(F, WS_TOPW);
    unsigned* STOK = (unsigned*)wsp(F, WS_STOK); float* SW = (float*)wsp(F, WS_SW); unsigned* SDST = (unsigned*)wsp(F, WS_SDST); int* TILEE = (int*)wsp(F, WS_TILEE);
    const int tid = F.tid;
    for (int vb = F.c; vb < 256; vb += F.G) {
        { const int e = tid & 63, part = tid >> 6; unsigned t = 0, bfv = 0;
          for (int blk = 32 * part; blk < 32 * part + 32; ++blk) { const unsigned v = CNT[blk * 64 + e]; t += v; if (blk < vb) bfv += v; }
          red[part * 64 + e] = t; red[512 + part * 64 + e] = bfv; }
        if (tid < 128) selm[tid] = 0u;
        __syncthreads();
        if (tid < 64) { unsigned T = 0, B = 0;
#pragma unroll
            for (int p = 0; p < 8; ++p) { T += red[p * 64 + tid]; B += red[512 + p * 64 + tid]; }
            tot[tid] = T; padv[tid] = (T + 255u) & ~255u; bef[tid] = B; }
        __syncthreads();
        if (tid < 64) { unsigned b = 0; for (int e = 0; e < tid; ++e) b += padv[e]; base[tid] = b; }
        const int tok = tid >> 3, slot = tid & 7, gt = vb * 64 + tok; const int e = TOPE[(size_t)gt * 8 + slot];
        __hip_atomic_fetch_or(&selm[e * 2 + (tok >> 5)], 1u << (tok & 31), __ATOMIC_RELAXED, __HIP_MEMORY_SCOPE_WORKGROUP);
        __syncthreads();
        { const unsigned lo = selm[e * 2], hi = selm[e * 2 + 1];
          const unsigned rank = (tok < 32) ? __popc(lo & ((1u << tok) - 1u)) : (__popc(lo) + __popc(hi & ((1u << (tok - 32)) - 1u)));
          const unsigned pos = base[e] + bef[e] + rank;
          STOK[pos] = (unsigned)gt; SW[pos] = TOPW[(size_t)gt * 8 + slot]; SDST[pos] = (unsigned)(gt * 8 + slot); }
        if (vb < 64) { const unsigned n = padv[vb] - tot[vb]; if ((unsigned)tid < n) { const unsigned pos = base[vb] + tot[vb] + tid; STOK[pos] = 0u; SW[pos] = 0.f; SDST[pos] = 0xffffffffu; } }
        if (vb == 0) { const int ntiles = (int)((base[63] + padv[63]) >> 8);
            for (int pm = tid; pm < ntiles; pm += 512) { int ee = 0; for (int q = 0; q < 64; ++q) if ((unsigned)(256 * pm) >= base[q] && (unsigned)(256 * pm) < base[q] + padv[q]) ee = q; TILEE[pm] = ee; }
            if (tid == 0) TILEE[1000] = ntiles; }
        __syncthreads();
    }
}

struct RoutedOrder {
    int ntiles, G, c; const LAS int* tabE; const LAS unsigned* tabTok; int wave;
    __device__ __forceinline__ bool next(int i, pg8::Unit& u) const { const int pm = i * G + c; if (pm >= ntiles) return false; u.pm = pm; u.pn = tabE[i]; return true; }
    __device__ __forceinline__ unsigned rowtok(int i, int row) const { return tabTok[i * 256 + row]; }
};
struct DownOrder {
    int nunits, G, v; const LAS int* tabE; int wave;
    __device__ __forceinline__ bool next(int i, pg8::Unit& u) const { const int L = i * G + v; if (L >= nunits) return false; u.pm = L >> 2; u.pn = tabE[i] * 4 + (L & 3); return true; }
    __device__ __forceinline__ unsigned rowtok(int, int) const { return 0u; }
};

__device__ __forceinline__ void phase_combine(Frame& F, int l, bool do_store) {
    const bf16* Y = (const bf16*)wsp(F, WS_R1); bf16* XN = (bf16*)wsp(F, WS_R2); float* GATES = (float*)wsp(F, WS_GATES);
    const bool last = (l == NLAYER - 1);
    for (int vb = F.c; vb < 256; vb += F.G) {
        const int b = vb >> 6;
        const float* g2 = (const float*)wsp(F, WS_MODF) + (size_t)(l * 4 + b) * 6144 + 5 * 1024;
        float gbl = 0.f;
        if (!last) { norm1_tables(F, l + 1, b, false); gbl = (F.lane < 4) ? inp(F, I_IGB)[(l + 1) * 4 + F.lane] : (F.lane < 8 ? inp(F, I_FGB)[(l + 1) * 4 + F.lane - 4] : 0.f); }
        __syncthreads();
        v2u yn[8][2];
        const bf16* SHO = (const bf16*)wsp(F, WS_R1 + 128 * MiB);
#define CB_LOAD(tt) do { const int t_ = (tt); \
            _Pragma("unroll") for (int s = 0; s < 8; ++s) _Pragma("unroll") for (int j = 0; j < 2; ++j) yn[s][j] = *(const GAS v2u*)((const unsigned char*)Y + ((size_t)t_ * 8 + s) * 1024 + 8 * F.lane + 512 * j); \
            } while (0)
        CB_LOAD(vb * 64 + F.wave * 8);
        for (int i = 0; i < 8; ++i) {
            const int t = vb * 64 + F.wave * 8 + i;
            v2u yc[8][2]; f32x4 xc[2][2]; v4u sc2[2];
#pragma unroll
            for (int j = 0; j < 2; ++j) sc2[j] = *(const GAS v4u*)(SHO + (size_t)t * 1024 + 8 * F.lane + 512 * j);
#pragma unroll
            for (int s = 0; s < 8; ++s) { yc[s][0] = yn[s][0]; yc[s][1] = yn[s][1]; }
#pragma unroll
            for (int j = 0; j < 2; ++j) { xc[j][0] = *(const GAS f32x4*)(outp(F) + (size_t)t * 1024 + 8 * F.lane + 512 * j); xc[j][1] = *(const GAS f32x4*)(outp(F) + (size_t)t * 1024 + 8 * F.lane + 512 * j + 4); }
            if (i + 1 < 8) CB_LOAD(t + 1);
            float acc[2][8];
#pragma unroll
            for (int j = 0; j < 2; ++j)
#pragma unroll
                for (int q = 0; q < 8; ++q) acc[j][q] = 0.f;
#pragma unroll
            for (int s = 0; s < 8; ++s)
#pragma unroll
                for (int j = 0; j < 2; ++j) { const v2u q = yc[s][j];
                    const f32x2_t a0 = __builtin_amdgcn_cvt_pk_f32_fp8((int)q.x, false), a1 = __builtin_amdgcn_cvt_pk_f32_fp8((int)q.x, true), a2 = __builtin_amdgcn_cvt_pk_f32_fp8((int)q.y, false), a3 = __builtin_amdgcn_cvt_pk_f32_fp8((int)q.y, true);
                    acc[j][0] += a0.x; acc[j][1] += a0.y; acc[j][2] += a1.x; acc[j][3] += a1.y; acc[j][4] += a2.x; acc[j][5] += a2.y; acc[j][6] += a3.x; acc[j][7] += a3.y; }
            float v[2][8]; float* xr = outp(F) + (size_t)t * 1024 + 8 * F.lane;
#pragma unroll
            for (int j = 0; j < 2; ++j) { const f32x4 a = xc[j][0], c2 = xc[j][1];
                const f32x4 ga = *(const GAS f32x4*)(g2 + 8 * F.lane + 512 * j), gc = *(const GAS f32x4*)(g2 + 8 * F.lane + 512 * j + 4);
                const float sh[8] = {bflo(sc2[j].x), bfhi(sc2[j].x), bflo(sc2[j].y), bfhi(sc2[j].y), bflo(sc2[j].z), bfhi(sc2[j].z), bflo(sc2[j].w), bfhi(sc2[j].w)};
#pragma unroll
                for (int q = 0; q < 4; ++q) { v[j][q] = a[q] + ga[q] * (acc[j][q] * (1.f / YS_SCALE) + sh[q]); v[j][4 + q] = c2[q] + gc[q] * (acc[j][4 + q] * (1.f / YS_SCALE) + sh[4 + q]); } }
            if (last) {
                float ss = 0.f;
#pragma unroll
                for (int j = 0; j < 2; ++j)
#pragma unroll
                    for (int q = 0; q < 8; ++q) ss += v[j][q] * v[j][q];
                ss = wave_sum(ss, F.lane);
                const float r = 1.0f / sqrtf(ss * (1.f / 1024.f) + EPS);
#pragma unroll
                for (int j = 0; j < 2; ++j) { const float* fw = inp(F, I_FNW) + 8 * F.lane + 512 * j; const f32x4 w0 = *(const GAS f32x4*)fw, w1 = *(const GAS f32x4*)(fw + 4);
                    f32x4 o0, o1;
#pragma unroll
                    for (int q = 0; q < 4; ++q) { o0[q] = v[j][q] * r * w0[q]; o1[q] = v[j][4 + q] * r * w1[q]; }
                    if (do_store) { *(GAS f32x4*)(xr + 512 * j) = o0; *(GAS f32x4*)(xr + 512 * j + 4) = o1; } else asm volatile("" :: "v"(o0), "v"(o1)); }
            } else {
#pragma unroll
                for (int j = 0; j < 2; ++j) { f32x4 o0, o1;
#pragma unroll
                    for (int q = 0; q < 4; ++q) { o0[q] = v[j][q]; o1[q] = v[j][4 + q]; }
                    if (do_store) { *(GAS f32x4*)(xr + 512 * j) = o0; *(GAS f32x4*)(xr + 512 * j + 4) = o1; } else asm volatile("" :: "v"(o0), "v"(o1)); }
                if (do_store) norm_emit(F, v, (const LAS float*)(F.lds + LDS_TAB), (const LAS float*)(F.lds + LDS_TAB) + 1024, (const LAS float*)(F.lds), gbl, XN + (size_t)t * 1024, GATES + (size_t)t * 8);
            }
        }
#undef CB_LOAD
        __syncthreads();
    }
}

__device__ __forceinline__ void dbg_final(Frame& F, const float* src) {
    for (int vb = F.c; vb < 256; vb += F.G)
        for (int i = 0; i < 8; ++i) {
            const int t = vb * 64 + F.wave * 8 + i; const float* xr = src + (size_t)t * 1024 + 8 * F.lane; float* orow = outp(F) + (size_t)t * 1024 + 8 * F.lane;
            float v[2][8]; float ss = 0.f;
#pragma unroll
            for (int j = 0; j < 2; ++j) { const f32x4 a = *(const GAS f32x4*)(xr + 512 * j), c2 = *(const GAS f32x4*)(xr + 512 * j + 4);
#pragma unroll
                for (int q = 0; q < 4; ++q) { v[j][q] = a[q]; v[j][4 + q] = c2[q]; ss += a[q] * a[q] + c2[q] * c2[q]; } }
            ss = wave_sum(ss, F.lane);
            const float r = 1.0f / sqrtf(ss * (1.f / 1024.f) + EPS);
#pragma unroll
            for (int j = 0; j < 2; ++j) { const float* fw = inp(F, I_FNW) + 8 * F.lane + 512 * j; const f32x4 w0 = *(const GAS f32x4*)fw, w1 = *(const GAS f32x4*)(fw + 4);
                f32x4 o0, o1;
#pragma unroll
                for (int q = 0; q < 4; ++q) { o0[q] = v[j][q] * r * w0[q]; o1[q] = v[j][4 + q] * r * w1[q]; }
                *(GAS f32x4*)(orow + 512 * j) = o0; *(GAS f32x4*)(orow + 512 * j + 4) = o1; }
        }
}
struct Args { const float* in[24]; float* out; unsigned char* ws; };
#ifndef MK_EN_MASK
#define MK_EN_MASK 0xffffffffu
#endif
#define EN(k) (((MK_EN_MASK) >> (k)) & 1u)
#ifndef RP_G1
#define RP_G1 1
#endif
#ifndef RP_ATT
#define RP_ATT 1
#endif
#ifndef RP_ML
#define RP_ML 1
#endif
#ifndef RP_N2
#define RP_N2 1
#endif
#ifndef RP_CW
#define RP_CW 1
#endif
#ifndef RP_C
#define RP_C 1
#endif
#ifndef RP_D
#define RP_D 1
#endif
#ifndef RP_CV
#define RP_CV 1
#endif
#ifndef RP_PB
#define RP_PB 1
#endif
#ifndef RP_VT
#define RP_VT 1
#endif
#ifndef RP_PA
#define RP_PA 1
#endif
#ifndef RP_SC
#define RP_SC 1
#endif
#ifndef RP_SG
#define RP_SG 1
#endif
#ifndef ML_SKIP
#define ML_SKIP 0
#endif
#ifndef RP_X5
#define RP_X5 1
#endif
#ifndef RP_E
#define RP_E 1
#endif
#ifndef RP_HM
#define RP_HM 1
#endif
#ifndef RP_P1
#define RP_P1 1
#endif
#ifndef RP_SD
#define RP_SD 1
#endif
#ifndef N2_SKIP
#define N2_SKIP 0
#endif
#ifndef MK_LAST_PHASE
#define MK_LAST_PHASE 1000
#endif
__global__ void __launch_bounds__(512, 2) mk_fwd(Args args) {
    extern __shared__ __attribute__((aligned(16))) unsigned char lds_raw[];
    Frame F;
    F.lds = (LAS unsigned char*)lds_raw;
    const int wave0 = __builtin_amdgcn_readfirstlane((int)threadIdx.x >> 6);
#define RELOAD_IDS() do { int l_ = lane_now(); F.lane = l_; F.wave = wave0; F.tid = wave0 * 64 + l_; } while (0)
    RELOAD_IDS();
    F.G = gridDim.x; F.c = blockIdx.x;
    F.out = args.out; F.ws = args.ws;
    if (F.tid < 16) ((LAS unsigned*)(F.lds + LDS_CTL))[F.tid] = 0u;
#pragma unroll
    for (int i = 0; i < 24; ++i) if (F.tid == 64 + i) *(LAS unsigned long long*)(F.lds + LDS_CTL + 64 + 8 * i) = (unsigned long long)args.in[i];
    __syncthreads();
    XcdBarrier bar = xcd_barrier_post((unsigned*)wsp(F, WS_CTL) + CW_BAR, (volatile LAS unsigned*)(F.lds + LDS_CTL));
#define P6 ((bf16*)wsp(F, WS_P6))
#define VT ((bf16*)wsp(F, WS_VT))
#define R2 ((bf16*)wsp(F, WS_R2))
#define MODF ((const float*)wsp(F, WS_MODF))
#define GRID_BAR() do { XcdBarrier b_ = bar; asm volatile("" : "+s"(b_.bar), "+s"(b_.x)); xcd_barrier(b_); } while (0)
    int phase_no = 0;
#ifndef RP_BAR
#define RP_BAR 1
#endif
#define PHASE_END() do { for (int rb_ = 0; rb_ < RP_BAR; ++rb_) GRID_BAR(); RELOAD_IDS(); if (++phase_no >= MK_LAST_PHASE) goto finish; } while (0)

    if (EN(0)) { mod_partials(F);
    for (int rp = 0; rp < RP_CW; ++rp) { RELOAD_IDS(); conv_weights(F, 0); } }
    PHASE_END();
    for (int rp = 0; rp < RP_P1; ++rp) if (EN(1)) phase_norm1_first(F);
    PHASE_END();

#pragma unroll
    for (int l = 0; l < NLAYER; ++l) {
        if (EN(2)) { phase_mlstm_scalars(F); RELOAD_IDS(); }
        for (int rp = 0; rp < RP_G1; ++rp) if (EN(2)) {
            pg8::Gemm g{R2, (const bf16*)wsp(F, WS_BIN), 1024, 1024}; pg8::StaticOrder S; S.init(NTOK, P6W, F.G, F.c, F.wave);
            EpiPlain E{P6, P6W};
            pg8::gemm_phase<EpiPlain, pg8::StaticOrder, true, false>(F.lds, g, S, E);
        }
        for (int rp = 0; rp < RP_VT; ++rp) if (EN(3)) {
            pg8::Gemm g{(const bf16*)wsp(F, WS_AIN), R2, 1024, 1024}; pg8::StaticOrder S; S.init(2048, NTOK, F.G, F.c, F.wave);
            EpiPlain E{VT, NTOK};
            pg8::gemm_phase<EpiPlain, pg8::StaticOrder, true, false>(F.lds, g, S, E);
        }
        PHASE_END();
        for (int pass = 0; pass < 2; ++pass) {
            if (((pass ^ F.c) & 1) == 0) { for (int rp = 0; rp < RP_CV; ++rp) if (EN(4)) phase_cvp(F, l); }
            else { for (int rp = 1; rp < RP_ATT; ++rp) phase_attn(F, false); if (EN(5)) phase_attn(F, true); }
            RELOAD_IDS();
        }
        PHASE_END();
        for (int rp = 0; rp < RP_ML; ++rp) if (EN(6)) phase_mlstm(F, (RP_ML > 1 && rp == 0) ? ML_SKIP : 0);
        PHASE_END();
        for (int pass = 0; pass < 2; ++pass) {
            if (((pass ^ F.c) & 1) == 0) { for (int rp = 1; rp < RP_HM; ++rp) phase_hm_final(F, l, false); if (EN(7)) phase_hm_final(F, l, true); }
            else {
        for (int rp = 0; rp < RP_PB; ++rp) if (EN(8)) {
            pg8::Gemm g{P6 + P_SQ, (const bf16*)wsp(F, WS_BB), 1024, P6W}; pg8::StaticOrder S; S.init(NTOK, 1024, F.G, F.c, F.wave);
            EpiGateT1 E{P6 + P_GB, P6W, (bf16*)wsp(F, WS_VT)};
            pg8::gemm_phase<EpiGateT1, pg8::StaticOrder, true, false>(F.lds, g, S, E);
        }
            }
            RELOAD_IDS();
        }
        PHASE_END();
        for (int rp = 0; rp < RP_PA; ++rp) if (EN(9)) {
            pg8::Gemm g{P6 + P_MQK, (const bf16*)wsp(F, WS_BA), 1024, P6W}; pg8::StaticOrder S; S.init(NTOK, 1024, F.G, F.c, F.wave);
            EpiGateY E{P6 + P_GA, P6W, (const bf16*)wsp(F, WS_VT), R2};
            pg8::gemm_phase<EpiGateY, pg8::StaticOrder, true, false>(F.lds, g, S, E);
        }
        PHASE_END();
        for (int rp = 0; rp < RP_X5; ++rp) if (EN(10)) {
            pg8::Gemm g{R2, (const bf16*)wsp(F, WS_BO), 1024, 1024}; pg8::StaticOrder S; S.init(NTOK, 1024, F.G, F.c, F.wave);
            EpiRes E{l == 0 ? inp(F, I_X) : outp(F), outp(F), MODF + (size_t)(l * 4) * 6144 + 2 * 1024, (RP_X5 > 1 && rp + 1 < RP_X5) ? 1 : 0};
            pg8::gemm_phase<EpiRes, pg8::StaticOrder, true, false>(F.lds, g, S, E);
        }
        PHASE_END();
        for (int rp = 0; rp < RP_N2; ++rp) if (EN(11)) phase_norm2_router(F, l, (RP_N2 > 1 && rp == 0) ? N2_SKIP : 0);
        PHASE_END();
        for (int rp = 0; rp < RP_SC; ++rp) if (EN(12)) phase_scatter(F);
        PHASE_END();
        {
            const int* TILEE = (const int*)wsp(F, WS_TILEE); const unsigned* STOK = (const unsigned*)wsp(F, WS_STOK);
            const int ntiles = TILEE[1000];
            LAS int* tabE = (LAS int*)(F.lds + LDS_TAB); LAS unsigned* tabTok = (LAS unsigned*)(F.lds + LDS_TAB + 64);
            LAS float* tabW = (LAS float*)(F.lds + LDS_TAB + 64 + 3072); const float* SWp = (const float*)wsp(F, WS_SW);
            for (int i = 0; i < 3; ++i) { const int pm = i * F.G + F.c; if (pm < ntiles) { if (F.tid == 0) tabE[i] = TILEE[pm]; if (F.tid < 256) { tabTok[i * 256 + F.tid] = STOK[(size_t)pm * 256 + F.tid]; tabW[i * 256 + F.tid] = SWp[(size_t)pm * 256 + F.tid]; } } }
            __syncthreads();
            for (int rp = 0; rp < RP_C; ++rp) if (EN(13)) {
                pg8::Gemm g{(const bf16*)wsp(F, WS_R1), (const bf16*)wsp(F, WS_BGU), 1024, 1024}; RoutedOrder S{ntiles, F.G, F.c, tabE, tabTok, F.wave};
                EpiHid E{R2, 128, tabW, F.c, F.G, 0};
                pg8::gemm_phase<EpiHid, RoutedOrder, true, true>(F.lds, g, S, E);
            }
            for (int rp = 0; rp < RP_SG; ++rp) if (EN(14)) {
                pg8::Gemm g{(const bf16*)wsp(F, WS_R1), (const bf16*)wsp(F, WS_BSGU), 1024, 1024}; pg8::StaticOrder S; S.init(NTOK, 512, F.G, F.G - 1 - F.c, F.wave);
                EpiHid E{(bf16*)wsp(F, WS_R3), 256, nullptr, 0, 1, 1};
                pg8::gemm_phase<EpiHid, pg8::StaticOrder, true, false>(F.lds, g, S, E);
            }
        }
        PHASE_END();
        {
            const int* TILEE = (const int*)wsp(F, WS_TILEE);
            const int ntiles = TILEE[1000], nunits = 4 * ntiles;
            const int v = (F.G % 8 == 0) ? (F.c % 8) * (F.G / 8) + F.c / 8 : F.c;
            LAS int* tabE = (LAS int*)(F.lds + LDS_TAB);
            if (F.tid < 16) { const int L = F.tid * F.G + v; tabE[F.tid] = (L < nunits) ? TILEE[L >> 2] : 0; }
            LAS unsigned* tabD = (LAS unsigned*)(F.lds + LDS_TAB + 64); const unsigned* SDp = (const unsigned*)wsp(F, WS_SDST);
            for (int i = 0; i < 10; ++i) { const int L = i * F.G + v; if (L < nunits && F.tid < 256) tabD[i * 256 + F.tid] = SDp[(size_t)(L >> 2) * 256 + F.tid]; }
            __syncthreads();
            for (int rp = 0; rp < RP_D; ++rp) if (EN(15)) {
                pg8::Gemm g{R2, (const bf16*)wsp(F, WS_BD), 128, 128}; DownOrder S{nunits, F.G, v, tabE, F.wave};
                EpiScatter E{(bf16*)wsp(F, WS_R1), tabD, v, F.G, (RP_D > 1 && rp > 0) ? 1 : 0};
                pg8::gemm_phase<EpiScatter, DownOrder, true, false>(F.lds, g, S, E);
            }
            for (int rp = 0; rp < RP_SD; ++rp) if (EN(16)) {
                pg8::Gemm g{(const bf16*)wsp(F, WS_R3), (const bf16*)wsp(F, WS_BSD), 256, 256}; pg8::StaticOrder S; S.init(NTOK, 1024, F.G, F.c, F.wave);
                EpiPlain E{(bf16*)wsp(F, WS_R1 + 128 * MiB), 1024};
                pg8::gemm_phase<EpiPlain, pg8::StaticOrder, true, false>(F.lds, g, S, E);
            }
        }
        PHASE_END();
        for (int rp = 1; rp < RP_E; ++rp) phase_combine(F, l, false);
        if (EN(17)) phase_combine(F, l, true);
        if (l + 1 < NLAYER) { RELOAD_IDS(); if (EN(18)) conv_weights(F, l + 1); PHASE_END(); }
    }
#undef P6
#undef VT
#undef R2
#undef MODF
finish:
    if (MK_LAST_PHASE < 1000) dbg_final(F, phase_no >= 8 ? (const float*)outp(F) : inp(F, I_X));
}

extern "C" void kernel_launch(void* const* d_in, const int* in_sizes, int n_in, void* d_out, int out_size, void* d_ws, size_t ws_size, hipStream_t stream) {
    static int grid = 0;
    if (grid == 0) {
        if (n_in != 24 || in_sizes[0] != NTOK * DM || out_size != NTOK * DM || ws_size < WS_END) {
            fprintf(stderr, "kernel_launch: unexpected shapes (n_in %d, in0 %d, out %d, ws %zu < %zu); nothing launched\n", n_in, n_in > 0 ? in_sizes[0] : -1, out_size, ws_size, (size_t)WS_END); grid = -1; return; }
        int dev = 0, cus = 0, per_cu = 0;
        if (hipGetDevice(&dev) != hipSuccess || hipDeviceGetAttribute(&cus, hipDeviceAttributeMultiprocessorCount, dev) != hipSuccess) { grid = -1; return; }
        if (hipFuncSetAttribute((const void*)mk_fwd, hipFuncAttributeMaxDynamicSharedMemorySize, LDS_BYTES) != hipSuccess) { fprintf(stderr, "kernel_launch: hipFuncSetAttribute failed\n"); grid = -1; return; }
        if (hipOccupancyMaxActiveBlocksPerMultiprocessor(&per_cu, (const void*)mk_fwd, 512, LDS_BYTES) != hipSuccess || per_cu < 1)
            fprintf(stderr, "kernel_launch: note: occupancy query reports %d workgroups per CU\n", per_cu);
        (void)hipGetLastError();
        grid = cus;
    }
    if (grid < 0) return;
    if (hipMemsetAsync((char*)d_ws + WS_CTL, 0, CTL_ZERO_BYTES, stream) != hipSuccess) return;
    Args a{};
    for (int i = 0; i < 24; ++i) a.in[i] = (const float*)d_in[i];
    a.out = (float*)d_out; a.ws = (unsigned char*)d_ws;
    hipLaunchKernelGGL(mk_fwd, dim3(grid), dim3(512), LDS_BYTES, stream, a);
}
```

```cpp
#include <hip/hip_runtime.h>
#include <cstdio>
#include <cstdint>
#include <cmath>
namespace pg8 {
#define PG8_LAS __attribute__((address_space(3)))
typedef unsigned short bf16_t;
typedef short bf16x8 __attribute__((ext_vector_type(8)));
typedef float f32x4 __attribute__((ext_vector_type(4)));
typedef unsigned u32x4 __attribute__((ext_vector_type(4)));
constexpr int BM = 256, BK = 64, HALF = 128, HTB = HALF * BK * 2  , STAGE_BYTES = 8 * HTB, NXCD = 8, WGM = 8;

__host__ __device__ __forceinline__ int lds_byte(int r, int c) { const int st = (r >> 4) * 2 + (c >> 5), rr = r & 15, cc = c & 31, ob = rr * 64 + cc * 2; return st * 1024 + (ob ^ (((ob >> 9) & 1) << 5)); }
__host__ __device__ __forceinline__ void stage_rc(int b, int& R, int& C) { const int st = b / 1024, sb = b % 1024, swz = sb ^ (((sb >> 9) & 1) << 5); R = (st >> 1) * 16 + swz / 64; C = (st & 1) * 32 + (swz % 64) / 2; }
__host__ __device__ __forceinline__ int perm32(int rho) { const int n = rho >> 4, i = rho & 15; return 8 * (i >> 2) + 4 * n + (i & 3); }

struct Unit { int pm, pn; };
struct Gemm { const bf16_t* A; const bf16_t* Bt; int K; int lda; };

struct StaticOrder {
    int nM, nN, nwg, G, c, wave;
    __device__ void init(int M, int N, int G_, int c_, int wave_) { nM = M / BM; nN = N / BM; nwg = nM * nN; G = G_; c = c_; wave = wave_; }
    __device__ bool next(int i, Unit& u) const {
        const long L = (long)i * G + c; if (L >= nwg) return false;
        int wgid = (int)L; { const int q = nwg / NXCD, r = nwg % NXCD, xcd = wgid % NXCD, off = wgid / NXCD; wgid = (xcd < r ? xcd * (q + 1) : r * (q + 1) + (xcd - r) * q) + off; }
        const int nig = WGM * nN, gid = wgid / nig, fm = gid * WGM, gsz = (nM - fm) < WGM ? (nM - fm) : WGM;
        u.pm = fm + ((wgid % nig) % gsz); u.pn = (wgid % nig) / gsz; return true;
    }
    __device__ __forceinline__ unsigned rowtok(int, int) const { return 0u; }
};

template <class Epi, class Sched, bool ALIGN_EPI, bool GATHER>
__device__ __forceinline__ void gemm_phase(PG8_LAS unsigned char* lds, const Gemm g, const Sched& S, const Epi& E) {
    int lane_; asm volatile("v_mbcnt_lo_u32_b32 %0, -1, 0\n\tv_mbcnt_hi_u32_b32 %0, -1, %0" : "=v"(lane_));
    const int wid = S.wave, lane = lane_, tid = wid * 64 + lane, wr = wid >> 2, wc = wid & 3, fr = lane & 15, fq = lane >> 4;
    int K_ = g.K, lda_ = g.lda; asm volatile("" : "+s"(K_), "+s"(lda_));
    const int K = K_, nt = K / BK, lda = lda_;
    unsigned vA[2][2], voffB[2];
#pragma unroll
    for (int i = 0; i < 2; ++i) { int R, C; stage_rc(tid * 16 + i * 8192, R, C); const int Rb = Epi::PERM ? ((R & ~31) + perm32(R & 31)) : R;
        voffB[i] = (unsigned)(Rb * K + C) * 2u;
#pragma unroll
        for (int h = 0; h < 2; ++h) vA[h][i] = (unsigned)(((GATHER ? h * HALF : 0) + R) * lda + C) * 2u; }
    const size_t kstep = (size_t)(BK * 2);
    const size_t hstepB = (size_t)HALF * K * 2, tstepB = 2 * hstepB;
    const size_t tstepA = (size_t)BM * lda * 2, hstepA = (size_t)HALF * lda * 2;
    const unsigned ldsw = (unsigned)wid * 1024u;
    const int aoff = lds_byte(wr * 64 + fr, fq * 8), boff = lds_byte(wc * 32 + fr, fq * 8);
#define PG8_SA(b, h) (((b) * 2 + (h)) * HTB)
#define PG8_SB(b, h) ((4 + (b) * 2 + (h)) * HTB)
#define PG8_STAGE(bufoff, gbase, voff) do { _Pragma("unroll") for (int _i = 0; _i < 2; ++_i) \
        __builtin_amdgcn_global_load_lds((const unsigned*)((const char*)(gbase) + (voff)[_i]), (PG8_LAS unsigned*)(lds + (bufoff) + ldsw + _i * 8192), 16, 0, 0); } while (0)
#define PG8_GATHER_SET(ui_, h) do { int l2_; asm volatile("v_mbcnt_lo_u32_b32 %0, -1, 0\n\tv_mbcnt_hi_u32_b32 %0, -1, %0" : "=v"(l2_)); const int tid2_ = wid * 64 + l2_; _Pragma("unroll") for (int _i = 0; _i < 2; ++_i) { int R_, C_; stage_rc(tid2_ * 16 + _i * 8192, R_, C_); vA[h][_i] = (S.rowtok((ui_), (h) * HALF + R_) * (unsigned)lda + (unsigned)C_) * 2u; } } while (0)
#define PG8_STAGE_A(bufoff, gbase, h, NX) do { _Pragma("unroll") for (int _i = 0; _i < 2; ++_i) { const unsigned _v = GATHER ? vA[h][_i] : vA[0][_i]; \
        __builtin_amdgcn_global_load_lds((const unsigned*)((const char*)(gbase) + (GATHER ? (size_t)0 : (size_t)(h) * hstepA) + _v), (PG8_LAS unsigned*)(lds + (bufoff) + ldsw + _i * 8192), 16, 0, 0); } } while (0)
#define PG8_LDA(dst, b, h) do { _Pragma("unroll") for (int m = 0; m < 4; ++m) _Pragma("unroll") for (int k = 0; k < 2; ++k) dst[m][k] = *(const PG8_LAS bf16x8*)(lds + PG8_SA(b, h) + aoff + m * 2048 + k * 1024); } while (0)
#define PG8_LDB(dst, b, h) do { _Pragma("unroll") for (int n = 0; n < 2; ++n) _Pragma("unroll") for (int k = 0; k < 2; ++k) dst[n][k] = *(const PG8_LAS bf16x8*)(lds + PG8_SB(b, h) + boff + n * 2048 + k * 1024); } while (0)
#define PG8_MMA(ai, bj, At, Bt) do { __builtin_amdgcn_s_setprio(1); _Pragma("unroll") for (int m = 0; m < 4; ++m) _Pragma("unroll") for (int n = 0; n < 2; ++n) _Pragma("unroll") for (int k = 0; k < 2; ++k) \
        acc[ai][bj][m][n] = __builtin_amdgcn_mfma_f32_16x16x32_bf16(Bt[n][k], At[m][k], acc[ai][bj][m][n], 0, 0, 0); __builtin_amdgcn_s_setprio(0); } while (0)
#define PG8_WAIT_V(n) asm volatile("s_waitcnt vmcnt(" #n ")" ::: "memory")
#define PG8_WAIT_L(n) asm volatile("s_waitcnt lgkmcnt(" #n ")" ::: "memory")
#define PG8_BAR __builtin_amdgcn_s_barrier()
#define PG8_SCHED __builtin_amdgcn_sched_barrier(0)
    Unit cur, nxt; int ui = 0;
    if (!S.next(0, cur)) return;
    if constexpr (GATHER) { PG8_GATHER_SET(0, 0); PG8_GATHER_SET(0, 1); }
    f32x4 acc[2][2][4][2];
#pragma unroll
    for (int a = 0; a < 2; ++a)
#pragma unroll
        for (int b = 0; b < 2; ++b)
#pragma unroll
            for (int m = 0; m < 4; ++m)
#pragma unroll
                for (int n = 0; n < 2; ++n) acc[a][b][m][n] = (f32x4){0.f, 0.f, 0.f, 0.f};
    bf16x8 At[4][2], B0[2][2], B1[2][2];
    const char* cA = (const char*)g.A + (GATHER ? (size_t)0 : (size_t)cur.pm * tstepA); const char* cB = (const char*)g.Bt + (size_t)cur.pn * tstepB;
    PG8_STAGE(PG8_SB(0, 0), cB, voffB); PG8_STAGE(PG8_SB(0, 1), cB + hstepB, voffB); PG8_STAGE_A(PG8_SA(0, 0), cA, 0, false); PG8_STAGE_A(PG8_SA(0, 1), cA, 1, false);
    if (wr == 1) PG8_BAR;
    PG8_WAIT_V(2); PG8_BAR;
    PG8_STAGE(PG8_SB(1, 0), cB + kstep, voffB); PG8_STAGE_A(PG8_SA(1, 0), cA + kstep, 0, false); PG8_STAGE(PG8_SB(1, 1), cB + hstepB + kstep, voffB);
    PG8_WAIT_V(6); PG8_BAR;
    for (;;) {
        const bool has_next = S.next(ui + 1, nxt);
        const char* nA = (has_next && !GATHER) ? (const char*)g.A + (size_t)nxt.pm * tstepA : (GATHER ? (const char*)g.A : cA);
        const char* nB = has_next ? (const char*)g.Bt + (size_t)nxt.pn * tstepB : cB;
        for (int t = 0; t < nt; t += 2) {
            const bool last = (t == nt - 2);
            const char* a1 = cA + (size_t)(t + 1) * kstep;
            const char* a2 = last ? nA : cA + (size_t)(t + 2) * kstep; const char* b2 = last ? nB : cB + (size_t)(t + 2) * kstep;
            const char* a3 = a2 + kstep; const char* b3 = b2 + kstep;
            if constexpr (GATHER) { if (last && has_next) PG8_GATHER_SET(ui + 1, 0); }
            PG8_LDB(B0, 0, 0); PG8_LDB(B1, 0, 1); PG8_SCHED; PG8_LDA(At, 0, 0); PG8_STAGE_A(PG8_SA(1, 1), a1, 1, false);
            if constexpr (GATHER) { if (last && has_next) PG8_GATHER_SET(ui + 1, 1); }
            PG8_WAIT_V(8); PG8_WAIT_L(0); PG8_BAR; PG8_MMA(0, 0, At, B0); PG8_MMA(0, 1, At, B1); PG8_BAR; PG8_SCHED;
            PG8_LDA(At, 0, 1); PG8_STAGE(PG8_SB(0, 0), b2, voffB); PG8_STAGE(PG8_SB(0, 1), b2 + hstepB, voffB); PG8_STAGE_A(PG8_SA(0, 0), a2, 0, last);
            PG8_WAIT_V(8); PG8_WAIT_L(0); PG8_BAR; PG8_MMA(1, 0, At, B0); PG8_MMA(1, 1, At, B1); PG8_BAR; PG8_SCHED;
            PG8_LDB(B0, 1, 0); PG8_LDB(B1, 1, 1); PG8_SCHED; PG8_LDA(At, 1, 0); PG8_STAGE_A(PG8_SA(0, 1), a2, 1, last);
            PG8_WAIT_V(8); PG8_WAIT_L(0); PG8_BAR; PG8_MMA(0, 0, At, B0); PG8_MMA(0, 1, At, B1); PG8_BAR; PG8_SCHED;
            PG8_LDA(At, 1, 1); PG8_STAGE(PG8_SB(1, 0), b3, voffB); PG8_STAGE(PG8_SB(1, 1), b3 + hstepB, voffB); PG8_STAGE_A(PG8_SA(1, 0), a3, 0, last);
            PG8_WAIT_V(8); PG8_WAIT_L(0); PG8_BAR; PG8_MMA(1, 0, At, B0); PG8_MMA(1, 1, At, B1); PG8_BAR; PG8_SCHED;
        }
        if constexpr (ALIGN_EPI) { if (wr == 0) PG8_BAR; }
        { Unit eu; eu.pm = __builtin_amdgcn_readfirstlane(cur.pm); eu.pn = __builtin_amdgcn_readfirstlane(cur.pn); int fr_ = fr, fq_ = fq; asm volatile("" : "+s"(eu.pm), "+s"(eu.pn), "+v"(fr_), "+v"(fq_));
          E(acc, eu, wr, wc, fr_, fq_); }
        if (!has_next) break;
#pragma unroll
        for (int a = 0; a < 2; ++a)
#pragma unroll
            for (int b = 0; b < 2; ++b)
#pragma unroll
                for (int m = 0; m < 4; ++m)
#pragma unroll
                    for (int n = 0; n < 2; ++n) acc[a][b][m][n] = (f32x4){0.f, 0.f, 0.f, 0.f};
        cur = nxt; cA = nA; cB = nB; ++ui;
        if constexpr (ALIGN_EPI) { if (wr == 1) PG8_BAR; }
    }
    PG8_WAIT_V(0);
    if constexpr (!ALIGN_EPI) { if (wr == 0) PG8_BAR; }
    PG8_BAR;
#undef PG8_SA
#undef PG8_SB
#undef PG8_STAGE
#undef PG8_STAGE_A
#undef PG8_GATHER_SET
#undef PG8_LDA
#undef PG8_LDB
#undef PG8_MMA
#undef PG8_WAIT_V
#undef PG8_WAIT_L
#undef PG8_BAR
#undef PG8_SCHED
}
}

constexpr int NTOK = 16384, DM = 1024, SEQ = 4096, NB = 4, NLAYER = 2;
constexpr int INW = 8200;
constexpr int C_MQK = 0, C_MV = 1024, C_MO = 2048, C_MI = 3072, C_MF = 3076, C_SQ = 3080, C_SK = 4104, C_SV = 5128, C_GA = 6152, C_GB = 7176;
constexpr int P6W = 6144;
constexpr int P_MQK = 0, P_MO = 1024, P_SQ = 2048, P_SK = 3072, P_GA = 4096, P_GB = 5120;
constexpr int NEXP = 64, EFF = 128, SFF = 256, TOPK = 8;
constexpr int MAXROWS = NTOK * TOPK + NEXP * 256;
constexpr int MAXTILES = MAXROWS / 256;
constexpr float EPS = 1e-6f;
constexpr float LOG2E = 1.4426950408889634f;

constexpr size_t MiB = 1u << 20;
constexpr size_t WS_CTL = 0, CTL_ZERO_BYTES = 3456 * 4;
constexpr size_t WS_MODP = 1 * MiB;
constexpr size_t WS_MODF = 4 * MiB;
constexpr size_t WS_GATES = WS_MODF + 256 * 1024;
constexpr size_t WS_TOPE = WS_GATES + 512 * 1024;
constexpr size_t WS_TOPW = WS_TOPE + 512 * 1024;
constexpr size_t WS_CNT = WS_TOPW + 512 * 1024;
constexpr size_t WS_STOK = WS_CNT + 64 * 1024;
constexpr size_t WS_SW = WS_STOK + 576 * 1024;
constexpr size_t WS_SDST = WS_SW + 576 * 1024;
constexpr size_t WS_TILEE = WS_SDST + 576 * 1024;
constexpr size_t WS_MISC_END = WS_TILEE + 4096;
static_assert(WS_MISC_END <= 8 * MiB, "misc region");
constexpr size_t WS_BIN = 8 * MiB;
constexpr size_t WS_AIN = WS_BIN + 12 * MiB;
constexpr size_t WS_BA = WS_AIN + 4 * MiB, WS_BB = WS_BA + 2 * MiB, WS_BO = WS_BB + 2 * MiB;
constexpr size_t WS_BGU = WS_BO + 2 * MiB;
constexpr size_t WS_BD = WS_BGU + 32 * MiB;
constexpr size_t WS_BSGU = WS_BD + 16 * MiB;
constexpr size_t WS_BSD = WS_BSGU + 1 * MiB;
constexpr size_t WS_W_END = WS_BSD + 1 * MiB;
constexpr size_t WS_R1 = 80 * MiB;
constexpr size_t WS_P6 = WS_R1, WS_VT = WS_R1 + 192 * MiB;
constexpr size_t WS_R2 = WS_R1 + 256 * MiB;
constexpr size_t WS_R3 = WS_R2 + 36 * MiB;
constexpr size_t WS_PT = WS_R3 + 8 * MiB;
constexpr size_t WS_END = WS_PT + 18 * MiB;
static_assert(WS_W_END <= WS_R1, "weights region");
constexpr int CW_BAR = 0;

constexpr int LDS_BYTES = 147456;
constexpr int LDS_MAIN = 131072;
constexpr int LDS_TAB = 131072;
constexpr int LDS_CTL = LDS_BYTES - 512;

#define GAS __attribute__((address_space(1)))
#define LAS __attribute__((address_space(3)))
typedef unsigned short bf16;
typedef unsigned v4u __attribute__((ext_vector_type(4)));
typedef unsigned v2u __attribute__((ext_vector_type(2)));
typedef float f32x4 __attribute__((ext_vector_type(4)));
typedef float f32x16 __attribute__((ext_vector_type(16)));
typedef short bf16x8 __attribute__((ext_vector_type(8)));
typedef short s16x4 __attribute__((ext_vector_type(4)));
typedef GAS unsigned gu32;
#define RLX_AGENT __ATOMIC_RELAXED, __HIP_MEMORY_SCOPE_AGENT
#define LDS_WAIT() asm volatile("s_waitcnt lgkmcnt(0)" ::: "memory")
typedef float f32x2_t __attribute__((ext_vector_type(2))); typedef __bf16 bf16x2_t __attribute__((ext_vector_type(2)));
__device__ __forceinline__ unsigned pk2(float lo, float hi) { f32x2_t v = {lo, hi}; bf16x2_t b = __builtin_convertvector(v, bf16x2_t); return __builtin_bit_cast(unsigned, b); }
__device__ __forceinline__ unsigned short f2bf(float f) { return (unsigned short)(pk2(f, 0.f) & 0xffffu); }
__device__ __forceinline__ float bflo(unsigned w) { return __uint_as_float(w << 16); }
__device__ __forceinline__ float bfhi(unsigned w) { return __uint_as_float(w & 0xffff0000u); }
__device__ __forceinline__ float bf2f(unsigned short h) { return __uint_as_float((unsigned)h << 16); }
__device__ __forceinline__ float sigmoidf_(float x) { return __builtin_amdgcn_rcpf(1.f + __builtin_amdgcn_exp2f(-x * LOG2E)); }
__device__ __forceinline__ int crow(int r, int hi) { return (r & 3) + 8 * (r >> 2) + 4 * hi; }
__device__ __forceinline__ int lane_now() { int l; asm volatile("v_mbcnt_lo_u32_b32 %0, -1, 0\n\tv_mbcnt_hi_u32_b32 %0, -1, %0" : "=v"(l)); return l; }
__device__ __forceinline__ float shfl_xor_l(float v, int d, int lane) { return __int_as_float(__builtin_amdgcn_ds_bpermute((lane ^ d) << 2, __float_as_int(v))); }
__device__ __forceinline__ float shfl_up_l(float v, int d, int lane) { return __int_as_float(__builtin_amdgcn_ds_bpermute(((lane - d) & 63) << 2, __float_as_int(v))); }
__device__ __forceinline__ float wave_sum(float v, int lane) {
#pragma unroll
    for (int o = 1; o < 64; o <<= 1) v += shfl_xor_l(v, o, lane);
    return v;
}

#define XB_TMO      128
#define XB_XCNT(j)  (256  + 64 * (j))
#define XB_XSUB(j)  (1280 + 64 * (j))
#define XB_XGEN(j)  (2304 + 64 * (j))
#define XB_TOP      3328
#define XB_TOPGEN   3392
#define XCD_BAR_WORDS 3456
#define XB_SPIN_CAP (1u << 18)
__device__ __forceinline__ unsigned xb_ld(unsigned* p)              { return __hip_atomic_load(p, __ATOMIC_RELAXED, __HIP_MEMORY_SCOPE_AGENT); }
__device__ __forceinline__ unsigned xb_add(unsigned* p, unsigned v) { return __hip_atomic_fetch_add(p, v, __ATOMIC_RELAXED, __HIP_MEMORY_SCOPE_AGENT); }
__device__ __forceinline__ unsigned xb_xcc_id() { return (unsigned)__builtin_amdgcn_s_getreg((3 << 11) | 20) & 0xFu; }
#define XB_SPIN(cond, bar) do { unsigned _sp = 0; while (cond) { __builtin_amdgcn_s_sleep(1); \
    if ((++_sp & 255u) == 0u) { if (xb_ld(&(bar)[XB_TMO])) break; if (_sp > XB_SPIN_CAP) { atomicAdd(&(bar)[XB_TMO], 1u); break; } } } } while (0)
struct XcdBarrier { unsigned* bar; unsigned x; volatile LAS unsigned* st; };
__device__ __forceinline__ XcdBarrier xcd_barrier_post(unsigned* bar, volatile LAS unsigned* st) {
    XcdBarrier b; b.bar = bar; b.x = xb_xcc_id(); b.st = st;
    if (threadIdx.x == 0) (void)xb_add(&bar[XB_XCNT(b.x)], 1u);
    return b;
}
__device__ __forceinline__ void xcd_barrier_complete(unsigned* bar, unsigned x, unsigned& nloc, unsigned& nx) {
    const unsigned G = gridDim.x * gridDim.y * gridDim.z;
    unsigned sum, cnt, mine, sp = 0u;
    for (;;) {
        sum = 0u; cnt = 0u; mine = 0u;
#pragma unroll
        for (unsigned j = 0; j < 16; ++j) { const unsigned c = xb_ld(&bar[XB_XCNT(j)]); sum += c; cnt += (c > 0u) ? 1u : 0u; mine = (j == x) ? c : mine; }
        if (sum == G) break;
        __builtin_amdgcn_s_sleep(1);
        if ((++sp & 255u) == 0u) { if (xb_ld(&bar[XB_TMO])) break; if (sp > XB_SPIN_CAP) { atomicAdd(&bar[XB_TMO], 1u); break; } }
    }
    nloc = mine > 0u ? mine : 1u; nx = cnt > 0u ? cnt : 1u;
}
__device__ __forceinline__ void xcd_barrier(const XcdBarrier& b) {
    asm volatile("s_waitcnt vmcnt(0)" ::: "memory");
    __syncthreads();
    if (threadIdx.x == 0) {
        unsigned* bar = b.bar;
        __builtin_amdgcn_s_waitcnt(0);
        unsigned nloc = b.st[0], nx = b.st[1];
        if (nloc == 0u) { xcd_barrier_complete(bar, b.x, nloc, nx); b.st[0] = nloc; b.st[1] = nx; }
        const unsigned old = xb_add(&bar[XB_XSUB(b.x)], 1u);
        const unsigned gen = old / nloc;
        if (old + 1u == (gen + 1u) * nloc) {
            __builtin_amdgcn_fence(__ATOMIC_RELEASE, "agent");
            asm volatile("s_waitcnt vmcnt(0)" ::: "memory");
            const unsigned og = xb_add(&bar[XB_TOP], 1u);
            const unsigned tg = og / nx;
            if (og + 1u == (tg + 1u) * nx) xb_add(&bar[XB_TOPGEN], 1u);
            else XB_SPIN(xb_ld(&bar[XB_TOPGEN]) == tg, bar);
            __builtin_amdgcn_fence(__ATOMIC_ACQUIRE, "agent");
            xb_add(&bar[XB_XGEN(b.x)], 1u);
            asm volatile("s_waitcnt vmcnt(0)" ::: "memory");
        } else {
            XB_SPIN(xb_ld(&bar[XB_XGEN(b.x)]) == gen, bar);
            __builtin_amdgcn_fence(__ATOMIC_ACQUIRE, "agent");
            asm volatile("s_waitcnt vmcnt(0)" ::: "memory");
        }
    }
    __syncthreads();
}

struct Frame {
    LAS unsigned char* lds;
    int tid, lane, wave, G, c;
    float* out; unsigned char* ws;
};
__device__ __forceinline__ unsigned char* wsp(const Frame& F, size_t off) { unsigned char* p = F.ws; asm volatile("" : "+s"(p)); return (unsigned char*)(GAS unsigned char*)(p + off); }
__device__ __forceinline__ float* outp(const Frame& F) { float* p = F.out; asm volatile("" : "+s"(p)); return (float*)(GAS float*)p; }
__device__ __forceinline__ const float* inp(const Frame& F, int i) {
    const LAS unsigned* p = (const LAS unsigned*)(F.lds + LDS_CTL + 64) + 2 * i;
    const unsigned lo = __builtin_amdgcn_readfirstlane(p[0]), hi = __builtin_amdgcn_readfirstlane(p[1]);
    return (const float*)(const GAS float*)(((unsigned long long)hi << 32) | lo);
}
__device__ __forceinline__ bf16* xmid(const Frame& F, int l) { return (l == NLAYER - 1) ? (bf16*)wsp(F, WS_VT) : (bf16*)outp(F); }
enum { I_X = 0, I_C, I_ADAW, I_ADAB, I_N1W, I_WIN, I_CONVW, I_CONVB, I_IGB, I_FGB, I_MNW, I_WPA, I_WPB, I_WOUT, I_N2W, I_RW, I_RB, I_WG, I_WU, I_WD, I_SG, I_SU, I_SD, I_FNW };

#define EPI_LOOP_BEGIN \
    _Pragma("unroll") for (int ai = 0; ai < 2; ++ai) _Pragma("unroll") for (int m = 0; m < 4; ++m) { const int rl = ai * 128 + wr * 64 + m * 16 + fr; (void)rl; \
    _Pragma("unroll") for (int bj = 0; bj < 2; ++bj) { const int cl = bj * 128 + wc * 32 + 8 * fq; (void)cl; const pg8::f32x4 v0 = acc[ai][bj][m][0], v1 = acc[ai][bj][m][1];
#define EPI_LOOP_END } }

struct EpiPlain {
    static constexpr bool PERM = true;
    bf16* O; int ldc;
    __device__ __forceinline__ void operator()(const pg8::f32x4 (&acc)[2][2][4][2], const pg8::Unit& u, int wr, int wc, int fr, int fq) const {
        EPI_LOOP_BEGIN
            v4u w; w.x = pk2(v0[0], v0[1]); w.y = pk2(v0[2], v0[3]); w.z = pk2(v1[0], v1[1]); w.w = pk2(v1[2], v1[3]);
            *(GAS v4u*)(O + (size_t)(u.pm * 256 + rl) * ldc + u.pn * 256 + cl) = w;
        EPI_LOOP_END
    }
};
#define SG8(q_, v0_, v1_, o0_, o1_, OP) do { \
        o0_[0] = OP(sigmoidf_(bflo(q_.x)) * v0_[0], 0); o0_[1] = OP(sigmoidf_(bfhi(q_.x)) * v0_[1], 1); o0_[2] = OP(sigmoidf_(bflo(q_.y)) * v0_[2], 2); o0_[3] = OP(sigmoidf_(bfhi(q_.y)) * v0_[3], 3); \
        o1_[0] = OP(sigmoidf_(bflo(q_.z)) * v1_[0], 4); o1_[1] = OP(sigmoidf_(bfhi(q_.z)) * v1_[1], 5); o1_[2] = OP(sigmoidf_(bflo(q_.w)) * v1_[2], 6); o1_[3] = OP(sigmoidf_(bfhi(q_.w)) * v1_[3], 7); } while (0)
struct EpiGateT1 {
    static constexpr bool PERM = true;
    const bf16* Gt; int gld; bf16* T1;
    __device__ __forceinline__ void operator()(const pg8::f32x4 (&acc)[2][2][4][2], const pg8::Unit& u, int wr, int wc, int fr, int fq) const {
#pragma unroll
        for (int ai = 0; ai < 2; ++ai) {
            v4u gq[4][2];
#pragma unroll
            for (int m = 0; m < 4; ++m)
#pragma unroll
                for (int bj = 0; bj < 2; ++bj) { const size_t row = (size_t)(u.pm * 256 + ai * 128 + wr * 64 + m * 16 + fr); const int col = u.pn * 256 + bj * 128 + wc * 32 + 8 * fq; gq[m][bj] = *(const GAS v4u*)(Gt + row * gld + col); }
#pragma unroll
            for (int m = 0; m < 4; ++m)
#pragma unroll
                for (int bj = 0; bj < 2; ++bj) { const size_t row = (size_t)(u.pm * 256 + ai * 128 + wr * 64 + m * 16 + fr); const int col = u.pn * 256 + bj * 128 + wc * 32 + 8 * fq;
                    const pg8::f32x4 v0 = acc[ai][bj][m][0], v1 = acc[ai][bj][m][1]; f32x4 o0, o1;
#define OPN(x_, i_) (x_)
                    SG8(gq[m][bj], v0, v1, o0, o1, OPN);
#undef OPN
                    v4u tw; tw.x = pk2(o0[0], o0[1]); tw.y = pk2(o0[2], o0[3]); tw.z = pk2(o1[0], o1[1]); tw.w = pk2(o1[2], o1[3]);
                    *(GAS v4u*)(T1 + row * 1024 + col) = tw; }
        }
    }
};
struct EpiGateY {
    static constexpr bool PERM = true;
    const bf16* Gt; int gld; const bf16* T1; bf16* Y;
    __device__ __forceinline__ void operator()(const pg8::f32x4 (&acc)[2][2][4][2], const pg8::Unit& u, int wr, int wc, int fr, int fq) const {
#pragma unroll
        for (int ai = 0; ai < 2; ++ai) {
            v4u gq[4][2], tq[4][2];
#pragma unroll
            for (int m = 0; m < 4; ++m)
#pragma unroll
                for (int bj = 0; bj < 2; ++bj) { const size_t row = (size_t)(u.pm * 256 + ai * 128 + wr * 64 + m * 16 + fr); const int col = u.pn * 256 + bj * 128 + wc * 32 + 8 * fq;
                    gq[m][bj] = *(const GAS v4u*)(Gt + row * gld + col); tq[m][bj] = *(const GAS v4u*)(T1 + row * 1024 + col); }
#pragma unroll
            for (int m = 0; m < 4; ++m)
#pragma unroll
                for (int bj = 0; bj < 2; ++bj) { const size_t row = (size_t)(u.pm * 256 + ai * 128 + wr * 64 + m * 16 + fr); const int col = u.pn * 256 + bj * 128 + wc * 32 + 8 * fq;
                    const pg8::f32x4 v0 = acc[ai][bj][m][0], v1 = acc[ai][bj][m][1]; f32x4 o0, o1;
                    const v4u t4 = tq[m][bj]; const float tt[8] = {bflo(t4.x), bfhi(t4.x), bflo(t4.y), bfhi(t4.y), bflo(t4.z), bfhi(t4.z), bflo(t4.w), bfhi(t4.w)};
#define OPT(x_, i_) (tt[i_] + (x_))
                    SG8(gq[m][bj], v0, v1, o0, o1, OPT);
#undef OPT
                    v4u w; w.x = pk2(o0[0], o0[1]); w.y = pk2(o0[2], o0[3]); w.z = pk2(o1[0], o1[1]); w.w = pk2(o1[2], o1[3]);
                    *(GAS v4u*)(Y + row * 1024 + col) = w; }
        }
    }
};
#undef SG8
struct EpiRes {
    static constexpr bool PERM = true;
    const bf16* xin; bf16* out; const float* gv; int nostore;
    __device__ __forceinline__ void operator()(const pg8::f32x4 (&acc)[2][2][4][2], const pg8::Unit& u, int wr, int wc, int fr, int fq) const {
        const float* gb = gv + (size_t)(u.pm >> 4) * 6144;
        f32x4 g0[2], g1[2];
#pragma unroll
        for (int bj = 0; bj < 2; ++bj) { const int col = u.pn * 256 + bj * 128 + wc * 32 + 8 * fq; g0[bj] = *(const GAS f32x4*)(gb + col); g1[bj] = *(const GAS f32x4*)(gb + col + 4); }
#pragma unroll
        for (int ai = 0; ai < 2; ++ai)
#pragma unroll
            for (int mh = 0; mh < 2; ++mh) {
                v4u xb[2][2];
#pragma unroll
                for (int mm = 0; mm < 2; ++mm)
#pragma unroll
                    for (int bj = 0; bj < 2; ++bj) { const size_t row = (size_t)(u.pm * 256 + ai * 128 + wr * 64 + (2 * mh + mm) * 16 + fr); const int col = u.pn * 256 + bj * 128 + wc * 32 + 8 * fq;
                        xb[mm][bj] = *(const GAS v4u*)(xin + row * 1024 + col); }
#pragma unroll
                for (int mm = 0; mm < 2; ++mm)
#pragma unroll
                    for (int bj = 0; bj < 2; ++bj) { const int m = 2 * mh + mm; const size_t row = (size_t)(u.pm * 256 + ai * 128 + wr * 64 + m * 16 + fr); const int col = u.pn * 256 + bj * 128 + wc * 32 + 8 * fq;
                        const v4u x = xb[mm][bj]; const f32x4 a0 = acc[ai][bj][m][0], a1 = acc[ai][bj][m][1];
                        v4u o;
                        o.x = pk2(bflo(x.x) + g0[bj][0] * a0[0], bfhi(x.x) + g0[bj][1] * a0[1]); o.y = pk2(bflo(x.y) + g0[bj][2] * a0[2], bfhi(x.y) + g0[bj][3] * a0[3]);
                        o.z = pk2(bflo(x.z) + g1[bj][0] * a1[0], bfhi(x.z) + g1[bj][1] * a1[1]); o.w = pk2(bflo(x.w) + g1[bj][2] * a1[2], bfhi(x.w) + g1[bj][3] * a1[3]);
                        if (nostore) { asm volatile("" :: "v"(o)); } else { *(GAS v4u*)(out + row * 1024 + col) = o; } }
            }
    }
};
struct EpiHid {
    static constexpr bool PERM = true;
    bf16* O; int ldo; const LAS float* roww; int ubase; int ustride; int shared;
    __device__ __forceinline__ void operator()(const pg8::f32x4 (&acc)[2][2][4][2], const pg8::Unit& u, int wr, int wc, int fr, int fq) const {
#pragma unroll
        for (int ai = 0; ai < 2; ++ai)
#pragma unroll
            for (int m = 0; m < 4; ++m) {
                const int rl = ai * 128 + wr * 64 + m * 16 + fr; const size_t pos = (size_t)u.pm * 256 + rl;
                const float w = shared ? 1.f : roww[((u.pm - ubase) / ustride) * 256 + rl];
                const int col = (shared ? 128 * u.pn : 0) + wc * 32 + 8 * fq;
                float h[8];
#pragma unroll
                for (int n = 0; n < 2; ++n)
#pragma unroll
                    for (int j = 0; j < 4; ++j) { const float gt = acc[ai][0][m][n][j], up = acc[ai][1][m][n][j]; h[n * 4 + j] = gt * sigmoidf_(gt) * up * w; }
                v4u o; o.x = pk2(h[0], h[1]); o.y = pk2(h[2], h[3]); o.z = pk2(h[4], h[5]); o.w = pk2(h[6], h[7]);
                *(GAS v4u*)(O + pos * ldo + col) = o;
                asm volatile("" ::: "memory");
            }
    }
};
constexpr float YS_SCALE = 4.0f;
struct EpiScatter {
    static constexpr bool PERM = true;
    bf16* Y; const LAS unsigned* dst; int v; int G; int nostore;
    __device__ __forceinline__ void operator()(const pg8::f32x4 (&acc)[2][2][4][2], const pg8::Unit& u, int wr, int wc, int fr, int fq) const {
        const int q = u.pn & 3;
#pragma unroll
        for (int ai = 0; ai < 2; ++ai)
#pragma unroll
            for (int m = 0; m < 4; ++m) {
                const int rl = ai * 128 + wr * 64 + m * 16 + fr; const unsigned d = dst[((4 * u.pm + q - v) / G) * 256 + rl];
                if (nostore) { asm volatile("" :: "v"(acc[ai][0][m][0]), "v"(acc[ai][0][m][1]), "v"(acc[ai][1][m][0]), "v"(acc[ai][1][m][1])); } else if (d != 0xffffffffu) {
#pragma unroll
                    for (int bj = 0; bj < 2; ++bj) { const pg8::f32x4 v0 = acc[ai][bj][m][0] * YS_SCALE, v1 = acc[ai][bj][m][1] * YS_SCALE;
                        int w0 = 0, w1 = 0;
#define YS_CL(x_) __builtin_amdgcn_fmed3f((x_), -440.f, 440.f)
                        w0 = __builtin_amdgcn_cvt_pk_fp8_f32(YS_CL(v0[0]), YS_CL(v0[1]), w0, false); w0 = __builtin_amdgcn_cvt_pk_fp8_f32(YS_CL(v0[2]), YS_CL(v0[3]), w0, true);
                        w1 = __builtin_amdgcn_cvt_pk_fp8_f32(YS_CL(v1[0]), YS_CL(v1[1]), w1, false); w1 = __builtin_amdgcn_cvt_pk_fp8_f32(YS_CL(v1[2]), YS_CL(v1[3]), w1, true);
#undef YS_CL
                        v2u w; w.x = (unsigned)w0; w.y = (unsigned)w1;
                        *(GAS v2u*)((unsigned char*)Y + (size_t)d * 1024 + q * 256 + bj * 128 + wc * 32 + 8 * fq) = w; }
                }
            }
    }
};

struct TrDesc { const float* sp; bf16* dp; int ldw, ldt; float scale; };
__device__ __forceinline__ void tr_load(const TrDesc& d, float (&tv)[32]) {
    const GAS float* sp = (const GAS float*)d.sp;
#pragma unroll
    for (int i = 0; i < 32; ++i) tv[i] = sp[(size_t)(2 * i) * d.ldw];
}
__device__ __forceinline__ void tr_store(const TrDesc& d, const float (&tv)[32], LAS float* scr, int lane) {
#pragma unroll
    for (int i = 0; i < 32; ++i) { const int kk = 2 * i + (lane >> 5); scr[kk * 33 + (lane & 31)] = tv[i]; }
    LDS_WAIT();
    const int c = lane & 7; const float scale = d.scale;
#pragma unroll
    for (int j = 0; j < 4; ++j) { const int n = (lane >> 3) + 8 * j; const LAS float* s = scr + (8 * c) * 33 + n;
        v4u o; o.x = pk2(s[0 * 33] * scale, s[1 * 33] * scale); o.y = pk2(s[2 * 33] * scale, s[3 * 33] * scale); o.z = pk2(s[4 * 33] * scale, s[5 * 33] * scale); o.w = pk2(s[6 * 33] * scale, s[7 * 33] * scale);
        *(GAS v4u*)(d.dp + (size_t)n * d.ldt + 8 * c) = o; }
    LDS_WAIT();
}
constexpr int CW_N_IN = 8 * 512, CW_N_P = 3 * 512, CW_N_E = 4096, CW_N_S = 4 * 64, CW_N_SD = 128;
constexpr int CW_TOTAL = CW_N_IN + CW_N_P + 3 * CW_N_E + CW_N_S + CW_N_SD;
__device__ __forceinline__ TrDesc tr_decode(Frame& F, int l, int it) {
    const float* src; int ldw; bf16* dst; int ldt; int kb, nb; float sc = 1.f;
    int r = it;
    if (r < CW_N_IN) { const int job = r >> 9, rr = r & 511; kb = rr >> 5; nb = rr & 31;
        int col; bf16* BIN = (bf16*)wsp(F, WS_BIN); bf16* AIN = (bf16*)wsp(F, WS_AIN);
        switch (job) {
            case 0: col = C_MQK; dst = BIN; break;
            case 1: col = C_MO; dst = BIN + (size_t)1024 * 1024; break;
            case 2: col = C_SQ; dst = BIN + (size_t)2048 * 1024; sc = LOG2E * 0.125f; break;
            case 3: col = C_SK; dst = BIN + (size_t)3072 * 1024; break;
            case 4: col = C_GA; dst = BIN + (size_t)4096 * 1024; break;
            case 5: col = C_GB; dst = BIN + (size_t)5120 * 1024; break;
            case 6: col = C_MV; dst = AIN; break;
            default: col = C_SV; dst = AIN + (size_t)1024 * 1024; break;
        }
        src = inp(F, I_WIN) + (size_t)l * DM * INW + col; ldw = INW; ldt = 1024; }
    else if ((r -= CW_N_IN) < CW_N_P) { const int job = r >> 9, rr = r & 511; kb = rr >> 5; nb = rr & 31;
        src = inp(F, job == 0 ? I_WPA : (job == 1 ? I_WPB : I_WOUT)) + (size_t)l * DM * DM; ldw = 1024;
        dst = (bf16*)wsp(F, job == 0 ? WS_BA : (job == 1 ? WS_BB : WS_BO)); ldt = 1024; }
    else if ((r -= CW_N_P) < 2 * CW_N_E) { const int up = r >= CW_N_E; if (up) r -= CW_N_E; const int e = r >> 6, rr = r & 63; kb = rr >> 2; nb = rr & 3;
        src = inp(F, up ? I_WU : I_WG) + ((size_t)l * NEXP + e) * DM * EFF; ldw = EFF;
        dst = (bf16*)wsp(F, WS_BGU) + ((size_t)e * 256 + (up ? 128 : 0)) * 1024; ldt = 1024; }
    else if ((r -= 2 * CW_N_E) < CW_N_E) { const int e = r >> 6, rr = r & 63; kb = rr >> 5; nb = rr & 31;
        src = inp(F, I_WD) + ((size_t)l * NEXP + e) * EFF * DM; ldw = DM;
        dst = (bf16*)wsp(F, WS_BD) + (size_t)e * 1024 * 128; ldt = 128; }
    else if ((r -= CW_N_E) < CW_N_S) { const int job = r >> 6, rr = r & 63; kb = rr >> 2; nb = rr & 3;
        const int up = job >> 1, hi = job & 1;
        src = inp(F, up ? I_SU : I_SG) + (size_t)l * DM * SFF + hi * 128; ldw = SFF;
        dst = (bf16*)wsp(F, WS_BSGU) + (size_t)(hi * 256 + up * 128) * 1024; ldt = 1024; }
    else { r -= CW_N_S; kb = r >> 5; nb = r & 31;
        src = inp(F, I_SD) + (size_t)l * SFF * DM; ldw = DM; dst = (bf16*)wsp(F, WS_BSD); ldt = 256; }
    TrDesc d; const int k0 = 64 * kb, n0 = 32 * nb; const int ln = lane_now();
    d.sp = src + (size_t)(k0 + (ln >> 5)) * ldw + n0 + (ln & 31); d.dp = dst + (size_t)n0 * ldt + k0; d.ldw = ldw; d.ldt = ldt; d.scale = sc;
    return d;
}
__device__ __forceinline__ void conv_weights(Frame& F, int l) {
    LAS float* scr = (LAS float*)(F.lds + F.wave * 16384);
    int gw = F.c * 8 + F.wave; asm volatile("" : "+s"(gw)); const int NGW = F.G * 8;
    int it = gw;
    if (it >= CW_TOTAL) return;
    TrDesc dc = tr_decode(F, l, it); float tc[32]; tr_load(dc, tc);
    for (;;) {
        const int itn = it + NGW; const bool more = itn < CW_TOTAL;
        TrDesc dn = dc; float tn[32];
        if (more) { dn = tr_decode(F, l, itn); tr_load(dn, tn); }
        tr_store(dc, tc, scr, F.lane);
        if (!more) break;
        it = itn; dc = dn;
#pragma unroll
        for (int i = 0; i < 32; ++i) tc[i] = tn[i];
    }
}
__device__ __forceinline__ void mod_partials(Frame& F) {
    LAS float* sc = (LAS float*)(F.lds);
    for (int i = F.tid; i < 4096; i += 512) { const float v = inp(F, I_C)[i]; sc[i] = v / (1.f + __expf(-v)); }
    __syncthreads();
    float* MODP = (float*)wsp(F, WS_MODP);
    for (int it = F.c; it < 384; it += F.G) {
        const int l = it / 192, rem = it % 192, g = rem >> 4, kp = rem & 15, j = g * 512 + F.tid;
        const float* w = inp(F, I_ADAW) + ((size_t)l * DM + 64 * kp) * 6144 + j;
        float a0 = 0.f, a1 = 0.f, a2 = 0.f, a3 = 0.f;
#pragma unroll 16
        for (int k = 0; k < 64; ++k) { const float wv = w[(size_t)k * 6144]; const int kk = 64 * kp + k;
            a0 += sc[kk] * wv; a1 += sc[1024 + kk] * wv; a2 += sc[2048 + kk] * wv; a3 += sc[3072 + kk] * wv; }
        float* o = MODP + ((size_t)(kp * 2 + l) * 4) * 6144 + j;
        o[0] = a0; o[6144] = a1; o[2 * 6144] = a2; o[3 * 6144] = a3;
    }
    __syncthreads();
}
__device__ __forceinline__ float modv(const Frame& F, int l, int b, int j) {
    const float* MODP = (const float*)wsp(F, WS_MODP);
    float s = inp(F, I_ADAB)[l * 6144 + j];
#pragma unroll
    for (int kp = 0; kp < 16; ++kp) s += MODP[((size_t)(kp * 2 + l) * 4 + b) * 6144 + j];
    return s;
}

__device__ __forceinline__ void norm_emit(Frame& F, const float (&v)[2][8], const LAS float* cA, const LAS float* cB, const LAS float* Wg, const float gbias_lane  , bf16* xn_row, float* gate_row) {
    float ss = 0.f;
#pragma unroll
    for (int j = 0; j < 2; ++j)
#pragma unroll
        for (int i = 0; i < 8; ++i) ss += v[j][i] * v[j][i];
    ss = wave_sum(ss, F.lane);
    const float r = 1.0f / sqrtf(ss * (1.f / 1024.f) + EPS);
    float h[2][8];
#pragma unroll
    for (int j = 0; j < 2; ++j) { const int k = 8 * F.lane + 512 * j;
        const f32x4 a0 = *(const LAS f32x4*)(cA + k), a1 = *(const LAS f32x4*)(cA + k + 4), b0 = *(const LAS f32x4*)(cB + k), b1 = *(const LAS f32x4*)(cB + k + 4);
#pragma unroll
        for (int i = 0; i < 4; ++i) { h[j][i] = v[j][i] * r * a0[i] + b0[i]; h[j][4 + i] = v[j][4 + i] * r * a1[i] + b1[i]; }
        v4u o; o.x = pk2(h[j][0], h[j][1]); o.y = pk2(h[j][2], h[j][3]); o.z = pk2(h[j][4], h[j][5]); o.w = pk2(h[j][6], h[j][7]);
        *(GAS v4u*)(xn_row + k) = o; }
    float mine = 0.f;
#pragma unroll
    for (int g = 0; g < 8; ++g) { float p = 0.f;
#pragma unroll
        for (int j = 0; j < 2; ++j) { const int k = 8 * F.lane + 512 * j; const f32x4 w0 = *(const LAS f32x4*)(Wg + g * 1024 + k), w1 = *(const LAS f32x4*)(Wg + g * 1024 + k + 4);
#pragma unroll
            for (int i = 0; i < 4; ++i) { p += h[j][i] * w0[i]; p += h[j][4 + i] * w1[i]; } }
        p = wave_sum(p, F.lane);
        if (F.lane == g) mine = p; }
    if (F.lane < 8) { float z = mine + gbias_lane; if (F.lane >= 4) z = fminf(z, 0.f) - __logf(1.f + __expf(-fabsf(z))); gate_row[F.lane] = z; }
}
__device__ __forceinline__ void norm1_tables(Frame& F, int l, int b, bool from_modp) {
    LAS float* cA = (LAS float*)(F.lds + LDS_TAB); LAS float* cB = cA + 1024; LAS float* Wg = (LAS float*)(F.lds);
    const float* MODF = (const float*)wsp(F, WS_MODF) + (size_t)(l * 4 + b) * 6144;
    for (int k = F.tid; k < 1024; k += 512) {
        const float sh = from_modp ? modv(F, l, b, k) : MODF[k], sc = from_modp ? modv(F, l, b, 1024 + k) : MODF[1024 + k];
        cA[k] = inp(F, I_N1W)[l * 1024 + k] * (1.f + sc); cB[k] = sh; }
    const float* w_in = inp(F, I_WIN) + (size_t)l * DM * INW;
    for (int idx = F.tid; idx < 8192; idx += 512) { const int k = idx >> 3, g = idx & 7; Wg[g * 1024 + k] = w_in[(size_t)k * INW + C_MI + g]; }
}
__device__ __forceinline__ void phase_norm1_first(Frame& F) {
    float* MODF = (float*)wsp(F, WS_MODF);
    for (int idx = F.c * 512 + F.tid; idx < 2 * 4 * 6144; idx += F.G * 512) { const int l = idx / 24576, rem = idx % 24576, b = rem / 6144, j = rem % 6144; MODF[idx] = modv(F, l, b, j); }
    bf16* XN = (bf16*)wsp(F, WS_R2); float* GATES = (float*)wsp(F, WS_GATES); bf16* XB = (bf16*)outp(F);
    for (int vb = F.c; vb < 256; vb += F.G) {
        norm1_tables(F, 0, vb >> 6, true);
        __syncthreads();
        const float gbl = (F.lane < 4) ? inp(F, I_IGB)[F.lane] : (F.lane < 8 ? inp(F, I_FGB)[F.lane - 4] : 0.f);
        for (int i = 0; i < 8; ++i) {
            const int t = vb * 64 + F.wave * 8 + i; const float* xr = inp(F, I_X) + (size_t)t * 1024 + 8 * F.lane;
            float v[2][8];
#pragma unroll
            for (int j = 0; j < 2; ++j) { const f32x4 a = *(const GAS f32x4*)(xr + 512 * j), b2 = *(const GAS f32x4*)(xr + 512 * j + 4);
#pragma unroll
                for (int q = 0; q < 4; ++q) { v[j][q] = a[q]; v[j][4 + q] = b2[q]; } }
#pragma unroll
            for (int j = 0; j < 2; ++j) { v4u o; o.x = pk2(v[j][0], v[j][1]); o.y = pk2(v[j][2], v[j][3]); o.z = pk2(v[j][4], v[j][5]); o.w = pk2(v[j][6], v[j][7]);
                *(GAS v4u*)(XB + (size_t)t * 1024 + 8 * F.lane + 512 * j) = o; }
            norm_emit(F, v, (const LAS float*)(F.lds + LDS_TAB), (const LAS float*)(F.lds + LDS_TAB) + 1024, (const LAS float*)(F.lds), gbl, XN + (size_t)t * 1024, GATES + (size_t)t * 8);
        }
        __syncthreads();
    }
}

__device__ __forceinline__ void phase_conv(Frame& F, int l) {
    const bf16* P6 = (const bf16*)wsp(F, WS_P6); bf16* MQK = (bf16*)wsp(F, WS_R2);
    const int cg = F.tid & 127, tq = F.tid >> 7, ch = cg * 8;
    float w[4][8], bias[8];
#pragma unroll
    for (int j = 0; j < 4; ++j) { const float* p = inp(F, I_CONVW) + ((size_t)l * 4 + j) * 1024 + ch; const f32x4 a = *(const GAS f32x4*)p, b = *(const GAS f32x4*)(p + 4);
#pragma unroll
        for (int i = 0; i < 4; ++i) { w[j][i] = a[i]; w[j][4 + i] = b[i]; } }
    { const float* p = inp(F, I_CONVB) + (size_t)l * 1024 + ch; const f32x4 a = *(const GAS f32x4*)p, b = *(const GAS f32x4*)(p + 4);
#pragma unroll
      for (int i = 0; i < 4; ++i) { bias[i] = a[i]; bias[4 + i] = b[i]; } }
    const float osc = (ch < 512) ? 0.08838834764831845f : 1.0f;
    for (int vb = F.c; vb < 256; vb += F.G) {
        const int tbeg = vb * 64 + tq * 16;
        float u0[8], u1[8], u2[8];
#define CV_LOAD(dst, tt) do { const int t_ = (tt); if (t_ >= 0 && (t_ >> 12) == (tbeg >> 12)) { const v4u q = *(const GAS v4u*)(P6 + (size_t)t_ * P6W + ch); \
            dst[0] = bflo(q.x); dst[1] = bfhi(q.x); dst[2] = bflo(q.y); dst[3] = bfhi(q.y); dst[4] = bflo(q.z); dst[5] = bfhi(q.z); dst[6] = bflo(q.w); dst[7] = bfhi(q.w); } \
            else { _Pragma("unroll") for (int i_ = 0; i_ < 8; ++i_) dst[i_] = 0.f; } } while (0)
        CV_LOAD(u0, tbeg - 3); CV_LOAD(u1, tbeg - 2); CV_LOAD(u2, tbeg - 1);
        for (int tt = 0; tt < 16; ++tt) {
            const int t = tbeg + tt; float u3[8]; CV_LOAD(u3, t);
            float o[8];
#pragma unroll
            for (int i = 0; i < 8; ++i) { const float a = bias[i] + w[0][i] * u0[i] + w[1][i] * u1[i] + w[2][i] * u2[i] + w[3][i] * u3[i]; o[i] = a * sigmoidf_(a) * osc; }
            v4u q; q.x = pk2(o[0], o[1]); q.y = pk2(o[2], o[3]); q.z = pk2(o[4], o[5]); q.w = pk2(o[6], o[7]);
            *(GAS v4u*)(MQK + (size_t)t * 1024 + ch) = q;
#pragma unroll
            for (int i = 0; i < 8; ++i) { u0[i] = u1[i]; u1[i] = u2[i]; u2[i] = u3[i]; }
        }
#undef CV_LOAD
    }
}

constexpr float SB_EXIT = -80.0f;
constexpr int AT_NSLOT = 12, AT_SLOTB = 8192, AT_FLAGS = AT_NSLOT * AT_SLOTB;
__device__ __forceinline__ void at_dma(const void* gsrc, LAS unsigned char* ldst) { __builtin_amdgcn_global_load_lds((const GAS unsigned*)gsrc, (LAS unsigned*)ldst, 16, 0, 0); }
__device__ __forceinline__ void attn_unit(Frame& F, int b, int h, int qb, bool do_store) {
    bf16* P6 = (bf16*)wsp(F, WS_P6); const bf16* VT = (const bf16*)wsp(F, WS_VT);
    LAS unsigned char* L = F.lds;
    const int lane = F.lane, r32 = lane & 31, hh = lane >> 5, wid = F.wave;
    const int tb = b * SEQ, t0 = qb * 256 + wid * 32;
    const int D0 = 8 * qb, Dw = D0 + wid;
    const bf16* dsrc; int dtile_stride; int doff;
    if (wid < 4) { const int row = 8 * wid + (lane >> 3), pos = lane & 7; dsrc = P6 + (size_t)(tb + row) * P6W + P_SK + h * 64 + ((pos ^ (row & 7)) * 8); dtile_stride = 32 * P6W; doff = wid * 1024; }
    else { const int d = 16 * (wid - 4) + (lane >> 2), pos = lane & 3; dsrc = VT + (size_t)(1024 + h * 64 + d) * NTOK + tb + ((pos ^ ((d >> 2) & 3)) * 8); dtile_stride = 32; doff = 4096 + (wid - 4) * 1024; }
#define AT_DMA(T_) do { const int T__ = (T_); if (T__ >= 0) at_dma(dsrc + (size_t)T__ * dtile_stride, L + (T__ % AT_NSLOT) * AT_SLOTB + doff); } while (0)
    for (int T = D0 + 7; T >= D0 - 1; --T) AT_DMA(T);
    bf16x8 qf[4];
#pragma unroll
    for (int kk = 0; kk < 4; ++kk) qf[kk] = *(const GAS bf16x8*)(P6 + (size_t)(tb + t0 + r32) * P6W + P_SQ + h * 64 + 16 * kk + 8 * hh);
    f32x16 o0 = {}, o1 = {};
    float Rrun = 0.f;
    bool done = false;
    LAS unsigned* flags = (LAS unsigned*)(L + AT_FLAGS);
    asm volatile("s_waitcnt vmcnt(0)" ::: "memory");
    if (lane == 0) flags[wid] = 1u;
    __syncthreads();
    int koff[4], vlo[2][2], vhi[2][2];
#pragma unroll
    for (int kk = 0; kk < 4; ++kk) koff[kk] = r32 * 128 + (((2 * kk + hh) ^ (r32 & 7)) * 16);
#pragma unroll
    for (int dt = 0; dt < 2; ++dt)
#pragma unroll
        for (int s = 0; s < 2; ++s) { const int d = 32 * dt + r32, sw = (d >> 2) & 3; vlo[dt][s] = 4096 + d * 64 + (((2 * s) ^ sw) * 16) + 8 * hh; vhi[dt][s] = 4096 + d * 64 + (((2 * s + 1) ^ sw) * 16) + 8 * hh; }
#define AT_TILE(DIAG_) do { \
            const LAS unsigned char* S = L + (T % AT_NSLOT) * AT_SLOTB; \
            f32x16 p = {}; \
            _Pragma("unroll") \
            for (int kk = 0; kk < 4; ++kk) { const bf16x8 kf = *(const LAS bf16x8*)(S + koff[kk]); p = __builtin_amdgcn_mfma_f32_32x32x16_bf16(kf, qf[kk], p, 0, 0, 0); } \
            bf16x8 vf[2][2]; \
            _Pragma("unroll") \
            for (int dt = 0; dt < 2; ++dt) \
            _Pragma("unroll") \
                for (int s = 0; s < 2; ++s) { const v2u lo = *(const LAS v2u*)(S + vlo[dt][s]), hi = *(const LAS v2u*)(S + vhi[dt][s]); v4u t; t.x = lo.x; t.y = lo.y; t.z = hi.x; t.w = hi.y; vf[dt][s] = __builtin_bit_cast(bf16x8, t); } \
            float lf[16]; \
            _Pragma("unroll") \
            for (int r = 0; r < 16; ++r) { const float z = p[r]; const float e = __builtin_amdgcn_exp2f(-fabsf(z)); const float lg = __builtin_amdgcn_logf(1.f + e); \
                float v = -(fmaxf(z, 0.f) + lg); if (DIAG_ && crow(r, hh) >= r32) v = 0.f; lf[r] = v; } \
 \
            float own[4], pair[4]; \
            _Pragma("unroll") \
            for (int g = 0; g < 4; ++g) { own[g] = (lf[4 * g] + lf[4 * g + 1]) + (lf[4 * g + 2] + lf[4 * g + 3]); \
                auto rr = __builtin_amdgcn_permlane32_swap(__float_as_uint(own[g]), __float_as_uint(own[g]), false, false); \
                pair[g] = __uint_as_float(rr[0]) + __uint_as_float(rr[1]); } \
            float sfx[4]; sfx[3] = Rrun; sfx[2] = sfx[3] + pair[3]; sfx[1] = sfx[2] + pair[2]; sfx[0] = sfx[1] + pair[1]; \
            const float nh = hh ? 0.f : 1.f; \
            float att[16]; \
            _Pragma("unroll") \
            for (int g = 0; g < 4; ++g) { float run = sfx[g] + nh * (pair[g] - own[g]); \
            _Pragma("unroll") \
                for (int i = 3; i >= 0; --i) { const int r = 4 * g + i; run += lf[r]; float a = __builtin_amdgcn_exp2f(p[r] + run); if (DIAG_ && crow(r, hh) >= r32) a = 0.f; att[r] = a; } } \
            Rrun = sfx[0] + pair[0]; \
            v4u pb0, pb1; \
            pb0.x = pk2(att[0], att[1]); pb0.y = pk2(att[2], att[3]); pb0.z = pk2(att[4], att[5]); pb0.w = pk2(att[6], att[7]); \
            pb1.x = pk2(att[8], att[9]); pb1.y = pk2(att[10], att[11]); pb1.z = pk2(att[12], att[13]); pb1.w = pk2(att[14], att[15]); \
            const bf16x8 b0 = __builtin_bit_cast(bf16x8, pb0), b1 = __builtin_bit_cast(bf16x8, pb1); \
            o0 = __builtin_amdgcn_mfma_f32_32x32x16_bf16(vf[0][0], b0, o0, 0, 0, 0); o0 = __builtin_amdgcn_mfma_f32_32x32x16_bf16(vf[0][1], b1, o0, 0, 0, 0); \
            o1 = __builtin_amdgcn_mfma_f32_32x32x16_bf16(vf[1][0], b0, o1, 0, 0, 0); o1 = __builtin_amdgcn_mfma_f32_32x32x16_bf16(vf[1][1], b1, o1, 0, 0, 0); \
            if (__all(Rrun < SB_EXIT)) done = true; \
        } while (0)
    for (int j = 0; ; ++j) {
        const int T = Dw - j;
        const bool active = !done && T >= 0;
        AT_DMA(D0 - j - 2);
        if (active) { if (j == 0) AT_TILE(true); else AT_TILE(false); }
        const bool more = !done && (Dw - (j + 1)) >= 0;
        if (lane == 0) flags[8 * ((j + 1) & 1) + wid] = more ? 1u : 0u;
        asm volatile("s_waitcnt vmcnt(0) lgkmcnt(0)" ::: "memory");
        __builtin_amdgcn_s_barrier();
        asm volatile("" ::: "memory");
        const LAS unsigned* fl = flags + 8 * ((j + 1) & 1);
        const unsigned any = fl[0] | fl[1] | fl[2] | fl[3] | fl[4] | fl[5] | fl[6] | fl[7];
        if (any == 0u) break;
    }
#undef AT_DMA
#undef AT_TILE
    if (do_store) {
        bf16* orow = P6 + (size_t)(tb + t0 + r32) * P6W + P_SQ + h * 64 + 4 * hh;
#pragma unroll
        for (int g = 0; g < 4; ++g) {
            v2u a; a.x = pk2(o0[4 * g], o0[4 * g + 1]); a.y = pk2(o0[4 * g + 2], o0[4 * g + 3]); *(GAS v2u*)(orow + 8 * g) = a;
            v2u c; c.x = pk2(o1[4 * g], o1[4 * g + 1]); c.y = pk2(o1[4 * g + 2], o1[4 * g + 3]); *(GAS v2u*)(orow + 32 + 8 * g) = c;
        }
    } else { asm volatile("" :: "v"(o0), "v"(o1)); }
    __syncthreads();
}
__device__ __forceinline__ void phase_attn(Frame& F, bool do_store) {
    const int v = (F.G % 8 == 0) ? (F.c % 8) * (F.G / 8) + F.c / 8 : F.c;
    for (int u = v; u < 1024; u += F.G) { const int bh = u >> 4, qb = u & 15; attn_unit(F, bh >> 4, bh & 15, qb, do_store); }
}

constexpr size_t MLS_U = 0, MLS_PM = 16 * 4096 * 4, MLS_BL = 2 * 16 * 4096 * 4, MLS_SUM = 3 * 16 * 4096 * 4;
__device__ __forceinline__ void phase_mlstm_scalars(Frame& F) {
    const float* GATES = (const float*)wsp(F, WS_GATES); unsigned char* R3 = wsp(F, WS_R3);
    const int lane = F.lane;
    for (int vb = F.c; vb < 256; vb += F.G) {
        if (F.wave != 0) continue;
        const int bh = vb >> 4, ch = vb & 15, b = bh >> 2, h = bh & 3, t0 = b * SEQ + 256 * ch;
        float carry_b = 0.f, carry_pm = -INFINITY;
#pragma unroll
        for (int sg = 0; sg < 4; ++sg) {
            const int tok = t0 + 64 * sg + lane;
            const float ig = *(const GAS float*)(GATES + (size_t)tok * 8 + h), lfv = *(const GAS float*)(GATES + (size_t)tok * 8 + 4 + h);
            float bc = lfv;
#pragma unroll
            for (int o = 1; o < 64; o <<= 1) { const float t = shfl_up_l(bc, o, lane); if (lane >= o) bc += t; }
            bc += carry_b;
            const float u = ig - bc;
            float pm = u;
#pragma unroll
            for (int o = 1; o < 64; o <<= 1) { const float t = shfl_up_l(pm, o, lane); if (lane >= o) pm = fmaxf(pm, t); }
            pm = fmaxf(pm, carry_pm);
            const size_t idx = (size_t)bh * 4096 + 256 * ch + 64 * sg + lane;
            *(GAS float*)(R3 + MLS_U + idx * 4) = u; *(GAS float*)(R3 + MLS_PM + idx * 4) = pm; *(GAS float*)(R3 + MLS_BL + idx * 4) = bc;
            carry_b = __int_as_float(__builtin_amdgcn_readlane(__float_as_int(bc), 63)); carry_pm = __int_as_float(__builtin_amdgcn_readlane(__float_as_int(pm), 63));
        }
        if (lane == 0) { *(GAS float*)(R3 + MLS_SUM + (size_t)(bh * 16 + ch) * 8) = carry_b; *(GAS float*)(R3 + MLS_SUM + (size_t)(bh * 16 + ch) * 8 + 4) = carry_pm; }
    }
}

constexpr int CVP_QS = 0, CVP_KS = 69632, CVP_U = 139264;
__device__ __forceinline__ void cvp_job(Frame& F, int l, int bh, int c) {
    LAS unsigned char* L = F.lds;
    const int b = bh >> 2, h = bh & 3, T0 = b * SEQ + 256 * c;
    const bf16* P6 = (const bf16*)wsp(F, WS_P6); const unsigned char* R3 = wsp(F, WS_R3);
    {
        const int cg = F.tid & 31, tr = F.tid >> 5, ch8 = 8 * cg;
        const int cq = (ch8 < 128) ? h * 128 + ch8 : 512 + h * 128 + (ch8 - 128);
        float w[4][8], bias[8];
#pragma unroll
        for (int j = 0; j < 4; ++j) { const float* p = inp(F, I_CONVW) + ((size_t)l * 4 + j) * 1024 + cq; const f32x4 a = *(const GAS f32x4*)p, bb = *(const GAS f32x4*)(p + 4);
#pragma unroll
            for (int i = 0; i < 4; ++i) { w[j][i] = a[i]; w[j][4 + i] = bb[i]; } }
        { const float* p = inp(F, I_CONVB) + (size_t)l * 1024 + cq; const f32x4 a = *(const GAS f32x4*)p, bb = *(const GAS f32x4*)(p + 4);
#pragma unroll
          for (int i = 0; i < 4; ++i) { bias[i] = a[i]; bias[4 + i] = bb[i]; } }
        const float osc = (ch8 < 128) ? 0.08838834764831845f : 1.0f;
        const int sbeg = 256 * c + 16 * tr;
        float u0[8], u1[8], u2[8];
#define CVP_LOAD(dst, ss) do { const int s_ = (ss); if (s_ >= 0) { const v4u q = *(const GAS v4u*)(P6 + (size_t)(b * SEQ + s_) * P6W + cq); \
            dst[0] = bflo(q.x); dst[1] = bfhi(q.x); dst[2] = bflo(q.y); dst[3] = bfhi(q.y); dst[4] = bflo(q.z); dst[5] = bfhi(q.z); dst[6] = bflo(q.w); dst[7] = bfhi(q.w); } \
            else { _Pragma("unroll") for (int i_ = 0; i_ < 8; ++i_) dst[i_] = 0.f; } } while (0)
        CVP_LOAD(u0, sbeg - 3); CVP_LOAD(u1, sbeg - 2); CVP_LOAD(u2, sbeg - 1);
        LAS unsigned char* tile = L + ((ch8 < 128) ? CVP_QS : CVP_KS) + ((ch8 & 127) * 2);
        for (int tt = 0; tt < 16; ++tt) {
            float u3[8]; CVP_LOAD(u3, sbeg + tt);
            float o[8];
#pragma unroll
            for (int i = 0; i < 8; ++i) { const float a = bias[i] + w[0][i] * u0[i] + w[1][i] * u1[i] + w[2][i] * u2[i] + w[3][i] * u3[i]; o[i] = a * sigmoidf_(a) * osc; }
            v4u q; q.x = pk2(o[0], o[1]); q.y = pk2(o[2], o[3]); q.z = pk2(o[4], o[5]); q.w = pk2(o[6], o[7]);
            *(LAS v4u*)(tile + (16 * tr + tt) * 272) = q;
#pragma unroll
            for (int i = 0; i < 8; ++i) { u0[i] = u1[i]; u1[i] = u2[i]; u2[i] = u3[i]; }
        }
#undef CVP_LOAD
        if (F.tid < 256) *(LAS float*)(L + CVP_U + F.tid * 4) = *(const GAS float*)(R3 + MLS_U + ((size_t)bh * 4096 + 256 * c + F.tid) * 4) * LOG2E;
    }
    __syncthreads();
    {
        const int lane = F.lane, wid = F.wave, r32 = lane & 31, hh = lane >> 5;
        const int qblk = (wid < 4) ? 7 - wid : wid - 4;
        float Mc = 0.f;
        for (int cc = 0; cc < c; ++cc) { const float a = *(const GAS float*)(R3 + MLS_SUM + (size_t)(bh * 16 + cc) * 8), pmx = *(const GAS float*)(R3 + MLS_SUM + (size_t)(bh * 16 + cc) * 8 + 4); Mc = a + fmaxf(Mc, pmx); }
        const float pmq = *(const GAS float*)(R3 + MLS_PM + ((size_t)bh * 4096 + 256 * c + 32 * qblk + r32) * 4);
        const float myMM2 = fmaxf(Mc, pmq) * LOG2E;
        bf16x8 qf[8];
#pragma unroll
        for (int kk = 0; kk < 8; ++kk) qf[kk] = *(const LAS bf16x8*)(L + CVP_QS + (32 * qblk + r32) * 272 + (16 * kk + 8 * hh) * 2);
        { unsigned char* QF = wsp(F, WS_R2) + (((size_t)(bh * 16 + c) * 8 + qblk) * 8) * 1024 + lane * 16;
#pragma unroll
          for (int kk = 0; kk < 8; ++kk) *(GAS bf16x8*)(QF + (size_t)kk * 1024) = qf[kk]; }
        unsigned char* PT = wsp(F, WS_PT) + ((size_t)(bh * 16 + c) * 36 + (qblk * (qblk + 1)) / 2) * 2048;
        const LAS float* U2 = (const LAS float*)(L + CVP_U);
        for (int kt = 0; kt <= qblk; ++kt) {
            f32x16 p = {};
#pragma unroll
            for (int kk = 0; kk < 8; ++kk) { const bf16x8 a = *(const LAS bf16x8*)(L + CVP_KS + (32 * kt + r32) * 272 + (16 * kk + 8 * hh) * 2); p = __builtin_amdgcn_mfma_f32_32x32x16_bf16(a, qf[kk], p, 0, 0, 0); }
            const bool diag = (kt == qblk);
            float pw[16];
#pragma unroll
            for (int g = 0; g < 4; ++g) { const f32x4 u2 = *(const LAS f32x4*)(U2 + 32 * kt + 8 * g + 4 * hh);
#pragma unroll
                for (int i = 0; i < 4; ++i) { const int r = 4 * g + i; float v = p[r] * __builtin_amdgcn_exp2f(u2[i] - myMM2); if (diag && (8 * g + 4 * hh + i) > r32) v = 0.f; pw[r] = v; } }
            v4u pb0, pb1;
            pb0.x = pk2(pw[0], pw[1]); pb0.y = pk2(pw[2], pw[3]); pb0.z = pk2(pw[4], pw[5]); pb0.w = pk2(pw[6], pw[7]);
            pb1.x = pk2(pw[8], pw[9]); pb1.y = pk2(pw[10], pw[11]); pb1.z = pk2(pw[12], pw[13]); pb1.w = pk2(pw[14], pw[15]);
            *(GAS v4u*)(PT + (size_t)kt * 2048 + lane * 16) = pb0; *(GAS v4u*)(PT + (size_t)kt * 2048 + 1024 + lane * 16) = pb1;
        }
        { const int dkt = wid & 3, kh = wid >> 2;
          unsigned char* KF = wsp(F, WS_R2) + 16 * MiB + (((size_t)(bh * 16 + c) * 8 + (dkt * 2 + kh)) * 8) * 1024 + lane * 16;
#pragma unroll
          for (int ks = 0; ks < 8; ++ks) { const int s0 = 128 * kh + 16 * ks + 8 * hh; bf16x8 bb;
#pragma unroll
              for (int j = 0; j < 8; ++j) bb[j] = *(const LAS short*)(L + CVP_KS + (s0 + j) * 272 + (32 * dkt + r32) * 2);
              *(GAS bf16x8*)(KF + (size_t)ks * 1024) = bb; } }
    }
    __syncthreads();
}
__device__ __forceinline__ void phase_cvp(Frame& F, int l) {
    const int v = (F.G % 8 == 0) ? (F.c % 8) * (F.G / 8) + F.c / 8 : F.c;
    for (int u = v; u < 256; u += F.G) cvp_job(F, l, u >> 4, u & 15);
}

constexpr int M2_KS = 0, M2_VT = 69632, M2_CT = 86528, M2_G = 95232, M2_U2 = 97280, M2_WC = 105472, M2_PART = 113664;
constexpr int M2_KP = 272, M2_VP = 528, M2_CP = 272;
__device__ __forceinline__ void mlstm_unit(Frame& F, int b, int h, int ds, int skip) {
    LAS unsigned char* L = F.lds;
    const int wid = F.wave;
    const int qblk = (wid < 4) ? 7 - wid : wid - 4;
    const int dkt = wid & 3, kh = wid >> 2;
#define M2_IDS() int lane_ = F.lane; asm volatile("" : "+v"(lane_)); const int lane = lane_, tid = wid * 64 + lane, r32 = lane & 31, hh = lane >> 5
    const bf16* VTg = (const bf16*)wsp(F, WS_VT);
    bf16* P6 = (bf16*)wsp(F, WS_P6);
    const int tb = b * SEQ, bh = b * 4 + h;
    { M2_IDS();
    for (int i = tid; i < 16 * 264; i += 512) { const int row = 16 + i / 264, col = i % 264; *(LAS bf16*)(L + M2_VT + row * M2_VP + col * 2) = (row == 16 && col < 256) ? (bf16)0x3F80 : (bf16)0; }
    for (int i = tid; i < 32 * 136; i += 512) *(LAS bf16*)(L + M2_CT + i * 2) = (bf16)0; }
    f32x16 st = {};
    float Mst = 0.f;
    v4u pv; float pu[4], ppm, pbl, psa, psm;
    bf16x8 qf[8];
    v4u kfr[8];
    v4u pbuf[8][2];
    const unsigned char* R3 = wsp(F, WS_R3);
#define M2_FETCH(cc) do { const int t0_ = tb + 256 * (cc); \
        { const int dvl_ = tid >> 5, seg_ = tid & 31; pv = *(const GAS v4u*)(VTg + (size_t)(h * 256 + ds * 16 + dvl_) * NTOK + t0_ + seg_ * 8); } \
        { const size_t ib_ = (size_t)bh * 4096 + 256 * (cc); \
          _Pragma("unroll") for (int i = 0; i < 4; ++i) pu[i] = *(const GAS float*)(R3 + MLS_U + (ib_ + 64 * i + lane) * 4); \
          ppm = *(const GAS float*)(R3 + MLS_PM + (ib_ + 32 * qblk + r32) * 4); pbl = *(const GAS float*)(R3 + MLS_BL + (ib_ + 32 * qblk + r32) * 4); \
          psa = *(const GAS float*)(R3 + MLS_SUM + (size_t)(bh * 16 + (cc)) * 8); psm = *(const GAS float*)(R3 + MLS_SUM + (size_t)(bh * 16 + (cc)) * 8 + 4); } } while (0)
#define M2_QFETCH(cc) do { const unsigned char* qf_ = wsp(F, WS_R2) + (((size_t)(bh * 16 + (cc)) * 8 + qblk) * 8) * 1024 + lane * 16; _Pragma("unroll") for (int kk = 0; kk < 8; ++kk) qf[kk] = *(const GAS bf16x8*)(qf_ + (size_t)kk * 1024); } while (0)
#define M2_KFETCH(cc) do { const unsigned char* kf_ = wsp(F, WS_R2) + 16 * MiB + (((size_t)(bh * 16 + (cc)) * 8 + (dkt * 2 + kh)) * 8) * 1024 + lane * 16; \
        _Pragma("unroll") for (int ks = 0; ks < 8; ++ks) kfr[ks] = *(const GAS v4u*)(kf_ + (size_t)ks * 1024); } while (0)
#define M2_PTQ(cc) (wsp(F, WS_PT) + ((size_t)(bh * 16 + (cc)) * 36 + (qblk * (qblk + 1)) / 2) * 2048 + lane * 16)
    { M2_IDS(); M2_FETCH(0); M2_QFETCH(0); M2_KFETCH(0);
      const unsigned char* pt_ = M2_PTQ(0);
#pragma unroll
      for (int kt = 0; kt < 8; ++kt) if (kt <= qblk) { pbuf[kt][0] = *(const GAS v4u*)(pt_ + (size_t)kt * 2048); pbuf[kt][1] = *(const GAS v4u*)(pt_ + (size_t)kt * 2048 + 1024); } }
    LAS float* WCw = (LAS float*)(L + M2_WC + wid * 1024);
    for (int c = 0; c < 16; ++c) {
        M2_IDS();
        const int t0 = tb + 256 * c;
        const bool more = (c + 1 < 16);
        { const int dvl_ = tid >> 5, seg_ = tid & 31; *(LAS v4u*)(L + M2_VT + dvl_ * M2_VP + seg_ * 16) = pv; }
        float cu[4]; const float cpm = ppm, cbl = pbl, csa = psa, csm = psm;
#pragma unroll
        for (int i = 0; i < 4; ++i) cu[i] = pu[i];
        if (more) M2_FETCH(c + 1);
        float myWIN, myEFLO, decay;
        {
            const float mml = fmaxf(Mst, csm);
#pragma unroll
            for (int i = 0; i < 4; ++i) WCw[64 * i + lane] = __expf(cu[i] - mml);
            const float mm = fmaxf(Mst, cpm);
            myWIN = __expf(Mst - mm); myEFLO = __expf(-(cbl + mm));
            decay = __expf(Mst - mml);
            Mst = csa + mml;
        }
        __syncthreads();
        f32x16 hT = {};
        if (!(skip & 4))
#pragma unroll
        for (int kk = 0; kk < 8; ++kk) { const bf16x8 a = *(const LAS bf16x8*)(L + M2_CT + r32 * M2_CP + (16 * kk + 8 * hh) * 2); hT = __builtin_amdgcn_mfma_f32_32x32x16_bf16(a, qf[kk], hT, 0, 0, 0); }
        if (more) M2_QFETCH(c + 1);
#pragma unroll
        for (int r = 0; r < 16; ++r) hT[r] *= myWIN;
        {
            const unsigned char* ptn = M2_PTQ(c + 1);
#pragma unroll
            for (int kt = 0; kt < 8; ++kt) if (kt <= qblk) {
#pragma unroll
                for (int s = 0; s < 2; ++s) if (!(skip & 1)) { const LAS unsigned char* vp = L + M2_VT + r32 * M2_VP + (32 * kt + 16 * s + 4 * hh) * 2;
                    const v2u lo = *(const LAS v2u*)vp, hi = *(const LAS v2u*)(vp + 16);
                    v4u t; t.x = lo.x; t.y = lo.y; t.z = hi.x; t.w = hi.y;
                    hT = __builtin_amdgcn_mfma_f32_32x32x16_bf16(__builtin_bit_cast(bf16x8, t), __builtin_bit_cast(bf16x8, pbuf[kt][s]), hT, 0, 0, 0); }
                if (more) { pbuf[kt][0] = *(const GAS v4u*)(ptn + (size_t)kt * 2048); pbuf[kt][1] = *(const GAS v4u*)(ptn + (size_t)kt * 2048 + 1024); }
            }
        }
        {
            const float dn = hT[8];
            auto rr = __builtin_amdgcn_permlane32_swap(__float_as_uint(dn), __float_as_uint(dn), false, false);
            const float den = __uint_as_float(rr[0]);
            const float inv = 1.0f / fmaxf(fabsf(den), myEFLO);
            bf16* orow = P6 + (size_t)(t0 + 32 * qblk + r32) * P6W + P_MQK + h * 256 + ds * 16 + 4 * hh;
            v2u o0, o1; o0.x = pk2(hT[0] * inv, hT[1] * inv); o0.y = pk2(hT[2] * inv, hT[3] * inv); o1.x = pk2(hT[4] * inv, hT[5] * inv); o1.y = pk2(hT[6] * inv, hT[7] * inv);
            if (!(skip & 8)) { *(GAS v2u*)orow = o0; *(GAS v2u*)(orow + 8) = o1; } else { asm volatile("" :: "v"(o0), "v"(o1)); }
        }
        f32x16 part = {};
#pragma unroll
        for (int ks = 0; ks < 8; ++ks) if (!(skip & 2)) {
            const int s0 = 128 * kh + 16 * ks + 8 * hh;
            const v4u raw = *(const LAS v4u*)(L + M2_VT + r32 * M2_VP + s0 * 2);
            const f32x4 w0 = *(const LAS f32x4*)(WCw + s0), w1 = *(const LAS f32x4*)(WCw + s0 + 4);
            v4u aw; aw.x = pk2(bflo(raw.x) * w0[0], bfhi(raw.x) * w0[1]); aw.y = pk2(bflo(raw.y) * w0[2], bfhi(raw.y) * w0[3]);
            aw.z = pk2(bflo(raw.z) * w1[0], bfhi(raw.z) * w1[1]); aw.w = pk2(bflo(raw.w) * w1[2], bfhi(raw.w) * w1[3]);
            part = __builtin_amdgcn_mfma_f32_32x32x16_bf16(__builtin_bit_cast(bf16x8, aw), __builtin_bit_cast(bf16x8, kfr[ks]), part, 0, 0, 0);
        }
        if (more) M2_KFETCH(c + 1);
        if (kh == 1) {
#pragma unroll
            for (int r = 0; r < 16; ++r) *(LAS float*)(L + M2_PART + dkt * 4096 + r * 256 + lane * 4) = part[r];
        }
        __syncthreads();
        if (kh == 0) {
#pragma unroll
            for (int r = 0; r < 16; ++r) { st[r] = st[r] * decay + part[r] + *(LAS float*)(L + M2_PART + dkt * 4096 + r * 256 + lane * 4);
                *(LAS bf16*)(L + M2_CT + crow(r, hh) * M2_CP + (32 * dkt + r32) * 2) = f2bf(st[r]); }
        }
    }
#undef M2_FETCH
#undef M2_QFETCH
#undef M2_KFETCH
#undef M2_PTQ
#undef M2_IDS
}
__device__ __forceinline__ void phase_mlstm(Frame& F, int skip) {
    const int v = (F.G % 8 == 0) ? (F.c % 8) * (F.G / 8) + F.c / 8 : F.c;
    for (int u = v; u < 256; u += F.G) { const int bh = u >> 4, ds = u & 15; mlstm_unit(F, bh >> 2, bh & 3, ds, skip); __syncthreads(); }
}

__device__ __forceinline__ void phase_hm_final(Frame& F, int l, bool do_store) {
    bf16* P6 = (bf16*)wsp(F, WS_P6);
    const float* mw = inp(F, I_MNW) + (size_t)l * 1024;
    for (int vb = F.c; vb < 256; vb += F.G) {
        for (int i = 0; i < 8; ++i) {
            const int t = vb * 64 + F.wave * 8 + i; bf16* row = P6 + (size_t)t * P6W;
#pragma unroll
            for (int j = 0; j < 4; ++j) {
                const int col = 256 * j + 4 * F.lane;
                const v2u hv = *(const GAS v2u*)(row + P_MQK + col), mo = *(const GAS v2u*)(row + P_MO + col);
                float x[4] = {bflo(hv.x), bfhi(hv.x), bflo(hv.y), bfhi(hv.y)};
                float ss = wave_sum(x[0] * x[0] + x[1] * x[1] + x[2] * x[2] + x[3] * x[3], F.lane);
                const float r = 1.0f / sqrtf(ss * (1.f / 256.f) + EPS);
                const f32x4 w = *(const GAS f32x4*)(mw + col);
                const float g[4] = {sigmoidf_(bflo(mo.x)), sigmoidf_(bfhi(mo.x)), sigmoidf_(bflo(mo.y)), sigmoidf_(bfhi(mo.y))};
                v2u o; o.x = pk2(x[0] * r * w[0] * g[0], x[1] * r * w[1] * g[1]); o.y = pk2(x[2] * r * w[2] * g[2], x[3] * r * w[3] * g[3]);
                if (do_store) *(GAS v2u*)(row + P_MQK + col) = o; else asm volatile("" :: "v"(o));
            }
        }
    }
}

#define N2_LD0(dst, k0) do { const GAS float* bq_ = bp + (size_t)(2 * (k0)) * 64; asm volatile("" : "+v"(bq_)); _Pragma("unroll") for (int q_ = 0; q_ < 32; ++q_) dst[q_] = bq_[(size_t)(2 * q_) * 64]; } while (0)
constexpr int N2_H2 = 0, N2_CA = 131328, N2_CB = N2_CA + 4096, N2_HIST = N2_CB + 4096;
__device__ __forceinline__ void phase_norm2_router(Frame& F, int l, int skip) {
    LAS unsigned char* L = F.lds;
    LAS float* H2 = (LAS float*)(L + N2_H2); LAS float* cA = (LAS float*)(L + N2_CA); LAS float* cB = (LAS float*)(L + N2_CB); LAS unsigned* hist = (LAS unsigned*)(L + N2_HIST);
    const int lane = F.lane, wid = F.wave, r32 = lane & 31, hh = lane >> 5;
    bf16* XN2 = (bf16*)wsp(F, WS_R1); int* TOPE = (int*)wsp(F, WS_TOPE); float* TOPW = (float*)wsp(F, WS_TOPW); unsigned* CNT = (unsigned*)wsp(F, WS_CNT);
    const float* Wr = inp(F, I_RW) + (size_t)l * 1024 * 64;
    const float rb = inp(F, I_RB)[l * 64 + lane];
    for (int vb = F.c; vb < 256; vb += F.G) {
        const int b = vb >> 6;
        const float* MODF = (const float*)wsp(F, WS_MODF) + (size_t)(l * 4 + b) * 6144;
        for (int k = F.tid; k < 1024; k += 512) { cA[k] = inp(F, I_N2W)[l * 1024 + k] * (1.f + MODF[4 * 1024 + k]); cB[k] = MODF[3 * 1024 + k]; }
        if (F.tid < 64) hist[F.tid] = 0u;
        const int eh = wid & 1, kq = wid >> 1;
        const GAS float* bp = (const GAS float*)(Wr + (size_t)(256 * kq + hh) * 64 + 32 * eh + r32);
        __syncthreads();
        for (int it = 0; it < 2; ++it) {
            const int T0 = vb * 64 + it * 32;
            float wA[32], wB[32];
            N2_LD0(wA, 0); N2_LD0(wB, 32);
            v4u xr4[4][2];
            if (!(skip & 4))
#pragma unroll
            for (int i = 0; i < 4; ++i) { const bf16* xr = xmid(F, l) + (size_t)(T0 + wid * 4 + i) * 1024 + 8 * lane;
#pragma unroll
                for (int j = 0; j < 2; ++j) xr4[i][j] = *(const GAS v4u*)(xr + 512 * j); }
#pragma unroll
            for (int i = 0; i < 4; ++i) if (!(skip & 4)) {
                const int tl = wid * 4 + i, t = T0 + tl;
                float v[2][8]; float ss = 0.f;
#pragma unroll
                for (int j = 0; j < 2; ++j) { const v4u a = xr4[i][j];
                    v[j][0] = bflo(a.x); v[j][1] = bfhi(a.x); v[j][2] = bflo(a.y); v[j][3] = bfhi(a.y); v[j][4] = bflo(a.z); v[j][5] = bfhi(a.z); v[j][6] = bflo(a.w); v[j][7] = bfhi(a.w);
#pragma unroll
                    for (int q = 0; q < 8; ++q) ss += v[j][q] * v[j][q]; }
                ss = wave_sum(ss, F.lane);
                const float r = 1.0f / sqrtf(ss * (1.f / 1024.f) + EPS);
#pragma unroll
                for (int j = 0; j < 2; ++j) { const int k = 8 * lane + 512 * j; float h[8];
                    const f32x4 a0 = *(const LAS f32x4*)(cA + k), a1 = *(const LAS f32x4*)(cA + k + 4), b0 = *(const LAS f32x4*)(cB + k), b1 = *(const LAS f32x4*)(cB + k + 4);
                    LAS float* hp = H2 + tl * 1025 + k;
#pragma unroll
                    for (int q = 0; q < 4; ++q) { h[q] = v[j][q] * r * a0[q] + b0[q]; h[4 + q] = v[j][4 + q] * r * a1[q] + b1[q]; }
#pragma unroll
                    for (int q = 0; q < 8; ++q) hp[q] = h[q];
                    v4u o; o.x = pk2(h[0], h[1]); o.y = pk2(h[2], h[3]); o.z = pk2(h[4], h[5]); o.w = pk2(h[6], h[7]);
                    *(GAS v4u*)(XN2 + (size_t)t * 1024 + k) = o; }
            }
            __syncthreads();
            f32x16 acc = {};
            {
                const LAS float* ap = H2 + r32 * 1025 + 256 * kq + hh;
#define N2_LD(dst, k0) N2_LD0(dst, k0)
#define N2_MM(src, k0) do { _Pragma("unroll") for (int q_ = 0; q_ < 32; ++q_) { if ((q_ & 7) == 0) asm volatile("" ::: "memory"); acc = __builtin_amdgcn_mfma_f32_32x32x2f32(ap[2 * ((k0) + q_)], src[q_], acc, 0, 0, 0); } } while (0)
                if (!(skip & 1)) { N2_MM(wA, 0); N2_LD(wA, 64); N2_MM(wB, 32); N2_LD(wB, 96); N2_MM(wA, 64); N2_MM(wB, 96); }
            }
            __syncthreads();
            LAS float* PART = (LAS float*)(L);
#pragma unroll
            for (int r = 0; r < 16; ++r) PART[(kq * 32 + crow(r, hh)) * 64 + 32 * eh + r32] = acc[r];
            __syncthreads();
            if (!(skip & 2))
            {
                LAS float* rowb = (LAS float*)(L + 32768 + wid * 4096);
                int lane_t = F.lane; asm volatile("" : "+v"(lane_t)); const int lane = lane_t;
                const int g = lane >> 3;
                float score[4], sel[4], s2[4]; int rk[4]; bool chosen[4];
#pragma unroll
                for (int i = 0; i < 4; ++i) { const int tl = wid * 4 + i;
                    const float x = (PART[(0 * 32 + tl) * 64 + lane] + PART[(1 * 32 + tl) * 64 + lane]) + (PART[(2 * 32 + tl) * 64 + lane] + PART[(3 * 32 + tl) * 64 + lane]);
                    score[i] = 1.f / (1.f + expf(-x)); sel[i] = score[i] + rb; rowb[i * 256 + lane] = sel[i]; }
                LDS_WAIT();
#pragma unroll
                for (int i = 0; i < 4; ++i) { const LAS float* row = rowb + i * 256;
                    const f32x4 a = *(const LAS f32x4*)(row + 8 * g), c2 = *(const LAS f32x4*)(row + 8 * g + 4);
                    float m1 = fmaxf(a[0], a[1]), m2 = fminf(a[0], a[1]);
#define TK_INS(v_) do { const float v__ = (v_); m2 = fmaxf(m2, fminf(m1, v__)); m1 = fmaxf(m1, v__); } while (0)
                    TK_INS(a[2]); TK_INS(a[3]); TK_INS(c2[0]); TK_INS(c2[1]); TK_INS(c2[2]); TK_INS(c2[3]);
#undef TK_INS
                    if ((lane & 7) == 0) rowb[i * 256 + 64 + g] = m1 + m2; }
                LDS_WAIT();
#pragma unroll
                for (int i = 0; i < 4; ++i) { const LAS float* row = rowb + i * 256;
                    const f32x4 a = *(const LAS f32x4*)(row + 64), c2 = *(const LAS f32x4*)(row + 68);
                    const float gsv[8] = {a[0], a[1], a[2], a[3], c2[0], c2[1], c2[2], c2[3]};
                    float mine = 0.f;
#pragma unroll
                    for (int q = 0; q < 8; ++q) if (q == g) mine = gsv[q];
                    int gr = 0;
#pragma unroll
                    for (int q = 0; q < 8; ++q) gr += ((gsv[q] > mine) || (gsv[q] == mine && q < g)) ? 1 : 0;
                    s2[i] = (gr < 4) ? sel[i] : -INFINITY;
                    rowb[i * 256 + 72 + lane] = s2[i]; }
                LDS_WAIT();
#pragma unroll
                for (int i = 0; i < 4; ++i) { const LAS float* row = rowb + i * 256; int r_ = 0;
#pragma unroll
                    for (int q4 = 0; q4 < 16; ++q4) { const f32x4 a = *(const LAS f32x4*)(row + 72 + 4 * q4);
#pragma unroll
                        for (int e = 0; e < 4; ++e) { const int j = 4 * q4 + e; r_ += ((a[e] > s2[i]) || (a[e] == s2[i] && j < lane)) ? 1 : 0; } }
                    rk[i] = r_; chosen[i] = r_ < 8;
                    rowb[i * 256 + 136 + lane] = chosen[i] ? score[i] : 0.f; }
                LDS_WAIT();
#pragma unroll
                for (int i = 0; i < 4; ++i) { const LAS float* row = rowb + i * 256; const int t = T0 + wid * 4 + i;
                    float wsum = 0.f;
#pragma unroll
                    for (int q4 = 0; q4 < 16; ++q4) { const f32x4 a = *(const LAS f32x4*)(row + 136 + 4 * q4); wsum += (a[0] + a[1]) + (a[2] + a[3]); }
                    if (chosen[i]) { TOPE[(size_t)t * 8 + rk[i]] = lane; TOPW[(size_t)t * 8 + rk[i]] = score[i] / wsum * 2.5f; __hip_atomic_fetch_add(&hist[lane], 1u, __ATOMIC_RELAXED, __HIP_MEMORY_SCOPE_WORKGROUP); } }
                LDS_WAIT();
            }
            __syncthreads();
        }
        if (F.tid < 64) CNT[vb * 64 + F.tid] = hist[F.tid];
        __syncthreads();
    }
}

__device__ __forceinline__ void phase_scatter(Frame& F) {
    LAS unsigned* red = (LAS unsigned*)(F.lds);
    LAS unsigned* tot = red + 1024; LAS unsigned* padv = tot + 64; LAS unsigned* bef = padv + 64; LAS unsigned* base = bef + 64; LAS unsigned* selm = base + 64;
    const unsigned* CNT = (const unsigned*)wsp(F, WS_CNT); const int* TOPE = (const int*)wsp(F, WS_TOPE); const float* TOPW = (const float*)wsp(F, WS_TOPW);
    unsigned* STOK = (unsigned*)wsp(F, WS_STOK); float* SW = (float*)wsp(F, WS_SW); unsigned* SDST = (unsigned*)wsp(F, WS_SDST); int* TILEE = (int*)wsp(F, WS_TILEE);
    const int tid = F.tid;
    for (int vb = F.c; vb < 256; vb += F.G) {
        { const int e = tid & 63, part = tid >> 6; unsigned t = 0, bfv = 0;
          for (int blk = 32 * part; blk < 32 * part + 32; ++blk) { const unsigned v = CNT[blk * 64 + e]; t += v; if (blk < vb) bfv += v; }
          red[part * 64 + e] = t; red[512 + part * 64 + e] = bfv; }
        if (tid < 128) selm[tid] = 0u;
        __syncthreads();
        if (tid < 64) { unsigned T = 0, B = 0;
#pragma unroll
            for (int p = 0; p < 8; ++p) { T += red[p * 64 + tid]; B += red[512 + p * 64 + tid]; }
            tot[tid] = T; padv[tid] = (T + 255u) & ~255u; bef[tid] = B; }
        __syncthreads();
        if (tid < 64) { unsigned b = 0; for (int e = 0; e < tid; ++e) b += padv[e]; base[tid] = b; }
        const int tok = tid >> 3, slot = tid & 7, gt = vb * 64 + tok; const int e = TOPE[(size_t)gt * 8 + slot];
        __hip_atomic_fetch_or(&selm[e * 2 + (tok >> 5)], 1u << (tok & 31), __ATOMIC_RELAXED, __HIP_MEMORY_SCOPE_WORKGROUP);
        __syncthreads();
        { const unsigned lo = selm[e * 2], hi = selm[e * 2 + 1];
          const unsigned rank = (tok < 32) ? __popc(lo & ((1u << tok) - 1u)) : (__popc(lo) + __popc(hi & ((1u << (tok - 32)) - 1u)));
          const unsigned pos = base[e] + bef[e] + rank;
          STOK[pos] = (unsigned)gt; SW[pos] = TOPW[(size_t)gt * 8 + slot]; SDST[pos] = (unsigned)(gt * 8 + slot); }
        if (vb < 64) { const unsigned n = padv[vb] - tot[vb]; if ((unsigned)tid < n) { const unsigned pos = base[vb] + tot[vb] + tid; STOK[pos] = 0u; SW[pos] = 0.f; SDST[pos] = 0xffffffffu; } }
        if (vb == 0) { const int ntiles = (int)((base[63] + padv[63]) >> 8);
            for (int pm = tid; pm < ntiles; pm += 512) { int ee = 0; for (int q = 0; q < 64; ++q) if ((unsigned)(256 * pm) >= base[q] && (unsigned)(256 * pm) < base[q] + padv[q]) ee = q; TILEE[pm] = ee; }
            if (tid == 0) TILEE[1000] = ntiles; }
        __syncthreads();
    }
}

struct RoutedOrder {
    int ntiles, G, c; const LAS int* tabE; const LAS unsigned* tabTok; int wave;
    __device__ __forceinline__ bool next(int i, pg8::Unit& u) const { const int pm = i * G + c; if (pm >= ntiles) return false; u.pm = pm; u.pn = tabE[i]; return true; }
    __device__ __forceinline__ unsigned rowtok(int i, int row) const { return tabTok[i * 256 + row]; }
};
struct DownOrder {
    int nunits, G, v; const LAS int* tabE; int wave;
    __device__ __forceinline__ bool next(int i, pg8::Unit& u) const { const int L = i * G + v; if (L >= nunits) return false; u.pm = L >> 2; u.pn = tabE[i] * 4 + (L & 3); return true; }
    __device__ __forceinline__ unsigned rowtok(int, int) const { return 0u; }
};

__device__ __forceinline__ void phase_combine(Frame& F, int l, bool do_store) {
    const bf16* Y = (const bf16*)wsp(F, WS_R1); bf16* XN = (bf16*)wsp(F, WS_R2); float* GATES = (float*)wsp(F, WS_GATES);
    const bool last = (l == NLAYER - 1);
    for (int vb = F.c; vb < 256; vb += F.G) {
        const int b = vb >> 6;
        const float* g2 = (const float*)wsp(F, WS_MODF) + (size_t)(l * 4 + b) * 6144 + 5 * 1024;
        float gbl = 0.f;
        if (!last) { norm1_tables(F, l + 1, b, false); gbl = (F.lane < 4) ? inp(F, I_IGB)[(l + 1) * 4 + F.lane] : (F.lane < 8 ? inp(F, I_FGB)[(l + 1) * 4 + F.lane - 4] : 0.f); }
        __syncthreads();
        v2u yn[8][2];
        const bf16* SHO = (const bf16*)wsp(F, WS_R1 + 128 * MiB);
#define CB_LOAD(tt) do { const int t_ = (tt); \
            _Pragma("unroll") for (int s = 0; s < 8; ++s) _Pragma("unroll") for (int j = 0; j < 2; ++j) yn[s][j] = *(const GAS v2u*)((const unsigned char*)Y + ((size_t)t_ * 8 + s) * 1024 + 8 * F.lane + 512 * j); \
            } while (0)
        CB_LOAD(vb * 64 + F.wave * 8);
        for (int i = 0; i < 8; ++i) {
            const int t = vb * 64 + F.wave * 8 + i;
            v2u yc[8][2]; v4u xc[2]; v4u sc2[2]; bf16* xbr = xmid(F, l) + (size_t)t * 1024 + 8 * F.lane;
#pragma unroll
            for (int j = 0; j < 2; ++j) sc2[j] = *(const GAS v4u*)(SHO + (size_t)t * 1024 + 8 * F.lane + 512 * j);
#pragma unroll
            for (int s = 0; s < 8; ++s) { yc[s][0] = yn[s][0]; yc[s][1] = yn[s][1]; }
#pragma unroll
            for (int j = 0; j < 2; ++j) xc[j] = *(const GAS v4u*)(xbr + 512 * j);
            if (i + 1 < 8) CB_LOAD(t + 1);
            float acc[2][8];
#pragma unroll
            for (int j = 0; j < 2; ++j)
#pragma unroll
                for (int q = 0; q < 8; ++q) acc[j][q] = 0.f;
#pragma unroll
            for (int s = 0; s < 8; ++s)
#pragma unroll
                for (int j = 0; j < 2; ++j) { const v2u q = yc[s][j];
                    const f32x2_t a0 = __builtin_amdgcn_cvt_pk_f32_fp8((int)q.x, false), a1 = __builtin_amdgcn_cvt_pk_f32_fp8((int)q.x, true), a2 = __builtin_amdgcn_cvt_pk_f32_fp8((int)q.y, false), a3 = __builtin_amdgcn_cvt_pk_f32_fp8((int)q.y, true);
                    acc[j][0] += a0.x; acc[j][1] += a0.y; acc[j][2] += a1.x; acc[j][3] += a1.y; acc[j][4] += a2.x; acc[j][5] += a2.y; acc[j][6] += a3.x; acc[j][7] += a3.y; }
            float v[2][8]; float* xr = outp(F) + (size_t)t * 1024 + 8 * F.lane;
#pragma unroll
            for (int j = 0; j < 2; ++j) { const f32x4 a = {bflo(xc[j].x), bfhi(xc[j].x), bflo(xc[j].y), bfhi(xc[j].y)}, c2 = {bflo(xc[j].z), bfhi(xc[j].z), bflo(xc[j].w), bfhi(xc[j].w)};
                const f32x4 ga = *(const GAS f32x4*)(g2 + 8 * F.lane + 512 * j), gc = *(const GAS f32x4*)(g2 + 8 * F.lane + 512 * j + 4);
                const float sh[8] = {bflo(sc2[j].x), bfhi(sc2[j].x), bflo(sc2[j].y), bfhi(sc2[j].y), bflo(sc2[j].z), bfhi(sc2[j].z), bflo(sc2[j].w), bfhi(sc2[j].w)};
#pragma unroll
                for (int q = 0; q < 4; ++q) { v[j][q] = a[q] + ga[q] * (acc[j][q] * (1.f / YS_SCALE) + sh[q]); v[j][4 + q] = c2[q] + gc[q] * (acc[j][4 + q] * (1.f / YS_SCALE) + sh[4 + q]); } }
            if (last) {
                float ss = 0.f;
#pragma unroll
                for (int j = 0; j < 2; ++j)
#pragma unroll
                    for (int q = 0; q < 8; ++q) ss += v[j][q] * v[j][q];
                ss = wave_sum(ss, F.lane);
                const float r = 1.0f / sqrtf(ss * (1.f / 1024.f) + EPS);
#pragma unroll
                for (int j = 0; j < 2; ++j) { const float* fw = inp(F, I_FNW) + 8 * F.lane + 512 * j; const f32x4 w0 = *(const GAS f32x4*)fw, w1 = *(const GAS f32x4*)(fw + 4);
                    f32x4 o0, o1;
#pragma unroll
                    for (int q = 0; q < 4; ++q) { o0[q] = v[j][q] * r * w0[q]; o1[q] = v[j][4 + q] * r * w1[q]; }
                    if (do_store) { *(GAS f32x4*)(xr + 512 * j) = o0; *(GAS f32x4*)(xr + 512 * j + 4) = o1; } else asm volatile("" :: "v"(o0), "v"(o1)); }
            } else {
#pragma unroll
                for (int j = 0; j < 2; ++j) { v4u o; o.x = pk2(v[j][0], v[j][1]); o.y = pk2(v[j][2], v[j][3]); o.z = pk2(v[j][4], v[j][5]); o.w = pk2(v[j][6], v[j][7]);
                    if (do_store) { *(GAS v4u*)(xbr + 512 * j) = o; } else asm volatile("" :: "v"(o)); }
                if (do_store) norm_emit(F, v, (const LAS float*)(F.lds + LDS_TAB), (const LAS float*)(F.lds + LDS_TAB) + 1024, (const LAS float*)(F.lds), gbl, XN + (size_t)t * 1024, GATES + (size_t)t * 8);
            }
        }
#undef CB_LOAD
        __syncthreads();
    }
}

__device__ __forceinline__ void dbg_final(Frame& F, const float* src) {
    for (int vb = F.c; vb < 256; vb += F.G)
        for (int i = 0; i < 8; ++i) {
            const int t = vb * 64 + F.wave * 8 + i; const float* xr = src + (size_t)t * 1024 + 8 * F.lane; float* orow = outp(F) + (size_t)t * 1024 + 8 * F.lane;
            float v[2][8]; float ss = 0.f;
#pragma unroll
            for (int j = 0; j < 2; ++j) { const f32x4 a = *(const GAS f32x4*)(xr + 512 * j), c2 = *(const GAS f32x4*)(xr + 512 * j + 4);
#pragma unroll
                for (int q = 0; q < 4; ++q) { v[j][q] = a[q]; v[j][4 + q] = c2[q]; ss += a[q] * a[q] + c2[q] * c2[q]; } }
            ss = wave_sum(ss, F.lane);
            const float r = 1.0f / sqrtf(ss * (1.f / 1024.f) + EPS);
#pragma unroll
            for (int j = 0; j < 2; ++j) { const float* fw = inp(F, I_FNW) + 8 * F.lane + 512 * j; const f32x4 w0 = *(const GAS f32x4*)fw, w1 = *(const GAS f32x4*)(fw + 4);
                f32x4 o0, o1;
#pragma unroll
                for (int q = 0; q < 4; ++q) { o0[q] = v[j][q] * r * w0[q]; o1[q] = v[j][4 + q] * r * w1[q]; }
                *(GAS f32x4*)(orow + 512 * j) = o0; *(GAS f32x4*)(orow + 512 * j + 4) = o1; }
        }
}
struct Args { const float* in[24]; float* out; unsigned char* ws; };
#ifndef MK_EN_MASK
#define MK_EN_MASK 0xffffffffu
#endif
#define EN(k) (((MK_EN_MASK) >> (k)) & 1u)
#ifndef RP_G1
#define RP_G1 1
#endif
#ifndef RP_ATT
#define RP_ATT 1
#endif
#ifndef RP_ML
#define RP_ML 1
#endif
#ifndef RP_N2
#define RP_N2 1
#endif
#ifndef RP_CW
#define RP_CW 1
#endif
#ifndef RP_C
#define RP_C 1
#endif
#ifndef RP_D
#define RP_D 1
#endif
#ifndef RP_CV
#define RP_CV 1
#endif
#ifndef RP_PB
#define RP_PB 1
#endif
#ifndef RP_VT
#define RP_VT 1
#endif
#ifndef RP_PA
#define RP_PA 1
#endif
#ifndef RP_SC
#define RP_SC 1
#endif
#ifndef RP_SG
#define RP_SG 1
#endif
#ifndef ML_SKIP
#define ML_SKIP 0
#endif
#ifndef RP_X5
#define RP_X5 1
#endif
#ifndef RP_E
#define RP_E 1
#endif
#ifndef RP_HM
#define RP_HM 1
#endif
#ifndef RP_P1
#define RP_P1 1
#endif
#ifndef RP_SD
#define RP_SD 1
#endif
#ifndef N2_SKIP
#define N2_SKIP 0
#endif
#ifndef MK_LAST_PHASE
#define MK_LAST_PHASE 1000
#endif
__global__ void __launch_bounds__(512, 2) mk_fwd(Args args) {
    extern __shared__ __attribute__((aligned(16))) unsigned char lds_raw[];
    Frame F;
    F.lds = (LAS unsigned char*)lds_raw;
    const int wave0 = __builtin_amdgcn_readfirstlane((int)threadIdx.x >> 6);
#define RELOAD_IDS() do { int l_ = lane_now(); F.lane = l_; F.wave = wave0; F.tid = wave0 * 64 + l_; } while (0)
    RELOAD_IDS();
    F.G = gridDim.x; F.c = blockIdx.x;
    F.out = args.out; F.ws = args.ws;
    if (F.tid < 16) ((LAS unsigned*)(F.lds + LDS_CTL))[F.tid] = 0u;
#pragma unroll
    for (int i = 0; i < 24; ++i) if (F.tid == 64 + i) *(LAS unsigned long long*)(F.lds + LDS_CTL + 64 + 8 * i) = (unsigned long long)args.in[i];
    __syncthreads();
    XcdBarrier bar = xcd_barrier_post((unsigned*)wsp(F, WS_CTL) + CW_BAR, (volatile LAS unsigned*)(F.lds + LDS_CTL));
#define P6 ((bf16*)wsp(F, WS_P6))
#define VT ((bf16*)wsp(F, WS_VT))
#define R2 ((bf16*)wsp(F, WS_R2))
#define MODF ((const float*)wsp(F, WS_MODF))
#define GRID_BAR() do { XcdBarrier b_ = bar; asm volatile("" : "+s"(b_.bar), "+s"(b_.x)); xcd_barrier(b_); } while (0)
    int phase_no = 0;
#ifndef RP_BAR
#define RP_BAR 1
#endif
#define PHASE_END() do { for (int rb_ = 0; rb_ < RP_BAR; ++rb_) GRID_BAR(); RELOAD_IDS(); if (++phase_no >= MK_LAST_PHASE) goto finish; } while (0)

    if (EN(0)) { mod_partials(F);
    for (int rp = 0; rp < RP_CW; ++rp) { RELOAD_IDS(); conv_weights(F, 0); } }
    PHASE_END();
    for (int rp = 0; rp < RP_P1; ++rp) if (EN(1)) phase_norm1_first(F);
    PHASE_END();

#pragma unroll
    for (int l = 0; l < NLAYER; ++l) {
        if (EN(2)) { phase_mlstm_scalars(F); RELOAD_IDS(); }
        for (int rp = 0; rp < RP_G1; ++rp) if (EN(2)) {
            pg8::Gemm g{R2, (const bf16*)wsp(F, WS_BIN), 1024, 1024}; pg8::StaticOrder S; S.init(NTOK, P6W, F.G, F.c, F.wave);
            EpiPlain E{P6, P6W};
            pg8::gemm_phase<EpiPlain, pg8::StaticOrder, true, false>(F.lds, g, S, E);
        }
        for (int rp = 0; rp < RP_VT; ++rp) if (EN(3)) {
            pg8::Gemm g{(const bf16*)wsp(F, WS_AIN), R2, 1024, 1024}; pg8::StaticOrder S; S.init(2048, NTOK, F.G, F.c, F.wave);
            EpiPlain E{VT, NTOK};
            pg8::gemm_phase<EpiPlain, pg8::StaticOrder, true, false>(F.lds, g, S, E);
        }
        PHASE_END();
        for (int pass = 0; pass < 2; ++pass) {
            if (((pass ^ F.c) & 1) == 0) { for (int rp = 0; rp < RP_CV; ++rp) if (EN(4)) phase_cvp(F, l); }
            else { for (int rp = 1; rp < RP_ATT; ++rp) phase_attn(F, false); if (EN(5)) phase_attn(F, true); }
            RELOAD_IDS();
        }
        PHASE_END();
        for (int rp = 0; rp < RP_ML; ++rp) if (EN(6)) phase_mlstm(F, (RP_ML > 1 && rp == 0) ? ML_SKIP : 0);
        PHASE_END();
        for (int pass = 0; pass < 2; ++pass) {
            if (((pass ^ F.c) & 1) == 0) { for (int rp = 1; rp < RP_HM; ++rp) phase_hm_final(F, l, false); if (EN(7)) phase_hm_final(F, l, true); }
            else {
        for (int rp = 0; rp < RP_PB; ++rp) if (EN(8)) {
            pg8::Gemm g{P6 + P_SQ, (const bf16*)wsp(F, WS_BB), 1024, P6W}; pg8::StaticOrder S; S.init(NTOK, 1024, F.G, F.c, F.wave);
            EpiGateT1 E{P6 + P_GB, P6W, (bf16*)wsp(F, WS_VT)};
            pg8::gemm_phase<EpiGateT1, pg8::StaticOrder, true, false>(F.lds, g, S, E);
        }
            }
            RELOAD_IDS();
        }
        PHASE_END();
        for (int rp = 0; rp < RP_PA; ++rp) if (EN(9)) {
            pg8::Gemm g{P6 + P_MQK, (const bf16*)wsp(F, WS_BA), 1024, P6W}; pg8::StaticOrder S; S.init(NTOK, 1024, F.G, F.c, F.wave);
            EpiGateY E{P6 + P_GA, P6W, (const bf16*)wsp(F, WS_VT), R2};
            pg8::gemm_phase<EpiGateY, pg8::StaticOrder, true, false>(F.lds, g, S, E);
        }
        PHASE_END();
        for (int rp = 0; rp < RP_X5; ++rp) if (EN(10)) {
            pg8::Gemm g{R2, (const bf16*)wsp(F, WS_BO), 1024, 1024}; pg8::StaticOrder S; S.init(NTOK, 1024, F.G, F.c, F.wave);
            EpiRes E{(const bf16*)outp(F), xmid(F, l), MODF + (size_t)(l * 4) * 6144 + 2 * 1024, (RP_X5 > 1 && rp + 1 < RP_X5) ? 1 : 0};
            pg8::gemm_phase<EpiRes, pg8::StaticOrder, true, false>(F.lds, g, S, E);
        }
        PHASE_END();
        for (int rp = 0; rp < RP_N2; ++rp) if (EN(11)) phase_norm2_router(F, l, (RP_N2 > 1 && rp == 0) ? N2_SKIP : 0);
        PHASE_END();
        for (int rp = 0; rp < RP_SC; ++rp) if (EN(12)) phase_scatter(F);
        PHASE_END();
        {
            const int* TILEE = (const int*)wsp(F, WS_TILEE); const unsigned* STOK = (const unsigned*)wsp(F, WS_STOK);
            const int ntiles = TILEE[1000];
            LAS int* tabE = (LAS int*)(F.lds + LDS_TAB); LAS unsigned* tabTok = (LAS unsigned*)(F.lds + LDS_TAB + 64);
            LAS float* tabW = (LAS float*)(F.lds + LDS_TAB + 64 + 3072); const float* SWp = (const float*)wsp(F, WS_SW);
            for (int i = 0; i < 3; ++i) { const int pm = i * F.G + F.c; if (pm < ntiles) { if (F.tid == 0) tabE[i] = TILEE[pm]; if (F.tid < 256) { tabTok[i * 256 + F.tid] = STOK[(size_t)pm * 256 + F.tid]; tabW[i * 256 + F.tid] = SWp[(size_t)pm * 256 + F.tid]; } } }
            __syncthreads();
            for (int rp = 0; rp < RP_C; ++rp) if (EN(13)) {
                pg8::Gemm g{(const bf16*)wsp(F, WS_R1), (const bf16*)wsp(F, WS_BGU), 1024, 1024}; RoutedOrder S{ntiles, F.G, F.c, tabE, tabTok, F.wave};
                EpiHid E{R2, 128, tabW, F.c, F.G, 0};
                pg8::gemm_phase<EpiHid, RoutedOrder, true, true>(F.lds, g, S, E);
            }
            for (int rp = 0; rp < RP_SG; ++rp) if (EN(14)) {
                pg8::Gemm g{(const bf16*)wsp(F, WS_R1), (const bf16*)wsp(F, WS_BSGU), 1024, 1024}; pg8::StaticOrder S; S.init(NTOK, 512, F.G, F.G - 1 - F.c, F.wave);
                EpiHid E{(bf16*)wsp(F, WS_R3), 256, nullptr, 0, 1, 1};
                pg8::gemm_phase<EpiHid, pg8::StaticOrder, true, false>(F.lds, g, S, E);
            }
        }
        PHASE_END();
        {
            const int* TILEE = (const int*)wsp(F, WS_TILEE);
            const int ntiles = TILEE[1000], nunits = 4 * ntiles;
            const int v = (F.G % 8 == 0) ? (F.c % 8) * (F.G / 8) + F.c / 8 : F.c;
            LAS int* tabE = (LAS int*)(F.lds + LDS_TAB);
            if (F.tid < 16) { const int L = F.tid * F.G + v; tabE[F.tid] = (L < nunits) ? TILEE[L >> 2] : 0; }
            LAS unsigned* tabD = (LAS unsigned*)(F.lds + LDS_TAB + 64); const unsigned* SDp = (const unsigned*)wsp(F, WS_SDST);
            for (int i = 0; i < 10; ++i) { const int L = i * F.G + v; if (L < nunits && F.tid < 256) tabD[i * 256 + F.tid] = SDp[(size_t)(L >> 2) * 256 + F.tid]; }
            __syncthreads();
            for (int rp = 0; rp < RP_D; ++rp) if (EN(15)) {
                pg8::Gemm g{R2, (const bf16*)wsp(F, WS_BD), 128, 128}; DownOrder S{nunits, F.G, v, tabE, F.wave};
                EpiScatter E{(bf16*)wsp(F, WS_R1), tabD, v, F.G, (RP_D > 1 && rp > 0) ? 1 : 0};
                pg8::gemm_phase<EpiScatter, DownOrder, true, false>(F.lds, g, S, E);
            }
            for (int rp = 0; rp < RP_SD; ++rp) if (EN(16)) {
                pg8::Gemm g{(const bf16*)wsp(F, WS_R3), (const bf16*)wsp(F, WS_BSD), 256, 256}; pg8::StaticOrder S; S.init(NTOK, 1024, F.G, F.c, F.wave);
                EpiPlain E{(bf16*)wsp(F, WS_R1 + 128 * MiB), 1024};
                pg8::gemm_phase<EpiPlain, pg8::StaticOrder, true, false>(F.lds, g, S, E);
            }
        }
        PHASE_END();
        for (int rp = 1; rp < RP_E; ++rp) phase_combine(F, l, false);
        if (EN(17)) phase_combine(F, l, true);
        if (l + 1 < NLAYER) { RELOAD_IDS(); if (EN(18)) conv_weights(F, l + 1); PHASE_END(); }
    }
#undef P6
#undef VT
#undef R2
#undef MODF
finish:
    if (MK_LAST_PHASE < 1000) dbg_final(F, phase_no >= 8 ? (const float*)outp(F) : inp(F, I_X));
}

extern "C" void kernel_launch(void* const* d_in, const int* in_sizes, int n_in, void* d_out, int out_size, void* d_ws, size_t ws_size, hipStream_t stream) {
    static int grid = 0;
    if (grid == 0) {
        if (n_in != 24 || in_sizes[0] != NTOK * DM || out_size != NTOK * DM || ws_size < WS_END) {
            fprintf(stderr, "kernel_launch: unexpected shapes (n_in %d, in0 %d, out %d, ws %zu < %zu); nothing launched\n", n_in, n_in > 0 ? in_sizes[0] : -1, out_size, ws_size, (size_t)WS_END); grid = -1; return; }
        int dev = 0, cus = 0, per_cu = 0;
        if (hipGetDevice(&dev) != hipSuccess || hipDeviceGetAttribute(&cus, hipDeviceAttributeMultiprocessorCount, dev) != hipSuccess) { grid = -1; return; }
        if (hipFuncSetAttribute((const void*)mk_fwd, hipFuncAttributeMaxDynamicSharedMemorySize, LDS_BYTES) != hipSuccess) { fprintf(stderr, "kernel_launch: hipFuncSetAttribute failed\n"); grid = -1; return; }
        if (hipOccupancyMaxActiveBlocksPerMultiprocessor(&per_cu, (const void*)mk_fwd, 512, LDS_BYTES) != hipSuccess || per_cu < 1)
            fprintf(stderr, "kernel_launch: note: occupancy query reports %d workgroups per CU\n", per_cu);
        (void)hipGetLastError();
        grid = cus;
    }
    if (grid < 0) return;
    if (hipMemsetAsync((char*)d_ws + WS_CTL, 0, CTL_ZERO_BYTES, stream) != hipSuccess) return;
    Args a{};
    for (int i = 0; i < 24; ++i) a.in[i] = (const float*)d_in[i];
    a.out = (float*)d_out; a.ws = (unsigned char*)d_ws;
    hipLaunchKernelGGL(mk_fwd, dim3(grid), dim3(512), LDS_BYTES, stream, a);
}
```

```cpp
#include <hip/hip_runtime.h>
#include <cstdio>
#include <cstdint>
#include <cmath>
namespace pg8 {
#define PG8_LAS __attribute__((address_space(3)))
typedef unsigned short bf16_t;
typedef short bf16x8 __attribute__((ext_vector_type(8)));
typedef float f32x4 __attribute__((ext_vector_type(4)));
typedef unsigned u32x4 __attribute__((ext_vector_type(4)));
constexpr int BM = 256, BK = 64, HALF = 128, HTB = HALF * BK * 2  , STAGE_BYTES = 8 * HTB, NXCD = 8, WGM = 8;

__host__ __device__ __forceinline__ int lds_byte(int r, int c) { const int st = (r >> 4) * 2 + (c >> 5), rr = r & 15, cc = c & 31, ob = rr * 64 + cc * 2; return st * 1024 + (ob ^ (((ob >> 9) & 1) << 5)); }
__host__ __device__ __forceinline__ void stage_rc(int b, int& R, int& C) { const int st = b / 1024, sb = b % 1024, swz = sb ^ (((sb >> 9) & 1) << 5); R = (st >> 1) * 16 + swz / 64; C = (st & 1) * 32 + (swz % 64) / 2; }
__host__ __device__ __forceinline__ int perm32(int rho) { const int n = rho >> 4, i = rho & 15; return 8 * (i >> 2) + 4 * n + (i & 3); }

struct Unit { int pm, pn; };
struct Gemm { const bf16_t* A; const bf16_t* Bt; int K; int lda; };

struct StaticOrder {
    int nM, nN, nwg, G, c, wave;
    __device__ void init(int M, int N, int G_, int c_, int wave_) { nM = M / BM; nN = N / BM; nwg = nM * nN; G = G_; c = c_; wave = wave_; }
    __device__ bool next(int i, Unit& u) const {
        const long L = (long)i * G + c; if (L >= nwg) return false;
        int wgid = (int)L; { const int q = nwg / NXCD, r = nwg % NXCD, xcd = wgid % NXCD, off = wgid / NXCD; wgid = (xcd < r ? xcd * (q + 1) : r * (q + 1) + (xcd - r) * q) + off; }
        const int nig = WGM * nN, gid = wgid / nig, fm = gid * WGM, gsz = (nM - fm) < WGM ? (nM - fm) : WGM;
        u.pm = fm + ((wgid % nig) % gsz); u.pn = (wgid % nig) / gsz; return true;
    }
    __device__ __forceinline__ unsigned rowtok(int, int) const { return 0u; }
};

template <class Epi, class Sched, bool ALIGN_EPI, bool GATHER>
__device__ __forceinline__ void gemm_phase(PG8_LAS unsigned char* lds, const Gemm g, const Sched& S, const Epi& E) {
    int lane_; asm volatile("v_mbcnt_lo_u32_b32 %0, -1, 0\n\tv_mbcnt_hi_u32_b32 %0, -1, %0" : "=v"(lane_));
    const int wid = S.wave, lane = lane_, tid = wid * 64 + lane, wr = wid >> 2, wc = wid & 3, fr = lane & 15, fq = lane >> 4;
    int K_ = g.K, lda_ = g.lda; asm volatile("" : "+s"(K_), "+s"(lda_));
    const int K = K_, nt = K / BK, lda = lda_;
    unsigned vA[2][2], voffB[2];
#pragma unroll
    for (int i = 0; i < 2; ++i) { int R, C; stage_rc(tid * 16 + i * 8192, R, C); const int Rb = Epi::PERM ? ((R & ~31) + perm32(R & 31)) : R;
        voffB[i] = (unsigned)(Rb * K + C) * 2u;
#pragma unroll
        for (int h = 0; h < 2; ++h) vA[h][i] = (unsigned)(((GATHER ? h * HALF : 0) + R) * lda + C) * 2u; }
    const size_t kstep = (size_t)(BK * 2);
    const size_t hstepB = (size_t)HALF * K * 2, tstepB = 2 * hstepB;
    const size_t tstepA = (size_t)BM * lda * 2, hstepA = (size_t)HALF * lda * 2;
    const unsigned ldsw = (unsigned)wid * 1024u;
    const int aoff = lds_byte(wr * 64 + fr, fq * 8), boff = lds_byte(wc * 32 + fr, fq * 8);
#define PG8_SA(b, h) (((b) * 2 + (h)) * HTB)
#define PG8_SB(b, h) ((4 + (b) * 2 + (h)) * HTB)
#define PG8_STAGE(bufoff, gbase, voff) do { _Pragma("unroll") for (int _i = 0; _i < 2; ++_i) \
        __builtin_amdgcn_global_load_lds((const unsigned*)((const char*)(gbase) + (voff)[_i]), (PG8_LAS unsigned*)(lds + (bufoff) + ldsw + _i * 8192), 16, 0, 0); } while (0)
#define PG8_GATHER_SET(ui_, h) do { int l2_; asm volatile("v_mbcnt_lo_u32_b32 %0, -1, 0\n\tv_mbcnt_hi_u32_b32 %0, -1, %0" : "=v"(l2_)); const int tid2_ = wid * 64 + l2_; _Pragma("unroll") for (int _i = 0; _i < 2; ++_i) { int R_, C_; stage_rc(tid2_ * 16 + _i * 8192, R_, C_); vA[h][_i] = (S.rowtok((ui_), (h) * HALF + R_) * (unsigned)lda + (unsigned)C_) * 2u; } } while (0)
#define PG8_STAGE_A(bufoff, gbase, h, NX) do { _Pragma("unroll") for (int _i = 0; _i < 2; ++_i) { const unsigned _v = GATHER ? vA[h][_i] : vA[0][_i]; \
        __builtin_amdgcn_global_load_lds((const unsigned*)((const char*)(gbase) + (GATHER ? (size_t)0 : (size_t)(h) * hstepA) + _v), (PG8_LAS unsigned*)(lds + (bufoff) + ldsw + _i * 8192), 16, 0, 0); } } while (0)
#define PG8_LDA(dst, b, h) do { _Pragma("unroll") for (int m = 0; m < 4; ++m) _Pragma("unroll") for (int k = 0; k < 2; ++k) dst[m][k] = *(const PG8_LAS bf16x8*)(lds + PG8_SA(b, h) + aoff + m * 2048 + k * 1024); } while (0)
#define PG8_LDB(dst, b, h) do { _Pragma("unroll") for (int n = 0; n < 2; ++n) _Pragma("unroll") for (int k = 0; k < 2; ++k) dst[n][k] = *(const PG8_LAS bf16x8*)(lds + PG8_SB(b, h) + boff + n * 2048 + k * 1024); } while (0)
#define PG8_MMA(ai, bj, At, Bt) do { __builtin_amdgcn_s_setprio(1); _Pragma("unroll") for (int m = 0; m < 4; ++m) _Pragma("unroll") for (int n = 0; n < 2; ++n) _Pragma("unroll") for (int k = 0; k < 2; ++k) \
        acc[ai][bj][m][n] = __builtin_amdgcn_mfma_f32_16x16x32_bf16(Bt[n][k], At[m][k], acc[ai][bj][m][n], 0, 0, 0); __builtin_amdgcn_s_setprio(0); } while (0)
#define PG8_WAIT_V(n) asm volatile("s_waitcnt vmcnt(" #n ")" ::: "memory")
#define PG8_WAIT_L(n) asm volatile("s_waitcnt lgkmcnt(" #n ")" ::: "memory")
#define PG8_BAR __builtin_amdgcn_s_barrier()
#define PG8_SCHED __builtin_amdgcn_sched_barrier(0)
    Unit cur, nxt; int ui = 0;
    if (!S.next(0, cur)) return;
    if constexpr (GATHER) { PG8_GATHER_SET(0, 0); PG8_GATHER_SET(0, 1); }
    f32x4 acc[2][2][4][2];
#pragma unroll
    for (int a = 0; a < 2; ++a)
#pragma unroll
        for (int b = 0; b < 2; ++b)
#pragma unroll
            for (int m = 0; m < 4; ++m)
#pragma unroll
                for (int n = 0; n < 2; ++n) acc[a][b][m][n] = (f32x4){0.f, 0.f, 0.f, 0.f};
    bf16x8 At[4][2], B0[2][2], B1[2][2];
    const char* cA = (const char*)g.A + (GATHER ? (size_t)0 : (size_t)cur.pm * tstepA); const char* cB = (const char*)g.Bt + (size_t)cur.pn * tstepB;
    PG8_STAGE(PG8_SB(0, 0), cB, voffB); PG8_STAGE(PG8_SB(0, 1), cB + hstepB, voffB); PG8_STAGE_A(PG8_SA(0, 0), cA, 0, false); PG8_STAGE_A(PG8_SA(0, 1), cA, 1, false);
    if (wr == 1) PG8_BAR;
    PG8_WAIT_V(2); PG8_BAR;
    PG8_STAGE(PG8_SB(1, 0), cB + kstep, voffB); PG8_STAGE_A(PG8_SA(1, 0), cA + kstep, 0, false); PG8_STAGE(PG8_SB(1, 1), cB + hstepB + kstep, voffB);
    PG8_WAIT_V(6); PG8_BAR;
    for (;;) {
        const bool has_next = S.next(ui + 1, nxt);
        const char* nA = (has_next && !GATHER) ? (const char*)g.A + (size_t)nxt.pm * tstepA : (GATHER ? (const char*)g.A : cA);
        const char* nB = has_next ? (const char*)g.Bt + (size_t)nxt.pn * tstepB : cB;
        for (int t = 0; t < nt; t += 2) {
            const bool last = (t == nt - 2);
            const char* a1 = cA + (size_t)(t + 1) * kstep;
            const char* a2 = last ? nA : cA + (size_t)(t + 2) * kstep; const char* b2 = last ? nB : cB + (size_t)(t + 2) * kstep;
            const char* a3 = a2 + kstep; const char* b3 = b2 + kstep;
            if constexpr (GATHER) { if (last && has_next) PG8_GATHER_SET(ui + 1, 0); }
            PG8_LDB(B0, 0, 0); PG8_LDB(B1, 0, 1); PG8_SCHED; PG8_LDA(At, 0, 0); PG8_STAGE_A(PG8_SA(1, 1), a1, 1, false);
            if constexpr (GATHER) { if (last && has_next) PG8_GATHER_SET(ui + 1, 1); }
            PG8_WAIT_V(8); PG8_WAIT_L(0); PG8_BAR; PG8_MMA(0, 0, At, B0); PG8_MMA(0, 1, At, B1); PG8_BAR; PG8_SCHED;
            PG8_LDA(At, 0, 1); PG8_STAGE(PG8_SB(0, 0), b2, voffB); PG8_STAGE(PG8_SB(0, 1), b2 + hstepB, voffB); PG8_STAGE_A(PG8_SA(0, 0), a2, 0, last);
            PG8_WAIT_V(8); PG8_WAIT_L(0); PG8_BAR; PG8_MMA(1, 0, At, B0); PG8_MMA(1, 1, At, B1); PG8_BAR; PG8_SCHED;
            PG8_LDB(B0, 1, 0); PG8_LDB(B1, 1, 1); PG8_SCHED; PG8_LDA(At, 1, 0); PG8_STAGE_A(PG8_SA(0, 1), a2, 1, last);
            PG8_WAIT_V(8); PG8_WAIT_L(0); PG8_BAR; PG8_MMA(0, 0, At, B0); PG8_MMA(0, 1, At, B1); PG8_BAR; PG8_SCHED;
            PG8_LDA(At, 1, 1); PG8_STAGE(PG8_SB(1, 0), b3, voffB); PG8_STAGE(PG8_SB(1, 1), b3 + hstepB, voffB); PG8_STAGE_A(PG8_SA(1, 0), a3, 0, last);
            PG8_WAIT_V(8); PG8_WAIT_L(0); PG8_BAR; PG8_MMA(1, 0, At, B0); PG8_MMA(1, 1, At, B1); PG8_BAR; PG8_SCHED;
        }
        if constexpr (ALIGN_EPI) { if (wr == 0) PG8_BAR; }
        { Unit eu; eu.pm = __builtin_amdgcn_readfirstlane(cur.pm); eu.pn = __builtin_amdgcn_readfirstlane(cur.pn); int fr_ = fr, fq_ = fq; asm volatile("" : "+s"(eu.pm), "+s"(eu.pn), "+v"(fr_), "+v"(fq_));
          E(acc, eu, wr, wc, fr_, fq_); }
        if (!has_next) break;
#pragma unroll
        for (int a = 0; a < 2; ++a)
#pragma unroll
            for (int b = 0; b < 2; ++b)
#pragma unroll
                for (int m = 0; m < 4; ++m)
#pragma unroll
                    for (int n = 0; n < 2; ++n) acc[a][b][m][n] = (f32x4){0.f, 0.f, 0.f, 0.f};
        cur = nxt; cA = nA; cB = nB; ++ui;
        if constexpr (ALIGN_EPI) { if (wr == 1) PG8_BAR; }
    }
    PG8_WAIT_V(0);
    if constexpr (!ALIGN_EPI) { if (wr == 0) PG8_BAR; }
    PG8_BAR;
#undef PG8_SA
#undef PG8_SB
#undef PG8_STAGE
#undef PG8_STAGE_A
#undef PG8_GATHER_SET
#undef PG8_LDA
#undef PG8_LDB
#undef PG8_MMA
#undef PG8_WAIT_V
#undef PG8_WAIT_L
#undef PG8_BAR
#undef PG8_SCHED
}
}

constexpr int NTOK = 16384, DM = 1024, SEQ = 4096, NB = 4, NLAYER = 2;
constexpr int INW = 8200;
constexpr int C_MQK = 0, C_MV = 1024, C_MO = 2048, C_MI = 3072, C_MF = 3076, C_SQ = 3080, C_SK = 4104, C_SV = 5128, C_GA = 6152, C_GB = 7176;
constexpr int P6W = 6144;
constexpr int P_MQK = 0, P_MO = 1024, P_SQ = 2048, P_SK = 3072, P_GA = 4096, P_GB = 5120;
constexpr int NEXP = 64, EFF = 128, SFF = 256, TOPK = 8;
constexpr int MAXROWS = NTOK * TOPK + NEXP * 256;
constexpr int MAXTILES = MAXROWS / 256;
constexpr float EPS = 1e-6f;
constexpr float LOG2E = 1.4426950408889634f;

constexpr size_t MiB = 1u << 20;
constexpr size_t WS_CTL = 0, CTL_ZERO_BYTES = 3456 * 4;
constexpr size_t WS_MODP = 1 * MiB;
constexpr size_t WS_MODF = 4 * MiB;
constexpr size_t WS_GATES = WS_MODF + 256 * 1024;
constexpr size_t WS_TOPE = WS_GATES + 512 * 1024;
constexpr size_t WS_TOPW = WS_TOPE + 512 * 1024;
constexpr size_t WS_CNT = WS_TOPW + 512 * 1024;
constexpr size_t WS_STOK = WS_CNT + 64 * 1024;
constexpr size_t WS_SW = WS_STOK + 576 * 1024;
constexpr size_t WS_SDST = WS_SW + 576 * 1024;
constexpr size_t WS_TILEE = WS_SDST + 576 * 1024;
constexpr size_t WS_MISC_END = WS_TILEE + 4096;
static_assert(WS_MISC_END <= 8 * MiB, "misc region");
constexpr size_t WS_BIN = 8 * MiB;
constexpr size_t WS_AIN = WS_BIN + 12 * MiB;
constexpr size_t WS_BA = WS_AIN + 4 * MiB, WS_BB = WS_BA + 2 * MiB, WS_BO = WS_BB + 2 * MiB;
constexpr size_t WS_BGU = WS_BO + 2 * MiB;
constexpr size_t WS_BD = WS_BGU + 32 * MiB;
constexpr size_t WS_BSGU = WS_BD + 16 * MiB;
constexpr size_t WS_BSD = WS_BSGU + 1 * MiB;
constexpr size_t WS_W_END = WS_BSD + 1 * MiB;
constexpr size_t WS_R1 = 80 * MiB;
constexpr size_t WS_P6 = WS_R1, WS_VT = WS_R1 + 192 * MiB;
constexpr size_t WS_R2 = WS_R1 + 256 * MiB;
constexpr size_t WS_R3 = WS_R2 + 36 * MiB;
constexpr size_t WS_PT = WS_R3 + 8 * MiB;
constexpr size_t WS_END = WS_PT + 18 * MiB;
static_assert(WS_W_END <= WS_R1, "weights region");
constexpr int CW_BAR = 0;

constexpr int LDS_BYTES = 147456;
constexpr int LDS_MAIN = 131072;
constexpr int LDS_TAB = 131072;
constexpr int LDS_CTL = LDS_BYTES - 512;

#define GAS __attribute__((address_space(1)))
#define LAS __attribute__((address_space(3)))
typedef unsigned short bf16;
typedef unsigned v4u __attribute__((ext_vector_type(4)));
typedef unsigned v2u __attribute__((ext_vector_type(2)));
typedef float f32x4 __attribute__((ext_vector_type(4)));
typedef float f32x16 __attribute__((ext_vector_type(16)));
typedef short bf16x8 __attribute__((ext_vector_type(8)));
typedef short s16x4 __attribute__((ext_vector_type(4)));
typedef GAS unsigned gu32;
#define RLX_AGENT __ATOMIC_RELAXED, __HIP_MEMORY_SCOPE_AGENT
#define LDS_WAIT() asm volatile("s_waitcnt lgkmcnt(0)" ::: "memory")
typedef float f32x2_t __attribute__((ext_vector_type(2))); typedef __bf16 bf16x2_t __attribute__((ext_vector_type(2)));
__device__ __forceinline__ unsigned pk2(float lo, float hi) { f32x2_t v = {lo, hi}; bf16x2_t b = __builtin_convertvector(v, bf16x2_t); return __builtin_bit_cast(unsigned, b); }
__device__ __forceinline__ unsigned short f2bf(float f) { return (unsigned short)(pk2(f, 0.f) & 0xffffu); }
__device__ __forceinline__ float bflo(unsigned w) { return __uint_as_float(w << 16); }
__device__ __forceinline__ float bfhi(unsigned w) { return __uint_as_float(w & 0xffff0000u); }
__device__ __forceinline__ float bf2f(unsigned short h) { return __uint_as_float((unsigned)h << 16); }
__device__ __forceinline__ float sigmoidf_(float x) { return __builtin_amdgcn_rcpf(1.f + __builtin_amdgcn_exp2f(-x * LOG2E)); }
__device__ __forceinline__ int crow(int r, int hi) { return (r & 3) + 8 * (r >> 2) + 4 * hi; }
__device__ __forceinline__ int lane_now() { int l; asm volatile("v_mbcnt_lo_u32_b32 %0, -1, 0\n\tv_mbcnt_hi_u32_b32 %0, -1, %0" : "=v"(l)); return l; }
__device__ __forceinline__ float shfl_xor_l(float v, int d, int lane) { return __int_as_float(__builtin_amdgcn_ds_bpermute((lane ^ d) << 2, __float_as_int(v))); }
__device__ __forceinline__ float shfl_up_l(float v, int d, int lane) { return __int_as_float(__builtin_amdgcn_ds_bpermute(((lane - d) & 63) << 2, __float_as_int(v))); }
__device__ __forceinline__ unsigned umax_(unsigned a, unsigned b) { return a > b ? a : b; }
__device__ __forceinline__ unsigned wave_umax_all(unsigned v) {
    v = umax_(v, (unsigned)__builtin_amdgcn_update_dpp(0, (int)v, 0x128, 0xf, 0xf, false));
    v = umax_(v, (unsigned)__builtin_amdgcn_update_dpp(0, (int)v, 0x124, 0xf, 0xf, false));
    v = umax_(v, (unsigned)__builtin_amdgcn_update_dpp(0, (int)v, 0x122, 0xf, 0xf, false));
    v = umax_(v, (unsigned)__builtin_amdgcn_update_dpp(0, (int)v, 0x121, 0xf, 0xf, false));
    { auto rr = __builtin_amdgcn_permlane16_swap(v, v, false, false); v = umax_(rr[0], rr[1]); }
    { auto rr = __builtin_amdgcn_permlane32_swap(v, v, false, false); v = umax_(rr[0], rr[1]); }
    return v;
}
__device__ __forceinline__ float wave_sum(float v, int lane) {
#pragma unroll
    for (int o = 1; o < 64; o <<= 1) v += shfl_xor_l(v, o, lane);
    return v;
}

#define XB_TMO      128
#define XB_XCNT(j)  (256  + 64 * (j))
#define XB_XSUB(j)  (1280 + 64 * (j))
#define XB_XGEN(j)  (2304 + 64 * (j))
#define XB_TOP      3328
#define XB_TOPGEN   3392
#define XCD_BAR_WORDS 3456
#define XB_SPIN_CAP (1u << 18)
__device__ __forceinline__ unsigned xb_ld(unsigned* p)              { return __hip_atomic_load(p, __ATOMIC_RELAXED, __HIP_MEMORY_SCOPE_AGENT); }
__device__ __forceinline__ unsigned xb_add(unsigned* p, unsigned v) { return __hip_atomic_fetch_add(p, v, __ATOMIC_RELAXED, __HIP_MEMORY_SCOPE_AGENT); }
__device__ __forceinline__ unsigned xb_xcc_id() { return (unsigned)__builtin_amdgcn_s_getreg((3 << 11) | 20) & 0xFu; }
#define XB_SPIN(cond, bar) do { unsigned _sp = 0; while (cond) { __builtin_amdgcn_s_sleep(1); \
    if ((++_sp & 255u) == 0u) { if (xb_ld(&(bar)[XB_TMO])) break; if (_sp > XB_SPIN_CAP) { atomicAdd(&(bar)[XB_TMO], 1u); break; } } } } while (0)
struct XcdBarrier { unsigned* bar; unsigned x; volatile LAS unsigned* st; };
__device__ __forceinline__ XcdBarrier xcd_barrier_post(unsigned* bar, volatile LAS unsigned* st) {
    XcdBarrier b; b.bar = bar; b.x = xb_xcc_id(); b.st = st;
    if (threadIdx.x == 0) (void)xb_add(&bar[XB_XCNT(b.x)], 1u);
    return b;
}
__device__ __forceinline__ void xcd_barrier_complete(unsigned* bar, unsigned x, unsigned& nloc, unsigned& nx) {
    const unsigned G = gridDim.x * gridDim.y * gridDim.z;
    unsigned sum, cnt, mine, sp = 0u;
    for (;;) {
        sum = 0u; cnt = 0u; mine = 0u;
#pragma unroll
        for (unsigned j = 0; j < 16; ++j) { const unsigned c = xb_ld(&bar[XB_XCNT(j)]); sum += c; cnt += (c > 0u) ? 1u : 0u; mine = (j == x) ? c : mine; }
        if (sum == G) break;
        __builtin_amdgcn_s_sleep(1);
        if ((++sp & 255u) == 0u) { if (xb_ld(&bar[XB_TMO])) break; if (sp > XB_SPIN_CAP) { atomicAdd(&bar[XB_TMO], 1u); break; } }
    }
    nloc = mine > 0u ? mine : 1u; nx = cnt > 0u ? cnt : 1u;
}
__device__ __forceinline__ void xcd_barrier(const XcdBarrier& b) {
    asm volatile("s_waitcnt vmcnt(0)" ::: "memory");
    __syncthreads();
    if (threadIdx.x == 0) {
        unsigned* bar = b.bar;
        __builtin_amdgcn_s_waitcnt(0);
        unsigned nloc = b.st[0], nx = b.st[1];
        if (nloc == 0u) { xcd_barrier_complete(bar, b.x, nloc, nx); b.st[0] = nloc; b.st[1] = nx; }
        const unsigned old = xb_add(&bar[XB_XSUB(b.x)], 1u);
        const unsigned gen = old / nloc;
        if (old + 1u == (gen + 1u) * nloc) {
            __builtin_amdgcn_fence(__ATOMIC_RELEASE, "agent");
            asm volatile("s_waitcnt vmcnt(0)" ::: "memory");
            const unsigned og = xb_add(&bar[XB_TOP], 1u);
            const unsigned tg = og / nx;
            if (og + 1u == (tg + 1u) * nx) xb_add(&bar[XB_TOPGEN], 1u);
            else XB_SPIN(xb_ld(&bar[XB_TOPGEN]) == tg, bar);
            __builtin_amdgcn_fence(__ATOMIC_ACQUIRE, "agent");
            xb_add(&bar[XB_XGEN(b.x)], 1u);
            asm volatile("s_waitcnt vmcnt(0)" ::: "memory");
        } else {
            XB_SPIN(xb_ld(&bar[XB_XGEN(b.x)]) == gen, bar);
            __builtin_amdgcn_fence(__ATOMIC_ACQUIRE, "agent");
            asm volatile("s_waitcnt vmcnt(0)" ::: "memory");
        }
    }
    __syncthreads();
}

struct Frame {
    LAS unsigned char* lds;
    int tid, lane, wave, G, c;
    float* out; unsigned char* ws;
};
__device__ __forceinline__ unsigned char* wsp(const Frame& F, size_t off) { unsigned char* p = F.ws; asm volatile("" : "+s"(p)); return (unsigned char*)(GAS unsigned char*)(p + off); }
__device__ __forceinline__ float* outp(const Frame& F) { float* p = F.out; asm volatile("" : "+s"(p)); return (float*)(GAS float*)p; }
__device__ __forceinline__ const float* inp(const Frame& F, int i) {
    const LAS unsigned* p = (const LAS unsigned*)(F.lds + LDS_CTL + 64) + 2 * i;
    const unsigned lo = __builtin_amdgcn_readfirstlane(p[0]), hi = __builtin_amdgcn_readfirstlane(p[1]);
    return (const float*)(const GAS float*)(((unsigned long long)hi << 32) | lo);
}
__device__ __forceinline__ bf16* xmid(const Frame& F, int l) { return (l == NLAYER - 1) ? (bf16*)wsp(F, WS_VT) : (bf16*)outp(F); }
enum { I_X = 0, I_C, I_ADAW, I_ADAB, I_N1W, I_WIN, I_CONVW, I_CONVB, I_IGB, I_FGB, I_MNW, I_WPA, I_WPB, I_WOUT, I_N2W, I_RW, I_RB, I_WG, I_WU, I_WD, I_SG, I_SU, I_SD, I_FNW };

#define EPI_LOOP_BEGIN \
    _Pragma("unroll") for (int ai = 0; ai < 2; ++ai) _Pragma("unroll") for (int m = 0; m < 4; ++m) { const int rl = ai * 128 + wr * 64 + m * 16 + fr; (void)rl; \
    _Pragma("unroll") for (int bj = 0; bj < 2; ++bj) { const int cl = bj * 128 + wc * 32 + 8 * fq; (void)cl; const pg8::f32x4 v0 = acc[ai][bj][m][0], v1 = acc[ai][bj][m][1];
#define EPI_LOOP_END } }

struct EpiPlain {
    static constexpr bool PERM = true;
    bf16* O; int ldc;
    __device__ __forceinline__ void operator()(const pg8::f32x4 (&acc)[2][2][4][2], const pg8::Unit& u, int wr, int wc, int fr, int fq) const {
        EPI_LOOP_BEGIN
            v4u w; w.x = pk2(v0[0], v0[1]); w.y = pk2(v0[2], v0[3]); w.z = pk2(v1[0], v1[1]); w.w = pk2(v1[2], v1[3]);
            *(GAS v4u*)(O + (size_t)(u.pm * 256 + rl) * ldc + u.pn * 256 + cl) = w;
        EPI_LOOP_END
    }
};
#define SG8(q_, v0_, v1_, o0_, o1_, OP) do { \
        o0_[0] = OP(sigmoidf_(bflo(q_.x)) * v0_[0], 0); o0_[1] = OP(sigmoidf_(bfhi(q_.x)) * v0_[1], 1); o0_[2] = OP(sigmoidf_(bflo(q_.y)) * v0_[2], 2); o0_[3] = OP(sigmoidf_(bfhi(q_.y)) * v0_[3], 3); \
        o1_[0] = OP(sigmoidf_(bflo(q_.z)) * v1_[0], 4); o1_[1] = OP(sigmoidf_(bfhi(q_.z)) * v1_[1], 5); o1_[2] = OP(sigmoidf_(bflo(q_.w)) * v1_[2], 6); o1_[3] = OP(sigmoidf_(bfhi(q_.w)) * v1_[3], 7); } while (0)
struct EpiGateT1 {
    static constexpr bool PERM = true;
    const bf16* Gt; int gld; bf16* T1;
    __device__ __forceinline__ void operator()(const pg8::f32x4 (&acc)[2][2][4][2], const pg8::Unit& u, int wr, int wc, int fr, int fq) const {
#pragma unroll
        for (int ai = 0; ai < 2; ++ai) {
            v4u gq[4][2];
#pragma unroll
            for (int m = 0; m < 4; ++m)
#pragma unroll
                for (int bj = 0; bj < 2; ++bj) { const size_t row = (size_t)(u.pm * 256 + ai * 128 + wr * 64 + m * 16 + fr); const int col = u.pn * 256 + bj * 128 + wc * 32 + 8 * fq; gq[m][bj] = *(const GAS v4u*)(Gt + row * gld + col); }
#pragma unroll
            for (int m = 0; m < 4; ++m)
#pragma unroll
                for (int bj = 0; bj < 2; ++bj) { const size_t row = (size_t)(u.pm * 256 + ai * 128 + wr * 64 + m * 16 + fr); const int col = u.pn * 256 + bj * 128 + wc * 32 + 8 * fq;
                    const pg8::f32x4 v0 = acc[ai][bj][m][0], v1 = acc[ai][bj][m][1]; f32x4 o0, o1;
#define OPN(x_, i_) (x_)
                    SG8(gq[m][bj], v0, v1, o0, o1, OPN);
#undef OPN
                    v4u tw; tw.x = pk2(o0[0], o0[1]); tw.y = pk2(o0[2], o0[3]); tw.z = pk2(o1[0], o1[1]); tw.w = pk2(o1[2], o1[3]);
                    *(GAS v4u*)(T1 + row * 1024 + col) = tw; }
        }
    }
};
struct EpiGateY {
    static constexpr bool PERM = true;
    const bf16* Gt; int gld; const bf16* T1; bf16* Y;
    __device__ __forceinline__ void operator()(const pg8::f32x4 (&acc)[2][2][4][2], const pg8::Unit& u, int wr, int wc, int fr, int fq) const {
#pragma unroll
        for (int ai = 0; ai < 2; ++ai) {
            v4u gq[4][2], tq[4][2];
#pragma unroll
            for (int m = 0; m < 4; ++m)
#pragma unroll
                for (int bj = 0; bj < 2; ++bj) { const size_t row = (size_t)(u.pm * 256 + ai * 128 + wr * 64 + m * 16 + fr); const int col = u.pn * 256 + bj * 128 + wc * 32 + 8 * fq;
                    gq[m][bj] = *(const GAS v4u*)(Gt + row * gld + col); tq[m][bj] = *(const GAS v4u*)(T1 + row * 1024 + col); }
#pragma unroll
            for (int m = 0; m < 4; ++m)
#pragma unroll
                for (int bj = 0; bj < 2; ++bj) { const size_t row = (size_t)(u.pm * 256 + ai * 128 + wr * 64 + m * 16 + fr); const int col = u.pn * 256 + bj * 128 + wc * 32 + 8 * fq;
                    const pg8::f32x4 v0 = acc[ai][bj][m][0], v1 = acc[ai][bj][m][1]; f32x4 o0, o1;
                    const v4u t4 = tq[m][bj]; const float tt[8] = {bflo(t4.x), bfhi(t4.x), bflo(t4.y), bfhi(t4.y), bflo(t4.z), bfhi(t4.z), bflo(t4.w), bfhi(t4.w)};
#define OPT(x_, i_) (tt[i_] + (x_))
                    SG8(gq[m][bj], v0, v1, o0, o1, OPT);
#undef OPT
                    v4u w; w.x = pk2(o0[0], o0[1]); w.y = pk2(o0[2], o0[3]); w.z = pk2(o1[0], o1[1]); w.w = pk2(o1[2], o1[3]);
                    *(GAS v4u*)(Y + row * 1024 + col) = w; }
        }
    }
};
#undef SG8
struct EpiRes {
    static constexpr bool PERM = true;
    const bf16* xin; bf16* out; const float* gv; int nostore;
    __device__ __forceinline__ void operator()(const pg8::f32x4 (&acc)[2][2][4][2], const pg8::Unit& u, int wr, int wc, int fr, int fq) const {
        const float* gb = gv + (size_t)(u.pm >> 4) * 6144;
        f32x4 g0[2], g1[2];
#pragma unroll
        for (int bj = 0; bj < 2; ++bj) { const int col = u.pn * 256 + bj * 128 + wc * 32 + 8 * fq; g0[bj] = *(const GAS f32x4*)(gb + col); g1[bj] = *(const GAS f32x4*)(gb + col + 4); }
#pragma unroll
        for (int ai = 0; ai < 2; ++ai)
#pragma unroll
            for (int mh = 0; mh < 2; ++mh) {
                v4u xb[2][2];
#pragma unroll
                for (int mm = 0; mm < 2; ++mm)
#pragma unroll
                    for (int bj = 0; bj < 2; ++bj) { const size_t row = (size_t)(u.pm * 256 + ai * 128 + wr * 64 + (2 * mh + mm) * 16 + fr); const int col = u.pn * 256 + bj * 128 + wc * 32 + 8 * fq;
                        xb[mm][bj] = *(const GAS v4u*)(xin + row * 1024 + col); }
#pragma unroll
                for (int mm = 0; mm < 2; ++mm)
#pragma unroll
                    for (int bj = 0; bj < 2; ++bj) { const int m = 2 * mh + mm; const size_t row = (size_t)(u.pm * 256 + ai * 128 + wr * 64 + m * 16 + fr); const int col = u.pn * 256 + bj * 128 + wc * 32 + 8 * fq;
                        const v4u x = xb[mm][bj]; const f32x4 a0 = acc[ai][bj][m][0], a1 = acc[ai][bj][m][1];
                        v4u o;
                        o.x = pk2(bflo(x.x) + g0[bj][0] * a0[0], bfhi(x.x) + g0[bj][1] * a0[1]); o.y = pk2(bflo(x.y) + g0[bj][2] * a0[2], bfhi(x.y) + g0[bj][3] * a0[3]);
                        o.z = pk2(bflo(x.z) + g1[bj][0] * a1[0], bfhi(x.z) + g1[bj][1] * a1[1]); o.w = pk2(bflo(x.w) + g1[bj][2] * a1[2], bfhi(x.w) + g1[bj][3] * a1[3]);
                        if (nostore) { asm volatile("" :: "v"(o)); } else { *(GAS v4u*)(out + row * 1024 + col) = o; } }
            }
    }
};
struct EpiHid {
    static constexpr bool PERM = true;
    bf16* O; int ldo; const LAS float* roww; int ubase; int ustride; int shared;
    __device__ __forceinline__ void operator()(const pg8::f32x4 (&acc)[2][2][4][2], const pg8::Unit& u, int wr, int wc, int fr, int fq) const {
#pragma unroll
        for (int ai = 0; ai < 2; ++ai)
#pragma unroll
            for (int m = 0; m < 4; ++m) {
                const int rl = ai * 128 + wr * 64 + m * 16 + fr; const size_t pos = (size_t)u.pm * 256 + rl;
                const float w = shared ? 1.f : roww[((u.pm - ubase) / ustride) * 256 + rl];
                const int col = (shared ? 128 * u.pn : 0) + wc * 32 + 8 * fq;
                float h[8];
#pragma unroll
                for (int n = 0; n < 2; ++n)
#pragma unroll
                    for (int j = 0; j < 4; ++j) { const float gt = acc[ai][0][m][n][j], up = acc[ai][1][m][n][j]; h[n * 4 + j] = gt * sigmoidf_(gt) * up * w; }
                v4u o; o.x = pk2(h[0], h[1]); o.y = pk2(h[2], h[3]); o.z = pk2(h[4], h[5]); o.w = pk2(h[6], h[7]);
                *(GAS v4u*)(O + pos * ldo + col) = o;
                asm volatile("" ::: "memory");
            }
    }
};
constexpr float YS_SCALE = 4.0f;
struct EpiScatter {
    static constexpr bool PERM = true;
    bf16* Y; const LAS unsigned* dst; int v; int G; int nostore;
    __device__ __forceinline__ void operator()(const pg8::f32x4 (&acc)[2][2][4][2], const pg8::Unit& u, int wr, int wc, int fr, int fq) const {
        const int q = u.pn & 3;
#pragma unroll
        for (int ai = 0; ai < 2; ++ai)
#pragma unroll
            for (int m = 0; m < 4; ++m) {
                const int rl = ai * 128 + wr * 64 + m * 16 + fr; const unsigned d = dst[((4 * u.pm + q - v) / G) * 256 + rl];
                if (nostore) { asm volatile("" :: "v"(acc[ai][0][m][0]), "v"(acc[ai][0][m][1]), "v"(acc[ai][1][m][0]), "v"(acc[ai][1][m][1])); } else if (d != 0xffffffffu) {
#pragma unroll
                    for (int bj = 0; bj < 2; ++bj) { const pg8::f32x4 v0 = acc[ai][bj][m][0] * YS_SCALE, v1 = acc[ai][bj][m][1] * YS_SCALE;
                        int w0 = 0, w1 = 0;
#define YS_CL(x_) __builtin_amdgcn_fmed3f((x_), -440.f, 440.f)
                        w0 = __builtin_amdgcn_cvt_pk_fp8_f32(YS_CL(v0[0]), YS_CL(v0[1]), w0, false); w0 = __builtin_amdgcn_cvt_pk_fp8_f32(YS_CL(v0[2]), YS_CL(v0[3]), w0, true);
                        w1 = __builtin_amdgcn_cvt_pk_fp8_f32(YS_CL(v1[0]), YS_CL(v1[1]), w1, false); w1 = __builtin_amdgcn_cvt_pk_fp8_f32(YS_CL(v1[2]), YS_CL(v1[3]), w1, true);
#undef YS_CL
                        v2u w; w.x = (unsigned)w0; w.y = (unsigned)w1;
                        *(GAS v2u*)((unsigned char*)Y + (size_t)d * 1024 + q * 256 + bj * 128 + wc * 32 + 8 * fq) = w; }
                }
            }
    }
};

struct TrDesc { const float* sp; bf16* dp; int ldw, ldt; float scale; };
__device__ __forceinline__ void tr_load(const TrDesc& d, float (&tv)[32]) {
    const GAS float* sp = (const GAS float*)d.sp;
#pragma unroll
    for (int i = 0; i < 32; ++i) tv[i] = sp[(size_t)(2 * i) * d.ldw];
}
__device__ __forceinline__ void tr_store(const TrDesc& d, const float (&tv)[32], LAS float* scr, int lane) {
#pragma unroll
    for (int i = 0; i < 32; ++i) { const int kk = 2 * i + (lane >> 5); scr[kk * 33 + (lane & 31)] = tv[i]; }
    LDS_WAIT();
    const int c = lane & 7; const float scale = d.scale;
#pragma unroll
    for (int j = 0; j < 4; ++j) { const int n = (lane >> 3) + 8 * j; const LAS float* s = scr + (8 * c) * 33 + n;
        v4u o; o.x = pk2(s[0 * 33] * scale, s[1 * 33] * scale); o.y = pk2(s[2 * 33] * scale, s[3 * 33] * scale); o.z = pk2(s[4 * 33] * scale, s[5 * 33] * scale); o.w = pk2(s[6 * 33] * scale, s[7 * 33] * scale);
        *(GAS v4u*)(d.dp + (size_t)n * d.ldt + 8 * c) = o; }
    LDS_WAIT();
}
constexpr int CW_N_IN = 8 * 512, CW_N_P = 3 * 512, CW_N_E = 4096, CW_N_S = 4 * 64, CW_N_SD = 128;
constexpr int CW_TOTAL = CW_N_IN + CW_N_P + 3 * CW_N_E + CW_N_S + CW_N_SD;
__device__ __forceinline__ TrDesc tr_decode(Frame& F, int l, int it) {
    const float* src; int ldw; bf16* dst; int ldt; int kb, nb; float sc = 1.f;
    int r = it;
    if (r < CW_N_IN) { const int job = r >> 9, rr = r & 511; kb = rr >> 5; nb = rr & 31;
        int col; bf16* BIN = (bf16*)wsp(F, WS_BIN); bf16* AIN = (bf16*)wsp(F, WS_AIN);
        switch (job) {
            case 0: col = C_MQK; dst = BIN; break;
            case 1: col = C_MO; dst = BIN + (size_t)1024 * 1024; break;
            case 2: col = C_SQ; dst = BIN + (size_t)2048 * 1024; sc = LOG2E * 0.125f; break;
            case 3: col = C_SK; dst = BIN + (size_t)3072 * 1024; break;
            case 4: col = C_GA; dst = BIN + (size_t)4096 * 1024; break;
            case 5: col = C_GB; dst = BIN + (size_t)5120 * 1024; break;
            case 6: col = C_MV; dst = AIN; break;
            default: col = C_SV; dst = AIN + (size_t)1024 * 1024; break;
        }
        src = inp(F, I_WIN) + (size_t)l * DM * INW + col; ldw = INW; ldt = 1024; }
    else if ((r -= CW_N_IN) < CW_N_P) { const int job = r >> 9, rr = r & 511; kb = rr >> 5; nb = rr & 31;
        src = inp(F, job == 0 ? I_WPA : (job == 1 ? I_WPB : I_WOUT)) + (size_t)l * DM * DM; ldw = 1024;
        dst = (bf16*)wsp(F, job == 0 ? WS_BA : (job == 1 ? WS_BB : WS_BO)); ldt = 1024; }
    else if ((r -= CW_N_P) < 2 * CW_N_E) { const int up = r >= CW_N_E; if (up) r -= CW_N_E; const int e = r >> 6, rr = r & 63; kb = rr >> 2; nb = rr & 3;
        src = inp(F, up ? I_WU : I_WG) + ((size_t)l * NEXP + e) * DM * EFF; ldw = EFF;
        dst = (bf16*)wsp(F, WS_BGU) + ((size_t)e * 256 + (up ? 128 : 0)) * 1024; ldt = 1024; }
    else if ((r -= 2 * CW_N_E) < CW_N_E) { const int e = r >> 6, rr = r & 63; kb = rr >> 5; nb = rr & 31;
        src = inp(F, I_WD) + ((size_t)l * NEXP + e) * EFF * DM; ldw = DM;
        dst = (bf16*)wsp(F, WS_BD) + (size_t)e * 1024 * 128; ldt = 128; }
    else if ((r -= CW_N_E) < CW_N_S) { const int job = r >> 6, rr = r & 63; kb = rr >> 2; nb = rr & 3;
        const int up = job >> 1, hi = job & 1;
        src = inp(F, up ? I_SU : I_SG) + (size_t)l * DM * SFF + hi * 128; ldw = SFF;
        dst = (bf16*)wsp(F, WS_BSGU) + (size_t)(hi * 256 + up * 128) * 1024; ldt = 1024; }
    else { r -= CW_N_S; kb = r >> 5; nb = r & 31;
        src = inp(F, I_SD) + (size_t)l * SFF * DM; ldw = DM; dst = (bf16*)wsp(F, WS_BSD); ldt = 256; }
    TrDesc d; const int k0 = 64 * kb, n0 = 32 * nb; const int ln = lane_now();
    d.sp = src + (size_t)(k0 + (ln >> 5)) * ldw + n0 + (ln & 31); d.dp = dst + (size_t)n0 * ldt + k0; d.ldw = ldw; d.ldt = ldt; d.scale = sc;
    return d;
}
__device__ __forceinline__ void conv_weights(Frame& F, int l) {
    LAS float* scr = (LAS float*)(F.lds + F.wave * 16384);
    int gw = F.c * 8 + F.wave; asm volatile("" : "+s"(gw)); const int NGW = F.G * 8;
    int it = gw;
    if (it >= CW_TOTAL) return;
    TrDesc dc = tr_decode(F, l, it); float tc[32]; tr_load(dc, tc);
    for (;;) {
        const int itn = it + NGW; const bool more = itn < CW_TOTAL;
        TrDesc dn = dc; float tn[32];
        if (more) { dn = tr_decode(F, l, itn); tr_load(dn, tn); }
        tr_store(dc, tc, scr, F.lane);
        if (!more) break;
        it = itn; dc = dn;
#pragma unroll
        for (int i = 0; i < 32; ++i) tc[i] = tn[i];
    }
}
__device__ __forceinline__ void mod_partials(Frame& F) {
    LAS float* sc = (LAS float*)(F.lds);
    for (int i = F.tid; i < 4096; i += 512) { const float v = inp(F, I_C)[i]; sc[i] = v / (1.f + __expf(-v)); }
    __syncthreads();
    float* MODP = (float*)wsp(F, WS_MODP);
    for (int it = F.c; it < 384; it += F.G) {
        const int l = it / 192, rem = it % 192, g = rem >> 4, kp = rem & 15, j = g * 512 + F.tid;
        const float* w = inp(F, I_ADAW) + ((size_t)l * DM + 64 * kp) * 6144 + j;
        float a0 = 0.f, a1 = 0.f, a2 = 0.f, a3 = 0.f;
#pragma unroll 16
        for (int k = 0; k < 64; ++k) { const float wv = w[(size_t)k * 6144]; const int kk = 64 * kp + k;
            a0 += sc[kk] * wv; a1 += sc[1024 + kk] * wv; a2 += sc[2048 + kk] * wv; a3 += sc[3072 + kk] * wv; }
        float* o = MODP + ((size_t)(kp * 2 + l) * 4) * 6144 + j;
        o[0] = a0; o[6144] = a1; o[2 * 6144] = a2; o[3 * 6144] = a3;
    }
    __syncthreads();
}
__device__ __forceinline__ float modv(const Frame& F, int l, int b, int j) {
    const float* MODP = (const float*)wsp(F, WS_MODP);
    float s = inp(F, I_ADAB)[l * 6144 + j];
#pragma unroll
    for (int kp = 0; kp < 16; ++kp) s += MODP[((size_t)(kp * 2 + l) * 4 + b) * 6144 + j];
    return s;
}

__device__ __forceinline__ void norm_emit(Frame& F, const float (&v)[2][8], const LAS float* cA, const LAS float* cB, const LAS float* Wg, const float gbias_lane  , bf16* xn_row, float* gate_row) {
    float ss = 0.f;
#pragma unroll
    for (int j = 0; j < 2; ++j)
#pragma unroll
        for (int i = 0; i < 8; ++i) ss += v[j][i] * v[j][i];
    ss = wave_sum(ss, F.lane);
    const float r = 1.0f / sqrtf(ss * (1.f / 1024.f) + EPS);
    float h[2][8];
#pragma unroll
    for (int j = 0; j < 2; ++j) { const int k = 8 * F.lane + 512 * j;
        const f32x4 a0 = *(const LAS f32x4*)(cA + k), a1 = *(const LAS f32x4*)(cA + k + 4), b0 = *(const LAS f32x4*)(cB + k), b1 = *(const LAS f32x4*)(cB + k + 4);
#pragma unroll
        for (int i = 0; i < 4; ++i) { h[j][i] = v[j][i] * r * a0[i] + b0[i]; h[j][4 + i] = v[j][4 + i] * r * a1[i] + b1[i]; }
        v4u o; o.x = pk2(h[j][0], h[j][1]); o.y = pk2(h[j][2], h[j][3]); o.z = pk2(h[j][4], h[j][5]); o.w = pk2(h[j][6], h[j][7]);
        *(GAS v4u*)(xn_row + k) = o; }
    float mine = 0.f;
#pragma unroll
    for (int g = 0; g < 8; ++g) { float p = 0.f;
#pragma unroll
        for (int j = 0; j < 2; ++j) { const int k = 8 * F.lane + 512 * j; const f32x4 w0 = *(const LAS f32x4*)(Wg + g * 1024 + k), w1 = *(const LAS f32x4*)(Wg + g * 1024 + k + 4);
#pragma unroll
            for (int i = 0; i < 4; ++i) { p += h[j][i] * w0[i]; p += h[j][4 + i] * w1[i]; } }
        p = wave_sum(p, F.lane);
        if (F.lane == g) mine = p; }
    if (F.lane < 8) { float z = mine + gbias_lane; if (F.lane >= 4) z = fminf(z, 0.f) - __logf(1.f + __expf(-fabsf(z))); gate_row[F.lane] = z; }
}
__device__ __forceinline__ void norm1_tables(Frame& F, int l, int b, bool from_modp) {
    LAS float* cA = (LAS float*)(F.lds + LDS_TAB); LAS float* cB = cA + 1024; LAS float* Wg = (LAS float*)(F.lds);
    const float* MODF = (const float*)wsp(F, WS_MODF) + (size_t)(l * 4 + b) * 6144;
    for (int k = F.tid; k < 1024; k += 512) {
        const float sh = from_modp ? modv(F, l, b, k) : MODF[k], sc = from_modp ? modv(F, l, b, 1024 + k) : MODF[1024 + k];
        cA[k] = inp(F, I_N1W)[l * 1024 + k] * (1.f + sc); cB[k] = sh; }
    const float* w_in = inp(F, I_WIN) + (size_t)l * DM * INW;
    for (int idx = F.tid; idx < 8192; idx += 512) { const int k = idx >> 3, g = idx & 7; Wg[g * 1024 + k] = w_in[(size_t)k * INW + C_MI + g]; }
}
__device__ __forceinline__ void phase_norm1_first(Frame& F) {
    float* MODF = (float*)wsp(F, WS_MODF);
    for (int idx = F.c * 512 + F.tid; idx < 2 * 4 * 6144; idx += F.G * 512) { const int l = idx / 24576, rem = idx % 24576, b = rem / 6144, j = rem % 6144; MODF[idx] = modv(F, l, b, j); }
    bf16* XN = (bf16*)wsp(F, WS_R2); float* GATES = (float*)wsp(F, WS_GATES); bf16* XB = (bf16*)outp(F);
    for (int vb = F.c; vb < 256; vb += F.G) {
        norm1_tables(F, 0, vb >> 6, true);
        __syncthreads();
        const float gbl = (F.lane < 4) ? inp(F, I_IGB)[F.lane] : (F.lane < 8 ? inp(F, I_FGB)[F.lane - 4] : 0.f);
        for (int i = 0; i < 8; ++i) {
            const int t = vb * 64 + F.wave * 8 + i; const float* xr = inp(F, I_X) + (size_t)t * 1024 + 8 * F.lane;
            float v[2][8];
#pragma unroll
            for (int j = 0; j < 2; ++j) { const f32x4 a = *(const GAS f32x4*)(xr + 512 * j), b2 = *(const GAS f32x4*)(xr + 512 * j + 4);
#pragma unroll
                for (int q = 0; q < 4; ++q) { v[j][q] = a[q]; v[j][4 + q] = b2[q]; } }
#pragma unroll
            for (int j = 0; j < 2; ++j) { v4u o; o.x = pk2(v[j][0], v[j][1]); o.y = pk2(v[j][2], v[j][3]); o.z = pk2(v[j][4], v[j][5]); o.w = pk2(v[j][6], v[j][7]);
                *(GAS v4u*)(XB + (size_t)t * 1024 + 8 * F.lane + 512 * j) = o; }
            norm_emit(F, v, (const LAS float*)(F.lds + LDS_TAB), (const LAS float*)(F.lds + LDS_TAB) + 1024, (const LAS float*)(F.lds), gbl, XN + (size_t)t * 1024, GATES + (size_t)t * 8);
        }
        __syncthreads();
    }
}

__device__ __forceinline__ void phase_conv(Frame& F, int l) {
    const bf16* P6 = (const bf16*)wsp(F, WS_P6); bf16* MQK = (bf16*)wsp(F, WS_R2);
    const int cg = F.tid & 127, tq = F.tid >> 7, ch = cg * 8;
    float w[4][8], bias[8];
#pragma unroll
    for (int j = 0; j < 4; ++j) { const float* p = inp(F, I_CONVW) + ((size_t)l * 4 + j) * 1024 + ch; const f32x4 a = *(const GAS f32x4*)p, b = *(const GAS f32x4*)(p + 4);
#pragma unroll
        for (int i = 0; i < 4; ++i) { w[j][i] = a[i]; w[j][4 + i] = b[i]; } }
    { const float* p = inp(F, I_CONVB) + (size_t)l * 1024 + ch; const f32x4 a = *(const GAS f32x4*)p, b = *(const GAS f32x4*)(p + 4);
#pragma unroll
      for (int i = 0; i < 4; ++i) { bias[i] = a[i]; bias[4 + i] = b[i]; } }
    const float osc = (ch < 512) ? 0.08838834764831845f : 1.0f;
    for (int vb = F.c; vb < 256; vb += F.G) {
        const int tbeg = vb * 64 + tq * 16;
        float u0[8], u1[8], u2[8];
#define CV_LOAD(dst, tt) do { const int t_ = (tt); if (t_ >= 0 && (t_ >> 12) == (tbeg >> 12)) { const v4u q = *(const GAS v4u*)(P6 + (size_t)t_ * P6W + ch); \
            dst[0] = bflo(q.x); dst[1] = bfhi(q.x); dst[2] = bflo(q.y); dst[3] = bfhi(q.y); dst[4] = bflo(q.z); dst[5] = bfhi(q.z); dst[6] = bflo(q.w); dst[7] = bfhi(q.w); } \
            else { _Pragma("unroll") for (int i_ = 0; i_ < 8; ++i_) dst[i_] = 0.f; } } while (0)
        CV_LOAD(u0, tbeg - 3); CV_LOAD(u1, tbeg - 2); CV_LOAD(u2, tbeg - 1);
        for (int tt = 0; tt < 16; ++tt) {
            const int t = tbeg + tt; float u3[8]; CV_LOAD(u3, t);
            float o[8];
#pragma unroll
            for (int i = 0; i < 8; ++i) { const float a = bias[i] + w[0][i] * u0[i] + w[1][i] * u1[i] + w[2][i] * u2[i] + w[3][i] * u3[i]; o[i] = a * sigmoidf_(a) * osc; }
            v4u q; q.x = pk2(o[0], o[1]); q.y = pk2(o[2], o[3]); q.z = pk2(o[4], o[5]); q.w = pk2(o[6], o[7]);
            *(GAS v4u*)(MQK + (size_t)t * 1024 + ch) = q;
#pragma unroll
            for (int i = 0; i < 8; ++i) { u0[i] = u1[i]; u1[i] = u2[i]; u2[i] = u3[i]; }
        }
#undef CV_LOAD
    }
}

constexpr float SB_EXIT = -80.0f;
constexpr int AT_NSLOT = 12, AT_SLOTB = 8192, AT_FLAGS = AT_NSLOT * AT_SLOTB;
__device__ __forceinline__ void at_dma(const void* gsrc, LAS unsigned char* ldst) { __builtin_amdgcn_global_load_lds((const GAS unsigned*)gsrc, (LAS unsigned*)ldst, 16, 0, 0); }
__device__ __forceinline__ void attn_unit(Frame& F, int b, int h, int qb, bool do_store) {
    bf16* P6 = (bf16*)wsp(F, WS_P6); const bf16* VT = (const bf16*)wsp(F, WS_VT);
    LAS unsigned char* L = F.lds;
    const int lane = F.lane, r32 = lane & 31, hh = lane >> 5, wid = F.wave;
    const int tb = b * SEQ, t0 = qb * 256 + wid * 32;
    const int D0 = 8 * qb, Dw = D0 + wid;
    const bf16* dsrc; int dtile_stride; int doff;
    if (wid < 4) { const int row = 8 * wid + (lane >> 3), pos = lane & 7; dsrc = P6 + (size_t)(tb + row) * P6W + P_SK + h * 64 + ((pos ^ (row & 7)) * 8); dtile_stride = 32 * P6W; doff = wid * 1024; }
    else { const int d = 16 * (wid - 4) + (lane >> 2), pos = lane & 3; dsrc = VT + (size_t)(1024 + h * 64 + d) * NTOK + tb + ((pos ^ ((d >> 2) & 3)) * 8); dtile_stride = 32; doff = 4096 + (wid - 4) * 1024; }
#define AT_DMA(T_) do { const int T__ = (T_); if (T__ >= 0) at_dma(dsrc + (size_t)T__ * dtile_stride, L + (T__ % AT_NSLOT) * AT_SLOTB + doff); } while (0)
    for (int T = D0 + 7; T >= D0 - 1; --T) AT_DMA(T);
    bf16x8 qf[4];
#pragma unroll
    for (int kk = 0; kk < 4; ++kk) qf[kk] = *(const GAS bf16x8*)(P6 + (size_t)(tb + t0 + r32) * P6W + P_SQ + h * 64 + 16 * kk + 8 * hh);
    f32x16 o0 = {}, o1 = {};
    float Rrun = 0.f;
    bool done = false;
    LAS unsigned* flags = (LAS unsigned*)(L + AT_FLAGS);
    asm volatile("s_waitcnt vmcnt(0)" ::: "memory");
    if (lane == 0) flags[wid] = 1u;
    __syncthreads();
    int koff[4], vlo[2][2], vhi[2][2];
#pragma unroll
    for (int kk = 0; kk < 4; ++kk) koff[kk] = r32 * 128 + (((2 * kk + hh) ^ (r32 & 7)) * 16);
#pragma unroll
    for (int dt = 0; dt < 2; ++dt)
#pragma unroll
        for (int s = 0; s < 2; ++s) { const int d = 32 * dt + r32, sw = (d >> 2) & 3; vlo[dt][s] = 4096 + d * 64 + (((2 * s) ^ sw) * 16) + 8 * hh; vhi[dt][s] = 4096 + d * 64 + (((2 * s + 1) ^ sw) * 16) + 8 * hh; }
#define AT_TILE(DIAG_) do { \
            const LAS unsigned char* S = L + (T % AT_NSLOT) * AT_SLOTB; \
            f32x16 p = {}; \
            _Pragma("unroll") \
            for (int kk = 0; kk < 4; ++kk) { const bf16x8 kf = *(const LAS bf16x8*)(S + koff[kk]); p = __builtin_amdgcn_mfma_f32_32x32x16_bf16(kf, qf[kk], p, 0, 0, 0); } \
            bf16x8 vf[2][2]; \
            _Pragma("unroll") \
            for (int dt = 0; dt < 2; ++dt) \
            _Pragma("unroll") \
                for (int s = 0; s < 2; ++s) { const v2u lo = *(const LAS v2u*)(S + vlo[dt][s]), hi = *(const LAS v2u*)(S + vhi[dt][s]); v4u t; t.x = lo.x; t.y = lo.y; t.z = hi.x; t.w = hi.y; vf[dt][s] = __builtin_bit_cast(bf16x8, t); } \
            float lf[16]; \
            _Pragma("unroll") \
            for (int r = 0; r < 16; ++r) { const float z = p[r]; const float e = __builtin_amdgcn_exp2f(-fabsf(z)); const float lg = __builtin_amdgcn_logf(1.f + e); \
                float v = -(fmaxf(z, 0.f) + lg); if (DIAG_ && crow(r, hh) >= r32) v = 0.f; lf[r] = v; } \
 \
            float own[4], pair[4]; \
            _Pragma("unroll") \
            for (int g = 0; g < 4; ++g) { own[g] = (lf[4 * g] + lf[4 * g + 1]) + (lf[4 * g + 2] + lf[4 * g + 3]); \
                auto rr = __builtin_amdgcn_permlane32_swap(__float_as_uint(own[g]), __float_as_uint(own[g]), false, false); \
                pair[g] = __uint_as_float(rr[0]) + __uint_as_float(rr[1]); } \
            float sfx[4]; sfx[3] = Rrun; sfx[2] = sfx[3] + pair[3]; sfx[1] = sfx[2] + pair[2]; sfx[0] = sfx[1] + pair[1]; \
            const float nh = hh ? 0.f : 1.f; \
            float att[16]; \
            _Pragma("unroll") \
            for (int g = 0; g < 4; ++g) { float run = sfx[g] + nh * (pair[g] - own[g]); \
            _Pragma("unroll") \
                for (int i = 3; i >= 0; --i) { const int r = 4 * g + i; run += lf[r]; float a = __builtin_amdgcn_exp2f(p[r] + run); if (DIAG_ && crow(r, hh) >= r32) a = 0.f; att[r] = a; } } \
            Rrun = sfx[0] + pair[0]; \
            v4u pb0, pb1; \
            pb0.x = pk2(att[0], att[1]); pb0.y = pk2(att[2], att[3]); pb0.z = pk2(att[4], att[5]); pb0.w = pk2(att[6], att[7]); \
            pb1.x = pk2(att[8], att[9]); pb1.y = pk2(att[10], att[11]); pb1.z = pk2(att[12], att[13]); pb1.w = pk2(att[14], att[15]); \
            const bf16x8 b0 = __builtin_bit_cast(bf16x8, pb0), b1 = __builtin_bit_cast(bf16x8, pb1); \
            o0 = __builtin_amdgcn_mfma_f32_32x32x16_bf16(vf[0][0], b0, o0, 0, 0, 0); o0 = __builtin_amdgcn_mfma_f32_32x32x16_bf16(vf[0][1], b1, o0, 0, 0, 0); \
            o1 = __builtin_amdgcn_mfma_f32_32x32x16_bf16(vf[1][0], b0, o1, 0, 0, 0); o1 = __builtin_amdgcn_mfma_f32_32x32x16_bf16(vf[1][1], b1, o1, 0, 0, 0); \
            if (__all(Rrun < SB_EXIT)) done = true; \
        } while (0)
    for (int j = 0; ; ++j) {
        const int T = Dw - j;
        const bool active = !done && T >= 0;
        AT_DMA(D0 - j - 2);
        if (active) { if (j == 0) AT_TILE(true); else AT_TILE(false); }
        const bool more = !done && (Dw - (j + 1)) >= 0;
        if (lane == 0) flags[8 * ((j + 1) & 1) + wid] = more ? 1u : 0u;
        asm volatile("s_waitcnt vmcnt(0) lgkmcnt(0)" ::: "memory");
        __builtin_amdgcn_s_barrier();
        asm volatile("" ::: "memory");
        const LAS unsigned* fl = flags + 8 * ((j + 1) & 1);
        const unsigned any = fl[0] | fl[1] | fl[2] | fl[3] | fl[4] | fl[5] | fl[6] | fl[7];
        if (any == 0u) break;
    }
#undef AT_DMA
#undef AT_TILE
    if (do_store) {
        bf16* orow = P6 + (size_t)(tb + t0 + r32) * P6W + P_SQ + h * 64 + 4 * hh;
#pragma unroll
        for (int g = 0; g < 4; ++g) {
            v2u a; a.x = pk2(o0[4 * g], o0[4 * g + 1]); a.y = pk2(o0[4 * g + 2], o0[4 * g + 3]); *(GAS v2u*)(orow + 8 * g) = a;
            v2u c; c.x = pk2(o1[4 * g], o1[4 * g + 1]); c.y = pk2(o1[4 * g + 2], o1[4 * g + 3]); *(GAS v2u*)(orow + 32 + 8 * g) = c;
        }
    } else { asm volatile("" :: "v"(o0), "v"(o1)); }
    __syncthreads();
}
__device__ __forceinline__ void phase_attn(Frame& F, bool do_store) {
    const int v = (F.G % 8 == 0) ? (F.c % 8) * (F.G / 8) + F.c / 8 : F.c;
    for (int u = v; u < 1024; u += F.G) { const int bh = u >> 4, qb = u & 15; attn_unit(F, bh >> 4, bh & 15, qb, do_store); }
}

constexpr size_t MLS_U = 0, MLS_PM = 16 * 4096 * 4, MLS_BL = 2 * 16 * 4096 * 4, MLS_SUM = 3 * 16 * 4096 * 4;
__device__ __forceinline__ void phase_mlstm_scalars(Frame& F) {
    const float* GATES = (const float*)wsp(F, WS_GATES); unsigned char* R3 = wsp(F, WS_R3);
    const int lane = F.lane;
    for (int vb = F.c; vb < 256; vb += F.G) {
        if (F.wave != 0) continue;
        const int bh = vb >> 4, ch = vb & 15, b = bh >> 2, h = bh & 3, t0 = b * SEQ + 256 * ch;
        float carry_b = 0.f, carry_pm = -INFINITY;
#pragma unroll
        for (int sg = 0; sg < 4; ++sg) {
            const int tok = t0 + 64 * sg + lane;
            const float ig = *(const GAS float*)(GATES + (size_t)tok * 8 + h), lfv = *(const GAS float*)(GATES + (size_t)tok * 8 + 4 + h);
            float bc = lfv;
#pragma unroll
            for (int o = 1; o < 64; o <<= 1) { const float t = shfl_up_l(bc, o, lane); if (lane >= o) bc += t; }
            bc += carry_b;
            const float u = ig - bc;
            float pm = u;
#pragma unroll
            for (int o = 1; o < 64; o <<= 1) { const float t = shfl_up_l(pm, o, lane); if (lane >= o) pm = fmaxf(pm, t); }
            pm = fmaxf(pm, carry_pm);
            const size_t idx = (size_t)bh * 4096 + 256 * ch + 64 * sg + lane;
            *(GAS float*)(R3 + MLS_U + idx * 4) = u; *(GAS float*)(R3 + MLS_PM + idx * 4) = pm; *(GAS float*)(R3 + MLS_BL + idx * 4) = bc;
            carry_b = __int_as_float(__builtin_amdgcn_readlane(__float_as_int(bc), 63)); carry_pm = __int_as_float(__builtin_amdgcn_readlane(__float_as_int(pm), 63));
        }
        if (lane == 0) { *(GAS float*)(R3 + MLS_SUM + (size_t)(bh * 16 + ch) * 8) = carry_b; *(GAS float*)(R3 + MLS_SUM + (size_t)(bh * 16 + ch) * 8 + 4) = carry_pm; }
    }
}

constexpr int CVP_QS = 0, CVP_KS = 69632, CVP_U = 139264;
__device__ __forceinline__ void cvp_job(Frame& F, int l, int bh, int c) {
    LAS unsigned char* L = F.lds;
    const int b = bh >> 2, h = bh & 3, T0 = b * SEQ + 256 * c;
    const bf16* P6 = (const bf16*)wsp(F, WS_P6); const unsigned char* R3 = wsp(F, WS_R3);
    {
        const int cg = F.tid & 31, tr = F.tid >> 5, ch8 = 8 * cg;
        const int cq = (ch8 < 128) ? h * 128 + ch8 : 512 + h * 128 + (ch8 - 128);
        float w[4][8], bias[8];
#pragma unroll
        for (int j = 0; j < 4; ++j) { const float* p = inp(F, I_CONVW) + ((size_t)l * 4 + j) * 1024 + cq; const f32x4 a = *(const GAS f32x4*)p, bb = *(const GAS f32x4*)(p + 4);
#pragma unroll
            for (int i = 0; i < 4; ++i) { w[j][i] = a[i]; w[j][4 + i] = bb[i]; } }
        { const float* p = inp(F, I_CONVB) + (size_t)l * 1024 + cq; const f32x4 a = *(const GAS f32x4*)p, bb = *(const GAS f32x4*)(p + 4);
#pragma unroll
          for (int i = 0; i < 4; ++i) { bias[i] = a[i]; bias[4 + i] = bb[i]; } }
        const float osc = (ch8 < 128) ? 0.08838834764831845f : 1.0f;
        const int sbeg = 256 * c + 16 * tr;
        float u0[8], u1[8], u2[8];
#define CVP_LOAD(dst, ss) do { const int s_ = (ss); if (s_ >= 0) { const v4u q = *(const GAS v4u*)(P6 + (size_t)(b * SEQ + s_) * P6W + cq); \
            dst[0] = bflo(q.x); dst[1] = bfhi(q.x); dst[2] = bflo(q.y); dst[3] = bfhi(q.y); dst[4] = bflo(q.z); dst[5] = bfhi(q.z); dst[6] = bflo(q.w); dst[7] = bfhi(q.w); } \
            else { _Pragma("unroll") for (int i_ = 0; i_ < 8; ++i_) dst[i_] = 0.f; } } while (0)
        CVP_LOAD(u0, sbeg - 3); CVP_LOAD(u1, sbeg - 2); CVP_LOAD(u2, sbeg - 1);
        LAS unsigned char* tile = L + ((ch8 < 128) ? CVP_QS : CVP_KS) + ((ch8 & 127) * 2);
        for (int tt = 0; tt < 16; ++tt) {
            float u3[8]; CVP_LOAD(u3, sbeg + tt);
            float o[8];
#pragma unroll
            for (int i = 0; i < 8; ++i) { const float a = bias[i] + w[0][i] * u0[i] + w[1][i] * u1[i] + w[2][i] * u2[i] + w[3][i] * u3[i]; o[i] = a * sigmoidf_(a) * osc; }
            v4u q; q.x = pk2(o[0], o[1]); q.y = pk2(o[2], o[3]); q.z = pk2(o[4], o[5]); q.w = pk2(o[6], o[7]);
            *(LAS v4u*)(tile + (16 * tr + tt) * 272) = q;
#pragma unroll
            for (int i = 0; i < 8; ++i) { u0[i] = u1[i]; u1[i] = u2[i]; u2[i] = u3[i]; }
        }
#undef CVP_LOAD
        if (F.tid < 256) *(LAS float*)(L + CVP_U + F.tid * 4) = *(const GAS float*)(R3 + MLS_U + ((size_t)bh * 4096 + 256 * c + F.tid) * 4) * LOG2E;
    }
    __syncthreads();
    {
        const int lane = F.lane, wid = F.wave, r32 = lane & 31, hh = lane >> 5;
        const int qblk = (wid < 4) ? 7 - wid : wid - 4;
        float Mc = 0.f;
        for (int cc = 0; cc < c; ++cc) { const float a = *(const GAS float*)(R3 + MLS_SUM + (size_t)(bh * 16 + cc) * 8), pmx = *(const GAS float*)(R3 + MLS_SUM + (size_t)(bh * 16 + cc) * 8 + 4); Mc = a + fmaxf(Mc, pmx); }
        const float pmq = *(const GAS float*)(R3 + MLS_PM + ((size_t)bh * 4096 + 256 * c + 32 * qblk + r32) * 4);
        const float myMM2 = fmaxf(Mc, pmq) * LOG2E;
        bf16x8 qf[8];
#pragma unroll
        for (int kk = 0; kk < 8; ++kk) qf[kk] = *(const LAS bf16x8*)(L + CVP_QS + (32 * qblk + r32) * 272 + (16 * kk + 8 * hh) * 2);
        { unsigned char* QF = wsp(F, WS_R2) + (((size_t)(bh * 16 + c) * 8 + qblk) * 8) * 1024 + lane * 16;
#pragma unroll
          for (int kk = 0; kk < 8; ++kk) *(GAS bf16x8*)(QF + (size_t)kk * 1024) = qf[kk]; }
        unsigned char* PT = wsp(F, WS_PT) + ((size_t)(bh * 16 + c) * 36 + (qblk * (qblk + 1)) / 2) * 2048;
        const LAS float* U2 = (const LAS float*)(L + CVP_U);
        for (int kt = 0; kt <= qblk; ++kt) {
            f32x16 p = {};
#pragma unroll
            for (int kk = 0; kk < 8; ++kk) { const bf16x8 a = *(const LAS bf16x8*)(L + CVP_KS + (32 * kt + r32) * 272 + (16 * kk + 8 * hh) * 2); p = __builtin_amdgcn_mfma_f32_32x32x16_bf16(a, qf[kk], p, 0, 0, 0); }
            const bool diag = (kt == qblk);
            float pw[16];
#pragma unroll
            for (int g = 0; g < 4; ++g) { const f32x4 u2 = *(const LAS f32x4*)(U2 + 32 * kt + 8 * g + 4 * hh);
#pragma unroll
                for (int i = 0; i < 4; ++i) { const int r = 4 * g + i; float v = p[r] * __builtin_amdgcn_exp2f(u2[i] - myMM2); if (diag && (8 * g + 4 * hh + i) > r32) v = 0.f; pw[r] = v; } }
            v4u pb0, pb1;
            pb0.x = pk2(pw[0], pw[1]); pb0.y = pk2(pw[2], pw[3]); pb0.z = pk2(pw[4], pw[5]); pb0.w = pk2(pw[6], pw[7]);
            pb1.x = pk2(pw[8], pw[9]); pb1.y = pk2(pw[10], pw[11]); pb1.z = pk2(pw[12], pw[13]); pb1.w = pk2(pw[14], pw[15]);
            *(GAS v4u*)(PT + (size_t)kt * 2048 + lane * 16) = pb0; *(GAS v4u*)(PT + (size_t)kt * 2048 + 1024 + lane * 16) = pb1;
        }
        { const int dkt = wid & 3, kh = wid >> 2;
          unsigned char* KF = wsp(F, WS_R2) + 16 * MiB + (((size_t)(bh * 16 + c) * 8 + (dkt * 2 + kh)) * 8) * 1024 + lane * 16;
#pragma unroll
          for (int ks = 0; ks < 8; ++ks) { const int s0 = 128 * kh + 16 * ks + 8 * hh; bf16x8 bb;
#pragma unroll
              for (int j = 0; j < 8; ++j) bb[j] = *(const LAS short*)(L + CVP_KS + (s0 + j) * 272 + (32 * dkt + r32) * 2);
              *(GAS bf16x8*)(KF + (size_t)ks * 1024) = bb; } }
    }
    __syncthreads();
}
__device__ __forceinline__ void phase_cvp(Frame& F, int l) {
    const int v = (F.G % 8 == 0) ? (F.c % 8) * (F.G / 8) + F.c / 8 : F.c;
    for (int u = v; u < 256; u += F.G) cvp_job(F, l, u >> 4, u & 15);
}

constexpr int M2_KS = 0, M2_VT = 69632, M2_CT = 86528, M2_G = 95232, M2_U2 = 97280, M2_WC = 105472, M2_PART = 113664;
constexpr int M2_KP = 272, M2_VP = 528, M2_CP = 272;
__device__ __forceinline__ void mlstm_unit(Frame& F, int b, int h, int ds, int skip) {
    LAS unsigned char* L = F.lds;
    const int wid = F.wave;
    const int qblk = (wid < 4) ? 7 - wid : wid - 4;
    const int dkt = wid & 3, kh = wid >> 2;
#define M2_IDS() int lane_ = F.lane; asm volatile("" : "+v"(lane_)); const int lane = lane_, tid = wid * 64 + lane, r32 = lane & 31, hh = lane >> 5
    const bf16* VTg = (const bf16*)wsp(F, WS_VT);
    bf16* P6 = (bf16*)wsp(F, WS_P6);
    const int tb = b * SEQ, bh = b * 4 + h;
    { M2_IDS();
    for (int i = tid; i < 16 * 264; i += 512) { const int row = 16 + i / 264, col = i % 264; *(LAS bf16*)(L + M2_VT + row * M2_VP + col * 2) = (row == 16 && col < 256) ? (bf16)0x3F80 : (bf16)0; }
    for (int i = tid; i < 32 * 136; i += 512) *(LAS bf16*)(L + M2_CT + i * 2) = (bf16)0; }
    f32x16 st = {};
    float Mst = 0.f;
    v4u pv; float pu[4], ppm, pbl, psa, psm;
    bf16x8 qf[8];
    v4u kfr[8];
    v4u pbuf[8][2];
    const unsigned char* R3 = wsp(F, WS_R3);
#define M2_FETCH(cc) do { const int t0_ = tb + 256 * (cc); \
        { const int dvl_ = tid >> 5, seg_ = tid & 31; pv = *(const GAS v4u*)(VTg + (size_t)(h * 256 + ds * 16 + dvl_) * NTOK + t0_ + seg_ * 8); } \
        { const size_t ib_ = (size_t)bh * 4096 + 256 * (cc); \
          _Pragma("unroll") for (int i = 0; i < 4; ++i) pu[i] = *(const GAS float*)(R3 + MLS_U + (ib_ + 64 * i + lane) * 4); \
          ppm = *(const GAS float*)(R3 + MLS_PM + (ib_ + 32 * qblk + r32) * 4); pbl = *(const GAS float*)(R3 + MLS_BL + (ib_ + 32 * qblk + r32) * 4); \
          psa = *(const GAS float*)(R3 + MLS_SUM + (size_t)(bh * 16 + (cc)) * 8); psm = *(const GAS float*)(R3 + MLS_SUM + (size_t)(bh * 16 + (cc)) * 8 + 4); } } while (0)
#define M2_QFETCH(cc) do { const unsigned char* qf_ = wsp(F, WS_R2) + (((size_t)(bh * 16 + (cc)) * 8 + qblk) * 8) * 1024 + lane * 16; _Pragma("unroll") for (int kk = 0; kk < 8; ++kk) qf[kk] = *(const GAS bf16x8*)(qf_ + (size_t)kk * 1024); } while (0)
#define M2_KFETCH(cc) do { const unsigned char* kf_ = wsp(F, WS_R2) + 16 * MiB + (((size_t)(bh * 16 + (cc)) * 8 + (dkt * 2 + kh)) * 8) * 1024 + lane * 16; \
        _Pragma("unroll") for (int ks = 0; ks < 8; ++ks) kfr[ks] = *(const GAS v4u*)(kf_ + (size_t)ks * 1024); } while (0)
#define M2_PTQ(cc) (wsp(F, WS_PT) + ((size_t)(bh * 16 + (cc)) * 36 + (qblk * (qblk + 1)) / 2) * 2048 + lane * 16)
    { M2_IDS(); M2_FETCH(0); M2_QFETCH(0); M2_KFETCH(0);
      const unsigned char* pt_ = M2_PTQ(0);
#pragma unroll
      for (int kt = 0; kt < 8; ++kt) if (kt <= qblk) { pbuf[kt][0] = *(const GAS v4u*)(pt_ + (size_t)kt * 2048); pbuf[kt][1] = *(const GAS v4u*)(pt_ + (size_t)kt * 2048 + 1024); } }
    LAS float* WCw = (LAS float*)(L + M2_WC + wid * 1024);
    for (int c = 0; c < 16; ++c) {
        M2_IDS();
        const int t0 = tb + 256 * c;
        const bool more = (c + 1 < 16);
        { const int dvl_ = tid >> 5, seg_ = tid & 31; *(LAS v4u*)(L + M2_VT + dvl_ * M2_VP + seg_ * 16) = pv; }
        float cu[4]; const float cpm = ppm, cbl = pbl, csa = psa, csm = psm;
#pragma unroll
        for (int i = 0; i < 4; ++i) cu[i] = pu[i];
        if (more) M2_FETCH(c + 1);
        float myWIN, myEFLO, decay;
        {
            const float mml = fmaxf(Mst, csm);
#pragma unroll
            for (int i = 0; i < 4; ++i) WCw[64 * i + lane] = __expf(cu[i] - mml);
            const float mm = fmaxf(Mst, cpm);
            myWIN = __expf(Mst - mm); myEFLO = __expf(-(cbl + mm));
            decay = __expf(Mst - mml);
            Mst = csa + mml;
        }
        __syncthreads();
        f32x16 hT = {};
        if (!(skip & 4))
#pragma unroll
        for (int kk = 0; kk < 8; ++kk) { const bf16x8 a = *(const LAS bf16x8*)(L + M2_CT + r32 * M2_CP + (16 * kk + 8 * hh) * 2); hT = __builtin_amdgcn_mfma_f32_32x32x16_bf16(a, qf[kk], hT, 0, 0, 0); }
        if (more) M2_QFETCH(c + 1);
#pragma unroll
        for (int r = 0; r < 16; ++r) hT[r] *= myWIN;
        {
            const unsigned char* ptn = M2_PTQ(c + 1);
#pragma unroll
            for (int kt = 0; kt < 8; ++kt) if (kt <= qblk) {
#pragma unroll
                for (int s = 0; s < 2; ++s) if (!(skip & 1)) { const LAS unsigned char* vp = L + M2_VT + r32 * M2_VP + (32 * kt + 16 * s + 4 * hh) * 2;
                    const v2u lo = *(const LAS v2u*)vp, hi = *(const LAS v2u*)(vp + 16);
                    v4u t; t.x = lo.x; t.y = lo.y; t.z = hi.x; t.w = hi.y;
                    hT = __builtin_amdgcn_mfma_f32_32x32x16_bf16(__builtin_bit_cast(bf16x8, t), __builtin_bit_cast(bf16x8, pbuf[kt][s]), hT, 0, 0, 0); }
                if (more) { pbuf[kt][0] = *(const GAS v4u*)(ptn + (size_t)kt * 2048); pbuf[kt][1] = *(const GAS v4u*)(ptn + (size_t)kt * 2048 + 1024); }
            }
        }
        {
            const float dn = hT[8];
            auto rr = __builtin_amdgcn_permlane32_swap(__float_as_uint(dn), __float_as_uint(dn), false, false);
            const float den = __uint_as_float(rr[0]);
            const float inv = 1.0f / fmaxf(fabsf(den), myEFLO);
            bf16* orow = P6 + (size_t)(t0 + 32 * qblk + r32) * P6W + P_MQK + h * 256 + ds * 16 + 4 * hh;
            v2u o0, o1; o0.x = pk2(hT[0] * inv, hT[1] * inv); o0.y = pk2(hT[2] * inv, hT[3] * inv); o1.x = pk2(hT[4] * inv, hT[5] * inv); o1.y = pk2(hT[6] * inv, hT[7] * inv);
            if (!(skip & 8)) { *(GAS v2u*)orow = o0; *(GAS v2u*)(orow + 8) = o1; } else { asm volatile("" :: "v"(o0), "v"(o1)); }
        }
        f32x16 part = {};
#pragma unroll
        for (int ks = 0; ks < 8; ++ks) if (!(skip & 2)) {
            const int s0 = 128 * kh + 16 * ks + 8 * hh;
            const v4u raw = *(const LAS v4u*)(L + M2_VT + r32 * M2_VP + s0 * 2);
            const f32x4 w0 = *(const LAS f32x4*)(WCw + s0), w1 = *(const LAS f32x4*)(WCw + s0 + 4);
            v4u aw; aw.x = pk2(bflo(raw.x) * w0[0], bfhi(raw.x) * w0[1]); aw.y = pk2(bflo(raw.y) * w0[2], bfhi(raw.y) * w0[3]);
            aw.z = pk2(bflo(raw.z) * w1[0], bfhi(raw.z) * w1[1]); aw.w = pk2(bflo(raw.w) * w1[2], bfhi(raw.w) * w1[3]);
            part = __builtin_amdgcn_mfma_f32_32x32x16_bf16(__builtin_bit_cast(bf16x8, aw), __builtin_bit_cast(bf16x8, kfr[ks]), part, 0, 0, 0);
        }
        if (more) M2_KFETCH(c + 1);
        if (kh == 1) {
#pragma unroll
            for (int r = 0; r < 16; ++r) *(LAS float*)(L + M2_PART + dkt * 4096 + r * 256 + lane * 4) = part[r];
        }
        __syncthreads();
        if (kh == 0) {
#pragma unroll
            for (int r = 0; r < 16; ++r) { st[r] = st[r] * decay + part[r] + *(LAS float*)(L + M2_PART + dkt * 4096 + r * 256 + lane * 4);
                *(LAS bf16*)(L + M2_CT + crow(r, hh) * M2_CP + (32 * dkt + r32) * 2) = f2bf(st[r]); }
        }
    }
#undef M2_FETCH
#undef M2_QFETCH
#undef M2_KFETCH
#undef M2_PTQ
#undef M2_IDS
}
__device__ __forceinline__ void phase_mlstm(Frame& F, int skip) {
    const int v = (F.G % 8 == 0) ? (F.c % 8) * (F.G / 8) + F.c / 8 : F.c;
    for (int u = v; u < 256; u += F.G) { const int bh = u >> 4, ds = u & 15; mlstm_unit(F, bh >> 2, bh & 3, ds, skip); __syncthreads(); }
}

__device__ __forceinline__ void phase_hm_final(Frame& F, int l, bool do_store) {
    bf16* P6 = (bf16*)wsp(F, WS_P6);
    const float* mw = inp(F, I_MNW) + (size_t)l * 1024;
    for (int vb = F.c; vb < 256; vb += F.G) {
        for (int i = 0; i < 8; ++i) {
            const int t = vb * 64 + F.wave * 8 + i; bf16* row = P6 + (size_t)t * P6W;
#pragma unroll
            for (int j = 0; j < 4; ++j) {
                const int col = 256 * j + 4 * F.lane;
                const v2u hv = *(const GAS v2u*)(row + P_MQK + col), mo = *(const GAS v2u*)(row + P_MO + col);
                float x[4] = {bflo(hv.x), bfhi(hv.x), bflo(hv.y), bfhi(hv.y)};
                float ss = wave_sum(x[0] * x[0] + x[1] * x[1] + x[2] * x[2] + x[3] * x[3], F.lane);
                const float r = 1.0f / sqrtf(ss * (1.f / 256.f) + EPS);
                const f32x4 w = *(const GAS f32x4*)(mw + col);
                const float g[4] = {sigmoidf_(bflo(mo.x)), sigmoidf_(bfhi(mo.x)), sigmoidf_(bflo(mo.y)), sigmoidf_(bfhi(mo.y))};
                v2u o; o.x = pk2(x[0] * r * w[0] * g[0], x[1] * r * w[1] * g[1]); o.y = pk2(x[2] * r * w[2] * g[2], x[3] * r * w[3] * g[3]);
                if (do_store) *(GAS v2u*)(row + P_MQK + col) = o; else asm volatile("" :: "v"(o));
            }
        }
    }
}

#define N2_LD0(dst, k0) do { const GAS float* bq_ = bp + (size_t)(2 * (k0)) * 64; asm volatile("" : "+v"(bq_)); _Pragma("unroll") for (int q_ = 0; q_ < 32; ++q_) dst[q_] = bq_[(size_t)(2 * q_) * 64]; } while (0)
constexpr int N2_H2 = 0, N2_CA = 131328, N2_CB = N2_CA + 4096, N2_HIST = N2_CB + 4096;
__device__ __forceinline__ void phase_norm2_router(Frame& F, int l, int skip) {
    LAS unsigned char* L = F.lds;
    LAS float* H2 = (LAS float*)(L + N2_H2); LAS float* cA = (LAS float*)(L + N2_CA); LAS float* cB = (LAS float*)(L + N2_CB); LAS unsigned* hist = (LAS unsigned*)(L + N2_HIST);
    const int lane = F.lane, wid = F.wave, r32 = lane & 31, hh = lane >> 5;
    bf16* XN2 = (bf16*)wsp(F, WS_R1); int* TOPE = (int*)wsp(F, WS_TOPE); float* TOPW = (float*)wsp(F, WS_TOPW); unsigned* CNT = (unsigned*)wsp(F, WS_CNT);
    const float* Wr = inp(F, I_RW) + (size_t)l * 1024 * 64;
    const float rb = inp(F, I_RB)[l * 64 + lane];
    for (int vb = F.c; vb < 256; vb += F.G) {
        const int b = vb >> 6;
        const float* MODF = (const float*)wsp(F, WS_MODF) + (size_t)(l * 4 + b) * 6144;
        for (int k = F.tid; k < 1024; k += 512) { cA[k] = inp(F, I_N2W)[l * 1024 + k] * (1.f + MODF[4 * 1024 + k]); cB[k] = MODF[3 * 1024 + k]; }
        if (F.tid < 64) hist[F.tid] = 0u;
        const int eh = wid & 1, kq = wid >> 1;
        const GAS float* bp = (const GAS float*)(Wr + (size_t)(256 * kq + hh) * 64 + 32 * eh + r32);
        __syncthreads();
        for (int it = 0; it < 2; ++it) {
            const int T0 = vb * 64 + it * 32;
            float wA[32], wB[32];
            N2_LD0(wA, 0); N2_LD0(wB, 32);
            v4u xr4[4][2];
            if (!(skip & 4))
#pragma unroll
            for (int i = 0; i < 4; ++i) { const bf16* xr = xmid(F, l) + (size_t)(T0 + wid * 4 + i) * 1024 + 8 * lane;
#pragma unroll
                for (int j = 0; j < 2; ++j) xr4[i][j] = *(const GAS v4u*)(xr + 512 * j); }
#pragma unroll
            for (int i = 0; i < 4; ++i) if (!(skip & 4)) {
                const int tl = wid * 4 + i, t = T0 + tl;
                float v[2][8]; float ss = 0.f;
#pragma unroll
                for (int j = 0; j < 2; ++j) { const v4u a = xr4[i][j];
                    v[j][0] = bflo(a.x); v[j][1] = bfhi(a.x); v[j][2] = bflo(a.y); v[j][3] = bfhi(a.y); v[j][4] = bflo(a.z); v[j][5] = bfhi(a.z); v[j][6] = bflo(a.w); v[j][7] = bfhi(a.w);
#pragma unroll
                    for (int q = 0; q < 8; ++q) ss += v[j][q] * v[j][q]; }
                ss = wave_sum(ss, F.lane);
                const float r = 1.0f / sqrtf(ss * (1.f / 1024.f) + EPS);
#pragma unroll
                for (int j = 0; j < 2; ++j) { const int k = 8 * lane + 512 * j; float h[8];
                    const f32x4 a0 = *(const LAS f32x4*)(cA + k), a1 = *(const LAS f32x4*)(cA + k + 4), b0 = *(const LAS f32x4*)(cB + k), b1 = *(const LAS f32x4*)(cB + k + 4);
                    LAS float* hp = H2 + tl * 1025 + k;
#pragma unroll
                    for (int q = 0; q < 4; ++q) { h[q] = v[j][q] * r * a0[q] + b0[q]; h[4 + q] = v[j][4 + q] * r * a1[q] + b1[q]; }
#pragma unroll
                    for (int q = 0; q < 8; ++q) hp[q] = h[q];
                    v4u o; o.x = pk2(h[0], h[1]); o.y = pk2(h[2], h[3]); o.z = pk2(h[4], h[5]); o.w = pk2(h[6], h[7]);
                    *(GAS v4u*)(XN2 + (size_t)t * 1024 + k) = o; }
            }
            __syncthreads();
            f32x16 acc = {};
            {
                const LAS float* ap = H2 + r32 * 1025 + 256 * kq + hh;
#define N2_LD(dst, k0) N2_LD0(dst, k0)
#define N2_MM(src, k0) do { _Pragma("unroll") for (int q_ = 0; q_ < 32; ++q_) { if ((q_ & 7) == 0) asm volatile("" ::: "memory"); acc = __builtin_amdgcn_mfma_f32_32x32x2f32(ap[2 * ((k0) + q_)], src[q_], acc, 0, 0, 0); } } while (0)
                if (!(skip & 1)) { N2_MM(wA, 0); N2_LD(wA, 64); N2_MM(wB, 32); N2_LD(wB, 96); N2_MM(wA, 64); N2_MM(wB, 96); }
            }
            __syncthreads();
            LAS float* PART = (LAS float*)(L);
#pragma unroll
            for (int r = 0; r < 16; ++r) PART[(kq * 32 + crow(r, hh)) * 64 + 32 * eh + r32] = acc[r];
            __syncthreads();
            if (!(skip & 2))
            {
                LAS float* rowb = (LAS float*)(L + 32768 + wid * 4096);
                int lane_t = F.lane; asm volatile("" : "+v"(lane_t)); const int lane = lane_t;
                const int g = lane >> 3;
                float score[4], sel[4]; unsigned key[4];
#pragma unroll
                for (int i = 0; i < 4; ++i) { const int tl = wid * 4 + i;
                    const float x = (PART[(0 * 32 + tl) * 64 + lane] + PART[(1 * 32 + tl) * 64 + lane]) + (PART[(2 * 32 + tl) * 64 + lane] + PART[(3 * 32 + tl) * 64 + lane]);
                    score[i] = 1.f / (1.f + expf(-x)); sel[i] = score[i] + rb; rowb[i * 256 + lane] = sel[i]; }
                LDS_WAIT();
#pragma unroll
                for (int i = 0; i < 4; ++i) { const LAS float* row = rowb + i * 256;
                    const f32x4 a = *(const LAS f32x4*)(row + 8 * g), c2 = *(const LAS f32x4*)(row + 8 * g + 4);
                    float m1 = fmaxf(a[0], a[1]), m2 = fminf(a[0], a[1]);
#define TK_INS(v_) do { const float v__ = (v_); m2 = fmaxf(m2, fminf(m1, v__)); m1 = fmaxf(m1, v__); } while (0)
                    TK_INS(a[2]); TK_INS(a[3]); TK_INS(c2[0]); TK_INS(c2[1]); TK_INS(c2[2]); TK_INS(c2[3]);
#undef TK_INS
                    if ((lane & 7) == 0) rowb[i * 256 + 64 + g] = m1 + m2; }
                LDS_WAIT();
#pragma unroll
                for (int i = 0; i < 4; ++i) { const LAS float* row = rowb + i * 256;
                    const f32x4 a = *(const LAS f32x4*)(row + 64), c2 = *(const LAS f32x4*)(row + 68);
                    const float gsv[8] = {a[0], a[1], a[2], a[3], c2[0], c2[1], c2[2], c2[3]};
                    float mine = 0.f;
#pragma unroll
                    for (int q = 0; q < 8; ++q) if (q == g) mine = gsv[q];
                    int gr = 0;
#pragma unroll
                    for (int q = 0; q < 8; ++q) gr += ((gsv[q] > mine) || (gsv[q] == mine && q < g)) ? 1 : 0;
                    const unsigned sb = __float_as_uint(sel[i]); key[i] = (gr < 4) ? (sb ^ ((unsigned)((int)sb >> 31) | 0x80000000u)) : 0u; }
                unsigned chosenm = 0u; float wsum[4] = {0.f, 0.f, 0.f, 0.f}; int myE = 0; float myS = 0.f;
#pragma unroll
                for (int r = 0; r < 8; ++r)
#pragma unroll
                    for (int i = 0; i < 4; ++i) {
                        const unsigned m = wave_umax_all(key[i]);
                        const int idx = __builtin_ctzll(__builtin_amdgcn_ballot_w64(key[i] == m));
                        const float sc = __int_as_float(__builtin_amdgcn_readlane(__float_as_int(score[i]), idx));
                        wsum[i] += sc;
                        if (lane == idx) { key[i] = 0u; chosenm += 1u; }
                        if (lane == 8 * i + r) { myE = idx; myS = sc; }
                    }
                {
                    const int ti = lane >> 3; const float ws_ = (ti == 0) ? wsum[0] : (ti == 1) ? wsum[1] : (ti == 2) ? wsum[2] : wsum[3];
                    if (lane < 32) { const size_t o = (size_t)(T0 + wid * 4) * 8 + lane;
                        *(GAS int*)(TOPE + o) = myE; *(GAS float*)(TOPW + o) = myS / ws_ * 2.5f; }
                    if (chosenm) __hip_atomic_fetch_add(&hist[lane], chosenm, __ATOMIC_RELAXED, __HIP_MEMORY_SCOPE_WORKGROUP);
                }
                LDS_WAIT();
            }
            __syncthreads();
        }
        if (F.tid < 64) CNT[vb * 64 + F.tid] = hist[F.tid];
        __syncthreads();
    }
}

__device__ __forceinline__ void phase_scatter(Frame& F) {
    LAS unsigned* red = (LAS unsigned*)(F.lds);
    LAS unsigned* tot = red + 1024; LAS unsigned* padv = tot + 64; LAS unsigned* bef = padv + 64; LAS unsigned* base = bef + 64; LAS unsigned* selm = base + 64;
    const unsigned* CNT = (const unsigned*)wsp(F, WS_CNT); const int* TOPE = (const int*)wsp(F, WS_TOPE); const float* TOPW = (const float*)wsp(F, WS_TOPW);
    unsigned* STOK = (unsigned*)wsp(F, WS_STOK); float* SW = (float*)wsp(F, WS_SW); unsigned* SDST = (unsigned*)wsp(F, WS_SDST); int* TILEE = (int*)wsp(F, WS_TILEE);
    const int tid = F.tid;
    for (int vb = F.c; vb < 256; vb += F.G) {
        { const int e = tid & 63, part = tid >> 6; unsigned t = 0, bfv = 0;
          for (int blk = 32 * part; blk < 32 * part + 32; ++blk) { const unsigned v = CNT[blk * 64 + e]; t += v; if (blk < vb) bfv += v; }
          red[part * 64 + e] = t; red[512 + part * 64 + e] = bfv; }
        if (tid < 128) selm[tid] = 0u;
        __syncthreads();
        if (tid < 64) { unsigned T = 0, B = 0;
#pragma unroll
            for (int p = 0; p < 8; ++p) { T += red[p * 64 + tid]; B += red[512 + p * 64 + tid]; }
            tot[tid] = T; padv[tid] = (T + 255u) & ~255u; bef[tid] = B; }
        __syncthreads();
        if (tid < 64) { unsigned b = 0; for (int e = 0; e < tid; ++e) b += padv[e]; base[tid] = b; }
        const int tok = tid >> 3, slot = tid & 7, gt = vb * 64 + tok; const int e = TOPE[(size_t)gt * 8 + slot];
        __hip_atomic_fetch_or(&selm[e * 2 + (tok >> 5)], 1u << (tok & 31), __ATOMIC_RELAXED, __HIP_MEMORY_SCOPE_WORKGROUP);
        __syncthreads();
        { const unsigned lo = selm[e * 2], hi = selm[e * 2 + 1];
          const unsigned rank = (tok < 32) ? __popc(lo & ((1u << tok) - 1u)) : (__popc(lo) + __popc(hi & ((1u << (tok - 32)) - 1u)));
          const unsigned pos = base[e] + bef[e] + rank;
          STOK[pos] = (unsigned)gt; SW[pos] = TOPW[(size_t)gt * 8 + slot]; SDST[pos] = (unsigned)(gt * 8 + slot); }
        if (vb < 64) { const unsigned n = padv[vb] - tot[vb]; if ((unsigned)tid < n) { const unsigned pos = base[vb] + tot[vb] + tid; STOK[pos] = 0u; SW[pos] = 0.f; SDST[pos] = 0xffffffffu; } }
        if (vb == 0) { const int ntiles = (int)((base[63] + padv[63]) >> 8);
            for (int pm = tid; pm < ntiles; pm += 512) { int ee = 0; for (int q = 0; q < 64; ++q) if ((unsigned)(256 * pm) >= base[q] && (unsigned)(256 * pm) < base[q] + padv[q]) ee = q; TILEE[pm] = ee; }
            if (tid == 0) TILEE[1000] = ntiles; }
        __syncthreads();
    }
}

struct RoutedOrder {
    int ntiles, G, c; const LAS int* tabE; const LAS unsigned* tabTok; int wave;
    __device__ __forceinline__ bool next(int i, pg8::Unit& u) const { const int pm = i * G + c; if (pm >= ntiles) return false; u.pm = pm; u.pn = tabE[i]; return true; }
    __device__ __forceinline__ unsigned rowtok(int i, int row) const { return tabTok[i * 256 + row]; }
};
struct DownOrder {
    int nunits, G, v; const LAS int* tabE; int wave;
    __device__ __forceinline__ bool next(int i, pg8::Unit& u) const { const int L = i * G + v; if (L >= nunits) return false; u.pm = L >> 2; u.pn = tabE[i] * 4 + (L & 3); return true; }
    __device__ __forceinline__ unsigned rowtok(int, int) const { return 0u; }
};

__device__ __forceinline__ void phase_combine(Frame& F, int l, bool do_store) {
    const bf16* Y = (const bf16*)wsp(F, WS_R1); bf16* XN = (bf16*)wsp(F, WS_R2); float* GATES = (float*)wsp(F, WS_GATES);
    const bool last = (l == NLAYER - 1);
    for (int vb = F.c; vb < 256; vb += F.G) {
        const int b = vb >> 6;
        const float* g2 = (const float*)wsp(F, WS_MODF) + (size_t)(l * 4 + b) * 6144 + 5 * 1024;
        float gbl = 0.f;
        if (!last) { norm1_tables(F, l + 1, b, false); gbl = (F.lane < 4) ? inp(F, I_IGB)[(l + 1) * 4 + F.lane] : (F.lane < 8 ? inp(F, I_FGB)[(l + 1) * 4 + F.lane - 4] : 0.f); }
        __syncthreads();
        v2u yn[8][2];
        const bf16* SHO = (const bf16*)wsp(F, WS_R1 + 128 * MiB);
#define CB_LOAD(tt) do { const int t_ = (tt); \
            _Pragma("unroll") for (int s = 0; s < 8; ++s) _Pragma("unroll") for (int j = 0; j < 2; ++j) yn[s][j] = *(const GAS v2u*)((const unsigned char*)Y + ((size_t)t_ * 8 + s) * 1024 + 8 * F.lane + 512 * j); \
            } while (0)
        CB_LOAD(vb * 64 + F.wave * 8);
        for (int i = 0; i < 8; ++i) {
            const int t = vb * 64 + F.wave * 8 + i;
            v2u yc[8][2]; v4u xc[2]; v4u sc2[2]; bf16* xbr = xmid(F, l) + (size_t)t * 1024 + 8 * F.lane;
#pragma unroll
            for (int j = 0; j < 2; ++j) sc2[j] = *(const GAS v4u*)(SHO + (size_t)t * 1024 + 8 * F.lane + 512 * j);
#pragma unroll
            for (int s = 0; s < 8; ++s) { yc[s][0] = yn[s][0]; yc[s][1] = yn[s][1]; }
#pragma unroll
            for (int j = 0; j < 2; ++j) xc[j] = *(const GAS v4u*)(xbr + 512 * j);
            if (i + 1 < 8) CB_LOAD(t + 1);
            float acc[2][8];
#pragma unroll
            for (int j = 0; j < 2; ++j)
#pragma unroll
                for (int q = 0; q < 8; ++q) acc[j][q] = 0.f;
#pragma unroll
            for (int s = 0; s < 8; ++s)
#pragma unroll
                for (int j = 0; j < 2; ++j) { const v2u q = yc[s][j];
                    const f32x2_t a0 = __builtin_amdgcn_cvt_pk_f32_fp8((int)q.x, false), a1 = __builtin_amdgcn_cvt_pk_f32_fp8((int)q.x, true), a2 = __builtin_amdgcn_cvt_pk_f32_fp8((int)q.y, false), a3 = __builtin_amdgcn_cvt_pk_f32_fp8((int)q.y, true);
                    acc[j][0] += a0.x; acc[j][1] += a0.y; acc[j][2] += a1.x; acc[j][3] += a1.y; acc[j][4] += a2.x; acc[j][5] += a2.y; acc[j][6] += a3.x; acc[j][7] += a3.y; }
            float v[2][8]; float* xr = outp(F) + (size_t)t * 1024 + 8 * F.lane;
#pragma unroll
            for (int j = 0; j < 2; ++j) { const f32x4 a = {bflo(xc[j].x), bfhi(xc[j].x), bflo(xc[j].y), bfhi(xc[j].y)}, c2 = {bflo(xc[j].z), bfhi(xc[j].z), bflo(xc[j].w), bfhi(xc[j].w)};
                const f32x4 ga = *(const GAS f32x4*)(g2 + 8 * F.lane + 512 * j), gc = *(const GAS f32x4*)(g2 + 8 * F.lane + 512 * j + 4);
                const float sh[8] = {bflo(sc2[j].x), bfhi(sc2[j].x), bflo(sc2[j].y), bfhi(sc2[j].y), bflo(sc2[j].z), bfhi(sc2[j].z), bflo(sc2[j].w), bfhi(sc2[j].w)};
#pragma unroll
                for (int q = 0; q < 4; ++q) { v[j][q] = a[q] + ga[q] * (acc[j][q] * (1.f / YS_SCALE) + sh[q]); v[j][4 + q] = c2[q] + gc[q] * (acc[j][4 + q] * (1.f / YS_SCALE) + sh[4 + q]); } }
            if (last) {
                float ss = 0.f;
#pragma unroll
                for (int j = 0; j < 2; ++j)
#pragma unroll
                    for (int q = 0; q < 8; ++q) ss += v[j][q] * v[j][q];
                ss = wave_sum(ss, F.lane);
                const float r = 1.0f / sqrtf(ss * (1.f / 1024.f) + EPS);
#pragma unroll
                for (int j = 0; j < 2; ++j) { const float* fw = inp(F, I_FNW) + 8 * F.lane + 512 * j; const f32x4 w0 = *(const GAS f32x4*)fw, w1 = *(const GAS f32x4*)(fw + 4);
                    f32x4 o0, o1;
#pragma unroll
                    for (int q = 0; q < 4; ++q) { o0[q] = v[j][q] * r * w0[q]; o1[q] = v[j][4 + q] * r * w1[q]; }
                    if (do_store) { *(GAS f32x4*)(xr + 512 * j) = o0; *(GAS f32x4*)(xr + 512 * j + 4) = o1; } else asm volatile("" :: "v"(o0), "v"(o1)); }
            } else {
#pragma unroll
                for (int j = 0; j < 2; ++j) { v4u o; o.x = pk2(v[j][0], v[j][1]); o.y = pk2(v[j][2], v[j][3]); o.z = pk2(v[j][4], v[j][5]); o.w = pk2(v[j][6], v[j][7]);
                    if (do_store) { *(GAS v4u*)(xbr + 512 * j) = o; } else asm volatile("" :: "v"(o)); }
                if (do_store) norm_emit(F, v, (const LAS float*)(F.lds + LDS_TAB), (const LAS float*)(F.lds + LDS_TAB) + 1024, (const LAS float*)(F.lds), gbl, XN + (size_t)t * 1024, GATES + (size_t)t * 8);
            }
        }
#undef CB_LOAD
        __syncthreads();
    }
}

__device__ __forceinline__ void dbg_final(Frame& F, const float* src) {
    for (int vb = F.c; vb < 256; vb += F.G)
        for (int i = 0; i < 8; ++i) {
            const int t = vb * 64 + F.wave * 8 + i; const float* xr = src + (size_t)t * 1024 + 8 * F.lane; float* orow = outp(F) + (size_t)t * 1024 + 8 * F.lane;
            float v[2][8]; float ss = 0.f;
#pragma unroll
            for (int j = 0; j < 2; ++j) { const f32x4 a = *(const GAS f32x4*)(xr + 512 * j), c2 = *(const GAS f32x4*)(xr + 512 * j + 4);
#pragma unroll
                for (int q = 0; q < 4; ++q) { v[j][q] = a[q]; v[j][4 + q] = c2[q]; ss += a[q] * a[q] + c2[q] * c2[q]; } }
            ss = wave_sum(ss, F.lane);
            const float r = 1.0f / sqrtf(ss * (1.f / 1024.f) + EPS);
#pragma unroll
            for (int j = 0; j < 2; ++j) { const float* fw = inp(F, I_FNW) + 8 * F.lane + 512 * j; const f32x4 w0 = *(const GAS f32x4*)fw, w1 = *(const GAS f32x4*)(fw + 4);
                f32x4 o0, o1;
#pragma unroll
                for (int q = 0; q < 4; ++q) { o0[q] = v[j][q] * r * w0[q]; o1[q] = v[j][4 + q] * r * w1[q]; }
                *(GAS f32x4*)(orow + 512 * j) = o0; *(GAS f32x4*)(orow + 512 * j + 4) = o1; }
        }
}
struct Args { const float* in[24]; float* out; unsigned char* ws; };
#ifndef MK_EN_MASK
#define MK_EN_MASK 0xffffffffu
#endif
#define EN(k) (((MK_EN_MASK) >> (k)) & 1u)
#ifndef RP_G1
#define RP_G1 1
#endif
#ifndef RP_ATT
#define RP_ATT 1
#endif
#ifndef RP_ML
#define RP_ML 1
#endif
#ifndef RP_N2
#define RP_N2 1
#endif
#ifndef RP_CW
#define RP_CW 1
#endif
#ifndef RP_C
#define RP_C 1
#endif
#ifndef RP_D
#define RP_D 1
#endif
#ifndef RP_CV
#define RP_CV 1
#endif
#ifndef RP_PB
#define RP_PB 1
#endif
#ifndef RP_VT
#define RP_VT 1
#endif
#ifndef RP_PA
#define RP_PA 1
#endif
#ifndef RP_SC
#define RP_SC 1
#endif
#ifndef RP_SG
#define RP_SG 1
#endif
#ifndef ML_SKIP
#define ML_SKIP 0
#endif
#ifndef RP_X5
#define RP_X5 1
#endif
#ifndef RP_E
#define RP_E 1
#endif
#ifndef RP_HM
#define RP_HM 1
#endif
#ifndef RP_P1
#define RP_P1 1
#endif
#ifndef RP_SD
#define RP_SD 1
#endif
#ifndef N2_SKIP
#define N2_SKIP 0
#endif
#ifndef MK_LAST_PHASE
#define MK_LAST_PHASE 1000
#endif
__global__ void __launch_bounds__(512, 2) mk_fwd(Args args) {
    extern __shared__ __attribute__((aligned(16))) unsigned char lds_raw[];
    Frame F;
    F.lds = (LAS unsigned char*)lds_raw;
    const int wave0 = __builtin_amdgcn_readfirstlane((int)threadIdx.x >> 6);
#define RELOAD_IDS() do { int l_ = lane_now(); F.lane = l_; F.wave = wave0; F.tid = wave0 * 64 + l_; } while (0)
    RELOAD_IDS();
    F.G = gridDim.x; F.c = blockIdx.x;
    F.out = args.out; F.ws = args.ws;
    if (F.tid < 16) ((LAS unsigned*)(F.lds + LDS_CTL))[F.tid] = 0u;
#pragma unroll
    for (int i = 0; i < 24; ++i) if (F.tid == 64 + i) *(LAS unsigned long long*)(F.lds + LDS_CTL + 64 + 8 * i) = (unsigned long long)args.in[i];
    __syncthreads();
    XcdBarrier bar = xcd_barrier_post((unsigned*)wsp(F, WS_CTL) + CW_BAR, (volatile LAS unsigned*)(F.lds + LDS_CTL));
#define P6 ((bf16*)wsp(F, WS_P6))
#define VT ((bf16*)wsp(F, WS_VT))
#define R2 ((bf16*)wsp(F, WS_R2))
#define MODF ((const float*)wsp(F, WS_MODF))
#define GRID_BAR() do { XcdBarrier b_ = bar; asm volatile("" : "+s"(b_.bar), "+s"(b_.x)); xcd_barrier(b_); } while (0)
    int phase_no = 0;
#ifndef RP_BAR
#define RP_BAR 1
#endif
#define PHASE_END() do { for (int rb_ = 0; rb_ < RP_BAR; ++rb_) GRID_BAR(); RELOAD_IDS(); if (++phase_no >= MK_LAST_PHASE) goto finish; } while (0)

    if (EN(0)) { mod_partials(F);
    for (int rp = 0; rp < RP_CW; ++rp) { RELOAD_IDS(); conv_weights(F, 0); } }
    PHASE_END();
    for (int rp = 0; rp < RP_P1; ++rp) if (EN(1)) phase_norm1_first(F);
    PHASE_END();

#pragma unroll
    for (int l = 0; l < NLAYER; ++l) {
        if (EN(2)) { phase_mlstm_scalars(F); RELOAD_IDS(); }
        for (int rp = 0; rp < RP_G1; ++rp) if (EN(2)) {
            pg8::Gemm g{R2, (const bf16*)wsp(F, WS_BIN), 1024, 1024}; pg8::StaticOrder S; S.init(NTOK, P6W, F.G, F.c, F.wave);
            EpiPlain E{P6, P6W};
            pg8::gemm_phase<EpiPlain, pg8::StaticOrder, true, false>(F.lds, g, S, E);
        }
        for (int rp = 0; rp < RP_VT; ++rp) if (EN(3)) {
            pg8::Gemm g{(const bf16*)wsp(F, WS_AIN), R2, 1024, 1024}; pg8::StaticOrder S; S.init(2048, NTOK, F.G, F.c, F.wave);
            EpiPlain E{VT, NTOK};
            pg8::gemm_phase<EpiPlain, pg8::StaticOrder, true, false>(F.lds, g, S, E);
        }
        PHASE_END();
        for (int pass = 0; pass < 2; ++pass) {
            if (((pass ^ F.c) & 1) == 0) { for (int rp = 0; rp < RP_CV; ++rp) if (EN(4)) phase_cvp(F, l); }
            else { for (int rp = 1; rp < RP_ATT; ++rp) phase_attn(F, false); if (EN(5)) phase_attn(F, true); }
            RELOAD_IDS();
        }
        PHASE_END();
        for (int rp = 0; rp < RP_ML; ++rp) if (EN(6)) phase_mlstm(F, (RP_ML > 1 && rp == 0) ? ML_SKIP : 0);
        PHASE_END();
        for (int pass = 0; pass < 2; ++pass) {
            if (((pass ^ F.c) & 1) == 0) { for (int rp = 1; rp < RP_HM; ++rp) phase_hm_final(F, l, false); if (EN(7)) phase_hm_final(F, l, true); }
            else {
        for (int rp = 0; rp < RP_PB; ++rp) if (EN(8)) {
            pg8::Gemm g{P6 + P_SQ, (const bf16*)wsp(F, WS_BB), 1024, P6W}; pg8::StaticOrder S; S.init(NTOK, 1024, F.G, F.c, F.wave);
            EpiGateT1 E{P6 + P_GB, P6W, (bf16*)wsp(F, WS_VT)};
            pg8::gemm_phase<EpiGateT1, pg8::StaticOrder, true, false>(F.lds, g, S, E);
        }
            }
            RELOAD_IDS();
        }
        PHASE_END();
        for (int rp = 0; rp < RP_PA; ++rp) if (EN(9)) {
            pg8::Gemm g{P6 + P_MQK, (const bf16*)wsp(F, WS_BA), 1024, P6W}; pg8::StaticOrder S; S.init(NTOK, 1024, F.G, F.c, F.wave);
            EpiGateY E{P6 + P_GA, P6W, (const bf16*)wsp(F, WS_VT), R2};
            pg8::gemm_phase<EpiGateY, pg8::StaticOrder, true, false>(F.lds, g, S, E);
        }
        PHASE_END();
        for (int rp = 0; rp < RP_X5; ++rp) if (EN(10)) {
            pg8::Gemm g{R2, (const bf16*)wsp(F, WS_BO), 1024, 1024}; pg8::StaticOrder S; S.init(NTOK, 1024, F.G, F.c, F.wave);
            EpiRes E{(const bf16*)outp(F), xmid(F, l), MODF + (size_t)(l * 4) * 6144 + 2 * 1024, (RP_X5 > 1 && rp + 1 < RP_X5) ? 1 : 0};
            pg8::gemm_phase<EpiRes, pg8::StaticOrder, true, false>(F.lds, g, S, E);
        }
        PHASE_END();
        for (int rp = 0; rp < RP_N2; ++rp) if (EN(11)) phase_norm2_router(F, l, (RP_N2 > 1 && rp == 0) ? N2_SKIP : 0);
        PHASE_END();
        for (int rp = 0; rp < RP_SC; ++rp) if (EN(12)) phase_scatter(F);
        PHASE_END();
        {
            const int* TILEE = (const int*)wsp(F, WS_TILEE); const unsigned* STOK = (const unsigned*)wsp(F, WS_STOK);
            const int ntiles = TILEE[1000];
            LAS int* tabE = (LAS int*)(F.lds + LDS_TAB); LAS unsigned* tabTok = (LAS unsigned*)(F.lds + LDS_TAB + 64);
            LAS float* tabW = (LAS float*)(F.lds + LDS_TAB + 64 + 3072); const float* SWp = (const float*)wsp(F, WS_SW);
            for (int i = 0; i < 3; ++i) { const int pm = i * F.G + F.c; if (pm < ntiles) { if (F.tid == 0) tabE[i] = TILEE[pm]; if (F.tid < 256) { tabTok[i * 256 + F.tid] = STOK[(size_t)pm * 256 + F.tid]; tabW[i * 256 + F.tid] = SWp[(size_t)pm * 256 + F.tid]; } } }
            __syncthreads();
            for (int rp = 0; rp < RP_C; ++rp) if (EN(13)) {
                pg8::Gemm g{(const bf16*)wsp(F, WS_R1), (const bf16*)wsp(F, WS_BGU), 1024, 1024}; RoutedOrder S{ntiles, F.G, F.c, tabE, tabTok, F.wave};
                EpiHid E{R2, 128, tabW, F.c, F.G, 0};
                pg8::gemm_phase<EpiHid, RoutedOrder, true, true>(F.lds, g, S, E);
            }
            for (int rp = 0; rp < RP_SG; ++rp) if (EN(14)) {
                pg8::Gemm g{(const bf16*)wsp(F, WS_R1), (const bf16*)wsp(F, WS_BSGU), 1024, 1024}; pg8::StaticOrder S; S.init(NTOK, 512, F.G, F.G - 1 - F.c, F.wave);
                EpiHid E{(bf16*)wsp(F, WS_R3), 256, nullptr, 0, 1, 1};
                pg8::gemm_phase<EpiHid, pg8::StaticOrder, true, false>(F.lds, g, S, E);
            }
        }
        PHASE_END();
        {
            const int* TILEE = (const int*)wsp(F, WS_TILEE);
            const int ntiles = TILEE[1000], nunits = 4 * ntiles;
            const int v = (F.G % 8 == 0) ? (F.c % 8) * (F.G / 8) + F.c / 8 : F.c;
            LAS int* tabE = (LAS int*)(F.lds + LDS_TAB);
            if (F.tid < 16) { const int L = F.tid * F.G + v; tabE[F.tid] = (L < nunits) ? TILEE[L >> 2] : 0; }
            LAS unsigned* tabD = (LAS unsigned*)(F.lds + LDS_TAB + 64); const unsigned* SDp = (const unsigned*)wsp(F, WS_SDST);
            for (int i = 0; i < 10; ++i) { const int L = i * F.G + v; if (L < nunits && F.tid < 256) tabD[i * 256 + F.tid] = SDp[(size_t)(L >> 2) * 256 + F.tid]; }
            __syncthreads();
            for (int rp = 0; rp < RP_D; ++rp) if (EN(15)) {
                pg8::Gemm g{R2, (const bf16*)wsp(F, WS_BD), 128, 128}; DownOrder S{nunits, F.G, v, tabE, F.wave};
                EpiScatter E{(bf16*)wsp(F, WS_R1), tabD, v, F.G, (RP_D > 1 && rp > 0) ? 1 : 0};
                pg8::gemm_phase<EpiScatter, DownOrder, true, false>(F.lds, g, S, E);
            }
            for (int rp = 0; rp < RP_SD; ++rp) if (EN(16)) {
                pg8::Gemm g{(const bf16*)wsp(F, WS_R3), (const bf16*)wsp(F, WS_BSD), 256, 256}; pg8::StaticOrder S; S.init(NTOK, 1024, F.G, F.c, F.wave);
                EpiPlain E{(bf16*)wsp(F, WS_R1 + 128 * MiB), 1024};
                pg8::gemm_phase<EpiPlain, pg8::StaticOrder, true, false>(F.lds, g, S, E);
            }
        }
        PHASE_END();
        for (int rp = 1; rp < RP_E; ++rp) phase_combine(F, l, false);
        if (EN(17)) phase_combine(F, l, true);
        if (l + 1 < NLAYER) { RELOAD_IDS(); if (EN(18)) conv_weights(F, l + 1); PHASE_END(); }
    }
#undef P6
#undef VT
#undef R2
#undef MODF
finish:
    if (MK_LAST_PHASE < 1000) dbg_final(F, phase_no >= 8 ? (const float*)outp(F) : inp(F, I_X));
}

extern "C" void kernel_launch(void* const* d_in, const int* in_sizes, int n_in, void* d_out, int out_size, void* d_ws, size_t ws_size, hipStream_t stream) {
    static int grid = 0;
    if (grid == 0) {
        if (n_in != 24 || in_sizes[0] != NTOK * DM || out_size != NTOK * DM || ws_size < WS_END) {
            fprintf(stderr, "kernel_launch: unexpected shapes (n_in %d, in0 %d, out %d, ws %zu < %zu); nothing launched\n", n_in, n_in > 0 ? in_sizes[0] : -1, out_size, ws_size, (size_t)WS_END); grid = -1; return; }
        int dev = 0, cus = 0, per_cu = 0;
        if (hipGetDevice(&dev) != hipSuccess || hipDeviceGetAttribute(&cus, hipDeviceAttributeMultiprocessorCount, dev) != hipSuccess) { grid = -1; return; }
        if (hipFuncSetAttribute((const void*)mk_fwd, hipFuncAttributeMaxDynamicSharedMemorySize, LDS_BYTES) != hipSuccess) { fprintf(stderr, "kernel_launch: hipFuncSetAttribute failed\n"); grid = -1; return; }
        if (hipOccupancyMaxActiveBlocksPerMultiprocessor(&per_cu, (const void*)mk_fwd, 512, LDS_BYTES) != hipSuccess || per_cu < 1)
            fprintf(stderr, "kernel_launch: note: occupancy query reports %d workgroups per CU\n", per_cu);
        (void)hipGetLastError();
        grid = cus;
    }
    if (grid < 0) return;
    if (hipMemsetAsync((char*)d_ws + WS_CTL, 0, CTL_ZERO_BYTES, stream) != hipSuccess) return;
    Args a{};
    for (int i = 0; i < 24; ++i) a.in[i] = (const float*)d_in[i];
    a.out = (float*)d_out; a.ws = (unsigned char*)d_ws;
    hipLaunchKernelGGL(mk_fwd, dim3(grid), dim3(512), LDS_BYTES, stream, a);
}
```

```cpp
#include <hip/hip_runtime.h>
#include <cstdio>
#include <cstdint>
#include <cmath>
namespace pg8 {
#define PG8_LAS __attribute__((address_space(3)))
typedef unsigned short bf16_t;
typedef short bf16x8 __attribute__((ext_vector_type(8)));
typedef float f32x4 __attribute__((ext_vector_type(4)));
typedef unsigned u32x4 __attribute__((ext_vector_type(4)));
constexpr int BM = 256, BK = 64, HALF = 128, HTB = HALF * BK * 2  , STAGE_BYTES = 8 * HTB, NXCD = 8, WGM = 8;

__host__ __device__ __forceinline__ int lds_byte(int r, int c) { const int st = (r >> 4) * 2 + (c >> 5), rr = r & 15, cc = c & 31, ob = rr * 64 + cc * 2; return st * 1024 + (ob ^ (((ob >> 9) & 1) << 5)); }
__host__ __device__ __forceinline__ void stage_rc(int b, int& R, int& C) { const int st = b / 1024, sb = b % 1024, swz = sb ^ (((sb >> 9) & 1) << 5); R = (st >> 1) * 16 + swz / 64; C = (st & 1) * 32 + (swz % 64) / 2; }
__host__ __device__ __forceinline__ int perm32(int rho) { const int n = rho >> 4, i = rho & 15; return 8 * (i >> 2) + 4 * n + (i & 3); }

struct Unit { int pm, pn; };
struct Gemm { const bf16_t* A; const bf16_t* Bt; int K; int lda; };

struct StaticOrder {
    int nM, nN, nwg, G, c, wave;
    __device__ void init(int M, int N, int G_, int c_, int wave_) { nM = M / BM; nN = N / BM; nwg = nM * nN; G = G_; c = c_; wave = wave_; }
    __device__ bool next(int i, Unit& u) const {
        const long L = (long)i * G + c; if (L >= nwg) return false;
        int wgid = (int)L; { const int q = nwg / NXCD, r = nwg % NXCD, xcd = wgid % NXCD, off = wgid / NXCD; wgid = (xcd < r ? xcd * (q + 1) : r * (q + 1) + (xcd - r) * q) + off; }
        const int nig = WGM * nN, gid = wgid / nig, fm = gid * WGM, gsz = (nM - fm) < WGM ? (nM - fm) : WGM;
        u.pm = fm + ((wgid % nig) % gsz); u.pn = (wgid % nig) / gsz; return true;
    }
    __device__ __forceinline__ unsigned rowtok(int, int) const { return 0u; }
};

template <class Epi, class Sched, bool ALIGN_EPI, bool GATHER>
__device__ __forceinline__ void gemm_phase(PG8_LAS unsigned char* lds, const Gemm g, const Sched& S, const Epi& E) {
    int lane_; asm volatile("v_mbcnt_lo_u32_b32 %0, -1, 0\n\tv_mbcnt_hi_u32_b32 %0, -1, %0" : "=v"(lane_));
    const int wid = S.wave, lane = lane_, tid = wid * 64 + lane, wr = wid >> 2, wc = wid & 3, fr = lane & 15, fq = lane >> 4;
    int K_ = g.K, lda_ = g.lda; asm volatile("" : "+s"(K_), "+s"(lda_));
    const int K = K_, nt = K / BK, lda = lda_;
    unsigned vA[2][2], voffB[2];
#pragma unroll
    for (int i = 0; i < 2; ++i) { int R, C; stage_rc(tid * 16 + i * 8192, R, C); const int Rb = Epi::PERM ? ((R & ~31) + perm32(R & 31)) : R;
        voffB[i] = (unsigned)(Rb * K + C) * 2u;
#pragma unroll
        for (int h = 0; h < 2; ++h) vA[h][i] = (unsigned)(((GATHER ? h * HALF : 0) + R) * lda + C) * 2u; }
    const size_t kstep = (size_t)(BK * 2);
    const size_t hstepB = (size_t)HALF * K * 2, tstepB = 2 * hstepB;
    const size_t tstepA = (size_t)BM * lda * 2, hstepA = (size_t)HALF * lda * 2;
    const unsigned ldsw = (unsigned)wid * 1024u;
    const int aoff = lds_byte(wr * 64 + fr, fq * 8), boff = lds_byte(wc * 32 + fr, fq * 8);
#define PG8_SA(b, h) (((b) * 2 + (h)) * HTB)
#define PG8_SB(b, h) ((4 + (b) * 2 + (h)) * HTB)
#define PG8_STAGE(bufoff, gbase, voff) do { _Pragma("unroll") for (int _i = 0; _i < 2; ++_i) \
        __builtin_amdgcn_global_load_lds((const unsigned*)((const char*)(gbase) + (voff)[_i]), (PG8_LAS unsigned*)(lds + (bufoff) + ldsw + _i * 8192), 16, 0, 0); } while (0)
#define PG8_GATHER_SET(ui_, h) do { int l2_; asm volatile("v_mbcnt_lo_u32_b32 %0, -1, 0\n\tv_mbcnt_hi_u32_b32 %0, -1, %0" : "=v"(l2_)); const int tid2_ = wid * 64 + l2_; _Pragma("unroll") for (int _i = 0; _i < 2; ++_i) { int R_, C_; stage_rc(tid2_ * 16 + _i * 8192, R_, C_); vA[h][_i] = (S.rowtok((ui_), (h) * HALF + R_) * (unsigned)lda + (unsigned)C_) * 2u; } } while (0)
#define PG8_STAGE_A(bufoff, gbase, h, NX) do { _Pragma("unroll") for (int _i = 0; _i < 2; ++_i) { const unsigned _v = GATHER ? vA[h][_i] : vA[0][_i]; \
        __builtin_amdgcn_global_load_lds((const unsigned*)((const char*)(gbase) + (GATHER ? (size_t)0 : (size_t)(h) * hstepA) + _v), (PG8_LAS unsigned*)(lds + (bufoff) + ldsw + _i * 8192), 16, 0, 0); } } while (0)
#define PG8_LDA(dst, b, h) do { _Pragma("unroll") for (int m = 0; m < 4; ++m) _Pragma("unroll") for (int k = 0; k < 2; ++k) dst[m][k] = *(const PG8_LAS bf16x8*)(lds + PG8_SA(b, h) + aoff + m * 2048 + k * 1024); } while (0)
#define PG8_LDB(dst, b, h) do { _Pragma("unroll") for (int n = 0; n < 2; ++n) _Pragma("unroll") for (int k = 0; k < 2; ++k) dst[n][k] = *(const PG8_LAS bf16x8*)(lds + PG8_SB(b, h) + boff + n * 2048 + k * 1024); } while (0)
#define PG8_MMA(ai, bj, At, Bt) do { __builtin_amdgcn_s_setprio(1); _Pragma("unroll") for (int m = 0; m < 4; ++m) _Pragma("unroll") for (int n = 0; n < 2; ++n) _Pragma("unroll") for (int k = 0; k < 2; ++k) \
        acc[ai][bj][m][n] = __builtin_amdgcn_mfma_f32_16x16x32_bf16(Bt[n][k], At[m][k], acc[ai][bj][m][n], 0, 0, 0); __builtin_amdgcn_s_setprio(0); } while (0)
#define PG8_WAIT_V(n) asm volatile("s_waitcnt vmcnt(" #n ")" ::: "memory")
#define PG8_WAIT_L(n) asm volatile("s_waitcnt lgkmcnt(" #n ")" ::: "memory")
#define PG8_BAR __builtin_amdgcn_s_barrier()
#define PG8_SCHED __builtin_amdgcn_sched_barrier(0)
    Unit cur, nxt; int ui = 0;
    if (!S.next(0, cur)) return;
    if constexpr (GATHER) { PG8_GATHER_SET(0, 0); PG8_GATHER_SET(0, 1); }
    f32x4 acc[2][2][4][2];
#pragma unroll
    for (int a = 0; a < 2; ++a)
#pragma unroll
        for (int b = 0; b < 2; ++b)
#pragma unroll
            for (int m = 0; m < 4; ++m)
#pragma unroll
                for (int n = 0; n < 2; ++n) acc[a][b][m][n] = (f32x4){0.f, 0.f, 0.f, 0.f};
    bf16x8 At[4][2], B0[2][2], B1[2][2];
    const char* cA = (const char*)g.A + (GATHER ? (size_t)0 : (size_t)cur.pm * tstepA); const char* cB = (const char*)g.Bt + (size_t)cur.pn * tstepB;
    PG8_STAGE(PG8_SB(0, 0), cB, voffB); PG8_STAGE(PG8_SB(0, 1), cB + hstepB, voffB); PG8_STAGE_A(PG8_SA(0, 0), cA, 0, false); PG8_STAGE_A(PG8_SA(0, 1), cA, 1, false);
    if (wr == 1) PG8_BAR;
    PG8_WAIT_V(2); PG8_BAR;
    PG8_STAGE(PG8_SB(1, 0), cB + kstep, voffB); PG8_STAGE_A(PG8_SA(1, 0), cA + kstep, 0, false); PG8_STAGE(PG8_SB(1, 1), cB + hstepB + kstep, voffB);
    PG8_WAIT_V(6); PG8_BAR;
    for (;;) {
        const bool has_next = S.next(ui + 1, nxt);
        const char* nA = (has_next && !GATHER) ? (const char*)g.A + (size_t)nxt.pm * tstepA : (GATHER ? (const char*)g.A : cA);
        const char* nB = has_next ? (const char*)g.Bt + (size_t)nxt.pn * tstepB : cB;
        for (int t = 0; t < nt; t += 2) {
            const bool last = (t == nt - 2);
            const char* a1 = cA + (size_t)(t + 1) * kstep;
            const char* a2 = last ? nA : cA + (size_t)(t + 2) * kstep; const char* b2 = last ? nB : cB + (size_t)(t + 2) * kstep;
            const char* a3 = a2 + kstep; const char* b3 = b2 + kstep;
            if constexpr (GATHER) { if (last && has_next) PG8_GATHER_SET(ui + 1, 0); }
            PG8_LDB(B0, 0, 0); PG8_LDB(B1, 0, 1); PG8_SCHED; PG8_LDA(At, 0, 0); PG8_STAGE_A(PG8_SA(1, 1), a1, 1, false);
            if constexpr (GATHER) { if (last && has_next) PG8_GATHER_SET(ui + 1, 1); }
            PG8_WAIT_V(8); PG8_WAIT_L(0); PG8_BAR; PG8_MMA(0, 0, At, B0); PG8_MMA(0, 1, At, B1); PG8_BAR; PG8_SCHED;
            PG8_LDA(At, 0, 1); PG8_STAGE(PG8_SB(0, 0), b2, voffB); PG8_STAGE(PG8_SB(0, 1), b2 + hstepB, voffB); PG8_STAGE_A(PG8_SA(0, 0), a2, 0, last);
            PG8_WAIT_V(8); PG8_WAIT_L(0); PG8_BAR; PG8_MMA(1, 0, At, B0); PG8_MMA(1, 1, At, B1); PG8_BAR; PG8_SCHED;
            PG8_LDB(B0, 1, 0); PG8_LDB(B1, 1, 1); PG8_SCHED; PG8_LDA(At, 1, 0); PG8_STAGE_A(PG8_SA(0, 1), a2, 1, last);
            PG8_WAIT_V(8); PG8_WAIT_L(0); PG8_BAR; PG8_MMA(0, 0, At, B0); PG8_MMA(0, 1, At, B1); PG8_BAR; PG8_SCHED;
            PG8_LDA(At, 1, 1); PG8_STAGE(PG8_SB(1, 0), b3, voffB); PG8_STAGE(PG8_SB(1, 1), b3 + hstepB, voffB); PG8_STAGE_A(PG8_SA(1, 0), a3, 0, last);
            PG8_WAIT_V(8); PG8_WAIT_L(0); PG8_BAR; PG8_MMA(1, 0, At, B0); PG8_MMA(1, 1, At, B1); PG8_BAR; PG8_SCHED;
        }
        if constexpr (ALIGN_EPI) { if (wr == 0) PG8_BAR; }
        { Unit eu; eu.pm = __builtin_amdgcn_readfirstlane(cur.pm); eu.pn = __builtin_amdgcn_readfirstlane(cur.pn); int fr_ = fr, fq_ = fq; asm volatile("" : "+s"(eu.pm), "+s"(eu.pn), "+v"(fr_), "+v"(fq_));
          E(acc, eu, wr, wc, fr_, fq_); }
        if (!has_next) break;
#pragma unroll
        for (int a = 0; a < 2; ++a)
#pragma unroll
            for (int b = 0; b < 2; ++b)
#pragma unroll
                for (int m = 0; m < 4; ++m)
#pragma unroll
                    for (int n = 0; n < 2; ++n) acc[a][b][m][n] = (f32x4){0.f, 0.f, 0.f, 0.f};
        cur = nxt; cA = nA; cB = nB; ++ui;
        if constexpr (ALIGN_EPI) { if (wr == 1) PG8_BAR; }
    }
    PG8_WAIT_V(0);
    if constexpr (!ALIGN_EPI) { if (wr == 0) PG8_BAR; }
    PG8_BAR;
#undef PG8_SA
#undef PG8_SB
#undef PG8_STAGE
#undef PG8_STAGE_A
#undef PG8_GATHER_SET
#undef PG8_LDA
#undef PG8_LDB
#undef PG8_MMA
#undef PG8_WAIT_V
#undef PG8_WAIT_L
#undef PG8_BAR
#undef PG8_SCHED
}
}

constexpr int NTOK = 16384, DM = 1024, SEQ = 4096, NB = 4, NLAYER = 2;
constexpr int INW = 8200;
constexpr int C_MQK = 0, C_MV = 1024, C_MO = 2048, C_MI = 3072, C_MF = 3076, C_SQ = 3080, C_SK = 4104, C_SV = 5128, C_GA = 6152, C_GB = 7176;
constexpr int P6W = 6144;
constexpr int P_MQK = 0, P_MO = 1024, P_SQ = 2048, P_SK = 3072, P_GA = 4096, P_GB = 5120;
constexpr int NEXP = 64, EFF = 128, SFF = 256, TOPK = 8;
constexpr int MAXROWS = NTOK * TOPK + NEXP * 256;
constexpr int MAXTILES = MAXROWS / 256;
constexpr float EPS = 1e-6f;
constexpr float LOG2E = 1.4426950408889634f;

constexpr size_t MiB = 1u << 20;
constexpr size_t WS_CTL = 0, CTL_ZERO_BYTES = 3456 * 4;
constexpr size_t WS_MODP = 1 * MiB;
constexpr size_t WS_MODF = 4 * MiB;
constexpr size_t WS_GATES = WS_MODF + 256 * 1024;
constexpr size_t WS_TOPE = WS_GATES + 512 * 1024;
constexpr size_t WS_TOPW = WS_TOPE + 512 * 1024;
constexpr size_t WS_CNT = WS_TOPW + 512 * 1024;
constexpr size_t WS_STOK = WS_CNT + 64 * 1024;
constexpr size_t WS_SW = WS_STOK + 576 * 1024;
constexpr size_t WS_SDST = WS_SW + 576 * 1024;
constexpr size_t WS_TILEE = WS_SDST + 576 * 1024;
constexpr size_t WS_MISC_END = WS_TILEE + 4096;
static_assert(WS_MISC_END <= 8 * MiB, "misc region");
constexpr size_t WS_BIN = 8 * MiB;
constexpr size_t WS_AIN = WS_BIN + 12 * MiB;
constexpr size_t WS_BA = WS_AIN + 4 * MiB, WS_BB = WS_BA + 2 * MiB, WS_BO = WS_BB + 2 * MiB;
constexpr size_t WS_BGU = WS_BO + 2 * MiB;
constexpr size_t WS_BD = WS_BGU + 32 * MiB;
constexpr size_t WS_BSGU = WS_BD + 16 * MiB;
constexpr size_t WS_BSD = WS_BSGU + 1 * MiB;
constexpr size_t WS_W_END = WS_BSD + 1 * MiB;
constexpr size_t WS_R1 = 80 * MiB;
constexpr size_t WS_P6 = WS_R1, WS_VT = WS_R1 + 192 * MiB;
constexpr size_t WS_R2 = WS_R1 + 256 * MiB;
constexpr size_t WS_R3 = WS_R2 + 36 * MiB;
constexpr size_t WS_PT = WS_R3 + 8 * MiB;
constexpr size_t WS_END = WS_PT + 18 * MiB;
static_assert(WS_W_END <= WS_R1, "weights region");
constexpr int CW_BAR = 0;

constexpr int LDS_BYTES = 147456;
constexpr int LDS_MAIN = 131072;
constexpr int LDS_TAB = 131072;
constexpr int LDS_CTL = LDS_BYTES - 512;

#define GAS __attribute__((address_space(1)))
#define LAS __attribute__((address_space(3)))
typedef unsigned short bf16;
typedef unsigned v4u __attribute__((ext_vector_type(4)));
typedef unsigned v2u __attribute__((ext_vector_type(2)));
typedef float f32x4 __attribute__((ext_vector_type(4)));
typedef float f32x16 __attribute__((ext_vector_type(16)));
typedef short bf16x8 __attribute__((ext_vector_type(8)));
typedef short s16x4 __attribute__((ext_vector_type(4)));
typedef GAS unsigned gu32;
#define RLX_AGENT __ATOMIC_RELAXED, __HIP_MEMORY_SCOPE_AGENT
#define LDS_WAIT() asm volatile("s_waitcnt lgkmcnt(0)" ::: "memory")
typedef float f32x2_t __attribute__((ext_vector_type(2))); typedef __bf16 bf16x2_t __attribute__((ext_vector_type(2)));
__device__ __forceinline__ unsigned pk2(float lo, float hi) { f32x2_t v = {lo, hi}; bf16x2_t b = __builtin_convertvector(v, bf16x2_t); return __builtin_bit_cast(unsigned, b); }
__device__ __forceinline__ unsigned short f2bf(float f) { return (unsigned short)(pk2(f, 0.f) & 0xffffu); }
__device__ __forceinline__ float bflo(unsigned w) { return __uint_as_float(w << 16); }
__device__ __forceinline__ float bfhi(unsigned w) { return __uint_as_float(w & 0xffff0000u); }
__device__ __forceinline__ float bf2f(unsigned short h) { return __uint_as_float((unsigned)h << 16); }
__device__ __forceinline__ float sigmoidf_(float x) { return __builtin_amdgcn_rcpf(1.f + __builtin_amdgcn_exp2f(-x * LOG2E)); }
__device__ __forceinline__ int crow(int r, int hi) { return (r & 3) + 8 * (r >> 2) + 4 * hi; }
__device__ __forceinline__ int lane_now() { int l; asm volatile("v_mbcnt_lo_u32_b32 %0, -1, 0\n\tv_mbcnt_hi_u32_b32 %0, -1, %0" : "=v"(l)); return l; }
__device__ __forceinline__ float shfl_xor_l(float v, int d, int lane) { return __int_as_float(__builtin_amdgcn_ds_bpermute((lane ^ d) << 2, __float_as_int(v))); }
__device__ __forceinline__ float shfl_up_l(float v, int d, int lane) { return __int_as_float(__builtin_amdgcn_ds_bpermute(((lane - d) & 63) << 2, __float_as_int(v))); }
__device__ __forceinline__ unsigned umax_(unsigned a, unsigned b) { return a > b ? a : b; }
__device__ __forceinline__ unsigned wave_umax_all(unsigned v) {
    v = umax_(v, (unsigned)__builtin_amdgcn_update_dpp(0, (int)v, 0x128, 0xf, 0xf, false));
    v = umax_(v, (unsigned)__builtin_amdgcn_update_dpp(0, (int)v, 0x124, 0xf, 0xf, false));
    v = umax_(v, (unsigned)__builtin_amdgcn_update_dpp(0, (int)v, 0x122, 0xf, 0xf, false));
    v = umax_(v, (unsigned)__builtin_amdgcn_update_dpp(0, (int)v, 0x121, 0xf, 0xf, false));
    { auto rr = __builtin_amdgcn_permlane16_swap(v, v, false, false); v = umax_(rr[0], rr[1]); }
    { auto rr = __builtin_amdgcn_permlane32_swap(v, v, false, false); v = umax_(rr[0], rr[1]); }
    return v;
}
__device__ __forceinline__ float half_sum32(float v) {
    v += __int_as_float(__builtin_amdgcn_update_dpp(0, __float_as_int(v), 0x128, 0xf, 0xf, false));
    v += __int_as_float(__builtin_amdgcn_update_dpp(0, __float_as_int(v), 0x124, 0xf, 0xf, false));
    v += __int_as_float(__builtin_amdgcn_update_dpp(0, __float_as_int(v), 0x122, 0xf, 0xf, false));
    v += __int_as_float(__builtin_amdgcn_update_dpp(0, __float_as_int(v), 0x121, 0xf, 0xf, false));
    { auto rr = __builtin_amdgcn_permlane16_swap(__float_as_uint(v), __float_as_uint(v), false, false); v = __uint_as_float(rr[0]) + __uint_as_float(rr[1]); }
    return v;
}
__device__ __forceinline__ float wave_sum(float v, int lane) {
#pragma unroll
    for (int o = 1; o < 64; o <<= 1) v += shfl_xor_l(v, o, lane);
    return v;
}

#define XB_TMO      128
#define XB_XCNT(j)  (256  + 64 * (j))
#define XB_XSUB(j)  (1280 + 64 * (j))
#define XB_XGEN(j)  (2304 + 64 * (j))
#define XB_TOP      3328
#define XB_TOPGEN   3392
#define XCD_BAR_WORDS 3456
#define XB_SPIN_CAP (1u << 18)
__device__ __forceinline__ unsigned xb_ld(unsigned* p)              { return __hip_atomic_load(p, __ATOMIC_RELAXED, __HIP_MEMORY_SCOPE_AGENT); }
__device__ __forceinline__ unsigned xb_add(unsigned* p, unsigned v) { return __hip_atomic_fetch_add(p, v, __ATOMIC_RELAXED, __HIP_MEMORY_SCOPE_AGENT); }
__device__ __forceinline__ unsigned xb_xcc_id() { return (unsigned)__builtin_amdgcn_s_getreg((3 << 11) | 20) & 0xFu; }
#define XB_SPIN(cond, bar) do { unsigned _sp = 0; while (cond) { __builtin_amdgcn_s_sleep(1); \
    if ((++_sp & 255u) == 0u) { if (xb_ld(&(bar)[XB_TMO])) break; if (_sp > XB_SPIN_CAP) { atomicAdd(&(bar)[XB_TMO], 1u); break; } } } } while (0)
struct XcdBarrier { unsigned* bar; unsigned x; volatile LAS unsigned* st; };
__device__ __forceinline__ XcdBarrier xcd_barrier_post(unsigned* bar, volatile LAS unsigned* st) {
    XcdBarrier b; b.bar = bar; b.x = xb_xcc_id(); b.st = st;
    if (threadIdx.x == 0) (void)xb_add(&bar[XB_XCNT(b.x)], 1u);
    return b;
}
__device__ __forceinline__ void xcd_barrier_complete(unsigned* bar, unsigned x, unsigned& nloc, unsigned& nx) {
    const unsigned G = gridDim.x * gridDim.y * gridDim.z;
    unsigned sum, cnt, mine, sp = 0u;
    for (;;) {
        sum = 0u; cnt = 0u; mine = 0u;
#pragma unroll
        for (unsigned j = 0; j < 16; ++j) { const unsigned c = xb_ld(&bar[XB_XCNT(j)]); sum += c; cnt += (c > 0u) ? 1u : 0u; mine = (j == x) ? c : mine; }
        if (sum == G) break;
        __builtin_amdgcn_s_sleep(1);
        if ((++sp & 255u) == 0u) { if (xb_ld(&bar[XB_TMO])) break; if (sp > XB_SPIN_CAP) { atomicAdd(&bar[XB_TMO], 1u); break; } }
    }
    nloc = mine > 0u ? mine : 1u; nx = cnt > 0u ? cnt : 1u;
}
__device__ __forceinline__ void xcd_barrier(const XcdBarrier& b) {
    asm volatile("s_waitcnt vmcnt(0)" ::: "memory");
    __syncthreads();
    if (threadIdx.x == 0) {
        unsigned* bar = b.bar;
        __builtin_amdgcn_s_waitcnt(0);
        unsigned nloc = b.st[0], nx = b.st[1];
        if (nloc == 0u) { xcd_barrier_complete(bar, b.x, nloc, nx); b.st[0] = nloc; b.st[1] = nx; }
        const unsigned old = xb_add(&bar[XB_XSUB(b.x)], 1u);
        const unsigned gen = old / nloc;
        if (old + 1u == (gen + 1u) * nloc) {
            __builtin_amdgcn_fence(__ATOMIC_RELEASE, "agent");
            asm volatile("s_waitcnt vmcnt(0)" ::: "memory");
            const unsigned og = xb_add(&bar[XB_TOP], 1u);
            const unsigned tg = og / nx;
            if (og + 1u == (tg + 1u) * nx) xb_add(&bar[XB_TOPGEN], 1u);
            else XB_SPIN(xb_ld(&bar[XB_TOPGEN]) == tg, bar);
            __builtin_amdgcn_fence(__ATOMIC_ACQUIRE, "agent");
            xb_add(&bar[XB_XGEN(b.x)], 1u);
            asm volatile("s_waitcnt vmcnt(0)" ::: "memory");
        } else {
            XB_SPIN(xb_ld(&bar[XB_XGEN(b.x)]) == gen, bar);
            __builtin_amdgcn_fence(__ATOMIC_ACQUIRE, "agent");
            asm volatile("s_waitcnt vmcnt(0)" ::: "memory");
        }
    }
    __syncthreads();
}

struct Frame {
    LAS unsigned char* lds;
    int tid, lane, wave, G, c;
    float* out; unsigned char* ws;
};
__device__ __forceinline__ unsigned char* wsp(const Frame& F, size_t off) { unsigned char* p = F.ws; asm volatile("" : "+s"(p)); return (unsigned char*)(GAS unsigned char*)(p + off); }
__device__ __forceinline__ float* outp(const Frame& F) { float* p = F.out; asm volatile("" : "+s"(p)); return (float*)(GAS float*)p; }
__device__ __forceinline__ const float* inp(const Frame& F, int i) {
    const LAS unsigned* p = (const LAS unsigned*)(F.lds + LDS_CTL + 64) + 2 * i;
    const unsigned lo = __builtin_amdgcn_readfirstlane(p[0]), hi = __builtin_amdgcn_readfirstlane(p[1]);
    return (const float*)(const GAS float*)(((unsigned long long)hi << 32) | lo);
}
__device__ __forceinline__ bf16* xmid(const Frame& F, int l) { return (l == NLAYER - 1) ? (bf16*)wsp(F, WS_VT) : (bf16*)outp(F); }
enum { I_X = 0, I_C, I_ADAW, I_ADAB, I_N1W, I_WIN, I_CONVW, I_CONVB, I_IGB, I_FGB, I_MNW, I_WPA, I_WPB, I_WOUT, I_N2W, I_RW, I_RB, I_WG, I_WU, I_WD, I_SG, I_SU, I_SD, I_FNW };

#define EPI_LOOP_BEGIN \
    _Pragma("unroll") for (int ai = 0; ai < 2; ++ai) _Pragma("unroll") for (int m = 0; m < 4; ++m) { const int rl = ai * 128 + wr * 64 + m * 16 + fr; (void)rl; \
    _Pragma("unroll") for (int bj = 0; bj < 2; ++bj) { const int cl = bj * 128 + wc * 32 + 8 * fq; (void)cl; const pg8::f32x4 v0 = acc[ai][bj][m][0], v1 = acc[ai][bj][m][1];
#define EPI_LOOP_END } }

struct EpiPlain {
    static constexpr bool PERM = true;
    bf16* O; int ldc;
    __device__ __forceinline__ void operator()(const pg8::f32x4 (&acc)[2][2][4][2], const pg8::Unit& u, int wr, int wc, int fr, int fq) const {
        EPI_LOOP_BEGIN
            v4u w; w.x = pk2(v0[0], v0[1]); w.y = pk2(v0[2], v0[3]); w.z = pk2(v1[0], v1[1]); w.w = pk2(v1[2], v1[3]);
            *(GAS v4u*)(O + (size_t)(u.pm * 256 + rl) * ldc + u.pn * 256 + cl) = w;
        EPI_LOOP_END
    }
};
#define SG8(q_, v0_, v1_, o0_, o1_, OP) do { \
        o0_[0] = OP(sigmoidf_(bflo(q_.x)) * v0_[0], 0); o0_[1] = OP(sigmoidf_(bfhi(q_.x)) * v0_[1], 1); o0_[2] = OP(sigmoidf_(bflo(q_.y)) * v0_[2], 2); o0_[3] = OP(sigmoidf_(bfhi(q_.y)) * v0_[3], 3); \
        o1_[0] = OP(sigmoidf_(bflo(q_.z)) * v1_[0], 4); o1_[1] = OP(sigmoidf_(bfhi(q_.z)) * v1_[1], 5); o1_[2] = OP(sigmoidf_(bflo(q_.w)) * v1_[2], 6); o1_[3] = OP(sigmoidf_(bfhi(q_.w)) * v1_[3], 7); } while (0)
struct EpiGateT1 {
    static constexpr bool PERM = true;
    const bf16* Gt; int gld; bf16* T1;
    __device__ __forceinline__ void operator()(const pg8::f32x4 (&acc)[2][2][4][2], const pg8::Unit& u, int wr, int wc, int fr, int fq) const {
#pragma unroll
        for (int ai = 0; ai < 2; ++ai) {
            v4u gq[4][2];
#pragma unroll
            for (int m = 0; m < 4; ++m)
#pragma unroll
                for (int bj = 0; bj < 2; ++bj) { const size_t row = (size_t)(u.pm * 256 + ai * 128 + wr * 64 + m * 16 + fr); const int col = u.pn * 256 + bj * 128 + wc * 32 + 8 * fq; gq[m][bj] = *(const GAS v4u*)(Gt + row * gld + col); }
#pragma unroll
            for (int m = 0; m < 4; ++m)
#pragma unroll
                for (int bj = 0; bj < 2; ++bj) { const size_t row = (size_t)(u.pm * 256 + ai * 128 + wr * 64 + m * 16 + fr); const int col = u.pn * 256 + bj * 128 + wc * 32 + 8 * fq;
                    const pg8::f32x4 v0 = acc[ai][bj][m][0], v1 = acc[ai][bj][m][1]; f32x4 o0, o1;
#define OPN(x_, i_) (x_)
                    SG8(gq[m][bj], v0, v1, o0, o1, OPN);
#undef OPN
                    v4u tw; tw.x = pk2(o0[0], o0[1]); tw.y = pk2(o0[2], o0[3]); tw.z = pk2(o1[0], o1[1]); tw.w = pk2(o1[2], o1[3]);
                    *(GAS v4u*)(T1 + row * 1024 + col) = tw; }
        }
    }
};
struct EpiGateY {
    static constexpr bool PERM = true;
    const bf16* Gt; int gld; const bf16* T1; bf16* Y;
    __device__ __forceinline__ void operator()(const pg8::f32x4 (&acc)[2][2][4][2], const pg8::Unit& u, int wr, int wc, int fr, int fq) const {
#pragma unroll
        for (int ai = 0; ai < 2; ++ai) {
            v4u gq[4][2], tq[4][2];
#pragma unroll
            for (int m = 0; m < 4; ++m)
#pragma unroll
                for (int bj = 0; bj < 2; ++bj) { const size_t row = (size_t)(u.pm * 256 + ai * 128 + wr * 64 + m * 16 + fr); const int col = u.pn * 256 + bj * 128 + wc * 32 + 8 * fq;
                    gq[m][bj] = *(const GAS v4u*)(Gt + row * gld + col); tq[m][bj] = *(const GAS v4u*)(T1 + row * 1024 + col); }
#pragma unroll
            for (int m = 0; m < 4; ++m)
#pragma unroll
                for (int bj = 0; bj < 2; ++bj) { const size_t row = (size_t)(u.pm * 256 + ai * 128 + wr * 64 + m * 16 + fr); const int col = u.pn * 256 + bj * 128 + wc * 32 + 8 * fq;
                    const pg8::f32x4 v0 = acc[ai][bj][m][0], v1 = acc[ai][bj][m][1]; f32x4 o0, o1;
                    const v4u t4 = tq[m][bj]; const float tt[8] = {bflo(t4.x), bfhi(t4.x), bflo(t4.y), bfhi(t4.y), bflo(t4.z), bfhi(t4.z), bflo(t4.w), bfhi(t4.w)};
#define OPT(x_, i_) (tt[i_] + (x_))
                    SG8(gq[m][bj], v0, v1, o0, o1, OPT);
#undef OPT
                    v4u w; w.x = pk2(o0[0], o0[1]); w.y = pk2(o0[2], o0[3]); w.z = pk2(o1[0], o1[1]); w.w = pk2(o1[2], o1[3]);
                    *(GAS v4u*)(Y + row * 1024 + col) = w; }
        }
    }
};
#undef SG8
struct EpiRes {
    static constexpr bool PERM = true;
    const bf16* xin; bf16* out; const float* gv; int nostore;
    __device__ __forceinline__ void operator()(const pg8::f32x4 (&acc)[2][2][4][2], const pg8::Unit& u, int wr, int wc, int fr, int fq) const {
        const float* gb = gv + (size_t)(u.pm >> 4) * 6144;
        f32x4 g0[2], g1[2];
#pragma unroll
        for (int bj = 0; bj < 2; ++bj) { const int col = u.pn * 256 + bj * 128 + wc * 32 + 8 * fq; g0[bj] = *(const GAS f32x4*)(gb + col); g1[bj] = *(const GAS f32x4*)(gb + col + 4); }
#pragma unroll
        for (int ai = 0; ai < 2; ++ai)
#pragma unroll
            for (int mh = 0; mh < 2; ++mh) {
                v4u xb[2][2];
#pragma unroll
                for (int mm = 0; mm < 2; ++mm)
#pragma unroll
                    for (int bj = 0; bj < 2; ++bj) { const size_t row = (size_t)(u.pm * 256 + ai * 128 + wr * 64 + (2 * mh + mm) * 16 + fr); const int col = u.pn * 256 + bj * 128 + wc * 32 + 8 * fq;
                        xb[mm][bj] = *(const GAS v4u*)(xin + row * 1024 + col); }
#pragma unroll
                for (int mm = 0; mm < 2; ++mm)
#pragma unroll
                    for (int bj = 0; bj < 2; ++bj) { const int m = 2 * mh + mm; const size_t row = (size_t)(u.pm * 256 + ai * 128 + wr * 64 + m * 16 + fr); const int col = u.pn * 256 + bj * 128 + wc * 32 + 8 * fq;
                        const v4u x = xb[mm][bj]; const f32x4 a0 = acc[ai][bj][m][0], a1 = acc[ai][bj][m][1];
                        v4u o;
                        o.x = pk2(bflo(x.x) + g0[bj][0] * a0[0], bfhi(x.x) + g0[bj][1] * a0[1]); o.y = pk2(bflo(x.y) + g0[bj][2] * a0[2], bfhi(x.y) + g0[bj][3] * a0[3]);
                        o.z = pk2(bflo(x.z) + g1[bj][0] * a1[0], bfhi(x.z) + g1[bj][1] * a1[1]); o.w = pk2(bflo(x.w) + g1[bj][2] * a1[2], bfhi(x.w) + g1[bj][3] * a1[3]);
                        if (nostore) { asm volatile("" :: "v"(o)); } else { *(GAS v4u*)(out + row * 1024 + col) = o; } }
            }
    }
};
struct EpiHid {
    static constexpr bool PERM = true;
    bf16* O; int ldo; const LAS float* roww; int ubase; int ustride; int shared;
    __device__ __forceinline__ void operator()(const pg8::f32x4 (&acc)[2][2][4][2], const pg8::Unit& u, int wr, int wc, int fr, int fq) const {
#pragma unroll
        for (int ai = 0; ai < 2; ++ai)
#pragma unroll
            for (int m = 0; m < 4; ++m) {
                const int rl = ai * 128 + wr * 64 + m * 16 + fr; const size_t pos = (size_t)u.pm * 256 + rl;
                const float w = shared ? 1.f : roww[((u.pm - ubase) / ustride) * 256 + rl];
                const int col = (shared ? 128 * u.pn : 0) + wc * 32 + 8 * fq;
                float h[8];
#pragma unroll
                for (int n = 0; n < 2; ++n)
#pragma unroll
                    for (int j = 0; j < 4; ++j) { const float gt = acc[ai][0][m][n][j], up = acc[ai][1][m][n][j]; h[n * 4 + j] = gt * sigmoidf_(gt) * up * w; }
                v4u o; o.x = pk2(h[0], h[1]); o.y = pk2(h[2], h[3]); o.z = pk2(h[4], h[5]); o.w = pk2(h[6], h[7]);
                *(GAS v4u*)(O + pos * ldo + col) = o;
                asm volatile("" ::: "memory");
            }
    }
};
constexpr float YS_SCALE = 4.0f;
struct EpiScatter {
    static constexpr bool PERM = true;
    bf16* Y; const LAS unsigned* dst; int v; int G; int nostore;
    __device__ __forceinline__ void operator()(const pg8::f32x4 (&acc)[2][2][4][2], const pg8::Unit& u, int wr, int wc, int fr, int fq) const {
        const int q = u.pn & 3;
#pragma unroll
        for (int ai = 0; ai < 2; ++ai)
#pragma unroll
            for (int m = 0; m < 4; ++m) {
                const int rl = ai * 128 + wr * 64 + m * 16 + fr; const unsigned d = dst[((4 * u.pm + q - v) / G) * 256 + rl];
                if (nostore) { asm volatile("" :: "v"(acc[ai][0][m][0]), "v"(acc[ai][0][m][1]), "v"(acc[ai][1][m][0]), "v"(acc[ai][1][m][1])); } else if (d != 0xffffffffu) {
#pragma unroll
                    for (int bj = 0; bj < 2; ++bj) { const pg8::f32x4 v0 = acc[ai][bj][m][0] * YS_SCALE, v1 = acc[ai][bj][m][1] * YS_SCALE;
                        int w0 = 0, w1 = 0;
#define YS_CL(x_) __builtin_amdgcn_fmed3f((x_), -440.f, 440.f)
                        w0 = __builtin_amdgcn_cvt_pk_fp8_f32(YS_CL(v0[0]), YS_CL(v0[1]), w0, false); w0 = __builtin_amdgcn_cvt_pk_fp8_f32(YS_CL(v0[2]), YS_CL(v0[3]), w0, true);
                        w1 = __builtin_amdgcn_cvt_pk_fp8_f32(YS_CL(v1[0]), YS_CL(v1[1]), w1, false); w1 = __builtin_amdgcn_cvt_pk_fp8_f32(YS_CL(v1[2]), YS_CL(v1[3]), w1, true);
#undef YS_CL
                        v2u w; w.x = (unsigned)w0; w.y = (unsigned)w1;
                        *(GAS v2u*)((unsigned char*)Y + (size_t)d * 1024 + q * 256 + bj * 128 + wc * 32 + 8 * fq) = w; }
                }
            }
    }
};

struct TrDesc { const float* sp; bf16* dp; int ldw, ldt; float scale; };
__device__ __forceinline__ void tr_load(const TrDesc& d, float (&tv)[32]) {
    const GAS float* sp = (const GAS float*)d.sp;
#pragma unroll
    for (int i = 0; i < 32; ++i) tv[i] = sp[(size_t)(2 * i) * d.ldw];
}
__device__ __forceinline__ void tr_store(const TrDesc& d, const float (&tv)[32], LAS float* scr, int lane) {
#pragma unroll
    for (int i = 0; i < 32; ++i) { const int kk = 2 * i + (lane >> 5); scr[kk * 33 + (lane & 31)] = tv[i]; }
    LDS_WAIT();
    const int c = lane & 7; const float scale = d.scale;
#pragma unroll
    for (int j = 0; j < 4; ++j) { const int n = (lane >> 3) + 8 * j; const LAS float* s = scr + (8 * c) * 33 + n;
        v4u o; o.x = pk2(s[0 * 33] * scale, s[1 * 33] * scale); o.y = pk2(s[2 * 33] * scale, s[3 * 33] * scale); o.z = pk2(s[4 * 33] * scale, s[5 * 33] * scale); o.w = pk2(s[6 * 33] * scale, s[7 * 33] * scale);
        *(GAS v4u*)(d.dp + (size_t)n * d.ldt + 8 * c) = o; }
    LDS_WAIT();
}
constexpr int CW_N_IN = 8 * 512, CW_N_P = 3 * 512, CW_N_E = 4096, CW_N_S = 4 * 64, CW_N_SD = 128;
constexpr int CW_TOTAL = CW_N_IN + CW_N_P + 3 * CW_N_E + CW_N_S + CW_N_SD;
__device__ __forceinline__ TrDesc tr_decode(Frame& F, int l, int it) {
    const float* src; int ldw; bf16* dst; int ldt; int kb, nb; float sc = 1.f;
    int r = it;
    if (r < CW_N_IN) { const int job = r >> 9, rr = r & 511; kb = rr >> 5; nb = rr & 31;
        int col; bf16* BIN = (bf16*)wsp(F, WS_BIN); bf16* AIN = (bf16*)wsp(F, WS_AIN);
        switch (job) {
            case 0: col = C_MQK; dst = BIN; break;
            case 1: col = C_MO; dst = BIN + (size_t)1024 * 1024; break;
            case 2: col = C_SQ; dst = BIN + (size_t)2048 * 1024; sc = LOG2E * 0.125f; break;
            case 3: col = C_SK; dst = BIN + (size_t)3072 * 1024; break;
            case 4: col = C_GA; dst = BIN + (size_t)4096 * 1024; break;
            case 5: col = C_GB; dst = BIN + (size_t)5120 * 1024; break;
            case 6: col = C_MV; dst = AIN; break;
            default: col = C_SV; dst = AIN + (size_t)1024 * 1024; break;
        }
        src = inp(F, I_WIN) + (size_t)l * DM * INW + col; ldw = INW; ldt = 1024; }
    else if ((r -= CW_N_IN) < CW_N_P) { const int job = r >> 9, rr = r & 511; kb = rr >> 5; nb = rr & 31;
        src = inp(F, job == 0 ? I_WPA : (job == 1 ? I_WPB : I_WOUT)) + (size_t)l * DM * DM; ldw = 1024;
        dst = (bf16*)wsp(F, job == 0 ? WS_BA : (job == 1 ? WS_BB : WS_BO)); ldt = 1024; }
    else if ((r -= CW_N_P) < 2 * CW_N_E) { const int up = r >= CW_N_E; if (up) r -= CW_N_E; const int e = r >> 6, rr = r & 63; kb = rr >> 2; nb = rr & 3;
        src = inp(F, up ? I_WU : I_WG) + ((size_t)l * NEXP + e) * DM * EFF; ldw = EFF;
        dst = (bf16*)wsp(F, WS_BGU) + ((size_t)e * 256 + (up ? 128 : 0)) * 1024; ldt = 1024; }
    else if ((r -= 2 * CW_N_E) < CW_N_E) { const int e = r >> 6, rr = r & 63; kb = rr >> 5; nb = rr & 31;
        src = inp(F, I_WD) + ((size_t)l * NEXP + e) * EFF * DM; ldw = DM;
        dst = (bf16*)wsp(F, WS_BD) + (size_t)e * 1024 * 128; ldt = 128; }
    else if ((r -= CW_N_E) < CW_N_S) { const int job = r >> 6, rr = r & 63; kb = rr >> 2; nb = rr & 3;
        const int up = job >> 1, hi = job & 1;
        src = inp(F, up ? I_SU : I_SG) + (size_t)l * DM * SFF + hi * 128; ldw = SFF;
        dst = (bf16*)wsp(F, WS_BSGU) + (size_t)(hi * 256 + up * 128) * 1024; ldt = 1024; }
    else { r -= CW_N_S; kb = r >> 5; nb = r & 31;
        src = inp(F, I_SD) + (size_t)l * SFF * DM; ldw = DM; dst = (bf16*)wsp(F, WS_BSD); ldt = 256; }
    TrDesc d; const int k0 = 64 * kb, n0 = 32 * nb; const int ln = lane_now();
    d.sp = src + (size_t)(k0 + (ln >> 5)) * ldw + n0 + (ln & 31); d.dp = dst + (size_t)n0 * ldt + k0; d.ldw = ldw; d.ldt = ldt; d.scale = sc;
    return d;
}
__device__ __forceinline__ void conv_weights(Frame& F, int l) {
    LAS float* scr = (LAS float*)(F.lds + F.wave * 16384);
    int gw = F.c * 8 + F.wave; asm volatile("" : "+s"(gw)); const int NGW = F.G * 8;
    int it = gw;
    if (it >= CW_TOTAL) return;
    TrDesc dc = tr_decode(F, l, it); float tc[32]; tr_load(dc, tc);
    for (;;) {
        const int itn = it + NGW; const bool more = itn < CW_TOTAL;
        TrDesc dn = dc; float tn[32];
        if (more) { dn = tr_decode(F, l, itn); tr_load(dn, tn); }
        tr_store(dc, tc, scr, F.lane);
        if (!more) break;
        it = itn; dc = dn;
#pragma unroll
        for (int i = 0; i < 32; ++i) tc[i] = tn[i];
    }
}
__device__ __forceinline__ void mod_partials(Frame& F) {
    LAS float* sc = (LAS float*)(F.lds);
    for (int i = F.tid; i < 4096; i += 512) { const float v = inp(F, I_C)[i]; sc[i] = v / (1.f + __expf(-v)); }
    __syncthreads();
    float* MODP = (float*)wsp(F, WS_MODP);
    for (int it = F.c; it < 384; it += F.G) {
        const int l = it / 192, rem = it % 192, g = rem >> 4, kp = rem & 15, j = g * 512 + F.tid;
        const float* w = inp(F, I_ADAW) + ((size_t)l * DM + 64 * kp) * 6144 + j;
        float a0 = 0.f, a1 = 0.f, a2 = 0.f, a3 = 0.f;
#pragma unroll 16
        for (int k = 0; k < 64; ++k) { const float wv = w[(size_t)k * 6144]; const int kk = 64 * kp + k;
            a0 += sc[kk] * wv; a1 += sc[1024 + kk] * wv; a2 += sc[2048 + kk] * wv; a3 += sc[3072 + kk] * wv; }
        float* o = MODP + ((size_t)(kp * 2 + l) * 4) * 6144 + j;
        o[0] = a0; o[6144] = a1; o[2 * 6144] = a2; o[3 * 6144] = a3;
    }
    __syncthreads();
}
__device__ __forceinline__ float modv(const Frame& F, int l, int b, int j) {
    const float* MODP = (const float*)wsp(F, WS_MODP);
    float s = inp(F, I_ADAB)[l * 6144 + j];
#pragma unroll
    for (int kp = 0; kp < 16; ++kp) s += MODP[((size_t)(kp * 2 + l) * 4 + b) * 6144 + j];
    return s;
}

__device__ __forceinline__ void norm_emit(Frame& F, const float (&v)[2][8], const LAS float* cA, const LAS float* cB, const LAS float* Wg, const float gbias_lane  , bf16* xn_row, float* gate_row) {
    float ss = 0.f;
#pragma unroll
    for (int j = 0; j < 2; ++j)
#pragma unroll
        for (int i = 0; i < 8; ++i) ss += v[j][i] * v[j][i];
    ss = wave_sum(ss, F.lane);
    const float r = 1.0f / sqrtf(ss * (1.f / 1024.f) + EPS);
    float h[2][8];
#pragma unroll
    for (int j = 0; j < 2; ++j) { const int k = 8 * F.lane + 512 * j;
        const f32x4 a0 = *(const LAS f32x4*)(cA + k), a1 = *(const LAS f32x4*)(cA + k + 4), b0 = *(const LAS f32x4*)(cB + k), b1 = *(const LAS f32x4*)(cB + k + 4);
#pragma unroll
        for (int i = 0; i < 4; ++i) { h[j][i] = v[j][i] * r * a0[i] + b0[i]; h[j][4 + i] = v[j][4 + i] * r * a1[i] + b1[i]; }
        v4u o; o.x = pk2(h[j][0], h[j][1]); o.y = pk2(h[j][2], h[j][3]); o.z = pk2(h[j][4], h[j][5]); o.w = pk2(h[j][6], h[j][7]);
        *(GAS v4u*)(xn_row + k) = o; }
    float mine = 0.f;
#pragma unroll
    for (int g = 0; g < 8; ++g) { float p = 0.f;
#pragma unroll
        for (int j = 0; j < 2; ++j) { const int k = 8 * F.lane + 512 * j; const f32x4 w0 = *(const LAS f32x4*)(Wg + g * 1024 + k), w1 = *(const LAS f32x4*)(Wg + g * 1024 + k + 4);
#pragma unroll
            for (int i = 0; i < 4; ++i) { p += h[j][i] * w0[i]; p += h[j][4 + i] * w1[i]; } }
        p = wave_sum(p, F.lane);
        if (F.lane == g) mine = p; }
    if (F.lane < 8) { float z = mine + gbias_lane; if (F.lane >= 4) z = fminf(z, 0.f) - __logf(1.f + __expf(-fabsf(z))); gate_row[F.lane] = z; }
}
__device__ __forceinline__ void norm1_tables(Frame& F, int l, int b, bool from_modp) {
    LAS float* cA = (LAS float*)(F.lds + LDS_TAB); LAS float* cB = cA + 1024; LAS float* Wg = (LAS float*)(F.lds);
    const float* MODF = (const float*)wsp(F, WS_MODF) + (size_t)(l * 4 + b) * 6144;
    for (int k = F.tid; k < 1024; k += 512) {
        const float sh = from_modp ? modv(F, l, b, k) : MODF[k], sc = from_modp ? modv(F, l, b, 1024 + k) : MODF[1024 + k];
        cA[k] = inp(F, I_N1W)[l * 1024 + k] * (1.f + sc); cB[k] = sh; }
    const float* w_in = inp(F, I_WIN) + (size_t)l * DM * INW;
    for (int idx = F.tid; idx < 8192; idx += 512) { const int k = idx >> 3, g = idx & 7; Wg[g * 1024 + k] = w_in[(size_t)k * INW + C_MI + g]; }
}
__device__ __forceinline__ void phase_norm1_first(Frame& F) {
    float* MODF = (float*)wsp(F, WS_MODF);
    for (int idx = F.c * 512 + F.tid; idx < 2 * 4 * 6144; idx += F.G * 512) { const int l = idx / 24576, rem = idx % 24576, b = rem / 6144, j = rem % 6144; MODF[idx] = modv(F, l, b, j); }
    bf16* XN = (bf16*)wsp(F, WS_R2); float* GATES = (float*)wsp(F, WS_GATES); bf16* XB = (bf16*)outp(F);
    for (int vb = F.c; vb < 256; vb += F.G) {
        norm1_tables(F, 0, vb >> 6, true);
        __syncthreads();
        const float gbl = (F.lane < 4) ? inp(F, I_IGB)[F.lane] : (F.lane < 8 ? inp(F, I_FGB)[F.lane - 4] : 0.f);
        for (int i = 0; i < 8; ++i) {
            const int t = vb * 64 + F.wave * 8 + i; const float* xr = inp(F, I_X) + (size_t)t * 1024 + 8 * F.lane;
            float v[2][8];
#pragma unroll
            for (int j = 0; j < 2; ++j) { const f32x4 a = *(const GAS f32x4*)(xr + 512 * j), b2 = *(const GAS f32x4*)(xr + 512 * j + 4);
#pragma unroll
                for (int q = 0; q < 4; ++q) { v[j][q] = a[q]; v[j][4 + q] = b2[q]; } }
#pragma unroll
            for (int j = 0; j < 2; ++j) { v4u o; o.x = pk2(v[j][0], v[j][1]); o.y = pk2(v[j][2], v[j][3]); o.z = pk2(v[j][4], v[j][5]); o.w = pk2(v[j][6], v[j][7]);
                *(GAS v4u*)(XB + (size_t)t * 1024 + 8 * F.lane + 512 * j) = o; }
            norm_emit(F, v, (const LAS float*)(F.lds + LDS_TAB), (const LAS float*)(F.lds + LDS_TAB) + 1024, (const LAS float*)(F.lds), gbl, XN + (size_t)t * 1024, GATES + (size_t)t * 8);
        }
        __syncthreads();
    }
}

__device__ __forceinline__ void phase_conv(Frame& F, int l) {
    const bf16* P6 = (const bf16*)wsp(F, WS_P6); bf16* MQK = (bf16*)wsp(F, WS_R2);
    const int cg = F.tid & 127, tq = F.tid >> 7, ch = cg * 8;
    float w[4][8], bias[8];
#pragma unroll
    for (int j = 0; j < 4; ++j) { const float* p = inp(F, I_CONVW) + ((size_t)l * 4 + j) * 1024 + ch; const f32x4 a = *(const GAS f32x4*)p, b = *(const GAS f32x4*)(p + 4);
#pragma unroll
        for (int i = 0; i < 4; ++i) { w[j][i] = a[i]; w[j][4 + i] = b[i]; } }
    { const float* p = inp(F, I_CONVB) + (size_t)l * 1024 + ch; const f32x4 a = *(const GAS f32x4*)p, b = *(const GAS f32x4*)(p + 4);
#pragma unroll
      for (int i = 0; i < 4; ++i) { bias[i] = a[i]; bias[4 + i] = b[i]; } }
    const float osc = (ch < 512) ? 0.08838834764831845f : 1.0f;
    for (int vb = F.c; vb < 256; vb += F.G) {
        const int tbeg = vb * 64 + tq * 16;
        float u0[8], u1[8], u2[8];
#define CV_LOAD(dst, tt) do { const int t_ = (tt); if (t_ >= 0 && (t_ >> 12) == (tbeg >> 12)) { const v4u q = *(const GAS v4u*)(P6 + (size_t)t_ * P6W + ch); \
            dst[0] = bflo(q.x); dst[1] = bfhi(q.x); dst[2] = bflo(q.y); dst[3] = bfhi(q.y); dst[4] = bflo(q.z); dst[5] = bfhi(q.z); dst[6] = bflo(q.w); dst[7] = bfhi(q.w); } \
            else { _Pragma("unroll") for (int i_ = 0; i_ < 8; ++i_) dst[i_] = 0.f; } } while (0)
        CV_LOAD(u0, tbeg - 3); CV_LOAD(u1, tbeg - 2); CV_LOAD(u2, tbeg - 1);
        for (int tt = 0; tt < 16; ++tt) {
            const int t = tbeg + tt; float u3[8]; CV_LOAD(u3, t);
            float o[8];
#pragma unroll
            for (int i = 0; i < 8; ++i) { const float a = bias[i] + w[0][i] * u0[i] + w[1][i] * u1[i] + w[2][i] * u2[i] + w[3][i] * u3[i]; o[i] = a * sigmoidf_(a) * osc; }
            v4u q; q.x = pk2(o[0], o[1]); q.y = pk2(o[2], o[3]); q.z = pk2(o[4], o[5]); q.w = pk2(o[6], o[7]);
            *(GAS v4u*)(MQK + (size_t)t * 1024 + ch) = q;
#pragma unroll
            for (int i = 0; i < 8; ++i) { u0[i] = u1[i]; u1[i] = u2[i]; u2[i] = u3[i]; }
        }
#undef CV_LOAD
    }
}

constexpr float SB_EXIT = -80.0f;
constexpr int AT_NSLOT = 12, AT_SLOTB = 8192, AT_FLAGS = AT_NSLOT * AT_SLOTB;
__device__ __forceinline__ void at_dma(const void* gsrc, LAS unsigned char* ldst) { __builtin_amdgcn_global_load_lds((const GAS unsigned*)gsrc, (LAS unsigned*)ldst, 16, 0, 0); }
__device__ __forceinline__ void attn_unit(Frame& F, int b, int h, int qb, bool do_store) {
    bf16* P6 = (bf16*)wsp(F, WS_P6); const bf16* VT = (const bf16*)wsp(F, WS_VT);
    LAS unsigned char* L = F.lds;
    const int lane = F.lane, r32 = lane & 31, hh = lane >> 5, wid = F.wave;
    const int tb = b * SEQ, t0 = qb * 256 + wid * 32;
    const int D0 = 8 * qb, Dw = D0 + wid;
    const bf16* dsrc; int dtile_stride; int doff;
    if (wid < 4) { const int row = 8 * wid + (lane >> 3), pos = lane & 7; dsrc = P6 + (size_t)(tb + row) * P6W + P_SK + h * 64 + ((pos ^ (row & 7)) * 8); dtile_stride = 32 * P6W; doff = wid * 1024; }
    else { const int d = 16 * (wid - 4) + (lane >> 2), pos = lane & 3; dsrc = VT + (size_t)(1024 + h * 64 + d) * NTOK + tb + ((pos ^ ((d >> 2) & 3)) * 8); dtile_stride = 32; doff = 4096 + (wid - 4) * 1024; }
#define AT_DMA(T_) do { const int T__ = (T_); if (T__ >= 0) at_dma(dsrc + (size_t)T__ * dtile_stride, L + (T__ % AT_NSLOT) * AT_SLOTB + doff); } while (0)
    for (int T = D0 + 7; T >= D0 - 1; --T) AT_DMA(T);
    bf16x8 qf[4];
#pragma unroll
    for (int kk = 0; kk < 4; ++kk) qf[kk] = *(const GAS bf16x8*)(P6 + (size_t)(tb + t0 + r32) * P6W + P_SQ + h * 64 + 16 * kk + 8 * hh);
    f32x16 o0 = {}, o1 = {};
    float Rrun = 0.f;
    bool done = false;
    LAS unsigned* flags = (LAS unsigned*)(L + AT_FLAGS);
    asm volatile("s_waitcnt vmcnt(0)" ::: "memory");
    if (lane == 0) flags[wid] = 1u;
    __syncthreads();
    int koff[4], vlo[2][2], vhi[2][2];
#pragma unroll
    for (int kk = 0; kk < 4; ++kk) koff[kk] = r32 * 128 + (((2 * kk + hh) ^ (r32 & 7)) * 16);
#pragma unroll
    for (int dt = 0; dt < 2; ++dt)
#pragma unroll
        for (int s = 0; s < 2; ++s) { const int d = 32 * dt + r32, sw = (d >> 2) & 3; vlo[dt][s] = 4096 + d * 64 + (((2 * s) ^ sw) * 16) + 8 * hh; vhi[dt][s] = 4096 + d * 64 + (((2 * s + 1) ^ sw) * 16) + 8 * hh; }
#define AT_TILE(DIAG_) do { \
            const LAS unsigned char* S = L + (T % AT_NSLOT) * AT_SLOTB; \
            f32x16 p = {}; \
            _Pragma("unroll") \
            for (int kk = 0; kk < 4; ++kk) { const bf16x8 kf = *(const LAS bf16x8*)(S + koff[kk]); p = __builtin_amdgcn_mfma_f32_32x32x16_bf16(kf, qf[kk], p, 0, 0, 0); } \
            bf16x8 vf[2][2]; \
            _Pragma("unroll") \
            for (int dt = 0; dt < 2; ++dt) \
            _Pragma("unroll") \
                for (int s = 0; s < 2; ++s) { const v2u lo = *(const LAS v2u*)(S + vlo[dt][s]), hi = *(const LAS v2u*)(S + vhi[dt][s]); v4u t; t.x = lo.x; t.y = lo.y; t.z = hi.x; t.w = hi.y; vf[dt][s] = __builtin_bit_cast(bf16x8, t); } \
            float lf[16]; \
            _Pragma("unroll") \
            for (int r = 0; r < 16; ++r) { const float z = p[r]; const float e = __builtin_amdgcn_exp2f(-fabsf(z)); const float lg = __builtin_amdgcn_logf(1.f + e); \
                float v = -(fmaxf(z, 0.f) + lg); if (DIAG_ && crow(r, hh) >= r32) v = 0.f; lf[r] = v; } \
 \
            float own[4], pair[4]; \
            _Pragma("unroll") \
            for (int g = 0; g < 4; ++g) { own[g] = (lf[4 * g] + lf[4 * g + 1]) + (lf[4 * g + 2] + lf[4 * g + 3]); \
                auto rr = __builtin_amdgcn_permlane32_swap(__float_as_uint(own[g]), __float_as_uint(own[g]), false, false); \
                pair[g] = __uint_as_float(rr[0]) + __uint_as_float(rr[1]); } \
            float sfx[4]; sfx[3] = Rrun; sfx[2] = sfx[3] + pair[3]; sfx[1] = sfx[2] + pair[2]; sfx[0] = sfx[1] + pair[1]; \
            const float nh = hh ? 0.f : 1.f; \
            float att[16]; \
            _Pragma("unroll") \
            for (int g = 0; g < 4; ++g) { float run = sfx[g] + nh * (pair[g] - own[g]); \
            _Pragma("unroll") \
                for (int i = 3; i >= 0; --i) { const int r = 4 * g + i; run += lf[r]; float a = __builtin_amdgcn_exp2f(p[r] + run); if (DIAG_ && crow(r, hh) >= r32) a = 0.f; att[r] = a; } } \
            Rrun = sfx[0] + pair[0]; \
            v4u pb0, pb1; \
            pb0.x = pk2(att[0], att[1]); pb0.y = pk2(att[2], att[3]); pb0.z = pk2(att[4], att[5]); pb0.w = pk2(att[6], att[7]); \
            pb1.x = pk2(att[8], att[9]); pb1.y = pk2(att[10], att[11]); pb1.z = pk2(att[12], att[13]); pb1.w = pk2(att[14], att[15]); \
            const bf16x8 b0 = __builtin_bit_cast(bf16x8, pb0), b1 = __builtin_bit_cast(bf16x8, pb1); \
            o0 = __builtin_amdgcn_mfma_f32_32x32x16_bf16(vf[0][0], b0, o0, 0, 0, 0); o0 = __builtin_amdgcn_mfma_f32_32x32x16_bf16(vf[0][1], b1, o0, 0, 0, 0); \
            o1 = __builtin_amdgcn_mfma_f32_32x32x16_bf16(vf[1][0], b0, o1, 0, 0, 0); o1 = __builtin_amdgcn_mfma_f32_32x32x16_bf16(vf[1][1], b1, o1, 0, 0, 0); \
            if (__all(Rrun < SB_EXIT)) done = true; \
        } while (0)
    for (int j = 0; ; ++j) {
        const int T = Dw - j;
        const bool active = !done && T >= 0;
        AT_DMA(D0 - j - 2);
        if (active) { if (j == 0) AT_TILE(true); else AT_TILE(false); }
        const bool more = !done && (Dw - (j + 1)) >= 0;
        if (lane == 0) flags[8 * ((j + 1) & 1) + wid] = more ? 1u : 0u;
        asm volatile("s_waitcnt vmcnt(0) lgkmcnt(0)" ::: "memory");
        __builtin_amdgcn_s_barrier();
        asm volatile("" ::: "memory");
        const LAS unsigned* fl = flags + 8 * ((j + 1) & 1);
        const unsigned any = fl[0] | fl[1] | fl[2] | fl[3] | fl[4] | fl[5] | fl[6] | fl[7];
        if (any == 0u) break;
    }
#undef AT_DMA
#undef AT_TILE
    if (do_store) {
        bf16* orow = P6 + (size_t)(tb + t0 + r32) * P6W + P_SQ + h * 64 + 4 * hh;
#pragma unroll
        for (int g = 0; g < 4; ++g) {
            v2u a; a.x = pk2(o0[4 * g], o0[4 * g + 1]); a.y = pk2(o0[4 * g + 2], o0[4 * g + 3]); *(GAS v2u*)(orow + 8 * g) = a;
            v2u c; c.x = pk2(o1[4 * g], o1[4 * g + 1]); c.y = pk2(o1[4 * g + 2], o1[4 * g + 3]); *(GAS v2u*)(orow + 32 + 8 * g) = c;
        }
    } else { asm volatile("" :: "v"(o0), "v"(o1)); }
    __syncthreads();
}
__device__ __forceinline__ void phase_attn(Frame& F, bool do_store) {
    const int v = (F.G % 8 == 0) ? (F.c % 8) * (F.G / 8) + F.c / 8 : F.c;
    for (int u = v; u < 1024; u += F.G) { const int bh = u >> 4, qb = u & 15; attn_unit(F, bh >> 4, bh & 15, qb, do_store); }
}

constexpr size_t MLS_U = 0, MLS_PM = 16 * 4096 * 4, MLS_BL = 2 * 16 * 4096 * 4, MLS_SUM = 3 * 16 * 4096 * 4;
__device__ __forceinline__ void phase_mlstm_scalars(Frame& F) {
    const float* GATES = (const float*)wsp(F, WS_GATES); unsigned char* R3 = wsp(F, WS_R3);
    const int lane = F.lane;
    for (int vb = F.c; vb < 256; vb += F.G) {
        if (F.wave != 0) continue;
        const int bh = vb >> 4, ch = vb & 15, b = bh >> 2, h = bh & 3, t0 = b * SEQ + 256 * ch;
        float carry_b = 0.f, carry_pm = -INFINITY;
#pragma unroll
        for (int sg = 0; sg < 4; ++sg) {
            const int tok = t0 + 64 * sg + lane;
            const float ig = *(const GAS float*)(GATES + (size_t)tok * 8 + h), lfv = *(const GAS float*)(GATES + (size_t)tok * 8 + 4 + h);
            float bc = lfv;
#pragma unroll
            for (int o = 1; o < 64; o <<= 1) { const float t = shfl_up_l(bc, o, lane); if (lane >= o) bc += t; }
            bc += carry_b;
            const float u = ig - bc;
            float pm = u;
#pragma unroll
            for (int o = 1; o < 64; o <<= 1) { const float t = shfl_up_l(pm, o, lane); if (lane >= o) pm = fmaxf(pm, t); }
            pm = fmaxf(pm, carry_pm);
            const size_t idx = (size_t)bh * 4096 + 256 * ch + 64 * sg + lane;
            *(GAS float*)(R3 + MLS_U + idx * 4) = u; *(GAS float*)(R3 + MLS_PM + idx * 4) = pm; *(GAS float*)(R3 + MLS_BL + idx * 4) = bc;
            carry_b = __int_as_float(__builtin_amdgcn_readlane(__float_as_int(bc), 63)); carry_pm = __int_as_float(__builtin_amdgcn_readlane(__float_as_int(pm), 63));
        }
        if (lane == 0) { *(GAS float*)(R3 + MLS_SUM + (size_t)(bh * 16 + ch) * 8) = carry_b; *(GAS float*)(R3 + MLS_SUM + (size_t)(bh * 16 + ch) * 8 + 4) = carry_pm; }
    }
}

constexpr int CVP_QS = 0, CVP_KS = 69632, CVP_U = 139264;
__device__ __forceinline__ void cvp_job(Frame& F, int l, int bh, int c) {
    LAS unsigned char* L = F.lds;
    const int b = bh >> 2, h = bh & 3, T0 = b * SEQ + 256 * c;
    const bf16* P6 = (const bf16*)wsp(F, WS_P6); const unsigned char* R3 = wsp(F, WS_R3);
    {
        const int cg = F.tid & 31, tr = F.tid >> 5, ch8 = 8 * cg;
        const int cq = (ch8 < 128) ? h * 128 + ch8 : 512 + h * 128 + (ch8 - 128);
        float w[4][8], bias[8];
#pragma unroll
        for (int j = 0; j < 4; ++j) { const float* p = inp(F, I_CONVW) + ((size_t)l * 4 + j) * 1024 + cq; const f32x4 a = *(const GAS f32x4*)p, bb = *(const GAS f32x4*)(p + 4);
#pragma unroll
            for (int i = 0; i < 4; ++i) { w[j][i] = a[i]; w[j][4 + i] = bb[i]; } }
        { const float* p = inp(F, I_CONVB) + (size_t)l * 1024 + cq; const f32x4 a = *(const GAS f32x4*)p, bb = *(const GAS f32x4*)(p + 4);
#pragma unroll
          for (int i = 0; i < 4; ++i) { bias[i] = a[i]; bias[4 + i] = bb[i]; } }
        const float osc = (ch8 < 128) ? 0.08838834764831845f : 1.0f;
        const int sbeg = 256 * c + 16 * tr;
        float u0[8], u1[8], u2[8];
#define CVP_LOAD(dst, ss) do { const int s_ = (ss); if (s_ >= 0) { const v4u q = *(const GAS v4u*)(P6 + (size_t)(b * SEQ + s_) * P6W + cq); \
            dst[0] = bflo(q.x); dst[1] = bfhi(q.x); dst[2] = bflo(q.y); dst[3] = bfhi(q.y); dst[4] = bflo(q.z); dst[5] = bfhi(q.z); dst[6] = bflo(q.w); dst[7] = bfhi(q.w); } \
            else { _Pragma("unroll") for (int i_ = 0; i_ < 8; ++i_) dst[i_] = 0.f; } } while (0)
        CVP_LOAD(u0, sbeg - 3); CVP_LOAD(u1, sbeg - 2); CVP_LOAD(u2, sbeg - 1);
        LAS unsigned char* tile = L + ((ch8 < 128) ? CVP_QS : CVP_KS) + ((ch8 & 127) * 2);
        for (int tt = 0; tt < 16; ++tt) {
            float u3[8]; CVP_LOAD(u3, sbeg + tt);
            float o[8];
#pragma unroll
            for (int i = 0; i < 8; ++i) { const float a = bias[i] + w[0][i] * u0[i] + w[1][i] * u1[i] + w[2][i] * u2[i] + w[3][i] * u3[i]; o[i] = a * sigmoidf_(a) * osc; }
            v4u q; q.x = pk2(o[0], o[1]); q.y = pk2(o[2], o[3]); q.z = pk2(o[4], o[5]); q.w = pk2(o[6], o[7]);
            *(LAS v4u*)(tile + (16 * tr + tt) * 272) = q;
#pragma unroll
            for (int i = 0; i < 8; ++i) { u0[i] = u1[i]; u1[i] = u2[i]; u2[i] = u3[i]; }
        }
#undef CVP_LOAD
        if (F.tid < 256) *(LAS float*)(L + CVP_U + F.tid * 4) = *(const GAS float*)(R3 + MLS_U + ((size_t)bh * 4096 + 256 * c + F.tid) * 4) * LOG2E;
    }
    __syncthreads();
    {
        const int lane = F.lane, wid = F.wave, r32 = lane & 31, hh = lane >> 5;
        const int qblk = (wid < 4) ? 7 - wid : wid - 4;
        float Mc = 0.f;
        for (int cc = 0; cc < c; ++cc) { const float a = *(const GAS float*)(R3 + MLS_SUM + (size_t)(bh * 16 + cc) * 8), pmx = *(const GAS float*)(R3 + MLS_SUM + (size_t)(bh * 16 + cc) * 8 + 4); Mc = a + fmaxf(Mc, pmx); }
        const float pmq = *(const GAS float*)(R3 + MLS_PM + ((size_t)bh * 4096 + 256 * c + 32 * qblk + r32) * 4);
        const float myMM2 = fmaxf(Mc, pmq) * LOG2E;
        bf16x8 qf[8];
#pragma unroll
        for (int kk = 0; kk < 8; ++kk) qf[kk] = *(const LAS bf16x8*)(L + CVP_QS + (32 * qblk + r32) * 272 + (16 * kk + 8 * hh) * 2);
        { unsigned char* QF = wsp(F, WS_R2) + (((size_t)(bh * 16 + c) * 8 + qblk) * 8) * 1024 + lane * 16;
#pragma unroll
          for (int kk = 0; kk < 8; ++kk) *(GAS bf16x8*)(QF + (size_t)kk * 1024) = qf[kk]; }
        unsigned char* PT = wsp(F, WS_PT) + ((size_t)(bh * 16 + c) * 36 + (qblk * (qblk + 1)) / 2) * 2048;
        const LAS float* U2 = (const LAS float*)(L + CVP_U);
        for (int kt = 0; kt <= qblk; ++kt) {
            f32x16 p = {};
#pragma unroll
            for (int kk = 0; kk < 8; ++kk) { const bf16x8 a = *(const LAS bf16x8*)(L + CVP_KS + (32 * kt + r32) * 272 + (16 * kk + 8 * hh) * 2); p = __builtin_amdgcn_mfma_f32_32x32x16_bf16(a, qf[kk], p, 0, 0, 0); }
            const bool diag = (kt == qblk);
            float pw[16];
#pragma unroll
            for (int g = 0; g < 4; ++g) { const f32x4 u2 = *(const LAS f32x4*)(U2 + 32 * kt + 8 * g + 4 * hh);
#pragma unroll
                for (int i = 0; i < 4; ++i) { const int r = 4 * g + i; float v = p[r] * __builtin_amdgcn_exp2f(u2[i] - myMM2); if (diag && (8 * g + 4 * hh + i) > r32) v = 0.f; pw[r] = v; } }
            v4u pb0, pb1;
            pb0.x = pk2(pw[0], pw[1]); pb0.y = pk2(pw[2], pw[3]); pb0.z = pk2(pw[4], pw[5]); pb0.w = pk2(pw[6], pw[7]);
            pb1.x = pk2(pw[8], pw[9]); pb1.y = pk2(pw[10], pw[11]); pb1.z = pk2(pw[12], pw[13]); pb1.w = pk2(pw[14], pw[15]);
            *(GAS v4u*)(PT + (size_t)kt * 2048 + lane * 16) = pb0; *(GAS v4u*)(PT + (size_t)kt * 2048 + 1024 + lane * 16) = pb1;
        }
        { const int dkt = wid & 3, kh = wid >> 2;
          unsigned char* KF = wsp(F, WS_R2) + 16 * MiB + (((size_t)(bh * 16 + c) * 8 + (dkt * 2 + kh)) * 8) * 1024 + lane * 16;
#pragma unroll
          for (int ks = 0; ks < 8; ++ks) { const int s0 = 128 * kh + 16 * ks + 8 * hh; bf16x8 bb;
#pragma unroll
              for (int j = 0; j < 8; ++j) bb[j] = *(const LAS short*)(L + CVP_KS + (s0 + j) * 272 + (32 * dkt + r32) * 2);
              *(GAS bf16x8*)(KF + (size_t)ks * 1024) = bb; } }
    }
    __syncthreads();
}
__device__ __forceinline__ void phase_cvp(Frame& F, int l) {
    const int v = (F.G % 8 == 0) ? (F.c % 8) * (F.G / 8) + F.c / 8 : F.c;
    for (int u = v; u < 256; u += F.G) cvp_job(F, l, u >> 4, u & 15);
}

constexpr int M2_KS = 0, M2_VT = 69632, M2_CT = 86528, M2_G = 95232, M2_U2 = 97280, M2_WC = 105472, M2_PART = 113664;
constexpr int M2_KP = 272, M2_VP = 528, M2_CP = 272;
__device__ __forceinline__ void mlstm_unit(Frame& F, int b, int h, int ds, int skip) {
    LAS unsigned char* L = F.lds;
    const int wid = F.wave;
    const int qblk = (wid < 4) ? 7 - wid : wid - 4;
    const int dkt = wid & 3, kh = wid >> 2;
#define M2_IDS() int lane_ = F.lane; asm volatile("" : "+v"(lane_)); const int lane = lane_, tid = wid * 64 + lane, r32 = lane & 31, hh = lane >> 5
    const bf16* VTg = (const bf16*)wsp(F, WS_VT);
    bf16* P6 = (bf16*)wsp(F, WS_P6);
    const int tb = b * SEQ, bh = b * 4 + h;
    { M2_IDS();
    for (int i = tid; i < 16 * 264; i += 512) { const int row = 16 + i / 264, col = i % 264; *(LAS bf16*)(L + M2_VT + row * M2_VP + col * 2) = (row == 16 && col < 256) ? (bf16)0x3F80 : (bf16)0; }
    for (int i = tid; i < 32 * 136; i += 512) *(LAS bf16*)(L + M2_CT + i * 2) = (bf16)0; }
    f32x16 st = {};
    float Mst = 0.f;
    v4u pv; float pu[4], ppm, pbl, psa, psm;
    bf16x8 qf[8];
    v4u kfr[8];
    v4u pbuf[8][2];
    const unsigned char* R3 = wsp(F, WS_R3);
#define M2_FETCH(cc) do { const int t0_ = tb + 256 * (cc); \
        { const int dvl_ = tid >> 5, seg_ = tid & 31; pv = *(const GAS v4u*)(VTg + (size_t)(h * 256 + ds * 16 + dvl_) * NTOK + t0_ + seg_ * 8); } \
        { const size_t ib_ = (size_t)bh * 4096 + 256 * (cc); \
          _Pragma("unroll") for (int i = 0; i < 4; ++i) pu[i] = *(const GAS float*)(R3 + MLS_U + (ib_ + 64 * i + lane) * 4); \
          ppm = *(const GAS float*)(R3 + MLS_PM + (ib_ + 32 * qblk + r32) * 4); pbl = *(const GAS float*)(R3 + MLS_BL + (ib_ + 32 * qblk + r32) * 4); \
          psa = *(const GAS float*)(R3 + MLS_SUM + (size_t)(bh * 16 + (cc)) * 8); psm = *(const GAS float*)(R3 + MLS_SUM + (size_t)(bh * 16 + (cc)) * 8 + 4); } } while (0)
#define M2_QFETCH(cc) do { const unsigned char* qf_ = wsp(F, WS_R2) + (((size_t)(bh * 16 + (cc)) * 8 + qblk) * 8) * 1024 + lane * 16; _Pragma("unroll") for (int kk = 0; kk < 8; ++kk) qf[kk] = *(const GAS bf16x8*)(qf_ + (size_t)kk * 1024); } while (0)
#define M2_KFETCH(cc) do { const unsigned char* kf_ = wsp(F, WS_R2) + 16 * MiB + (((size_t)(bh * 16 + (cc)) * 8 + (dkt * 2 + kh)) * 8) * 1024 + lane * 16; \
        _Pragma("unroll") for (int ks = 0; ks < 8; ++ks) kfr[ks] = *(const GAS v4u*)(kf_ + (size_t)ks * 1024); } while (0)
#define M2_PTQ(cc) (wsp(F, WS_PT) + ((size_t)(bh * 16 + (cc)) * 36 + (qblk * (qblk + 1)) / 2) * 2048 + lane * 16)
    { M2_IDS(); M2_FETCH(0); M2_QFETCH(0); M2_KFETCH(0);
      const unsigned char* pt_ = M2_PTQ(0);
#pragma unroll
      for (int kt = 0; kt < 8; ++kt) if (kt <= qblk) { pbuf[kt][0] = *(const GAS v4u*)(pt_ + (size_t)kt * 2048); pbuf[kt][1] = *(const GAS v4u*)(pt_ + (size_t)kt * 2048 + 1024); } }
    LAS float* WCw = (LAS float*)(L + M2_WC + wid * 1024);
    for (int c = 0; c < 16; ++c) {
        M2_IDS();
        const int t0 = tb + 256 * c;
        const bool more = (c + 1 < 16);
        { const int dvl_ = tid >> 5, seg_ = tid & 31; *(LAS v4u*)(L + M2_VT + dvl_ * M2_VP + seg_ * 16) = pv; }
        float cu[4]; const float cpm = ppm, cbl = pbl, csa = psa, csm = psm;
#pragma unroll
        for (int i = 0; i < 4; ++i) cu[i] = pu[i];
        if (more) M2_FETCH(c + 1);
        float myWIN, myEFLO, decay;
        {
            const float mml = fmaxf(Mst, csm);
#pragma unroll
            for (int i = 0; i < 4; ++i) WCw[64 * i + lane] = __expf(cu[i] - mml);
            const float mm = fmaxf(Mst, cpm);
            myWIN = __expf(Mst - mm); myEFLO = __expf(-(cbl + mm));
            decay = __expf(Mst - mml);
            Mst = csa + mml;
        }
        __syncthreads();
        f32x16 hT = {};
        if (!(skip & 4))
#pragma unroll
        for (int kk = 0; kk < 8; ++kk) { const bf16x8 a = *(const LAS bf16x8*)(L + M2_CT + r32 * M2_CP + (16 * kk + 8 * hh) * 2); hT = __builtin_amdgcn_mfma_f32_32x32x16_bf16(a, qf[kk], hT, 0, 0, 0); }
        if (more) M2_QFETCH(c + 1);
#pragma unroll
        for (int r = 0; r < 16; ++r) hT[r] *= myWIN;
        {
            const unsigned char* ptn = M2_PTQ(c + 1);
#pragma unroll
            for (int kt = 0; kt < 8; ++kt) if (kt <= qblk) {
#pragma unroll
                for (int s = 0; s < 2; ++s) if (!(skip & 1)) { const LAS unsigned char* vp = L + M2_VT + r32 * M2_VP + (32 * kt + 16 * s + 4 * hh) * 2;
                    const v2u lo = *(const LAS v2u*)vp, hi = *(const LAS v2u*)(vp + 16);
                    v4u t; t.x = lo.x; t.y = lo.y; t.z = hi.x; t.w = hi.y;
                    hT = __builtin_amdgcn_mfma_f32_32x32x16_bf16(__builtin_bit_cast(bf16x8, t), __builtin_bit_cast(bf16x8, pbuf[kt][s]), hT, 0, 0, 0); }
                if (more) { pbuf[kt][0] = *(const GAS v4u*)(ptn + (size_t)kt * 2048); pbuf[kt][1] = *(const GAS v4u*)(ptn + (size_t)kt * 2048 + 1024); }
            }
        }
        {
            const float dn = hT[8];
            auto rr = __builtin_amdgcn_permlane32_swap(__float_as_uint(dn), __float_as_uint(dn), false, false);
            const float den = __uint_as_float(rr[0]);
            const float inv = 1.0f / fmaxf(fabsf(den), myEFLO);
            bf16* orow = P6 + (size_t)(t0 + 32 * qblk + r32) * P6W + P_MQK + h * 256 + ds * 16 + 4 * hh;
            v2u o0, o1; o0.x = pk2(hT[0] * inv, hT[1] * inv); o0.y = pk2(hT[2] * inv, hT[3] * inv); o1.x = pk2(hT[4] * inv, hT[5] * inv); o1.y = pk2(hT[6] * inv, hT[7] * inv);
            if (!(skip & 8)) { *(GAS v2u*)orow = o0; *(GAS v2u*)(orow + 8) = o1; } else { asm volatile("" :: "v"(o0), "v"(o1)); }
        }
        f32x16 part = {};
#pragma unroll
        for (int ks = 0; ks < 8; ++ks) if (!(skip & 2)) {
            const int s0 = 128 * kh + 16 * ks + 8 * hh;
            const v4u raw = *(const LAS v4u*)(L + M2_VT + r32 * M2_VP + s0 * 2);
            const f32x4 w0 = *(const LAS f32x4*)(WCw + s0), w1 = *(const LAS f32x4*)(WCw + s0 + 4);
            v4u aw; aw.x = pk2(bflo(raw.x) * w0[0], bfhi(raw.x) * w0[1]); aw.y = pk2(bflo(raw.y) * w0[2], bfhi(raw.y) * w0[3]);
            aw.z = pk2(bflo(raw.z) * w1[0], bfhi(raw.z) * w1[1]); aw.w = pk2(bflo(raw.w) * w1[2], bfhi(raw.w) * w1[3]);
            part = __builtin_amdgcn_mfma_f32_32x32x16_bf16(__builtin_bit_cast(bf16x8, aw), __builtin_bit_cast(bf16x8, kfr[ks]), part, 0, 0, 0);
        }
        if (more) M2_KFETCH(c + 1);
        if (kh == 1) {
#pragma unroll
            for (int r = 0; r < 16; ++r) *(LAS float*)(L + M2_PART + dkt * 4096 + r * 256 + lane * 4) = part[r];
        }
        __syncthreads();
        if (kh == 0) {
#pragma unroll
            for (int r = 0; r < 16; ++r) { st[r] = st[r] * decay + part[r] + *(LAS float*)(L + M2_PART + dkt * 4096 + r * 256 + lane * 4);
                *(LAS bf16*)(L + M2_CT + crow(r, hh) * M2_CP + (32 * dkt + r32) * 2) = f2bf(st[r]); }
        }
    }
#undef M2_FETCH
#undef M2_QFETCH
#undef M2_KFETCH
#undef M2_PTQ
#undef M2_IDS
}
__device__ __forceinline__ void phase_mlstm(Frame& F, int skip) {
    const int v = (F.G % 8 == 0) ? (F.c % 8) * (F.G / 8) + F.c / 8 : F.c;
    for (int u = v; u < 256; u += F.G) { const int bh = u >> 4, ds = u & 15; mlstm_unit(F, bh >> 2, bh & 3, ds, skip); __syncthreads(); }
}

__device__ __forceinline__ void phase_hm_final(Frame& F, int l, bool do_store) {
    bf16* P6 = (bf16*)wsp(F, WS_P6);
    const float* mw = inp(F, I_MNW) + (size_t)l * 1024;
    for (int vb = F.c; vb < 256; vb += F.G) {
        v4u hn[2], mn[2];
#define HM_LOAD(tt) do { const bf16* r_ = P6 + (size_t)(tt) * P6W + 8 * F.lane; \
            _Pragma("unroll") for (int j = 0; j < 2; ++j) { hn[j] = *(const GAS v4u*)(r_ + P_MQK + 512 * j); mn[j] = *(const GAS v4u*)(r_ + P_MO + 512 * j); } } while (0)
        HM_LOAD(vb * 64 + F.wave * 8);
        for (int i = 0; i < 8; ++i) {
            const int t = vb * 64 + F.wave * 8 + i; bf16* row = P6 + (size_t)t * P6W + 8 * F.lane;
            v4u hc[2], mc[2];
#pragma unroll
            for (int j = 0; j < 2; ++j) { hc[j] = hn[j]; mc[j] = mn[j]; }
            if (i + 1 < 8) HM_LOAD(t + 1);
#pragma unroll
            for (int j = 0; j < 2; ++j) {
                const float x[8] = {bflo(hc[j].x), bfhi(hc[j].x), bflo(hc[j].y), bfhi(hc[j].y), bflo(hc[j].z), bfhi(hc[j].z), bflo(hc[j].w), bfhi(hc[j].w)};
                const float mo[8] = {bflo(mc[j].x), bfhi(mc[j].x), bflo(mc[j].y), bfhi(mc[j].y), bflo(mc[j].z), bfhi(mc[j].z), bflo(mc[j].w), bfhi(mc[j].w)};
                float ss = 0.f;
#pragma unroll
                for (int q = 0; q < 8; ++q) ss += x[q] * x[q];
                ss = half_sum32(ss);
                const float r = 1.0f / sqrtf(ss * (1.f / 256.f) + EPS);
                const f32x4 w0 = *(const GAS f32x4*)(mw + 512 * j + 8 * F.lane), w1 = *(const GAS f32x4*)(mw + 512 * j + 8 * F.lane + 4);
                float y[8];
#pragma unroll
                for (int q = 0; q < 4; ++q) { y[q] = x[q] * r * w0[q] * sigmoidf_(mo[q]); y[4 + q] = x[4 + q] * r * w1[q] * sigmoidf_(mo[4 + q]); }
                v4u o; o.x = pk2(y[0], y[1]); o.y = pk2(y[2], y[3]); o.z = pk2(y[4], y[5]); o.w = pk2(y[6], y[7]);
                if (do_store) *(GAS v4u*)(row + P_MQK + 512 * j) = o; else asm volatile("" :: "v"(o));
            }
        }
#undef HM_LOAD
    }
}

#define N2_LD0(dst, k0) do { const GAS float* bq_ = bp + (size_t)(2 * (k0)) * 64; asm volatile("" : "+v"(bq_)); _Pragma("unroll") for (int q_ = 0; q_ < 32; ++q_) dst[q_] = bq_[(size_t)(2 * q_) * 64]; } while (0)
constexpr int N2_H2 = 0, N2_CA = 131328, N2_CB = N2_CA + 4096, N2_HIST = N2_CB + 4096;
__device__ __forceinline__ void phase_norm2_router(Frame& F, int l, int skip) {
    LAS unsigned char* L = F.lds;
    LAS float* H2 = (LAS float*)(L + N2_H2); LAS float* cA = (LAS float*)(L + N2_CA); LAS float* cB = (LAS float*)(L + N2_CB); LAS unsigned* hist = (LAS unsigned*)(L + N2_HIST);
    const int lane = F.lane, wid = F.wave, r32 = lane & 31, hh = lane >> 5;
    bf16* XN2 = (bf16*)wsp(F, WS_R1); int* TOPE = (int*)wsp(F, WS_TOPE); float* TOPW = (float*)wsp(F, WS_TOPW); unsigned* CNT = (unsigned*)wsp(F, WS_CNT);
    const float* Wr = inp(F, I_RW) + (size_t)l * 1024 * 64;
    const float rb = inp(F, I_RB)[l * 64 + lane];
    for (int vb = F.c; vb < 256; vb += F.G) {
        const int b = vb >> 6;
        const float* MODF = (const float*)wsp(F, WS_MODF) + (size_t)(l * 4 + b) * 6144;
        for (int k = F.tid; k < 1024; k += 512) { cA[k] = inp(F, I_N2W)[l * 1024 + k] * (1.f + MODF[4 * 1024 + k]); cB[k] = MODF[3 * 1024 + k]; }
        if (F.tid < 64) hist[F.tid] = 0u;
        const int eh = wid & 1, kq = wid >> 1;
        const GAS float* bp = (const GAS float*)(Wr + (size_t)(256 * kq + hh) * 64 + 32 * eh + r32);
        __syncthreads();
        for (int it = 0; it < 2; ++it) {
            const int T0 = vb * 64 + it * 32;
            float wA[32], wB[32];
            N2_LD0(wA, 0); N2_LD0(wB, 32);
            v4u xr4[4][2];
            if (!(skip & 4))
#pragma unroll
            for (int i = 0; i < 4; ++i) { const bf16* xr = xmid(F, l) + (size_t)(T0 + wid * 4 + i) * 1024 + 8 * lane;
#pragma unroll
                for (int j = 0; j < 2; ++j) xr4[i][j] = *(const GAS v4u*)(xr + 512 * j); }
#pragma unroll
            for (int i = 0; i < 4; ++i) if (!(skip & 4)) {
                const int tl = wid * 4 + i, t = T0 + tl;
                float v[2][8]; float ss = 0.f;
#pragma unroll
                for (int j = 0; j < 2; ++j) { const v4u a = xr4[i][j];
                    v[j][0] = bflo(a.x); v[j][1] = bfhi(a.x); v[j][2] = bflo(a.y); v[j][3] = bfhi(a.y); v[j][4] = bflo(a.z); v[j][5] = bfhi(a.z); v[j][6] = bflo(a.w); v[j][7] = bfhi(a.w);
#pragma unroll
                    for (int q = 0; q < 8; ++q) ss += v[j][q] * v[j][q]; }
                ss = wave_sum(ss, F.lane);
                const float r = 1.0f / sqrtf(ss * (1.f / 1024.f) + EPS);
#pragma unroll
                for (int j = 0; j < 2; ++j) { const int k = 8 * lane + 512 * j; float h[8];
                    const f32x4 a0 = *(const LAS f32x4*)(cA + k), a1 = *(const LAS f32x4*)(cA + k + 4), b0 = *(const LAS f32x4*)(cB + k), b1 = *(const LAS f32x4*)(cB + k + 4);
                    LAS float* hp = H2 + tl * 1025 + k;
#pragma unroll
                    for (int q = 0; q < 4; ++q) { h[q] = v[j][q] * r * a0[q] + b0[q]; h[4 + q] = v[j][4 + q] * r * a1[q] + b1[q]; }
#pragma unroll
                    for (int q = 0; q < 8; ++q) hp[q] = h[q];
                    v4u o; o.x = pk2(h[0], h[1]); o.y = pk2(h[2], h[3]); o.z = pk2(h[4], h[5]); o.w = pk2(h[6], h[7]);
                    *(GAS v4u*)(XN2 + (size_t)t * 1024 + k) = o; }
            }
            __syncthreads();
            f32x16 acc = {};
            {
                const LAS float* ap = H2 + r32 * 1025 + 256 * kq + hh;
#define N2_LD(dst, k0) N2_LD0(dst, k0)
#define N2_MM(src, k0) do { _Pragma("unroll") for (int q_ = 0; q_ < 32; ++q_) { if ((q_ & 7) == 0) asm volatile("" ::: "memory"); acc = __builtin_amdgcn_mfma_f32_32x32x2f32(ap[2 * ((k0) + q_)], src[q_], acc, 0, 0, 0); } } while (0)
                if (!(skip & 1)) { N2_MM(wA, 0); N2_LD(wA, 64); N2_MM(wB, 32); N2_LD(wB, 96); N2_MM(wA, 64); N2_MM(wB, 96); }
            }
            __syncthreads();
            LAS float* PART = (LAS float*)(L);
#pragma unroll
            for (int r = 0; r < 16; ++r) PART[(kq * 32 + crow(r, hh)) * 64 + 32 * eh + r32] = acc[r];
            __syncthreads();
            if (!(skip & 2))
            {
                LAS float* rowb = (LAS float*)(L + 32768 + wid * 4096);
                int lane_t = F.lane; asm volatile("" : "+v"(lane_t)); const int lane = lane_t;
                const int g = lane >> 3;
                float score[4], sel[4]; unsigned key[4];
#pragma unroll
                for (int i = 0; i < 4; ++i) { const int tl = wid * 4 + i;
                    const float x = (PART[(0 * 32 + tl) * 64 + lane] + PART[(1 * 32 + tl) * 64 + lane]) + (PART[(2 * 32 + tl) * 64 + lane] + PART[(3 * 32 + tl) * 64 + lane]);
                    score[i] = 1.f / (1.f + expf(-x)); sel[i] = score[i] + rb; rowb[i * 256 + lane] = sel[i]; }
                LDS_WAIT();
#pragma unroll
                for (int i = 0; i < 4; ++i) { const LAS float* row = rowb + i * 256;
                    const f32x4 a = *(const LAS f32x4*)(row + 8 * g), c2 = *(const LAS f32x4*)(row + 8 * g + 4);
                    float m1 = fmaxf(a[0], a[1]), m2 = fminf(a[0], a[1]);
#define TK_INS(v_) do { const float v__ = (v_); m2 = fmaxf(m2, fminf(m1, v__)); m1 = fmaxf(m1, v__); } while (0)
                    TK_INS(a[2]); TK_INS(a[3]); TK_INS(c2[0]); TK_INS(c2[1]); TK_INS(c2[2]); TK_INS(c2[3]);
#undef TK_INS
                    if ((lane & 7) == 0) rowb[i * 256 + 64 + g] = m1 + m2; }
                LDS_WAIT();
#pragma unroll
                for (int i = 0; i < 4; ++i) { const LAS float* row = rowb + i * 256;
                    const f32x4 a = *(const LAS f32x4*)(row + 64), c2 = *(const LAS f32x4*)(row + 68);
                    const float gsv[8] = {a[0], a[1], a[2], a[3], c2[0], c2[1], c2[2], c2[3]};
                    float mine = 0.f;
#pragma unroll
                    for (int q = 0; q < 8; ++q) if (q == g) mine = gsv[q];
                    int gr = 0;
#pragma unroll
                    for (int q = 0; q < 8; ++q) gr += ((gsv[q] > mine) || (gsv[q] == mine && q < g)) ? 1 : 0;
                    const unsigned sb = __float_as_uint(sel[i]); key[i] = (gr < 4) ? (sb ^ ((unsigned)((int)sb >> 31) | 0x80000000u)) : 0u; }
                unsigned chosenm = 0u; float wsum[4] = {0.f, 0.f, 0.f, 0.f}; int myE = 0; float myS = 0.f;
#pragma unroll
                for (int r = 0; r < 8; ++r)
#pragma unroll
                    for (int i = 0; i < 4; ++i) {
                        const unsigned m = wave_umax_all(key[i]);
                        const int idx = __builtin_ctzll(__builtin_amdgcn_ballot_w64(key[i] == m));
                        const float sc = __int_as_float(__builtin_amdgcn_readlane(__float_as_int(score[i]), idx));
                        wsum[i] += sc;
                        if (lane == idx) { key[i] = 0u; chosenm += 1u; }
                        if (lane == 8 * i + r) { myE = idx; myS = sc; }
                    }
                {
                    const int ti = lane >> 3; const float ws_ = (ti == 0) ? wsum[0] : (ti == 1) ? wsum[1] : (ti == 2) ? wsum[2] : wsum[3];
                    if (lane < 32) { const size_t o = (size_t)(T0 + wid * 4) * 8 + lane;
                        *(GAS int*)(TOPE + o) = myE; *(GAS float*)(TOPW + o) = myS / ws_ * 2.5f; }
                    if (chosenm) __hip_atomic_fetch_add(&hist[lane], chosenm, __ATOMIC_RELAXED, __HIP_MEMORY_SCOPE_WORKGROUP);
                }
                LDS_WAIT();
            }
            __syncthreads();
        }
        if (F.tid < 64) CNT[vb * 64 + F.tid] = hist[F.tid];
        __syncthreads();
    }
}

__device__ __forceinline__ void phase_scatter(Frame& F) {
    LAS unsigned* red = (LAS unsigned*)(F.lds);
    LAS unsigned* tot = red + 1024; LAS unsigned* padv = tot + 64; LAS unsigned* bef = padv + 64; LAS unsigned* base = bef + 64; LAS unsigned* selm = base + 64;
    const unsigned* CNT = (const unsigned*)wsp(F, WS_CNT); const int* TOPE = (const int*)wsp(F, WS_TOPE); const float* TOPW = (const float*)wsp(F, WS_TOPW);
    unsigned* STOK = (unsigned*)wsp(F, WS_STOK); float* SW = (float*)wsp(F, WS_SW); unsigned* SDST = (unsigned*)wsp(F, WS_SDST); int* TILEE = (int*)wsp(F, WS_TILEE);
    const int tid = F.tid;
    for (int vb = F.c; vb < 256; vb += F.G) {
        { const int e = tid & 63, part = tid >> 6; unsigned t = 0, bfv = 0;
          for (int blk = 32 * part; blk < 32 * part + 32; ++blk) { const unsigned v = CNT[blk * 64 + e]; t += v; if (blk < vb) bfv += v; }
          red[part * 64 + e] = t; red[512 + part * 64 + e] = bfv; }
        if (tid < 128) selm[tid] = 0u;
        __syncthreads();
        if (tid < 64) { unsigned T = 0, B = 0;
#pragma unroll
            for (int p = 0; p < 8; ++p) { T += red[p * 64 + tid]; B += red[512 + p * 64 + tid]; }
            tot[tid] = T; padv[tid] = (T + 255u) & ~255u; bef[tid] = B; }
        __syncthreads();
        if (tid < 64) { unsigned b = 0; for (int e = 0; e < tid; ++e) b += padv[e]; base[tid] = b; }
        const int tok = tid >> 3, slot = tid & 7, gt = vb * 64 + tok; const int e = TOPE[(size_t)gt * 8 + slot];
        __hip_atomic_fetch_or(&selm[e * 2 + (tok >> 5)], 1u << (tok & 31), __ATOMIC_RELAXED, __HIP_MEMORY_SCOPE_WORKGROUP);
        __syncthreads();
        { const unsigned lo = selm[e * 2], hi = selm[e * 2 + 1];
          const unsigned rank = (tok < 32) ? __popc(lo & ((1u << tok) - 1u)) : (__popc(lo) + __popc(hi & ((1u << (tok - 32)) - 1u)));
          const unsigned pos = base[e] + bef[e] + rank;
          STOK[pos] = (unsigned)gt; SW[pos] = TOPW[(size_t)gt * 8 + slot]; SDST[pos] = (unsigned)(gt * 8 + slot); }
        if (vb < 64) { const unsigned n = padv[vb] - tot[vb]; if ((unsigned)tid < n) { const unsigned pos = base[vb] + tot[vb] + tid; STOK[pos] = 0u; SW[pos] = 0.f; SDST[pos] = 0xffffffffu; } }
        if (vb == 0) { const int ntiles = (int)((base[63] + padv[63]) >> 8);
            for (int pm = tid; pm < ntiles; pm += 512) { int ee = 0; for (int q = 0; q < 64; ++q) if ((unsigned)(256 * pm) >= base[q] && (unsigned)(256 * pm) < base[q] + padv[q]) ee = q; TILEE[pm] = ee; }
            if (tid == 0) TILEE[1000] = ntiles; }
        __syncthreads();
    }
}

struct RoutedOrder {
    int ntiles, G, c; const LAS int* tabE; const LAS unsigned* tabTok; int wave;
    __device__ __forceinline__ bool next(int i, pg8::Unit& u) const { const int pm = i * G + c; if (pm >= ntiles) return false; u.pm = pm; u.pn = tabE[i]; return true; }
    __device__ __forceinline__ unsigned rowtok(int i, int row) const { return tabTok[i * 256 + row]; }
};
struct DownOrder {
    int nunits, G, v; const LAS int* tabE; int wave;
    __device__ __forceinline__ bool next(int i, pg8::Unit& u) const { const int L = i * G + v; if (L >= nunits) return false; u.pm = L >> 2; u.pn = tabE[i] * 4 + (L & 3); return true; }
    __device__ __forceinline__ unsigned rowtok(int, int) const { return 0u; }
};

__device__ __forceinline__ void phase_combine(Frame& F, int l, bool do_store) {
    const bf16* Y = (const bf16*)wsp(F, WS_R1); bf16* XN = (bf16*)wsp(F, WS_R2); float* GATES = (float*)wsp(F, WS_GATES);
    const bool last = (l == NLAYER - 1);
    for (int vb = F.c; vb < 256; vb += F.G) {
        const int b = vb >> 6;
        const float* g2 = (const float*)wsp(F, WS_MODF) + (size_t)(l * 4 + b) * 6144 + 5 * 1024;
        float gbl = 0.f;
        if (!last) { norm1_tables(F, l + 1, b, false); gbl = (F.lane < 4) ? inp(F, I_IGB)[(l + 1) * 4 + F.lane] : (F.lane < 8 ? inp(F, I_FGB)[(l + 1) * 4 + F.lane - 4] : 0.f); }
        __syncthreads();
        v2u yn[8][2];
        const bf16* SHO = (const bf16*)wsp(F, WS_R1 + 128 * MiB);
#define CB_LOAD(tt) do { const int t_ = (tt); \
            _Pragma("unroll") for (int s = 0; s < 8; ++s) _Pragma("unroll") for (int j = 0; j < 2; ++j) yn[s][j] = *(const GAS v2u*)((const unsigned char*)Y + ((size_t)t_ * 8 + s) * 1024 + 8 * F.lane + 512 * j); \
            } while (0)
        CB_LOAD(vb * 64 + F.wave * 8);
        for (int i = 0; i < 8; ++i) {
            const int t = vb * 64 + F.wave * 8 + i;
            v2u yc[8][2]; v4u xc[2]; v4u sc2[2]; bf16* xbr = xmid(F, l) + (size_t)t * 1024 + 8 * F.lane;
#pragma unroll
            for (int j = 0; j < 2; ++j) sc2[j] = *(const GAS v4u*)(SHO + (size_t)t * 1024 + 8 * F.lane + 512 * j);
#pragma unroll
            for (int s = 0; s < 8; ++s) { yc[s][0] = yn[s][0]; yc[s][1] = yn[s][1]; }
#pragma unroll
            for (int j = 0; j < 2; ++j) xc[j] = *(const GAS v4u*)(xbr + 512 * j);
            if (i + 1 < 8) CB_LOAD(t + 1);
            float acc[2][8];
#pragma unroll
            for (int j = 0; j < 2; ++j)
#pragma unroll
                for (int q = 0; q < 8; ++q) acc[j][q] = 0.f;
#pragma unroll
            for (int s = 0; s < 8; ++s)
#pragma unroll
                for (int j = 0; j < 2; ++j) { const v2u q = yc[s][j];
                    const f32x2_t a0 = __builtin_amdgcn_cvt_pk_f32_fp8((int)q.x, false), a1 = __builtin_amdgcn_cvt_pk_f32_fp8((int)q.x, true), a2 = __builtin_amdgcn_cvt_pk_f32_fp8((int)q.y, false), a3 = __builtin_amdgcn_cvt_pk_f32_fp8((int)q.y, true);
                    acc[j][0] += a0.x; acc[j][1] += a0.y; acc[j][2] += a1.x; acc[j][3] += a1.y; acc[j][4] += a2.x; acc[j][5] += a2.y; acc[j][6] += a3.x; acc[j][7] += a3.y; }
            float v[2][8]; float* xr = outp(F) + (size_t)t * 1024 + 8 * F.lane;
#pragma unroll
            for (int j = 0; j < 2; ++j) { const f32x4 a = {bflo(xc[j].x), bfhi(xc[j].x), bflo(xc[j].y), bfhi(xc[j].y)}, c2 = {bflo(xc[j].z), bfhi(xc[j].z), bflo(xc[j].w), bfhi(xc[j].w)};
                const f32x4 ga = *(const GAS f32x4*)(g2 + 8 * F.lane + 512 * j), gc = *(const GAS f32x4*)(g2 + 8 * F.lane + 512 * j + 4);
                const float sh[8] = {bflo(sc2[j].x), bfhi(sc2[j].x), bflo(sc2[j].y), bfhi(sc2[j].y), bflo(sc2[j].z), bfhi(sc2[j].z), bflo(sc2[j].w), bfhi(sc2[j].w)};
#pragma unroll
                for (int q = 0; q < 4; ++q) { v[j][q] = a[q] + ga[q] * (acc[j][q] * (1.f / YS_SCALE) + sh[q]); v[j][4 + q] = c2[q] + gc[q] * (acc[j][4 + q] * (1.f / YS_SCALE) + sh[4 + q]); } }
            if (last) {
                float ss = 0.f;
#pragma unroll
                for (int j = 0; j < 2; ++j)
#pragma unroll
                    for (int q = 0; q < 8; ++q) ss += v[j][q] * v[j][q];
                ss = wave_sum(ss, F.lane);
                const float r = 1.0f / sqrtf(ss * (1.f / 1024.f) + EPS);
#pragma unroll
                for (int j = 0; j < 2; ++j) { const float* fw = inp(F, I_FNW) + 8 * F.lane + 512 * j; const f32x4 w0 = *(const GAS f32x4*)fw, w1 = *(const GAS f32x4*)(fw + 4);
                    f32x4 o0, o1;
#pragma unroll
                    for (int q = 0; q < 4; ++q) { o0[q] = v[j][q] * r * w0[q]; o1[q] = v[j][4 + q] * r * w1[q]; }
                    if (do_store) { *(GAS f32x4*)(xr + 512 * j) = o0; *(GAS f32x4*)(xr + 512 * j + 4) = o1; } else asm volatile("" :: "v"(o0), "v"(o1)); }
            } else {
#pragma unroll
                for (int j = 0; j < 2; ++j) { v4u o; o.x = pk2(v[j][0], v[j][1]); o.y = pk2(v[j][2], v[j][3]); o.z = pk2(v[j][4], v[j][5]); o.w = pk2(v[j][6], v[j][7]);
                    if (do_store) { *(GAS v4u*)(xbr + 512 * j) = o; } else asm volatile("" :: "v"(o)); }
                if (do_store) norm_emit(F, v, (const LAS float*)(F.lds + LDS_TAB), (const LAS float*)(F.lds + LDS_TAB) + 1024, (const LAS float*)(F.lds), gbl, XN + (size_t)t * 1024, GATES + (size_t)t * 8);
            }
        }
#undef CB_LOAD
        __syncthreads();
    }
}

__device__ __forceinline__ void dbg_final(Frame& F, const float* src) {
    for (int vb = F.c; vb < 256; vb += F.G)
        for (int i = 0; i < 8; ++i) {
            const int t = vb * 64 + F.wave * 8 + i; const float* xr = src + (size_t)t * 1024 + 8 * F.lane; float* orow = outp(F) + (size_t)t * 1024 + 8 * F.lane;
            float v[2][8]; float ss = 0.f;
#pragma unroll
            for (int j = 0; j < 2; ++j) { const f32x4 a = *(const GAS f32x4*)(xr + 512 * j), c2 = *(const GAS f32x4*)(xr + 512 * j + 4);
#pragma unroll
                for (int q = 0; q < 4; ++q) { v[j][q] = a[q]; v[j][4 + q] = c2[q]; ss += a[q] * a[q] + c2[q] * c2[q]; } }
            ss = wave_sum(ss, F.lane);
            const float r = 1.0f / sqrtf(ss * (1.f / 1024.f) + EPS);
#pragma unroll
            for (int j = 0; j < 2; ++j) { const float* fw = inp(F, I_FNW) + 8 * F.lane + 512 * j; const f32x4 w0 = *(const GAS f32x4*)fw, w1 = *(const GAS f32x4*)(fw + 4);
                f32x4 o0, o1;
#pragma unroll
                for (int q = 0; q < 4; ++q) { o0[q] = v[j][q] * r * w0[q]; o1[q] = v[j][4 + q] * r * w1[q]; }
                *(GAS f32x4*)(orow + 512 * j) = o0; *(GAS f32x4*)(orow + 512 * j + 4) = o1; }
        }
}
struct Args { const float* in[24]; float* out; unsigned char* ws; };
#ifndef MK_EN_MASK
#define MK_EN_MASK 0xffffffffu
#endif
#define EN(k) (((MK_EN_MASK) >> (k)) & 1u)
#ifndef RP_G1
#define RP_G1 1
#endif
#ifndef RP_ATT
#define RP_ATT 1
#endif
#ifndef RP_ML
#define RP_ML 1
#endif
#ifndef RP_N2
#define RP_N2 1
#endif
#ifndef RP_CW
#define RP_CW 1
#endif
#ifndef RP_C
#define RP_C 1
#endif
#ifndef RP_D
#define RP_D 1
#endif
#ifndef RP_CV
#define RP_CV 1
#endif
#ifndef RP_PB
#define RP_PB 1
#endif
#ifndef RP_VT
#define RP_VT 1
#endif
#ifndef RP_PA
#define RP_PA 1
#endif
#ifndef RP_SC
#define RP_SC 1
#endif
#ifndef RP_SG
#define RP_SG 1
#endif
#ifndef ML_SKIP
#define ML_SKIP 0
#endif
#ifndef RP_X5
#define RP_X5 1
#endif
#ifndef RP_E
#define RP_E 1
#endif
#ifndef RP_HM
#define RP_HM 1
#endif
#ifndef RP_P1
#define RP_P1 1
#endif
#ifndef RP_SD
#define RP_SD 1
#endif
#ifndef N2_SKIP
#define N2_SKIP 0
#endif
#ifndef MK_LAST_PHASE
#define MK_LAST_PHASE 1000
#endif
__global__ void __launch_bounds__(512, 2) mk_fwd(Args args) {
    extern __shared__ __attribute__((aligned(16))) unsigned char lds_raw[];
    Frame F;
    F.lds = (LAS unsigned char*)lds_raw;
    const int wave0 = __builtin_amdgcn_readfirstlane((int)threadIdx.x >> 6);
#define RELOAD_IDS() do { int l_ = lane_now(); F.lane = l_; F.wave = wave0; F.tid = wave0 * 64 + l_; } while (0)
    RELOAD_IDS();
    F.G = gridDim.x; F.c = blockIdx.x;
    F.out = args.out; F.ws = args.ws;
    if (F.tid < 16) ((LAS unsigned*)(F.lds + LDS_CTL))[F.tid] = 0u;
#pragma unroll
    for (int i = 0; i < 24; ++i) if (F.tid == 64 + i) *(LAS unsigned long long*)(F.lds + LDS_CTL + 64 + 8 * i) = (unsigned long long)args.in[i];
    __syncthreads();
    XcdBarrier bar = xcd_barrier_post((unsigned*)wsp(F, WS_CTL) + CW_BAR, (volatile LAS unsigned*)(F.lds + LDS_CTL));
#define P6 ((bf16*)wsp(F, WS_P6))
#define VT ((bf16*)wsp(F, WS_VT))
#define R2 ((bf16*)wsp(F, WS_R2))
#define MODF ((const float*)wsp(F, WS_MODF))
#define GRID_BAR() do { XcdBarrier b_ = bar; asm volatile("" : "+s"(b_.bar), "+s"(b_.x)); xcd_barrier(b_); } while (0)
    int phase_no = 0;
#ifndef RP_BAR
#define RP_BAR 1
#endif
#define PHASE_END() do { for (int rb_ = 0; rb_ < RP_BAR; ++rb_) GRID_BAR(); RELOAD_IDS(); if (++phase_no >= MK_LAST_PHASE) goto finish; } while (0)

    if (EN(0)) { mod_partials(F);
    for (int rp = 0; rp < RP_CW; ++rp) { RELOAD_IDS(); conv_weights(F, 0); } }
    PHASE_END();
    for (int rp = 0; rp < RP_P1; ++rp) if (EN(1)) phase_norm1_first(F);
    PHASE_END();

#pragma unroll
    for (int l = 0; l < NLAYER; ++l) {
        if (EN(2)) { phase_mlstm_scalars(F); RELOAD_IDS(); }
        for (int rp = 0; rp < RP_G1; ++rp) if (EN(2)) {
            pg8::Gemm g{R2, (const bf16*)wsp(F, WS_BIN), 1024, 1024}; pg8::StaticOrder S; S.init(NTOK, P6W, F.G, F.c, F.wave);
            EpiPlain E{P6, P6W};
            pg8::gemm_phase<EpiPlain, pg8::StaticOrder, true, false>(F.lds, g, S, E);
        }
        for (int rp = 0; rp < RP_VT; ++rp) if (EN(3)) {
            pg8::Gemm g{(const bf16*)wsp(F, WS_AIN), R2, 1024, 1024}; pg8::StaticOrder S; S.init(2048, NTOK, F.G, F.c, F.wave);
            EpiPlain E{VT, NTOK};
            pg8::gemm_phase<EpiPlain, pg8::StaticOrder, true, false>(F.lds, g, S, E);
        }
        PHASE_END();
        for (int pass = 0; pass < 2; ++pass) {
            if (((pass ^ F.c) & 1) == 0) { for (int rp = 0; rp < RP_CV; ++rp) if (EN(4)) phase_cvp(F, l); }
            else { for (int rp = 1; rp < RP_ATT; ++rp) phase_attn(F, false); if (EN(5)) phase_attn(F, true); }
            RELOAD_IDS();
        }
        PHASE_END();
        for (int rp = 0; rp < RP_ML; ++rp) if (EN(6)) phase_mlstm(F, (RP_ML > 1 && rp == 0) ? ML_SKIP : 0);
        PHASE_END();
        for (int pass = 0; pass < 2; ++pass) {
            if (((pass ^ F.c) & 1) == 0) { for (int rp = 1; rp < RP_HM; ++rp) phase_hm_final(F, l, false); if (EN(7)) phase_hm_final(F, l, true); }
            else {
        for (int rp = 0; rp < RP_PB; ++rp) if (EN(8)) {
            pg8::Gemm g{P6 + P_SQ, (const bf16*)wsp(F, WS_BB), 1024, P6W}; pg8::StaticOrder S; S.init(NTOK, 1024, F.G, F.c, F.wave);
            EpiGateT1 E{P6 + P_GB, P6W, (bf16*)wsp(F, WS_VT)};
            pg8::gemm_phase<EpiGateT1, pg8::StaticOrder, true, false>(F.lds, g, S, E);
        }
            }
            RELOAD_IDS();
        }
        PHASE_END();
        for (int rp = 0; rp < RP_PA; ++rp) if (EN(9)) {
            pg8::Gemm g{P6 + P_MQK, (const bf16*)wsp(F, WS_BA), 1024, P6W}; pg8::StaticOrder S; S.init(NTOK, 1024, F.G, F.c, F.wave);
            EpiGateY E{P6 + P_GA, P6W, (const bf16*)wsp(F, WS_VT), R2};
            pg8::gemm_phase<EpiGateY, pg8::StaticOrder, true, false>(F.lds, g, S, E);
        }
        PHASE_END();
        for (int rp = 0; rp < RP_X5; ++rp) if (EN(10)) {
            pg8::Gemm g{R2, (const bf16*)wsp(F, WS_BO), 1024, 1024}; pg8::StaticOrder S; S.init(NTOK, 1024, F.G, F.c, F.wave);
            EpiRes E{(const bf16*)outp(F), xmid(F, l), MODF + (size_t)(l * 4) * 6144 + 2 * 1024, (RP_X5 > 1 && rp + 1 < RP_X5) ? 1 : 0};
            pg8::gemm_phase<EpiRes, pg8::StaticOrder, true, false>(F.lds, g, S, E);
        }
        PHASE_END();
        for (int rp = 0; rp < RP_N2; ++rp) if (EN(11)) phase_norm2_router(F, l, (RP_N2 > 1 && rp == 0) ? N2_SKIP : 0);
        PHASE_END();
        for (int rp = 0; rp < RP_SC; ++rp) if (EN(12)) phase_scatter(F);
        PHASE_END();
        {
            const int* TILEE = (const int*)wsp(F, WS_TILEE); const unsigned* STOK = (const unsigned*)wsp(F, WS_STOK);
            const int ntiles = TILEE[1000];
            LAS int* tabE = (LAS int*)(F.lds + LDS_TAB); LAS unsigned* tabTok = (LAS unsigned*)(F.lds + LDS_TAB + 64);
            LAS float* tabW = (LAS float*)(F.lds + LDS_TAB + 64 + 3072); const float* SWp = (const float*)wsp(F, WS_SW);
            const int v = (F.G % 8 == 0) ? (F.c % 8) * (F.G / 8) + F.c / 8 : F.c;
            const int cs = (F.G % 8 == 0) ? (v + F.G / 2) % F.G : F.G - 1 - F.c;
            for (int i = 0; i < 3; ++i) { const int pm = i * F.G + v; if (pm < ntiles) { if (F.tid == 0) tabE[i] = TILEE[pm]; if (F.tid < 256) { tabTok[i * 256 + F.tid] = STOK[(size_t)pm * 256 + F.tid]; tabW[i * 256 + F.tid] = SWp[(size_t)pm * 256 + F.tid]; } } }
            __syncthreads();
            for (int rp = 0; rp < RP_C; ++rp) if (EN(13)) {
                pg8::Gemm g{(const bf16*)wsp(F, WS_R1), (const bf16*)wsp(F, WS_BGU), 1024, 1024}; RoutedOrder S{ntiles, F.G, v, tabE, tabTok, F.wave};
                EpiHid E{R2, 128, tabW, v, F.G, 0};
                pg8::gemm_phase<EpiHid, RoutedOrder, true, true>(F.lds, g, S, E);
            }
            for (int rp = 0; rp < RP_SG; ++rp) if (EN(14)) {
                pg8::Gemm g{(const bf16*)wsp(F, WS_R1), (const bf16*)wsp(F, WS_BSGU), 1024, 1024}; pg8::StaticOrder S; S.init(NTOK, 512, F.G, cs, F.wave);
                EpiHid E{(bf16*)wsp(F, WS_R3), 256, nullptr, 0, 1, 1};
                pg8::gemm_phase<EpiHid, pg8::StaticOrder, true, false>(F.lds, g, S, E);
            }
        }
        PHASE_END();
        {
            const int* TILEE = (const int*)wsp(F, WS_TILEE);
            const int ntiles = TILEE[1000], nunits = 4 * ntiles;
            const int v = (F.G % 8 == 0) ? (F.c % 8) * (F.G / 8) + F.c / 8 : F.c;
            LAS int* tabE = (LAS int*)(F.lds + LDS_TAB);
            if (F.tid < 16) { const int L = F.tid * F.G + v; tabE[F.tid] = (L < nunits) ? TILEE[L >> 2] : 0; }
            LAS unsigned* tabD = (LAS unsigned*)(F.lds + LDS_TAB + 64); const unsigned* SDp = (const unsigned*)wsp(F, WS_SDST);
            for (int i = 0; i < 10; ++i) { const int L = i * F.G + v; if (L < nunits && F.tid < 256) tabD[i * 256 + F.tid] = SDp[(size_t)(L >> 2) * 256 + F.tid]; }
            __syncthreads();
            for (int rp = 0; rp < RP_D; ++rp) if (EN(15)) {
                pg8::Gemm g{R2, (const bf16*)wsp(F, WS_BD), 128, 128}; DownOrder S{nunits, F.G, v, tabE, F.wave};
                EpiScatter E{(bf16*)wsp(F, WS_R1), tabD, v, F.G, (RP_D > 1 && rp > 0) ? 1 : 0};
                pg8::gemm_phase<EpiScatter, DownOrder, true, false>(F.lds, g, S, E);
            }
            for (int rp = 0; rp < RP_SD; ++rp) if (EN(16)) {
                pg8::Gemm g{(const bf16*)wsp(F, WS_R3), (const bf16*)wsp(F, WS_BSD), 256, 256}; pg8::StaticOrder S; S.init(NTOK, 1024, F.G, F.c, F.wave);
                EpiPlain E{(bf16*)wsp(F, WS_R1 + 128 * MiB), 1024};
                pg8::gemm_phase<EpiPlain, pg8::StaticOrder, true, false>(F.lds, g, S, E);
            }
        }
        PHASE_END();
        for (int rp = 1; rp < RP_E; ++rp) phase_combine(F, l, false);
        if (EN(17)) phase_combine(F, l, true);
        if (l + 1 < NLAYER) { RELOAD_IDS(); if (EN(18)) conv_weights(F, l + 1); PHASE_END(); }
    }
#undef P6
#undef VT
#undef R2
#undef MODF
finish:
    if (MK_LAST_PHASE < 1000) dbg_final(F, phase_no >= 8 ? (const float*)outp(F) : inp(F, I_X));
}

extern "C" void kernel_launch(void* const* d_in, const int* in_sizes, int n_in, void* d_out, int out_size, void* d_ws, size_t ws_size, hipStream_t stream) {
    static int grid = 0;
    if (grid == 0) {
        if (n_in != 24 || in_sizes[0] != NTOK * DM || out_size != NTOK * DM || ws_size < WS_END) {
            fprintf(stderr, "kernel_launch: unexpected shapes (n_in %d, in0 %d, out %d, ws %zu < %zu); nothing launched\n", n_in, n_in > 0 ? in_sizes[0] : -1, out_size, ws_size, (size_t)WS_END); grid = -1; return; }
        int dev = 0, cus = 0, per_cu = 0;
        if (hipGetDevice(&dev) != hipSuccess || hipDeviceGetAttribute(&cus, hipDeviceAttributeMultiprocessorCount, dev) != hipSuccess) { grid = -1; return; }
        if (hipFuncSetAttribute((const void*)mk_fwd, hipFuncAttributeMaxDynamicSharedMemorySize, LDS_BYTES) != hipSuccess) { fprintf(stderr, "kernel_launch: hipFuncSetAttribute failed\n"); grid = -1; return; }
        if (hipOccupancyMaxActiveBlocksPerMultiprocessor(&per_cu, (const void*)mk_fwd, 512, LDS_BYTES) != hipSuccess || per_cu < 1)
            fprintf(stderr, "kernel_launch: note: occupancy query reports %d workgroups per CU\n", per_cu);
        (void)hipGetLastError();
        grid = cus;
    }
    if (grid < 0) return;
    if (hipMemsetAsync((char*)d_ws + WS_CTL, 0, CTL_ZERO_BYTES, stream) != hipSuccess) return;
    Args a{};
    for (int i = 0; i < 24; ++i) a.in[i] = (const float*)d_in[i];
    a.out = (float*)d_out; a.ws = (unsigned char*)d_ws;
    hipLaunchKernelGGL(mk_fwd, dim3(grid), dim3(512), LDS_BYTES, stream, a);
}
```

```cpp
#include <hip/hip_runtime.h>
#include <cstdio>
#include <cstdint>
#include <cmath>
namespace pg8 {
#define PG8_LAS __attribute__((address_space(3)))
typedef unsigned short bf16_t;
typedef short bf16x8 __attribute__((ext_vector_type(8)));
typedef float f32x4 __attribute__((ext_vector_type(4)));
typedef unsigned u32x4 __attribute__((ext_vector_type(4)));
constexpr int BM = 256, BK = 64, HALF = 128, HTB = HALF * BK * 2  , STAGE_BYTES = 8 * HTB, NXCD = 8, WGM = 8;

__host__ __device__ __forceinline__ int lds_byte(int r, int c) { const int st = (r >> 4) * 2 + (c >> 5), rr = r & 15, cc = c & 31, ob = rr * 64 + cc * 2; return st * 1024 + (ob ^ (((ob >> 9) & 1) << 5)); }
__host__ __device__ __forceinline__ void stage_rc(int b, int& R, int& C) { const int st = b / 1024, sb = b % 1024, swz = sb ^ (((sb >> 9) & 1) << 5); R = (st >> 1) * 16 + swz / 64; C = (st & 1) * 32 + (swz % 64) / 2; }
__host__ __device__ __forceinline__ int perm32(int rho) { const int n = rho >> 4, i = rho & 15; return 8 * (i >> 2) + 4 * n + (i & 3); }

struct Unit { int pm, pn; };
struct Gemm { const bf16_t* A; const bf16_t* Bt; int K; int lda; };

struct StaticOrder {
    int nM, nN, nwg, G, c, wave;
    __device__ void init(int M, int N, int G_, int c_, int wave_) { nM = M / BM; nN = N / BM; nwg = nM * nN; G = G_; c = c_; wave = wave_; }
    __device__ bool next(int i, Unit& u) const {
        const long L = (long)i * G + c; if (L >= nwg) return false;
        int wgid = (int)L; { const int q = nwg / NXCD, r = nwg % NXCD, xcd = wgid % NXCD, off = wgid / NXCD; wgid = (xcd < r ? xcd * (q + 1) : r * (q + 1) + (xcd - r) * q) + off; }
        const int nig = WGM * nN, gid = wgid / nig, fm = gid * WGM, gsz = (nM - fm) < WGM ? (nM - fm) : WGM;
        u.pm = fm + ((wgid % nig) % gsz); u.pn = (wgid % nig) / gsz; return true;
    }
    __device__ __forceinline__ unsigned rowtok(int, int) const { return 0u; }
};

template <class Epi, class Sched, bool ALIGN_EPI, bool GATHER>
__device__ __forceinline__ void gemm_phase(PG8_LAS unsigned char* lds, const Gemm g, const Sched& S, const Epi& E) {
    int lane_; asm volatile("v_mbcnt_lo_u32_b32 %0, -1, 0\n\tv_mbcnt_hi_u32_b32 %0, -1, %0" : "=v"(lane_));
    const int wid = S.wave, lane = lane_, tid = wid * 64 + lane, wr = wid >> 2, wc = wid & 3, fr = lane & 15, fq = lane >> 4;
    int K_ = g.K, lda_ = g.lda; asm volatile("" : "+s"(K_), "+s"(lda_));
    const int K = K_, nt = K / BK, lda = lda_;
    unsigned vA[2][2], voffB[2];
#pragma unroll
    for (int i = 0; i < 2; ++i) { int R, C; stage_rc(tid * 16 + i * 8192, R, C); const int Rb = Epi::PERM ? ((R & ~31) + perm32(R & 31)) : R;
        voffB[i] = (unsigned)(Rb * K + C) * 2u;
#pragma unroll
        for (int h = 0; h < 2; ++h) vA[h][i] = (unsigned)(((GATHER ? h * HALF : 0) + R) * lda + C) * 2u; }
    const size_t kstep = (size_t)(BK * 2);
    const size_t hstepB = (size_t)HALF * K * 2, tstepB = 2 * hstepB;
    const size_t tstepA = (size_t)BM * lda * 2, hstepA = (size_t)HALF * lda * 2;
    const unsigned ldsw = (unsigned)wid * 1024u;
    const int aoff = lds_byte(wr * 64 + fr, fq * 8), boff = lds_byte(wc * 32 + fr, fq * 8);
#define PG8_SA(b, h) (((b) * 2 + (h)) * HTB)
#define PG8_SB(b, h) ((4 + (b) * 2 + (h)) * HTB)
#define PG8_STAGE(bufoff, gbase, voff) do { _Pragma("unroll") for (int _i = 0; _i < 2; ++_i) \
        __builtin_amdgcn_global_load_lds((const unsigned*)((const char*)(gbase) + (voff)[_i]), (PG8_LAS unsigned*)(lds + (bufoff) + ldsw + _i * 8192), 16, 0, 0); } while (0)
#define PG8_GATHER_SET(ui_, h) do { int l2_; asm volatile("v_mbcnt_lo_u32_b32 %0, -1, 0\n\tv_mbcnt_hi_u32_b32 %0, -1, %0" : "=v"(l2_)); const int tid2_ = wid * 64 + l2_; _Pragma("unroll") for (int _i = 0; _i < 2; ++_i) { int R_, C_; stage_rc(tid2_ * 16 + _i * 8192, R_, C_); vA[h][_i] = (S.rowtok((ui_), (h) * HALF + R_) * (unsigned)lda + (unsigned)C_) * 2u; } } while (0)
#define PG8_STAGE_A(bufoff, gbase, h, NX) do { _Pragma("unroll") for (int _i = 0; _i < 2; ++_i) { const unsigned _v = GATHER ? vA[h][_i] : vA[0][_i]; \
        __builtin_amdgcn_global_load_lds((const unsigned*)((const char*)(gbase) + (GATHER ? (size_t)0 : (size_t)(h) * hstepA) + _v), (PG8_LAS unsigned*)(lds + (bufoff) + ldsw + _i * 8192), 16, 0, 0); } } while (0)
#define PG8_LDA(dst, b, h) do { _Pragma("unroll") for (int m = 0; m < 4; ++m) _Pragma("unroll") for (int k = 0; k < 2; ++k) dst[m][k] = *(const PG8_LAS bf16x8*)(lds + PG8_SA(b, h) + aoff + m * 2048 + k * 1024); } while (0)
#define PG8_LDB(dst, b, h) do { _Pragma("unroll") for (int n = 0; n < 2; ++n) _Pragma("unroll") for (int k = 0; k < 2; ++k) dst[n][k] = *(const PG8_LAS bf16x8*)(lds + PG8_SB(b, h) + boff + n * 2048 + k * 1024); } while (0)
#define PG8_MMA(ai, bj, At, Bt) do { __builtin_amdgcn_s_setprio(1); _Pragma("unroll") for (int m = 0; m < 4; ++m) _Pragma("unroll") for (int n = 0; n < 2; ++n) _Pragma("unroll") for (int k = 0; k < 2; ++k) \
        acc[ai][bj][m][n] = __builtin_amdgcn_mfma_f32_16x16x32_bf16(Bt[n][k], At[m][k], acc[ai][bj][m][n], 0, 0, 0); __builtin_amdgcn_s_setprio(0); } while (0)
#define PG8_WAIT_V(n) asm volatile("s_waitcnt vmcnt(" #n ")" ::: "memory")
#define PG8_WAIT_L(n) asm volatile("s_waitcnt lgkmcnt(" #n ")" ::: "memory")
#define PG8_BAR __builtin_amdgcn_s_barrier()
#define PG8_SCHED __builtin_amdgcn_sched_barrier(0)
    Unit cur, nxt; int ui = 0;
    if (!S.next(0, cur)) return;
    if constexpr (GATHER) { PG8_GATHER_SET(0, 0); PG8_GATHER_SET(0, 1); }
    f32x4 acc[2][2][4][2];
#pragma unroll
    for (int a = 0; a < 2; ++a)
#pragma unroll
        for (int b = 0; b < 2; ++b)
#pragma unroll
            for (int m = 0; m < 4; ++m)
#pragma unroll
                for (int n = 0; n < 2; ++n) acc[a][b][m][n] = (f32x4){0.f, 0.f, 0.f, 0.f};
    bf16x8 At[4][2], B0[2][2], B1[2][2];
    const char* cA = (const char*)g.A + (GATHER ? (size_t)0 : (size_t)cur.pm * tstepA); const char* cB = (const char*)g.Bt + (size_t)cur.pn * tstepB;
    PG8_STAGE(PG8_SB(0, 0), cB, voffB); PG8_STAGE(PG8_SB(0, 1), cB + hstepB, voffB); PG8_STAGE_A(PG8_SA(0, 0), cA, 0, false); PG8_STAGE_A(PG8_SA(0, 1), cA, 1, false);
    if (wr == 1) PG8_BAR;
    PG8_WAIT_V(2); PG8_BAR;
    PG8_STAGE(PG8_SB(1, 0), cB + kstep, voffB); PG8_STAGE_A(PG8_SA(1, 0), cA + kstep, 0, false); PG8_STAGE(PG8_SB(1, 1), cB + hstepB + kstep, voffB);
    PG8_WAIT_V(6); PG8_BAR;
    for (;;) {
        const bool has_next = S.next(ui + 1, nxt);
        const char* nA = (has_next && !GATHER) ? (const char*)g.A + (size_t)nxt.pm * tstepA : (GATHER ? (const char*)g.A : cA);
        const char* nB = has_next ? (const char*)g.Bt + (size_t)nxt.pn * tstepB : cB;
        for (int t = 0; t < nt; t += 2) {
            const bool last = (t == nt - 2);
            const char* a1 = cA + (size_t)(t + 1) * kstep;
            const char* a2 = last ? nA : cA + (size_t)(t + 2) * kstep; const char* b2 = last ? nB : cB + (size_t)(t + 2) * kstep;
            const char* a3 = a2 + kstep; const char* b3 = b2 + kstep;
            if constexpr (GATHER) { if (last && has_next) PG8_GATHER_SET(ui + 1, 0); }
            PG8_LDB(B0, 0, 0); PG8_LDB(B1, 0, 1); PG8_SCHED; PG8_LDA(At, 0, 0); PG8_STAGE_A(PG8_SA(1, 1), a1, 1, false);
            if constexpr (GATHER) { if (last && has_next) PG8_GATHER_SET(ui + 1, 1); }
            PG8_WAIT_V(8); PG8_WAIT_L(0); PG8_BAR; PG8_MMA(0, 0, At, B0); PG8_MMA(0, 1, At, B1); PG8_BAR; PG8_SCHED;
            PG8_LDA(At, 0, 1); PG8_STAGE(PG8_SB(0, 0), b2, voffB); PG8_STAGE(PG8_SB(0, 1), b2 + hstepB, voffB); PG8_STAGE_A(PG8_SA(0, 0), a2, 0, last);
            PG8_WAIT_V(8); PG8_WAIT_L(0); PG8_BAR; PG8_MMA(1, 0, At, B0); PG8_MMA(1, 1, At, B1); PG8_BAR; PG8_SCHED;
            PG8_LDB(B0, 1, 0); PG8_LDB(B1, 1, 1); PG8_SCHED; PG8_LDA(At, 1, 0); PG8_STAGE_A(PG8_SA(0, 1), a2, 1, last);
            PG8_WAIT_V(8); PG8_WAIT_L(0); PG8_BAR; PG8_MMA(0, 0, At, B0); PG8_MMA(0, 1, At, B1); PG8_BAR; PG8_SCHED;
            PG8_LDA(At, 1, 1); PG8_STAGE(PG8_SB(1, 0), b3, voffB); PG8_STAGE(PG8_SB(1, 1), b3 + hstepB, voffB); PG8_STAGE_A(PG8_SA(1, 0), a3, 0, last);
            PG8_WAIT_V(8); PG8_WAIT_L(0); PG8_BAR; PG8_MMA(1, 0, At, B0); PG8_MMA(1, 1, At, B1); PG8_BAR; PG8_SCHED;
        }
        if constexpr (ALIGN_EPI) { if (wr == 0) PG8_BAR; }
        { Unit eu; eu.pm = __builtin_amdgcn_readfirstlane(cur.pm); eu.pn = __builtin_amdgcn_readfirstlane(cur.pn); int fr_ = fr, fq_ = fq; asm volatile("" : "+s"(eu.pm), "+s"(eu.pn), "+v"(fr_), "+v"(fq_));
          E(acc, eu, wr, wc, fr_, fq_); }
        if (!has_next) break;
#pragma unroll
        for (int a = 0; a < 2; ++a)
#pragma unroll
            for (int b = 0; b < 2; ++b)
#pragma unroll
                for (int m = 0; m < 4; ++m)
#pragma unroll
                    for (int n = 0; n < 2; ++n) acc[a][b][m][n] = (f32x4){0.f, 0.f, 0.f, 0.f};
        cur = nxt; cA = nA; cB = nB; ++ui;
        if constexpr (ALIGN_EPI) { if (wr == 1) PG8_BAR; }
    }
    PG8_WAIT_V(0);
    if constexpr (!ALIGN_EPI) { if (wr == 0) PG8_BAR; }
    PG8_BAR;
#undef PG8_SA
#undef PG8_SB
#undef PG8_STAGE
#undef PG8_STAGE_A
#undef PG8_GATHER_SET
#undef PG8_LDA
#undef PG8_LDB
#undef PG8_MMA
#undef PG8_WAIT_V
#undef PG8_WAIT_L
#undef PG8_BAR
#undef PG8_SCHED
}
}

constexpr int NTOK = 16384, DM = 1024, SEQ = 4096, NB = 4, NLAYER = 2;
constexpr int INW = 8200;
constexpr int C_MQK = 0, C_MV = 1024, C_MO = 2048, C_MI = 3072, C_MF = 3076, C_SQ = 3080, C_SK = 4104, C_SV = 5128, C_GA = 6152, C_GB = 7176;
constexpr int P6W = 6144;
constexpr int P_MQK = 0, P_MO = 1024, P_SQ = 2048, P_SK = 3072, P_GA = 4096, P_GB = 5120;
constexpr int NEXP = 64, EFF = 128, SFF = 256, TOPK = 8;
constexpr int MAXROWS = NTOK * TOPK + NEXP * 256;
constexpr int MAXTILES = MAXROWS / 256;
constexpr float EPS = 1e-6f;
constexpr float LOG2E = 1.4426950408889634f;

constexpr size_t MiB = 1u << 20;
constexpr size_t WS_CTL = 0, CTL_BAR_BYTES = 3456 * 4, WS_CUR = CTL_BAR_BYTES, CTL_ZERO_BYTES = CTL_BAR_BYTES + 512;
constexpr size_t WS_MODP = 1 * MiB;
constexpr size_t WS_MODF = 4 * MiB;
constexpr size_t WS_GATES = WS_MODF + 256 * 1024;
constexpr size_t WS_TOPE = WS_GATES + 512 * 1024;
constexpr size_t WS_TOPW = WS_TOPE + 512 * 1024;
constexpr size_t WS_CNT = WS_TOPW + 512 * 1024;
constexpr size_t WS_STOK = WS_CNT + 64 * 1024;
constexpr size_t WS_SW = WS_STOK + 576 * 1024;
constexpr size_t WS_SDST = WS_SW + 576 * 1024;
constexpr size_t WS_TILEE = WS_SDST + 576 * 1024;
constexpr size_t WS_MISC_END = WS_TILEE + 4096;
static_assert(WS_MISC_END <= 8 * MiB, "misc region");
constexpr size_t WS_BIN = 8 * MiB;
constexpr size_t WS_AIN = WS_BIN + 12 * MiB;
constexpr size_t WS_BA = WS_AIN + 4 * MiB, WS_BB = WS_BA + 2 * MiB, WS_BO = WS_BB + 2 * MiB;
constexpr size_t WS_BGU = WS_BO + 2 * MiB;
constexpr size_t WS_BD = WS_BGU + 32 * MiB;
constexpr size_t WS_BSGU = WS_BD + 16 * MiB;
constexpr size_t WS_BSD = WS_BSGU + 1 * MiB;
constexpr size_t WS_W_END = WS_BSD + 1 * MiB;
constexpr size_t WS_R1 = 80 * MiB;
constexpr size_t WS_P6 = WS_R1, WS_VT = WS_R1 + 192 * MiB;
constexpr size_t WS_R2 = WS_R1 + 256 * MiB;
constexpr size_t WS_R3 = WS_R2 + 36 * MiB;
constexpr size_t WS_PT = WS_R3 + 8 * MiB;
constexpr size_t WS_END = WS_PT + 18 * MiB;
constexpr int RS_CAP = 16384;
constexpr size_t WS_RSTOK = WS_PT, WS_RSW = WS_PT + 4 * MiB, WS_RSDST = WS_PT + 8 * MiB;
static_assert(WS_W_END <= WS_R1, "weights region");
constexpr int CW_BAR = 0;

constexpr int LDS_BYTES = 147456;
constexpr int LDS_MAIN = 131072;
constexpr int LDS_TAB = 131072;
constexpr int LDS_CTL = LDS_BYTES - 512;

#define GAS __attribute__((address_space(1)))
#define LAS __attribute__((address_space(3)))
typedef unsigned short bf16;
typedef unsigned v4u __attribute__((ext_vector_type(4)));
typedef unsigned v2u __attribute__((ext_vector_type(2)));
typedef float f32x4 __attribute__((ext_vector_type(4)));
typedef float f32x16 __attribute__((ext_vector_type(16)));
typedef short bf16x8 __attribute__((ext_vector_type(8)));
typedef short s16x4 __attribute__((ext_vector_type(4)));
typedef GAS unsigned gu32;
#define RLX_AGENT __ATOMIC_RELAXED, __HIP_MEMORY_SCOPE_AGENT
#define LDS_WAIT() asm volatile("s_waitcnt lgkmcnt(0)" ::: "memory")
typedef float f32x2_t __attribute__((ext_vector_type(2))); typedef __bf16 bf16x2_t __attribute__((ext_vector_type(2)));
__device__ __forceinline__ unsigned pk2(float lo, float hi) { f32x2_t v = {lo, hi}; bf16x2_t b = __builtin_convertvector(v, bf16x2_t); return __builtin_bit_cast(unsigned, b); }
__device__ __forceinline__ unsigned short f2bf(float f) { return (unsigned short)(pk2(f, 0.f) & 0xffffu); }
__device__ __forceinline__ float bflo(unsigned w) { return __uint_as_float(w << 16); }
__device__ __forceinline__ float bfhi(unsigned w) { return __uint_as_float(w & 0xffff0000u); }
__device__ __forceinline__ float bf2f(unsigned short h) { return __uint_as_float((unsigned)h << 16); }
__device__ __forceinline__ float sigmoidf_(float x) { return __builtin_amdgcn_rcpf(1.f + __builtin_amdgcn_exp2f(-x * LOG2E)); }
__device__ __forceinline__ int crow(int r, int hi) { return (r & 3) + 8 * (r >> 2) + 4 * hi; }
__device__ __forceinline__ int lane_now() { int l; asm volatile("v_mbcnt_lo_u32_b32 %0, -1, 0\n\tv_mbcnt_hi_u32_b32 %0, -1, %0" : "=v"(l)); return l; }
__device__ __forceinline__ float shfl_xor_l(float v, int d, int lane) { return __int_as_float(__builtin_amdgcn_ds_bpermute((lane ^ d) << 2, __float_as_int(v))); }
__device__ __forceinline__ float shfl_up_l(float v, int d, int lane) { return __int_as_float(__builtin_amdgcn_ds_bpermute(((lane - d) & 63) << 2, __float_as_int(v))); }
__device__ __forceinline__ unsigned umax_(unsigned a, unsigned b) { return a > b ? a : b; }
__device__ __forceinline__ unsigned wave_umax_all(unsigned v) {
    v = umax_(v, (unsigned)__builtin_amdgcn_update_dpp(0, (int)v, 0x128, 0xf, 0xf, false));
    v = umax_(v, (unsigned)__builtin_amdgcn_update_dpp(0, (int)v, 0x124, 0xf, 0xf, false));
    v = umax_(v, (unsigned)__builtin_amdgcn_update_dpp(0, (int)v, 0x122, 0xf, 0xf, false));
    v = umax_(v, (unsigned)__builtin_amdgcn_update_dpp(0, (int)v, 0x121, 0xf, 0xf, false));
    { auto rr = __builtin_amdgcn_permlane16_swap(v, v, false, false); v = umax_(rr[0], rr[1]); }
    { auto rr = __builtin_amdgcn_permlane32_swap(v, v, false, false); v = umax_(rr[0], rr[1]); }
    return v;
}
__device__ __forceinline__ float half_sum32(float v) {
    v += __int_as_float(__builtin_amdgcn_update_dpp(0, __float_as_int(v), 0x128, 0xf, 0xf, false));
    v += __int_as_float(__builtin_amdgcn_update_dpp(0, __float_as_int(v), 0x124, 0xf, 0xf, false));
    v += __int_as_float(__builtin_amdgcn_update_dpp(0, __float_as_int(v), 0x122, 0xf, 0xf, false));
    v += __int_as_float(__builtin_amdgcn_update_dpp(0, __float_as_int(v), 0x121, 0xf, 0xf, false));
    { auto rr = __builtin_amdgcn_permlane16_swap(__float_as_uint(v), __float_as_uint(v), false, false); v = __uint_as_float(rr[0]) + __uint_as_float(rr[1]); }
    return v;
}
__device__ __forceinline__ float wave_sum(float v, int lane) {
#pragma unroll
    for (int o = 1; o < 64; o <<= 1) v += shfl_xor_l(v, o, lane);
    return v;
}

#define XB_TMO      128
#define XB_XCNT(j)  (256  + 64 * (j))
#define XB_XSUB(j)  (1280 + 64 * (j))
#define XB_XGEN(j)  (2304 + 64 * (j))
#define XB_TOP      3328
#define XB_TOPGEN   3392
#define XCD_BAR_WORDS 3456
#define XB_SPIN_CAP (1u << 18)
__device__ __forceinline__ unsigned xb_ld(unsigned* p)              { return __hip_atomic_load(p, __ATOMIC_RELAXED, __HIP_MEMORY_SCOPE_AGENT); }
__device__ __forceinline__ unsigned xb_add(unsigned* p, unsigned v) { return __hip_atomic_fetch_add(p, v, __ATOMIC_RELAXED, __HIP_MEMORY_SCOPE_AGENT); }
__device__ __forceinline__ unsigned xb_xcc_id() { return (unsigned)__builtin_amdgcn_s_getreg((3 << 11) | 20) & 0xFu; }
#define XB_SPIN(cond, bar) do { unsigned _sp = 0; while (cond) { __builtin_amdgcn_s_sleep(1); \
    if ((++_sp & 255u) == 0u) { if (xb_ld(&(bar)[XB_TMO])) break; if (_sp > XB_SPIN_CAP) { atomicAdd(&(bar)[XB_TMO], 1u); break; } } } } while (0)
struct XcdBarrier { unsigned* bar; unsigned x; volatile LAS unsigned* st; };
__device__ __forceinline__ XcdBarrier xcd_barrier_post(unsigned* bar, volatile LAS unsigned* st) {
    XcdBarrier b; b.bar = bar; b.x = xb_xcc_id(); b.st = st;
    if (threadIdx.x == 0) (void)xb_add(&bar[XB_XCNT(b.x)], 1u);
    return b;
}
__device__ __forceinline__ void xcd_barrier_complete(unsigned* bar, unsigned x, unsigned& nloc, unsigned& nx) {
    const unsigned G = gridDim.x * gridDim.y * gridDim.z;
    unsigned sum, cnt, mine, sp = 0u;
    for (;;) {
        sum = 0u; cnt = 0u; mine = 0u;
#pragma unroll
        for (unsigned j = 0; j < 16; ++j) { const unsigned c = xb_ld(&bar[XB_XCNT(j)]); sum += c; cnt += (c > 0u) ? 1u : 0u; mine = (j == x) ? c : mine; }
        if (sum == G) break;
        __builtin_amdgcn_s_sleep(1);
        if ((++sp & 255u) == 0u) { if (xb_ld(&bar[XB_TMO])) break; if (sp > XB_SPIN_CAP) { atomicAdd(&bar[XB_TMO], 1u); break; } }
    }
    nloc = mine > 0u ? mine : 1u; nx = cnt > 0u ? cnt : 1u;
}
__device__ __forceinline__ void xcd_barrier(const XcdBarrier& b) {
    asm volatile("s_waitcnt vmcnt(0)" ::: "memory");
    __syncthreads();
    if (threadIdx.x == 0) {
        unsigned* bar = b.bar;
        __builtin_amdgcn_s_waitcnt(0);
        unsigned nloc = b.st[0], nx = b.st[1];
        if (nloc == 0u) { xcd_barrier_complete(bar, b.x, nloc, nx); b.st[0] = nloc; b.st[1] = nx; }
        const unsigned old = xb_add(&bar[XB_XSUB(b.x)], 1u);
        const unsigned gen = old / nloc;
        if (old + 1u == (gen + 1u) * nloc) {
            __builtin_amdgcn_fence(__ATOMIC_RELEASE, "agent");
            asm volatile("s_waitcnt vmcnt(0)" ::: "memory");
            const unsigned og = xb_add(&bar[XB_TOP], 1u);
            const unsigned tg = og / nx;
            if (og + 1u == (tg + 1u) * nx) xb_add(&bar[XB_TOPGEN], 1u);
            else XB_SPIN(xb_ld(&bar[XB_TOPGEN]) == tg, bar);
            __builtin_amdgcn_fence(__ATOMIC_ACQUIRE, "agent");
            xb_add(&bar[XB_XGEN(b.x)], 1u);
            asm volatile("s_waitcnt vmcnt(0)" ::: "memory");
        } else {
            XB_SPIN(xb_ld(&bar[XB_XGEN(b.x)]) == gen, bar);
            __builtin_amdgcn_fence(__ATOMIC_ACQUIRE, "agent");
            asm volatile("s_waitcnt vmcnt(0)" ::: "memory");
        }
    }
    __syncthreads();
}

struct Frame {
    LAS unsigned char* lds;
    int tid, lane, wave, G, c;
    float* out; unsigned char* ws;
};
__device__ __forceinline__ unsigned char* wsp(const Frame& F, size_t off) { unsigned char* p = F.ws; asm volatile("" : "+s"(p)); return (unsigned char*)(GAS unsigned char*)(p + off); }
__device__ __forceinline__ float* outp(const Frame& F) { float* p = F.out; asm volatile("" : "+s"(p)); return (float*)(GAS float*)p; }
__device__ __forceinline__ const float* inp(const Frame& F, int i) {
    const LAS unsigned* p = (const LAS unsigned*)(F.lds + LDS_CTL + 64) + 2 * i;
    const unsigned lo = __builtin_amdgcn_readfirstlane(p[0]), hi = __builtin_amdgcn_readfirstlane(p[1]);
    return (const float*)(const GAS float*)(((unsigned long long)hi << 32) | lo);
}
__device__ __forceinline__ bf16* xmid(const Frame& F, int l) { return (l == NLAYER - 1) ? (bf16*)wsp(F, WS_VT) : (bf16*)outp(F); }
enum { I_X = 0, I_C, I_ADAW, I_ADAB, I_N1W, I_WIN, I_CONVW, I_CONVB, I_IGB, I_FGB, I_MNW, I_WPA, I_WPB, I_WOUT, I_N2W, I_RW, I_RB, I_WG, I_WU, I_WD, I_SG, I_SU, I_SD, I_FNW };

#define EPI_LOOP_BEGIN \
    _Pragma("unroll") for (int ai = 0; ai < 2; ++ai) _Pragma("unroll") for (int m = 0; m < 4; ++m) { const int rl = ai * 128 + wr * 64 + m * 16 + fr; (void)rl; \
    _Pragma("unroll") for (int bj = 0; bj < 2; ++bj) { const int cl = bj * 128 + wc * 32 + 8 * fq; (void)cl; const pg8::f32x4 v0 = acc[ai][bj][m][0], v1 = acc[ai][bj][m][1];
#define EPI_LOOP_END } }

struct EpiPlain {
    static constexpr bool PERM = true;
    bf16* O; int ldc;
    __device__ __forceinline__ void operator()(const pg8::f32x4 (&acc)[2][2][4][2], const pg8::Unit& u, int wr, int wc, int fr, int fq) const {
        EPI_LOOP_BEGIN
            v4u w; w.x = pk2(v0[0], v0[1]); w.y = pk2(v0[2], v0[3]); w.z = pk2(v1[0], v1[1]); w.w = pk2(v1[2], v1[3]);
            *(GAS v4u*)(O + (size_t)(u.pm * 256 + rl) * ldc + u.pn * 256 + cl) = w;
        EPI_LOOP_END
    }
};
#define SG8(q_, v0_, v1_, o0_, o1_, OP) do { \
        o0_[0] = OP(sigmoidf_(bflo(q_.x)) * v0_[0], 0); o0_[1] = OP(sigmoidf_(bfhi(q_.x)) * v0_[1], 1); o0_[2] = OP(sigmoidf_(bflo(q_.y)) * v0_[2], 2); o0_[3] = OP(sigmoidf_(bfhi(q_.y)) * v0_[3], 3); \
        o1_[0] = OP(sigmoidf_(bflo(q_.z)) * v1_[0], 4); o1_[1] = OP(sigmoidf_(bfhi(q_.z)) * v1_[1], 5); o1_[2] = OP(sigmoidf_(bflo(q_.w)) * v1_[2], 6); o1_[3] = OP(sigmoidf_(bfhi(q_.w)) * v1_[3], 7); } while (0)
struct EpiGateT1 {
    static constexpr bool PERM = true;
    const bf16* Gt; int gld; bf16* T1;
    __device__ __forceinline__ void operator()(const pg8::f32x4 (&acc)[2][2][4][2], const pg8::Unit& u, int wr, int wc, int fr, int fq) const {
#pragma unroll
        for (int ai = 0; ai < 2; ++ai) {
            v4u gq[4][2];
#pragma unroll
            for (int m = 0; m < 4; ++m)
#pragma unroll
                for (int bj = 0; bj < 2; ++bj) { const size_t row = (size_t)(u.pm * 256 + ai * 128 + wr * 64 + m * 16 + fr); const int col = u.pn * 256 + bj * 128 + wc * 32 + 8 * fq; gq[m][bj] = *(const GAS v4u*)(Gt + row * gld + col); }
#pragma unroll
            for (int m = 0; m < 4; ++m)
#pragma unroll
                for (int bj = 0; bj < 2; ++bj) { const size_t row = (size_t)(u.pm * 256 + ai * 128 + wr * 64 + m * 16 + fr); const int col = u.pn * 256 + bj * 128 + wc * 32 + 8 * fq;
                    const pg8::f32x4 v0 = acc[ai][bj][m][0], v1 = acc[ai][bj][m][1]; f32x4 o0, o1;
#define OPN(x_, i_) (x_)
                    SG8(gq[m][bj], v0, v1, o0, o1, OPN);
#undef OPN
                    v4u tw; tw.x = pk2(o0[0], o0[1]); tw.y = pk2(o0[2], o0[3]); tw.z = pk2(o1[0], o1[1]); tw.w = pk2(o1[2], o1[3]);
                    *(GAS v4u*)(T1 + row * 1024 + col) = tw; }
        }
    }
};
struct EpiGateY {
    static constexpr bool PERM = true;
    const bf16* Gt; int gld; const bf16* T1; bf16* Y;
    __device__ __forceinline__ void operator()(const pg8::f32x4 (&acc)[2][2][4][2], const pg8::Unit& u, int wr, int wc, int fr, int fq) const {
#pragma unroll
        for (int ai = 0; ai < 2; ++ai) {
            v4u gq[4][2], tq[4][2];
#pragma unroll
            for (int m = 0; m < 4; ++m)
#pragma unroll
                for (int bj = 0; bj < 2; ++bj) { const size_t row = (size_t)(u.pm * 256 + ai * 128 + wr * 64 + m * 16 + fr); const int col = u.pn * 256 + bj * 128 + wc * 32 + 8 * fq;
                    gq[m][bj] = *(const GAS v4u*)(Gt + row * gld + col); tq[m][bj] = *(const GAS v4u*)(T1 + row * 1024 + col); }
#pragma unroll
            for (int m = 0; m < 4; ++m)
#pragma unroll
                for (int bj = 0; bj < 2; ++bj) { const size_t row = (size_t)(u.pm * 256 + ai * 128 + wr * 64 + m * 16 + fr); const int col = u.pn * 256 + bj * 128 + wc * 32 + 8 * fq;
                    const pg8::f32x4 v0 = acc[ai][bj][m][0], v1 = acc[ai][bj][m][1]; f32x4 o0, o1;
                    const v4u t4 = tq[m][bj]; const float tt[8] = {bflo(t4.x), bfhi(t4.x), bflo(t4.y), bfhi(t4.y), bflo(t4.z), bfhi(t4.z), bflo(t4.w), bfhi(t4.w)};
#define OPT(x_, i_) (tt[i_] + (x_))
                    SG8(gq[m][bj], v0, v1, o0, o1, OPT);
#undef OPT
                    v4u w; w.x = pk2(o0[0], o0[1]); w.y = pk2(o0[2], o0[3]); w.z = pk2(o1[0], o1[1]); w.w = pk2(o1[2], o1[3]);
                    *(GAS v4u*)(Y + row * 1024 + col) = w; }
        }
    }
};
#undef SG8
struct EpiRes {
    static constexpr bool PERM = true;
    const bf16* xin; bf16* out; const float* gv; int nostore;
    __device__ __forceinline__ void operator()(const pg8::f32x4 (&acc)[2][2][4][2], const pg8::Unit& u, int wr, int wc, int fr, int fq) const {
        const float* gb = gv + (size_t)(u.pm >> 4) * 6144;
        f32x4 g0[2], g1[2];
#pragma unroll
        for (int bj = 0; bj < 2; ++bj) { const int col = u.pn * 256 + bj * 128 + wc * 32 + 8 * fq; g0[bj] = *(const GAS f32x4*)(gb + col); g1[bj] = *(const GAS f32x4*)(gb + col + 4); }
#pragma unroll
        for (int ai = 0; ai < 2; ++ai)
#pragma unroll
            for (int mh = 0; mh < 2; ++mh) {
                v4u xb[2][2];
#pragma unroll
                for (int mm = 0; mm < 2; ++mm)
#pragma unroll
                    for (int bj = 0; bj < 2; ++bj) { const size_t row = (size_t)(u.pm * 256 + ai * 128 + wr * 64 + (2 * mh + mm) * 16 + fr); const int col = u.pn * 256 + bj * 128 + wc * 32 + 8 * fq;
                        xb[mm][bj] = *(const GAS v4u*)(xin + row * 1024 + col); }
#pragma unroll
                for (int mm = 0; mm < 2; ++mm)
#pragma unroll
                    for (int bj = 0; bj < 2; ++bj) { const int m = 2 * mh + mm; const size_t row = (size_t)(u.pm * 256 + ai * 128 + wr * 64 + m * 16 + fr); const int col = u.pn * 256 + bj * 128 + wc * 32 + 8 * fq;
                        const v4u x = xb[mm][bj]; const f32x4 a0 = acc[ai][bj][m][0], a1 = acc[ai][bj][m][1];
                        v4u o;
                        o.x = pk2(bflo(x.x) + g0[bj][0] * a0[0], bfhi(x.x) + g0[bj][1] * a0[1]); o.y = pk2(bflo(x.y) + g0[bj][2] * a0[2], bfhi(x.y) + g0[bj][3] * a0[3]);
                        o.z = pk2(bflo(x.z) + g1[bj][0] * a1[0], bfhi(x.z) + g1[bj][1] * a1[1]); o.w = pk2(bflo(x.w) + g1[bj][2] * a1[2], bfhi(x.w) + g1[bj][3] * a1[3]);
                        if (nostore) { asm volatile("" :: "v"(o)); } else { *(GAS v4u*)(out + row * 1024 + col) = o; } }
            }
    }
};
struct EpiHid {
    static constexpr bool PERM = true;
    bf16* O; int ldo; const LAS float* roww; int ubase; int ustride; int shared;
    __device__ __forceinline__ void operator()(const pg8::f32x4 (&acc)[2][2][4][2], const pg8::Unit& u, int wr, int wc, int fr, int fq) const {
#pragma unroll
        for (int ai = 0; ai < 2; ++ai)
#pragma unroll
            for (int m = 0; m < 4; ++m) {
                const int rl = ai * 128 + wr * 64 + m * 16 + fr; const size_t pos = (size_t)u.pm * 256 + rl;
                const float w = shared ? 1.f : roww[((u.pm - ubase) / ustride) * 256 + rl];
                const int col = (shared ? 128 * u.pn : 0) + wc * 32 + 8 * fq;
                float h[8];
#pragma unroll
                for (int n = 0; n < 2; ++n)
#pragma unroll
                    for (int j = 0; j < 4; ++j) { const float gt = acc[ai][0][m][n][j], up = acc[ai][1][m][n][j]; h[n * 4 + j] = gt * sigmoidf_(gt) * up * w; }
                v4u o; o.x = pk2(h[0], h[1]); o.y = pk2(h[2], h[3]); o.z = pk2(h[4], h[5]); o.w = pk2(h[6], h[7]);
                *(GAS v4u*)(O + pos * ldo + col) = o;
                asm volatile("" ::: "memory");
            }
    }
};
constexpr float YS_SCALE = 4.0f;
struct EpiScatter {
    static constexpr bool PERM = true;
    bf16* Y; const LAS unsigned* dst; int v; int G; int nostore;
    __device__ __forceinline__ void operator()(const pg8::f32x4 (&acc)[2][2][4][2], const pg8::Unit& u, int wr, int wc, int fr, int fq) const {
        const int q = u.pn & 3;
#pragma unroll
        for (int ai = 0; ai < 2; ++ai)
#pragma unroll
            for (int m = 0; m < 4; ++m) {
                const int rl = ai * 128 + wr * 64 + m * 16 + fr; const unsigned d = dst[((4 * u.pm + q - v) / G) * 256 + rl];
                if (nostore) { asm volatile("" :: "v"(acc[ai][0][m][0]), "v"(acc[ai][0][m][1]), "v"(acc[ai][1][m][0]), "v"(acc[ai][1][m][1])); } else if (d != 0xffffffffu) {
#pragma unroll
                    for (int bj = 0; bj < 2; ++bj) { const pg8::f32x4 v0 = acc[ai][bj][m][0] * YS_SCALE, v1 = acc[ai][bj][m][1] * YS_SCALE;
                        int w0 = 0, w1 = 0;
#define YS_CL(x_) __builtin_amdgcn_fmed3f((x_), -440.f, 440.f)
                        w0 = __builtin_amdgcn_cvt_pk_fp8_f32(YS_CL(v0[0]), YS_CL(v0[1]), w0, false); w0 = __builtin_amdgcn_cvt_pk_fp8_f32(YS_CL(v0[2]), YS_CL(v0[3]), w0, true);
                        w1 = __builtin_amdgcn_cvt_pk_fp8_f32(YS_CL(v1[0]), YS_CL(v1[1]), w1, false); w1 = __builtin_amdgcn_cvt_pk_fp8_f32(YS_CL(v1[2]), YS_CL(v1[3]), w1, true);
#undef YS_CL
                        v2u w; w.x = (unsigned)w0; w.y = (unsigned)w1;
                        *(GAS v2u*)((unsigned char*)Y + (size_t)d * 1024 + q * 256 + bj * 128 + wc * 32 + 8 * fq) = w; }
                }
            }
    }
};

struct TrDesc { const float* sp; bf16* dp; int ldw, ldt; float scale; };
__device__ __forceinline__ void tr_load(const TrDesc& d, float (&tv)[32]) {
    const GAS float* sp = (const GAS float*)d.sp;
#pragma unroll
    for (int i = 0; i < 32; ++i) tv[i] = sp[(size_t)(2 * i) * d.ldw];
}
__device__ __forceinline__ void tr_store(const TrDesc& d, const float (&tv)[32], LAS float* scr, int lane) {
#pragma unroll
    for (int i = 0; i < 32; ++i) { const int kk = 2 * i + (lane >> 5); scr[kk * 33 + (lane & 31)] = tv[i]; }
    LDS_WAIT();
    const int c = lane & 7; const float scale = d.scale;
#pragma unroll
    for (int j = 0; j < 4; ++j) { const int n = (lane >> 3) + 8 * j; const LAS float* s = scr + (8 * c) * 33 + n;
        v4u o; o.x = pk2(s[0 * 33] * scale, s[1 * 33] * scale); o.y = pk2(s[2 * 33] * scale, s[3 * 33] * scale); o.z = pk2(s[4 * 33] * scale, s[5 * 33] * scale); o.w = pk2(s[6 * 33] * scale, s[7 * 33] * scale);
        *(GAS v4u*)(d.dp + (size_t)n * d.ldt + 8 * c) = o; }
    LDS_WAIT();
}
constexpr int CW_N_IN = 8 * 512, CW_N_P = 3 * 512, CW_N_E = 4096, CW_N_S = 4 * 64, CW_N_SD = 128;
constexpr int CW_TOTAL = CW_N_IN + CW_N_P + 3 * CW_N_E + CW_N_S + CW_N_SD;
__device__ __forceinline__ TrDesc tr_decode(Frame& F, int l, int it) {
    const float* src; int ldw; bf16* dst; int ldt; int kb, nb; float sc = 1.f;
    int r = it;
    if (r < CW_N_IN) { const int job = r >> 9, rr = r & 511; kb = rr >> 5; nb = rr & 31;
        int col; bf16* BIN = (bf16*)wsp(F, WS_BIN); bf16* AIN = (bf16*)wsp(F, WS_AIN);
        switch (job) {
            case 0: col = C_MQK; dst = BIN; break;
            case 1: col = C_MO; dst = BIN + (size_t)1024 * 1024; break;
            case 2: col = C_SQ; dst = BIN + (size_t)2048 * 1024; sc = LOG2E * 0.125f; break;
            case 3: col = C_SK; dst = BIN + (size_t)3072 * 1024; break;
            case 4: col = C_GA; dst = BIN + (size_t)4096 * 1024; break;
            case 5: col = C_GB; dst = BIN + (size_t)5120 * 1024; break;
            case 6: col = C_MV; dst = AIN; break;
            default: col = C_SV; dst = AIN + (size_t)1024 * 1024; break;
        }
        src = inp(F, I_WIN) + (size_t)l * DM * INW + col; ldw = INW; ldt = 1024; }
    else if ((r -= CW_N_IN) < CW_N_P) { const int job = r >> 9, rr = r & 511; kb = rr >> 5; nb = rr & 31;
        src = inp(F, job == 0 ? I_WPA : (job == 1 ? I_WPB : I_WOUT)) + (size_t)l * DM * DM; ldw = 1024;
        dst = (bf16*)wsp(F, job == 0 ? WS_BA : (job == 1 ? WS_BB : WS_BO)); ldt = 1024; }
    else if ((r -= CW_N_P) < 2 * CW_N_E) { const int up = r >= CW_N_E; if (up) r -= CW_N_E; const int e = r >> 6, rr = r & 63; kb = rr >> 2; nb = rr & 3;
        src = inp(F, up ? I_WU : I_WG) + ((size_t)l * NEXP + e) * DM * EFF; ldw = EFF;
        dst = (bf16*)wsp(F, WS_BGU) + ((size_t)e * 256 + (up ? 128 : 0)) * 1024; ldt = 1024; }
    else if ((r -= 2 * CW_N_E) < CW_N_E) { const int e = r >> 6, rr = r & 63; kb = rr >> 5; nb = rr & 31;
        src = inp(F, I_WD) + ((size_t)l * NEXP + e) * EFF * DM; ldw = DM;
        dst = (bf16*)wsp(F, WS_BD) + (size_t)e * 1024 * 128; ldt = 128; }
    else if ((r -= CW_N_E) < CW_N_S) { const int job = r >> 6, rr = r & 63; kb = rr >> 2; nb = rr & 3;
        const int up = job >> 1, hi = job & 1;
        src = inp(F, up ? I_SU : I_SG) + (size_t)l * DM * SFF + hi * 128; ldw = SFF;
        dst = (bf16*)wsp(F, WS_BSGU) + (size_t)(hi * 256 + up * 128) * 1024; ldt = 1024; }
    else { r -= CW_N_S; kb = r >> 5; nb = r & 31;
        src = inp(F, I_SD) + (size_t)l * SFF * DM; ldw = DM; dst = (bf16*)wsp(F, WS_BSD); ldt = 256; }
    TrDesc d; const int k0 = 64 * kb, n0 = 32 * nb; const int ln = lane_now();
    d.sp = src + (size_t)(k0 + (ln >> 5)) * ldw + n0 + (ln & 31); d.dp = dst + (size_t)n0 * ldt + k0; d.ldw = ldw; d.ldt = ldt; d.scale = sc;
    return d;
}
__device__ __forceinline__ void conv_weights(Frame& F, int l) {
    LAS float* scr = (LAS float*)(F.lds + F.wave * 16384);
    int gw = F.c * 8 + F.wave; asm volatile("" : "+s"(gw)); const int NGW = F.G * 8;
    int it = gw;
    if (it >= CW_TOTAL) return;
    TrDesc dc = tr_decode(F, l, it); float tc[32]; tr_load(dc, tc);
    for (;;) {
        const int itn = it + NGW; const bool more = itn < CW_TOTAL;
        TrDesc dn = dc; float tn[32];
        if (more) { dn = tr_decode(F, l, itn); tr_load(dn, tn); }
        tr_store(dc, tc, scr, F.lane);
        if (!more) break;
        it = itn; dc = dn;
#pragma unroll
        for (int i = 0; i < 32; ++i) tc[i] = tn[i];
    }
}
__device__ __forceinline__ void mod_partials(Frame& F) {
    LAS float* sc = (LAS float*)(F.lds);
    for (int i = F.tid; i < 4096; i += 512) { const float v = inp(F, I_C)[i]; sc[i] = v / (1.f + __expf(-v)); }
    __syncthreads();
    float* MODP = (float*)wsp(F, WS_MODP);
    for (int it = F.c; it < 384; it += F.G) {
        const int l = it / 192, rem = it % 192, g = rem >> 4, kp = rem & 15, j = g * 512 + F.tid;
        const float* w = inp(F, I_ADAW) + ((size_t)l * DM + 64 * kp) * 6144 + j;
        float a0 = 0.f, a1 = 0.f, a2 = 0.f, a3 = 0.f;
#pragma unroll 16
        for (int k = 0; k < 64; ++k) { const float wv = w[(size_t)k * 6144]; const int kk = 64 * kp + k;
            a0 += sc[kk] * wv; a1 += sc[1024 + kk] * wv; a2 += sc[2048 + kk] * wv; a3 += sc[3072 + kk] * wv; }
        float* o = MODP + ((size_t)(kp * 2 + l) * 4) * 6144 + j;
        o[0] = a0; o[6144] = a1; o[2 * 6144] = a2; o[3 * 6144] = a3;
    }
    __syncthreads();
}
__device__ __forceinline__ float modv(const Frame& F, int l, int b, int j) {
    const float* MODP = (const float*)wsp(F, WS_MODP);
    float s = inp(F, I_ADAB)[l * 6144 + j];
#pragma unroll
    for (int kp = 0; kp < 16; ++kp) s += MODP[((size_t)(kp * 2 + l) * 4 + b) * 6144 + j];
    return s;
}

__device__ __forceinline__ void norm_emit(Frame& F, const float (&v)[2][8], const LAS float* cA, const LAS float* cB, const LAS float* Wg, const float gbias_lane  , bf16* xn_row, float* gate_row) {
    float ss = 0.f;
#pragma unroll
    for (int j = 0; j < 2; ++j)
#pragma unroll
        for (int i = 0; i < 8; ++i) ss += v[j][i] * v[j][i];
    ss = wave_sum(ss, F.lane);
    const float r = 1.0f / sqrtf(ss * (1.f / 1024.f) + EPS);
    float h[2][8];
#pragma unroll
    for (int j = 0; j < 2; ++j) { const int k = 8 * F.lane + 512 * j;
        const f32x4 a0 = *(const LAS f32x4*)(cA + k), a1 = *(const LAS f32x4*)(cA + k + 4), b0 = *(const LAS f32x4*)(cB + k), b1 = *(const LAS f32x4*)(cB + k + 4);
#pragma unroll
        for (int i = 0; i < 4; ++i) { h[j][i] = v[j][i] * r * a0[i] + b0[i]; h[j][4 + i] = v[j][4 + i] * r * a1[i] + b1[i]; }
        v4u o; o.x = pk2(h[j][0], h[j][1]); o.y = pk2(h[j][2], h[j][3]); o.z = pk2(h[j][4], h[j][5]); o.w = pk2(h[j][6], h[j][7]);
        *(GAS v4u*)(xn_row + k) = o; }
    float mine = 0.f;
#pragma unroll
    for (int g = 0; g < 8; ++g) { float p = 0.f;
#pragma unroll
        for (int j = 0; j < 2; ++j) { const int k = 8 * F.lane + 512 * j; const f32x4 w0 = *(const LAS f32x4*)(Wg + g * 1024 + k), w1 = *(const LAS f32x4*)(Wg + g * 1024 + k + 4);
#pragma unroll
            for (int i = 0; i < 4; ++i) { p += h[j][i] * w0[i]; p += h[j][4 + i] * w1[i]; } }
        p = wave_sum(p, F.lane);
        if (F.lane == g) mine = p; }
    if (F.lane < 8) { float z = mine + gbias_lane; if (F.lane >= 4) z = fminf(z, 0.f) - __logf(1.f + __expf(-fabsf(z))); gate_row[F.lane] = z; }
}
__device__ __forceinline__ void norm1_tables(Frame& F, int l, int b, bool from_modp) {
    LAS float* cA = (LAS float*)(F.lds + LDS_TAB); LAS float* cB = cA + 1024; LAS float* Wg = (LAS float*)(F.lds);
    const float* MODF = (const float*)wsp(F, WS_MODF) + (size_t)(l * 4 + b) * 6144;
    for (int k = F.tid; k < 1024; k += 512) {
        const float sh = from_modp ? modv(F, l, b, k) : MODF[k], sc = from_modp ? modv(F, l, b, 1024 + k) : MODF[1024 + k];
        cA[k] = inp(F, I_N1W)[l * 1024 + k] * (1.f + sc); cB[k] = sh; }
    const float* w_in = inp(F, I_WIN) + (size_t)l * DM * INW;
    for (int idx = F.tid; idx < 8192; idx += 512) { const int k = idx >> 3, g = idx & 7; Wg[g * 1024 + k] = w_in[(size_t)k * INW + C_MI + g]; }
}
__device__ __forceinline__ void phase_norm1_first(Frame& F) {
    float* MODF = (float*)wsp(F, WS_MODF);
    for (int idx = F.c * 512 + F.tid; idx < 2 * 4 * 6144; idx += F.G * 512) { const int l = idx / 24576, rem = idx % 24576, b = rem / 6144, j = rem % 6144; MODF[idx] = modv(F, l, b, j); }
    bf16* XN = (bf16*)wsp(F, WS_R2); float* GATES = (float*)wsp(F, WS_GATES); bf16* XB = (bf16*)outp(F);
    for (int vb = F.c; vb < 256; vb += F.G) {
        norm1_tables(F, 0, vb >> 6, true);
        __syncthreads();
        const float gbl = (F.lane < 4) ? inp(F, I_IGB)[F.lane] : (F.lane < 8 ? inp(F, I_FGB)[F.lane - 4] : 0.f);
        f32x4 xn_[2][2];
#define N1_LOAD(tt) do { const float* xr_ = inp(F, I_X) + (size_t)(tt) * 1024 + 8 * F.lane; \
            _Pragma("unroll") for (int j = 0; j < 2; ++j) { xn_[j][0] = *(const GAS f32x4*)(xr_ + 512 * j); xn_[j][1] = *(const GAS f32x4*)(xr_ + 512 * j + 4); } } while (0)
        N1_LOAD(vb * 64 + F.wave * 8);
        for (int i = 0; i < 8; ++i) {
            const int t = vb * 64 + F.wave * 8 + i;
            float v[2][8];
#pragma unroll
            for (int j = 0; j < 2; ++j) { const f32x4 a = xn_[j][0], b2 = xn_[j][1];
#pragma unroll
                for (int q = 0; q < 4; ++q) { v[j][q] = a[q]; v[j][4 + q] = b2[q]; } }
            if (i + 1 < 8) N1_LOAD(t + 1);
#pragma unroll
            for (int j = 0; j < 2; ++j) { v4u o; o.x = pk2(v[j][0], v[j][1]); o.y = pk2(v[j][2], v[j][3]); o.z = pk2(v[j][4], v[j][5]); o.w = pk2(v[j][6], v[j][7]);
                *(GAS v4u*)(XB + (size_t)t * 1024 + 8 * F.lane + 512 * j) = o; }
            norm_emit(F, v, (const LAS float*)(F.lds + LDS_TAB), (const LAS float*)(F.lds + LDS_TAB) + 1024, (const LAS float*)(F.lds), gbl, XN + (size_t)t * 1024, GATES + (size_t)t * 8);
        }
        __syncthreads();
    }
}

__device__ __forceinline__ void phase_conv(Frame& F, int l) {
    const bf16* P6 = (const bf16*)wsp(F, WS_P6); bf16* MQK = (bf16*)wsp(F, WS_R2);
    const int cg = F.tid & 127, tq = F.tid >> 7, ch = cg * 8;
    float w[4][8], bias[8];
#pragma unroll
    for (int j = 0; j < 4; ++j) { const float* p = inp(F, I_CONVW) + ((size_t)l * 4 + j) * 1024 + ch; const f32x4 a = *(const GAS f32x4*)p, b = *(const GAS f32x4*)(p + 4);
#pragma unroll
        for (int i = 0; i < 4; ++i) { w[j][i] = a[i]; w[j][4 + i] = b[i]; } }
    { const float* p = inp(F, I_CONVB) + (size_t)l * 1024 + ch; const f32x4 a = *(const GAS f32x4*)p, b = *(const GAS f32x4*)(p + 4);
#pragma unroll
      for (int i = 0; i < 4; ++i) { bias[i] = a[i]; bias[4 + i] = b[i]; } }
    const float osc = (ch < 512) ? 0.08838834764831845f : 1.0f;
    for (int vb = F.c; vb < 256; vb += F.G) {
        const int tbeg = vb * 64 + tq * 16;
        float u0[8], u1[8], u2[8];
#define CV_LOAD(dst, tt) do { const int t_ = (tt); if (t_ >= 0 && (t_ >> 12) == (tbeg >> 12)) { const v4u q = *(const GAS v4u*)(P6 + (size_t)t_ * P6W + ch); \
            dst[0] = bflo(q.x); dst[1] = bfhi(q.x); dst[2] = bflo(q.y); dst[3] = bfhi(q.y); dst[4] = bflo(q.z); dst[5] = bfhi(q.z); dst[6] = bflo(q.w); dst[7] = bfhi(q.w); } \
            else { _Pragma("unroll") for (int i_ = 0; i_ < 8; ++i_) dst[i_] = 0.f; } } while (0)
        CV_LOAD(u0, tbeg - 3); CV_LOAD(u1, tbeg - 2); CV_LOAD(u2, tbeg - 1);
        for (int tt = 0; tt < 16; ++tt) {
            const int t = tbeg + tt; float u3[8]; CV_LOAD(u3, t);
            float o[8];
#pragma unroll
            for (int i = 0; i < 8; ++i) { const float a = bias[i] + w[0][i] * u0[i] + w[1][i] * u1[i] + w[2][i] * u2[i] + w[3][i] * u3[i]; o[i] = a * sigmoidf_(a) * osc; }
            v4u q; q.x = pk2(o[0], o[1]); q.y = pk2(o[2], o[3]); q.z = pk2(o[4], o[5]); q.w = pk2(o[6], o[7]);
            *(GAS v4u*)(MQK + (size_t)t * 1024 + ch) = q;
#pragma unroll
            for (int i = 0; i < 8; ++i) { u0[i] = u1[i]; u1[i] = u2[i]; u2[i] = u3[i]; }
        }
#undef CV_LOAD
    }
}

constexpr float SB_EXIT = -80.0f;
constexpr int AT_NSLOT = 12, AT_SLOTB = 8192, AT_FLAGS = AT_NSLOT * AT_SLOTB;
__device__ __forceinline__ void at_dma(const void* gsrc, LAS unsigned char* ldst) { __builtin_amdgcn_global_load_lds((const GAS unsigned*)gsrc, (LAS unsigned*)ldst, 16, 0, 0); }
__device__ __forceinline__ void attn_unit(Frame& F, int b, int h, int qb, bool do_store) {
    bf16* P6 = (bf16*)wsp(F, WS_P6); const bf16* VT = (const bf16*)wsp(F, WS_VT);
    LAS unsigned char* L = F.lds;
    const int lane = F.lane, r32 = lane & 31, hh = lane >> 5, wid = F.wave;
    const int tb = b * SEQ, t0 = qb * 256 + wid * 32;
    const int D0 = 8 * qb, Dw = D0 + wid;
    const bf16* dsrc; int dtile_stride; int doff;
    if (wid < 4) { const int row = 8 * wid + (lane >> 3), pos = lane & 7; dsrc = P6 + (size_t)(tb + row) * P6W + P_SK + h * 64 + ((pos ^ (row & 7)) * 8); dtile_stride = 32 * P6W; doff = wid * 1024; }
    else { const int d = 16 * (wid - 4) + (lane >> 2), pos = lane & 3; dsrc = VT + (size_t)(1024 + h * 64 + d) * NTOK + tb + ((pos ^ ((d >> 2) & 3)) * 8); dtile_stride = 32; doff = 4096 + (wid - 4) * 1024; }
#define AT_DMA(T_) do { const int T__ = (T_); if (T__ >= 0) at_dma(dsrc + (size_t)T__ * dtile_stride, L + (T__ % AT_NSLOT) * AT_SLOTB + doff); } while (0)
    for (int T = D0 + 7; T >= D0 - 1; --T) AT_DMA(T);
    bf16x8 qf[4];
#pragma unroll
    for (int kk = 0; kk < 4; ++kk) qf[kk] = *(const GAS bf16x8*)(P6 + (size_t)(tb + t0 + r32) * P6W + P_SQ + h * 64 + 16 * kk + 8 * hh);
    f32x16 o0 = {}, o1 = {};
    float Rrun = 0.f;
    bool done = false;
    LAS unsigned* flags = (LAS unsigned*)(L + AT_FLAGS);
    asm volatile("s_waitcnt vmcnt(0)" ::: "memory");
    if (lane == 0) flags[wid] = 1u;
    __syncthreads();
    int koff[4], vlo[2][2], vhi[2][2];
#pragma unroll
    for (int kk = 0; kk < 4; ++kk) koff[kk] = r32 * 128 + (((2 * kk + hh) ^ (r32 & 7)) * 16);
#pragma unroll
    for (int dt = 0; dt < 2; ++dt)
#pragma unroll
        for (int s = 0; s < 2; ++s) { const int d = 32 * dt + r32, sw = (d >> 2) & 3; vlo[dt][s] = 4096 + d * 64 + (((2 * s) ^ sw) * 16) + 8 * hh; vhi[dt][s] = 4096 + d * 64 + (((2 * s + 1) ^ sw) * 16) + 8 * hh; }
#define AT_TILE(DIAG_) do { \
            const LAS unsigned char* S = L + (T % AT_NSLOT) * AT_SLOTB; \
            f32x16 p = {}; \
            _Pragma("unroll") \
            for (int kk = 0; kk < 4; ++kk) { const bf16x8 kf = *(const LAS bf16x8*)(S + koff[kk]); p = __builtin_amdgcn_mfma_f32_32x32x16_bf16(kf, qf[kk], p, 0, 0, 0); } \
            bf16x8 vf[2][2]; \
            _Pragma("unroll") \
            for (int dt = 0; dt < 2; ++dt) \
            _Pragma("unroll") \
                for (int s = 0; s < 2; ++s) { const v2u lo = *(const LAS v2u*)(S + vlo[dt][s]), hi = *(const LAS v2u*)(S + vhi[dt][s]); v4u t; t.x = lo.x; t.y = lo.y; t.z = hi.x; t.w = hi.y; vf[dt][s] = __builtin_bit_cast(bf16x8, t); } \
            float lf[16]; \
            _Pragma("unroll") \
            for (int r = 0; r < 16; ++r) { const float z = p[r]; const float e = __builtin_amdgcn_exp2f(-fabsf(z)); const float lg = __builtin_amdgcn_logf(1.f + e); \
                float v = -(fmaxf(z, 0.f) + lg); if (DIAG_ && crow(r, hh) >= r32) v = 0.f; lf[r] = v; } \
 \
            float own[4], pair[4]; \
            _Pragma("unroll") \
            for (int g = 0; g < 4; ++g) { own[g] = (lf[4 * g] + lf[4 * g + 1]) + (lf[4 * g + 2] + lf[4 * g + 3]); \
                auto rr = __builtin_amdgcn_permlane32_swap(__float_as_uint(own[g]), __float_as_uint(own[g]), false, false); \
                pair[g] = __uint_as_float(rr[0]) + __uint_as_float(rr[1]); } \
            float sfx[4]; sfx[3] = Rrun; sfx[2] = sfx[3] + pair[3]; sfx[1] = sfx[2] + pair[2]; sfx[0] = sfx[1] + pair[1]; \
            const float nh = hh ? 0.f : 1.f; \
            float att[16]; \
            _Pragma("unroll") \
            for (int g = 0; g < 4; ++g) { float run = sfx[g] + nh * (pair[g] - own[g]); \
            _Pragma("unroll") \
                for (int i = 3; i >= 0; --i) { const int r = 4 * g + i; run += lf[r]; float a = __builtin_amdgcn_exp2f(p[r] + run); if (DIAG_ && crow(r, hh) >= r32) a = 0.f; att[r] = a; } } \
            Rrun = sfx[0] + pair[0]; \
            v4u pb0, pb1; \
            pb0.x = pk2(att[0], att[1]); pb0.y = pk2(att[2], att[3]); pb0.z = pk2(att[4], att[5]); pb0.w = pk2(att[6], att[7]); \
            pb1.x = pk2(att[8], att[9]); pb1.y = pk2(att[10], att[11]); pb1.z = pk2(att[12], att[13]); pb1.w = pk2(att[14], att[15]); \
            const bf16x8 b0 = __builtin_bit_cast(bf16x8, pb0), b1 = __builtin_bit_cast(bf16x8, pb1); \
            o0 = __builtin_amdgcn_mfma_f32_32x32x16_bf16(vf[0][0], b0, o0, 0, 0, 0); o0 = __builtin_amdgcn_mfma_f32_32x32x16_bf16(vf[0][1], b1, o0, 0, 0, 0); \
            o1 = __builtin_amdgcn_mfma_f32_32x32x16_bf16(vf[1][0], b0, o1, 0, 0, 0); o1 = __builtin_amdgcn_mfma_f32_32x32x16_bf16(vf[1][1], b1, o1, 0, 0, 0); \
            if (__all(Rrun < SB_EXIT)) done = true; \
        } while (0)
    for (int j = 0; ; ++j) {
        const int T = Dw - j;
        const bool active = !done && T >= 0;
        AT_DMA(D0 - j - 2);
        if (active) { if (j == 0) AT_TILE(true); else AT_TILE(false); }
        const bool more = !done && (Dw - (j + 1)) >= 0;
        if (lane == 0) flags[8 * ((j + 1) & 1) + wid] = more ? 1u : 0u;
        asm volatile("s_waitcnt vmcnt(0) lgkmcnt(0)" ::: "memory");
        __builtin_amdgcn_s_barrier();
        asm volatile("" ::: "memory");
        const LAS unsigned* fl = flags + 8 * ((j + 1) & 1);
        const unsigned any = fl[0] | fl[1] | fl[2] | fl[3] | fl[4] | fl[5] | fl[6] | fl[7];
        if (any == 0u) break;
    }
#undef AT_DMA
#undef AT_TILE
    if (do_store) {
        bf16* orow = P6 + (size_t)(tb + t0 + r32) * P6W + P_SQ + h * 64 + 4 * hh;
#pragma unroll
        for (int g = 0; g < 4; ++g) {
            v2u a; a.x = pk2(o0[4 * g], o0[4 * g + 1]); a.y = pk2(o0[4 * g + 2], o0[4 * g + 3]); *(GAS v2u*)(orow + 8 * g) = a;
            v2u c; c.x = pk2(o1[4 * g], o1[4 * g + 1]); c.y = pk2(o1[4 * g + 2], o1[4 * g + 3]); *(GAS v2u*)(orow + 32 + 8 * g) = c;
        }
    } else { asm volatile("" :: "v"(o0), "v"(o1)); }
    __syncthreads();
}
__device__ __forceinline__ void phase_attn(Frame& F, bool do_store) {
    const int v = (F.G % 8 == 0) ? (F.c % 8) * (F.G / 8) + F.c / 8 : F.c;
    for (int u = v; u < 1024; u += F.G) { const int bh = u >> 4, qb = u & 15; attn_unit(F, bh >> 4, bh & 15, qb, do_store); }
}

constexpr size_t MLS_U = 0, MLS_PM = 16 * 4096 * 4, MLS_BL = 2 * 16 * 4096 * 4, MLS_SUM = 3 * 16 * 4096 * 4;
__device__ __forceinline__ void phase_mlstm_scalars(Frame& F) {
    const float* GATES = (const float*)wsp(F, WS_GATES); unsigned char* R3 = wsp(F, WS_R3);
    const int lane = F.lane;
    for (int vb = F.c; vb < 256; vb += F.G) {
        if (F.wave != 0) continue;
        const int bh = vb >> 4, ch = vb & 15, b = bh >> 2, h = bh & 3, t0 = b * SEQ + 256 * ch;
        float carry_b = 0.f, carry_pm = -INFINITY;
#pragma unroll
        for (int sg = 0; sg < 4; ++sg) {
            const int tok = t0 + 64 * sg + lane;
            const float ig = *(const GAS float*)(GATES + (size_t)tok * 8 + h), lfv = *(const GAS float*)(GATES + (size_t)tok * 8 + 4 + h);
            float bc = lfv;
#pragma unroll
            for (int o = 1; o < 64; o <<= 1) { const float t = shfl_up_l(bc, o, lane); if (lane >= o) bc += t; }
            bc += carry_b;
            const float u = ig - bc;
            float pm = u;
#pragma unroll
            for (int o = 1; o < 64; o <<= 1) { const float t = shfl_up_l(pm, o, lane); if (lane >= o) pm = fmaxf(pm, t); }
            pm = fmaxf(pm, carry_pm);
            const size_t idx = (size_t)bh * 4096 + 256 * ch + 64 * sg + lane;
            *(GAS float*)(R3 + MLS_U + idx * 4) = u; *(GAS float*)(R3 + MLS_PM + idx * 4) = pm; *(GAS float*)(R3 + MLS_BL + idx * 4) = bc;
            carry_b = __int_as_float(__builtin_amdgcn_readlane(__float_as_int(bc), 63)); carry_pm = __int_as_float(__builtin_amdgcn_readlane(__float_as_int(pm), 63));
        }
        if (lane == 0) { *(GAS float*)(R3 + MLS_SUM + (size_t)(bh * 16 + ch) * 8) = carry_b; *(GAS float*)(R3 + MLS_SUM + (size_t)(bh * 16 + ch) * 8 + 4) = carry_pm; }
    }
}

constexpr int CVP_QS = 0, CVP_KS = 69632, CVP_U = 139264;
__device__ __forceinline__ void cvp_job(Frame& F, int l, int bh, int c) {
    LAS unsigned char* L = F.lds;
    const int b = bh >> 2, h = bh & 3, T0 = b * SEQ + 256 * c;
    const bf16* P6 = (const bf16*)wsp(F, WS_P6); const unsigned char* R3 = wsp(F, WS_R3);
    {
        const int cg = F.tid & 31, tr = F.tid >> 5, ch8 = 8 * cg;
        const int cq = (ch8 < 128) ? h * 128 + ch8 : 512 + h * 128 + (ch8 - 128);
        float w[4][8], bias[8];
#pragma unroll
        for (int j = 0; j < 4; ++j) { const float* p = inp(F, I_CONVW) + ((size_t)l * 4 + j) * 1024 + cq; const f32x4 a = *(const GAS f32x4*)p, bb = *(const GAS f32x4*)(p + 4);
#pragma unroll
            for (int i = 0; i < 4; ++i) { w[j][i] = a[i]; w[j][4 + i] = bb[i]; } }
        { const float* p = inp(F, I_CONVB) + (size_t)l * 1024 + cq; const f32x4 a = *(const GAS f32x4*)p, bb = *(const GAS f32x4*)(p + 4);
#pragma unroll
          for (int i = 0; i < 4; ++i) { bias[i] = a[i]; bias[4 + i] = bb[i]; } }
        const float osc = (ch8 < 128) ? 0.08838834764831845f : 1.0f;
        const int sbeg = 256 * c + 16 * tr;
        float u0[8], u1[8], u2[8];
#define CVP_RAW(ss) ((ss) >= 0 ? *(const GAS v4u*)(P6 + (size_t)(b * SEQ + (ss)) * P6W + cq) : (v4u){0u, 0u, 0u, 0u})
#define CVP_DEC(dst, q) do { dst[0] = bflo(q.x); dst[1] = bfhi(q.x); dst[2] = bflo(q.y); dst[3] = bfhi(q.y); dst[4] = bflo(q.z); dst[5] = bfhi(q.z); dst[6] = bflo(q.w); dst[7] = bfhi(q.w); } while (0)
        LAS unsigned char* tile = L + ((ch8 < 128) ? CVP_QS : CVP_KS) + ((ch8 & 127) * 2);
        {
            v4u ra[11];
#pragma unroll
            for (int i = 0; i < 11; ++i) ra[i] = CVP_RAW(sbeg - 3 + i);
            v4u rb[8];
#pragma unroll
            for (int i = 0; i < 8; ++i) rb[i] = CVP_RAW(sbeg + 8 + i);
            CVP_DEC(u0, ra[0]); CVP_DEC(u1, ra[1]); CVP_DEC(u2, ra[2]);
#pragma unroll
            for (int tt = 0; tt < 16; ++tt) {
                float u3[8]; if (tt < 8) CVP_DEC(u3, ra[3 + tt]); else CVP_DEC(u3, rb[tt - 8]);
                float o[8];
#pragma unroll
                for (int i = 0; i < 8; ++i) { const float a = bias[i] + w[0][i] * u0[i] + w[1][i] * u1[i] + w[2][i] * u2[i] + w[3][i] * u3[i]; o[i] = a * sigmoidf_(a) * osc; }
                v4u q; q.x = pk2(o[0], o[1]); q.y = pk2(o[2], o[3]); q.z = pk2(o[4], o[5]); q.w = pk2(o[6], o[7]);
                *(LAS v4u*)(tile + (16 * tr + tt) * 272) = q;
#pragma unroll
                for (int i = 0; i < 8; ++i) { u0[i] = u1[i]; u1[i] = u2[i]; u2[i] = u3[i]; }
            }
        }
#undef CVP_RAW
#undef CVP_DEC
        if (F.tid < 256) *(LAS float*)(L + CVP_U + F.tid * 4) = *(const GAS float*)(R3 + MLS_U + ((size_t)bh * 4096 + 256 * c + F.tid) * 4) * LOG2E;
    }
    __syncthreads();
    {
        const int lane = F.lane, wid = F.wave, r32 = lane & 31, hh = lane >> 5;
        const int qblk = (wid < 4) ? 7 - wid : wid - 4;
        float Mc = 0.f;
        { const float a_l = *(const GAS float*)(R3 + MLS_SUM + (size_t)(bh * 16 + (lane & 15)) * 8), p_l = *(const GAS float*)(R3 + MLS_SUM + (size_t)(bh * 16 + (lane & 15)) * 8 + 4);
#pragma unroll
          for (int cc = 0; cc < 16; ++cc) if (cc < c) { const float a = __int_as_float(__builtin_amdgcn_readlane(__float_as_int(a_l), cc)), pmx = __int_as_float(__builtin_amdgcn_readlane(__float_as_int(p_l), cc)); Mc = a + fmaxf(Mc, pmx); } }
        const float pmq = *(const GAS float*)(R3 + MLS_PM + ((size_t)bh * 4096 + 256 * c + 32 * qblk + r32) * 4);
        const float myMM2 = fmaxf(Mc, pmq) * LOG2E;
        bf16x8 qf[8];
#pragma unroll
        for (int kk = 0; kk < 8; ++kk) qf[kk] = *(const LAS bf16x8*)(L + CVP_QS + (32 * qblk + r32) * 272 + (16 * kk + 8 * hh) * 2);
        { unsigned char* QF = wsp(F, WS_R2) + (((size_t)(bh * 16 + c) * 8 + qblk) * 8) * 1024 + lane * 16;
#pragma unroll
          for (int kk = 0; kk < 8; ++kk) *(GAS bf16x8*)(QF + (size_t)kk * 1024) = qf[kk]; }
        unsigned char* PT = wsp(F, WS_PT) + ((size_t)(bh * 16 + c) * 36 + (qblk * (qblk + 1)) / 2) * 2048;
        const LAS float* U2 = (const LAS float*)(L + CVP_U);
        for (int kt = 0; kt <= qblk; ++kt) {
            f32x16 p = {};
#pragma unroll
            for (int kk = 0; kk < 8; ++kk) { const bf16x8 a = *(const LAS bf16x8*)(L + CVP_KS + (32 * kt + r32) * 272 + (16 * kk + 8 * hh) * 2); p = __builtin_amdgcn_mfma_f32_32x32x16_bf16(a, qf[kk], p, 0, 0, 0); }
            const bool diag = (kt == qblk);
            float pw[16];
#pragma unroll
            for (int g = 0; g < 4; ++g) { const f32x4 u2 = *(const LAS f32x4*)(U2 + 32 * kt + 8 * g + 4 * hh);
#pragma unroll
                for (int i = 0; i < 4; ++i) { const int r = 4 * g + i; float v = p[r] * __builtin_amdgcn_exp2f(u2[i] - myMM2); if (diag && (8 * g + 4 * hh + i) > r32) v = 0.f; pw[r] = v; } }
            v4u pb0, pb1;
            pb0.x = pk2(pw[0], pw[1]); pb0.y = pk2(pw[2], pw[3]); pb0.z = pk2(pw[4], pw[5]); pb0.w = pk2(pw[6], pw[7]);
            pb1.x = pk2(pw[8], pw[9]); pb1.y = pk2(pw[10], pw[11]); pb1.z = pk2(pw[12], pw[13]); pb1.w = pk2(pw[14], pw[15]);
            *(GAS v4u*)(PT + (size_t)kt * 2048 + lane * 16) = pb0; *(GAS v4u*)(PT + (size_t)kt * 2048 + 1024 + lane * 16) = pb1;
        }
        { const int dkt = wid & 3, kh = wid >> 2;
          unsigned char* KF = wsp(F, WS_R2) + 16 * MiB + (((size_t)(bh * 16 + c) * 8 + (dkt * 2 + kh)) * 8) * 1024 + lane * 16;
#pragma unroll
          for (int ks = 0; ks < 8; ++ks) { const int s0 = 128 * kh + 16 * ks + 8 * hh; bf16x8 bb;
#pragma unroll
              for (int j = 0; j < 8; ++j) bb[j] = *(const LAS short*)(L + CVP_KS + (s0 + j) * 272 + (32 * dkt + r32) * 2);
              *(GAS bf16x8*)(KF + (size_t)ks * 1024) = bb; } }
    }
    __syncthreads();
}
__device__ __forceinline__ void phase_cvp(Frame& F, int l) {
    const int v = (F.G % 8 == 0) ? (F.c % 8) * (F.G / 8) + F.c / 8 : F.c;
    for (int u = v; u < 256; u += F.G) cvp_job(F, l, u >> 4, u & 15);
}

constexpr int M2_KS = 0, M2_VT = 69632, M2_CT = 86528, M2_G = 95232, M2_U2 = 97280, M2_WC = 105472, M2_PART = 113664;
constexpr int M2_KP = 272, M2_VP = 528, M2_CP = 272;
__device__ __forceinline__ void mlstm_unit(Frame& F, int b, int h, int ds, int skip) {
    LAS unsigned char* L = F.lds;
    const int wid = F.wave;
    const int qblk = (wid < 4) ? 7 - wid : wid - 4;
    const int dkt = wid & 3, kh = wid >> 2;
#define M2_IDS() int lane_ = F.lane; asm volatile("" : "+v"(lane_)); const int lane = lane_, tid = wid * 64 + lane, r32 = lane & 31, hh = lane >> 5
    const bf16* VTg = (const bf16*)wsp(F, WS_VT);
    bf16* P6 = (bf16*)wsp(F, WS_P6);
    const int tb = b * SEQ, bh = b * 4 + h;
    { M2_IDS();
    for (int i = tid; i < 16 * 264; i += 512) { const int row = 16 + i / 264, col = i % 264; *(LAS bf16*)(L + M2_VT + row * M2_VP + col * 2) = (row == 16 && col < 256) ? (bf16)0x3F80 : (bf16)0; }
    for (int i = tid; i < 32 * 136; i += 512) *(LAS bf16*)(L + M2_CT + i * 2) = (bf16)0; }
    f32x16 st = {};
    float Mst = 0.f;
    v4u pv; float pu[4], ppm, pbl, psa, psm;
    bf16x8 qf[8];
    v4u kfr[8];
    v4u pbuf[8][2];
    const unsigned char* R3 = wsp(F, WS_R3);
#define M2_FETCH(cc) do { const int t0_ = tb + 256 * (cc); \
        { const int dvl_ = tid >> 5, seg_ = tid & 31; pv = *(const GAS v4u*)(VTg + (size_t)(h * 256 + ds * 16 + dvl_) * NTOK + t0_ + seg_ * 8); } \
        { const size_t ib_ = (size_t)bh * 4096 + 256 * (cc); \
          _Pragma("unroll") for (int i = 0; i < 4; ++i) pu[i] = *(const GAS float*)(R3 + MLS_U + (ib_ + 64 * i + lane) * 4); \
          ppm = *(const GAS float*)(R3 + MLS_PM + (ib_ + 32 * qblk + r32) * 4); pbl = *(const GAS float*)(R3 + MLS_BL + (ib_ + 32 * qblk + r32) * 4); \
          psa = *(const GAS float*)(R3 + MLS_SUM + (size_t)(bh * 16 + (cc)) * 8); psm = *(const GAS float*)(R3 + MLS_SUM + (size_t)(bh * 16 + (cc)) * 8 + 4); } } while (0)
#define M2_QFETCH(cc) do { const unsigned char* qf_ = wsp(F, WS_R2) + (((size_t)(bh * 16 + (cc)) * 8 + qblk) * 8) * 1024 + lane * 16; _Pragma("unroll") for (int kk = 0; kk < 8; ++kk) qf[kk] = *(const GAS bf16x8*)(qf_ + (size_t)kk * 1024); } while (0)
#define M2_KFETCH(cc) do { const unsigned char* kf_ = wsp(F, WS_R2) + 16 * MiB + (((size_t)(bh * 16 + (cc)) * 8 + (dkt * 2 + kh)) * 8) * 1024 + lane * 16; \
        _Pragma("unroll") for (int ks = 0; ks < 8; ++ks) kfr[ks] = *(const GAS v4u*)(kf_ + (size_t)ks * 1024); } while (0)
#define M2_PTQ(cc) (wsp(F, WS_PT) + ((size_t)(bh * 16 + (cc)) * 36 + (qblk * (qblk + 1)) / 2) * 2048 + lane * 16)
    { M2_IDS(); M2_FETCH(0); M2_QFETCH(0); M2_KFETCH(0);
      const unsigned char* pt_ = M2_PTQ(0);
#pragma unroll
      for (int kt = 0; kt < 8; ++kt) if (kt <= qblk) { pbuf[kt][0] = *(const GAS v4u*)(pt_ + (size_t)kt * 2048); pbuf[kt][1] = *(const GAS v4u*)(pt_ + (size_t)kt * 2048 + 1024); } }
    LAS float* WCw = (LAS float*)(L + M2_WC + wid * 1024);
    for (int c = 0; c < 16; ++c) {
        M2_IDS();
        const int t0 = tb + 256 * c;
        const bool more = (c + 1 < 16);
        { const int dvl_ = tid >> 5, seg_ = tid & 31; *(LAS v4u*)(L + M2_VT + dvl_ * M2_VP + seg_ * 16) = pv; }
        float cu[4]; const float cpm = ppm, cbl = pbl, csa = psa, csm = psm;
#pragma unroll
        for (int i = 0; i < 4; ++i) cu[i] = pu[i];
        if (more) M2_FETCH(c + 1);
        float myWIN, myEFLO, decay;
        {
            const float mml = fmaxf(Mst, csm);
#pragma unroll
            for (int i = 0; i < 4; ++i) WCw[64 * i + lane] = __expf(cu[i] - mml);
            const float mm = fmaxf(Mst, cpm);
            myWIN = __expf(Mst - mm); myEFLO = __expf(-(cbl + mm));
            decay = __expf(Mst - mml);
            Mst = csa + mml;
        }
        __syncthreads();
        f32x16 hT = {};
        if (!(skip & 4))
#pragma unroll
        for (int kk = 0; kk < 8; ++kk) { const bf16x8 a = *(const LAS bf16x8*)(L + M2_CT + r32 * M2_CP + (16 * kk + 8 * hh) * 2); hT = __builtin_amdgcn_mfma_f32_32x32x16_bf16(a, qf[kk], hT, 0, 0, 0); }
        if (more && !(skip & 32)) M2_QFETCH(c + 1);
#pragma unroll
        for (int r = 0; r < 16; ++r) hT[r] *= myWIN;
        {
            const unsigned char* ptn = M2_PTQ(c + 1);
#pragma unroll
            for (int kt = 0; kt < 8; ++kt) if (kt <= qblk) {
#pragma unroll
                for (int s = 0; s < 2; ++s) if (!(skip & 1)) { const LAS unsigned char* vp = L + M2_VT + r32 * M2_VP + (32 * kt + 16 * s + 4 * hh) * 2;
                    const v2u lo = *(const LAS v2u*)vp, hi = *(const LAS v2u*)(vp + 16);
                    v4u t; t.x = lo.x; t.y = lo.y; t.z = hi.x; t.w = hi.y;
                    hT = __builtin_amdgcn_mfma_f32_32x32x16_bf16(__builtin_bit_cast(bf16x8, t), __builtin_bit_cast(bf16x8, pbuf[kt][s]), hT, 0, 0, 0); }
                if (more && !(skip & 16)) { pbuf[kt][0] = *(const GAS v4u*)(ptn + (size_t)kt * 2048); pbuf[kt][1] = *(const GAS v4u*)(ptn + (size_t)kt * 2048 + 1024); }
            }
        }
        {
            const float dn = hT[8];
            auto rr = __builtin_amdgcn_permlane32_swap(__float_as_uint(dn), __float_as_uint(dn), false, false);
            const float den = __uint_as_float(rr[0]);
            const float inv = 1.0f / fmaxf(fabsf(den), myEFLO);
            bf16* orow = P6 + (size_t)(t0 + 32 * qblk + r32) * P6W + P_MQK + h * 256 + ds * 16 + 4 * hh;
            v2u o0, o1; o0.x = pk2(hT[0] * inv, hT[1] * inv); o0.y = pk2(hT[2] * inv, hT[3] * inv); o1.x = pk2(hT[4] * inv, hT[5] * inv); o1.y = pk2(hT[6] * inv, hT[7] * inv);
            if (!(skip & 8)) { *(GAS v2u*)orow = o0; *(GAS v2u*)(orow + 8) = o1; } else { asm volatile("" :: "v"(o0), "v"(o1)); }
        }
        f32x16 part = {};
#pragma unroll
        for (int ks = 0; ks < 8; ++ks) if (!(skip & 2)) {
            const int s0 = 128 * kh + 16 * ks + 8 * hh;
            const v4u raw = *(const LAS v4u*)(L + M2_VT + r32 * M2_VP + s0 * 2);
            const f32x4 w0 = *(const LAS f32x4*)(WCw + s0), w1 = *(const LAS f32x4*)(WCw + s0 + 4);
            v4u aw; aw.x = pk2(bflo(raw.x) * w0[0], bfhi(raw.x) * w0[1]); aw.y = pk2(bflo(raw.y) * w0[2], bfhi(raw.y) * w0[3]);
            aw.z = pk2(bflo(raw.z) * w1[0], bfhi(raw.z) * w1[1]); aw.w = pk2(bflo(raw.w) * w1[2], bfhi(raw.w) * w1[3]);
            part = __builtin_amdgcn_mfma_f32_32x32x16_bf16(__builtin_bit_cast(bf16x8, aw), __builtin_bit_cast(bf16x8, kfr[ks]), part, 0, 0, 0);
        }
        if (more && !(skip & 64)) M2_KFETCH(c + 1);
        if (kh == 1) {
#pragma unroll
            for (int r = 0; r < 16; ++r) *(LAS float*)(L + M2_PART + dkt * 4096 + r * 256 + lane * 4) = part[r];
        }
        __syncthreads();
        if (kh == 0) {
#pragma unroll
            for (int r = 0; r < 16; ++r) { st[r] = st[r] * decay + part[r] + *(LAS float*)(L + M2_PART + dkt * 4096 + r * 256 + lane * 4);
                *(LAS bf16*)(L + M2_CT + crow(r, hh) * M2_CP + (32 * dkt + r32) * 2) = f2bf(st[r]); }
        }
    }
#undef M2_FETCH
#undef M2_QFETCH
#undef M2_KFETCH
#undef M2_PTQ
#undef M2_IDS
}
__device__ __forceinline__ void phase_mlstm(Frame& F, int skip) {
    const int v = (F.G % 8 == 0) ? (F.c % 8) * (F.G / 8) + F.c / 8 : F.c;
    for (int u = v; u < 256; u += F.G) { const int bh = u >> 4, ds = u & 15; mlstm_unit(F, bh >> 2, bh & 3, ds, skip); __syncthreads(); }
}

__device__ __forceinline__ void phase_hm_final(Frame& F, int l, bool do_store) {
    bf16* P6 = (bf16*)wsp(F, WS_P6);
    const float* mw = inp(F, I_MNW) + (size_t)l * 1024;
    for (int vb = F.c; vb < 256; vb += F.G) {
        v4u hn[2], mn[2];
#define HM_LOAD(tt) do { const bf16* r_ = P6 + (size_t)(tt) * P6W + 8 * F.lane; \
            _Pragma("unroll") for (int j = 0; j < 2; ++j) { hn[j] = *(const GAS v4u*)(r_ + P_MQK + 512 * j); mn[j] = *(const GAS v4u*)(r_ + P_MO + 512 * j); } } while (0)
        HM_LOAD(vb * 64 + F.wave * 8);
        for (int i = 0; i < 8; ++i) {
            const int t = vb * 64 + F.wave * 8 + i; bf16* row = P6 + (size_t)t * P6W + 8 * F.lane;
            v4u hc[2], mc[2];
#pragma unroll
            for (int j = 0; j < 2; ++j) { hc[j] = hn[j]; mc[j] = mn[j]; }
            if (i + 1 < 8) HM_LOAD(t + 1);
#pragma unroll
            for (int j = 0; j < 2; ++j) {
                const float x[8] = {bflo(hc[j].x), bfhi(hc[j].x), bflo(hc[j].y), bfhi(hc[j].y), bflo(hc[j].z), bfhi(hc[j].z), bflo(hc[j].w), bfhi(hc[j].w)};
                const float mo[8] = {bflo(mc[j].x), bfhi(mc[j].x), bflo(mc[j].y), bfhi(mc[j].y), bflo(mc[j].z), bfhi(mc[j].z), bflo(mc[j].w), bfhi(mc[j].w)};
                float ss = 0.f;
#pragma unroll
                for (int q = 0; q < 8; ++q) ss += x[q] * x[q];
                ss = half_sum32(ss);
                const float r = 1.0f / sqrtf(ss * (1.f / 256.f) + EPS);
                const f32x4 w0 = *(const GAS f32x4*)(mw + 512 * j + 8 * F.lane), w1 = *(const GAS f32x4*)(mw + 512 * j + 8 * F.lane + 4);
                float y[8];
#pragma unroll
                for (int q = 0; q < 4; ++q) { y[q] = x[q] * r * w0[q] * sigmoidf_(mo[q]); y[4 + q] = x[4 + q] * r * w1[q] * sigmoidf_(mo[4 + q]); }
                v4u o; o.x = pk2(y[0], y[1]); o.y = pk2(y[2], y[3]); o.z = pk2(y[4], y[5]); o.w = pk2(y[6], y[7]);
                if (do_store) *(GAS v4u*)(row + P_MQK + 512 * j) = o; else asm volatile("" :: "v"(o));
            }
        }
#undef HM_LOAD
    }
}

#define N2_LD0(dst, k0) do { const GAS float* bq_ = bp + (size_t)(2 * (k0)) * 64; asm volatile("" : "+v"(bq_)); _Pragma("unroll") for (int q_ = 0; q_ < 32; ++q_) dst[q_] = bq_[(size_t)(2 * q_) * 64]; } while (0)
constexpr int N2_H2 = 0, N2_CA = 131328, N2_CB = N2_CA + 4096, N2_HIST = N2_CB + 4096, N2_ST = N2_HIST + 256;
static_assert(N2_ST + 4864 <= LDS_CTL, "N2 LDS");
__device__ __forceinline__ void phase_norm2_router(Frame& F, int l, int skip, bool tail) {
    LAS unsigned char* L = F.lds;
    LAS float* H2 = (LAS float*)(L + N2_H2); LAS float* cA = (LAS float*)(L + N2_CA); LAS float* cB = (LAS float*)(L + N2_CB); LAS unsigned* hist = (LAS unsigned*)(L + N2_HIST);
    const int lane = F.lane, wid = F.wave, r32 = lane & 31, hh = lane >> 5;
    bf16* XN2 = (bf16*)wsp(F, WS_R1); unsigned* CUR = (unsigned*)wsp(F, WS_CUR) + l * 64;
    LAS int* stE = (LAS int*)(L + N2_ST); LAS float* stW = (LAS float*)(L + N2_ST + 2048); LAS unsigned* blockoff = (LAS unsigned*)(L + N2_ST + 4096); LAS unsigned* selm = (LAS unsigned*)(L + N2_ST + 4352);
    const float* Wr = inp(F, I_RW) + (size_t)l * 1024 * 64;
    const float rb = inp(F, I_RB)[l * 64 + lane];
    for (int vb = F.c; vb < 256; vb += F.G) {
        const int b = vb >> 6;
        const float* MODF = (const float*)wsp(F, WS_MODF) + (size_t)(l * 4 + b) * 6144;
        for (int k = F.tid; k < 1024; k += 512) { cA[k] = inp(F, I_N2W)[l * 1024 + k] * (1.f + MODF[4 * 1024 + k]); cB[k] = MODF[3 * 1024 + k]; }
        if (F.tid < 64) hist[F.tid] = 0u;
        const int eh = wid & 1, kq = wid >> 1;
        const GAS float* bp = (const GAS float*)(Wr + (size_t)(256 * kq + hh) * 64 + 32 * eh + r32);
        __syncthreads();
        for (int it = 0; it < 2; ++it) {
            const int T0 = vb * 64 + it * 32;
            float wA[32], wB[32];
            N2_LD0(wA, 0); N2_LD0(wB, 32);
            v4u xr4[4][2];
            if (!(skip & 4))
#pragma unroll
            for (int i = 0; i < 4; ++i) { const bf16* xr = xmid(F, l) + (size_t)(T0 + wid * 4 + i) * 1024 + 8 * lane;
#pragma unroll
                for (int j = 0; j < 2; ++j) xr4[i][j] = *(const GAS v4u*)(xr + 512 * j); }
#pragma unroll
            for (int i = 0; i < 4; ++i) if (!(skip & 4)) {
                const int tl = wid * 4 + i, t = T0 + tl;
                float v[2][8]; float ss = 0.f;
#pragma unroll
                for (int j = 0; j < 2; ++j) { const v4u a = xr4[i][j];
                    v[j][0] = bflo(a.x); v[j][1] = bfhi(a.x); v[j][2] = bflo(a.y); v[j][3] = bfhi(a.y); v[j][4] = bflo(a.z); v[j][5] = bfhi(a.z); v[j][6] = bflo(a.w); v[j][7] = bfhi(a.w);
#pragma unroll
                    for (int q = 0; q < 8; ++q) ss += v[j][q] * v[j][q]; }
                ss = wave_sum(ss, F.lane);
                const float r = 1.0f / sqrtf(ss * (1.f / 1024.f) + EPS);
#pragma unroll
                for (int j = 0; j < 2; ++j) { const int k = 8 * lane + 512 * j; float h[8];
                    const f32x4 a0 = *(const LAS f32x4*)(cA + k), a1 = *(const LAS f32x4*)(cA + k + 4), b0 = *(const LAS f32x4*)(cB + k), b1 = *(const LAS f32x4*)(cB + k + 4);
                    LAS float* hp = H2 + tl * 1025 + k;
#pragma unroll
                    for (int q = 0; q < 4; ++q) { h[q] = v[j][q] * r * a0[q] + b0[q]; h[4 + q] = v[j][4 + q] * r * a1[q] + b1[q]; }
#pragma unroll
                    for (int q = 0; q < 8; ++q) hp[q] = h[q];
                    v4u o; o.x = pk2(h[0], h[1]); o.y = pk2(h[2], h[3]); o.z = pk2(h[4], h[5]); o.w = pk2(h[6], h[7]);
                    *(GAS v4u*)(XN2 + (size_t)t * 1024 + k) = o; }
            }
            __syncthreads();
            f32x16 acc = {};
            {
                const LAS float* ap = H2 + r32 * 1025 + 256 * kq + hh;
#define N2_LD(dst, k0) N2_LD0(dst, k0)
#define N2_MM(src, k0) do { _Pragma("unroll") for (int q_ = 0; q_ < 32; ++q_) { if ((q_ & 7) == 0) asm volatile("" ::: "memory"); acc = __builtin_amdgcn_mfma_f32_32x32x2f32(ap[2 * ((k0) + q_)], src[q_], acc, 0, 0, 0); } } while (0)
                if (!(skip & 1)) { N2_MM(wA, 0); N2_LD(wA, 64); N2_MM(wB, 32); N2_LD(wB, 96); N2_MM(wA, 64); N2_MM(wB, 96); }
            }
            __syncthreads();
            LAS float* PART = (LAS float*)(L);
#pragma unroll
            for (int r = 0; r < 16; ++r) PART[(kq * 32 + crow(r, hh)) * 64 + 32 * eh + r32] = acc[r];
            __syncthreads();
            if (!(skip & 2))
            {
                LAS float* rowb = (LAS float*)(L + 32768 + wid * 4096);
                int lane_t = F.lane; asm volatile("" : "+v"(lane_t)); const int lane = lane_t;
                const int g = lane >> 3;
                float score[4], sel[4]; unsigned key[4];
#pragma unroll
                for (int i = 0; i < 4; ++i) { const int tl = wid * 4 + i;
                    const float x = (PART[(0 * 32 + tl) * 64 + lane] + PART[(1 * 32 + tl) * 64 + lane]) + (PART[(2 * 32 + tl) * 64 + lane] + PART[(3 * 32 + tl) * 64 + lane]);
                    score[i] = 1.f / (1.f + expf(-x)); sel[i] = score[i] + rb; rowb[i * 256 + lane] = sel[i]; }
                LDS_WAIT();
#pragma unroll
                for (int i = 0; i < 4; ++i) { const LAS float* row = rowb + i * 256;
                    const f32x4 a = *(const LAS f32x4*)(row + 8 * g), c2 = *(const LAS f32x4*)(row + 8 * g + 4);
                    float m1 = fmaxf(a[0], a[1]), m2 = fminf(a[0], a[1]);
#define TK_INS(v_) do { const float v__ = (v_); m2 = fmaxf(m2, fminf(m1, v__)); m1 = fmaxf(m1, v__); } while (0)
                    TK_INS(a[2]); TK_INS(a[3]); TK_INS(c2[0]); TK_INS(c2[1]); TK_INS(c2[2]); TK_INS(c2[3]);
#undef TK_INS
                    if ((lane & 7) == 0) rowb[i * 256 + 64 + g] = m1 + m2; }
                LDS_WAIT();
#pragma unroll
                for (int i = 0; i < 4; ++i) { const LAS float* row = rowb + i * 256;
                    const f32x4 a = *(const LAS f32x4*)(row + 64), c2 = *(const LAS f32x4*)(row + 68);
                    const float gsv[8] = {a[0], a[1], a[2], a[3], c2[0], c2[1], c2[2], c2[3]};
                    float mine = 0.f;
#pragma unroll
                    for (int q = 0; q < 8; ++q) if (q == g) mine = gsv[q];
                    int gr = 0;
#pragma unroll
                    for (int q = 0; q < 8; ++q) gr += ((gsv[q] > mine) || (gsv[q] == mine && q < g)) ? 1 : 0;
                    const unsigned sb = __float_as_uint(sel[i]); key[i] = (gr < 4) ? (sb ^ ((unsigned)((int)sb >> 31) | 0x80000000u)) : 0u; }
                unsigned chosenm = 0u; float wsum[4] = {0.f, 0.f, 0.f, 0.f}; int myE = 0; float myS = 0.f;
#pragma unroll
                for (int r = 0; r < 8; ++r)
#pragma unroll
                    for (int i = 0; i < 4; ++i) {
                        const unsigned m = wave_umax_all(key[i]);
                        const int idx = __builtin_ctzll(__builtin_amdgcn_ballot_w64(key[i] == m));
                        const float sc = __int_as_float(__builtin_amdgcn_readlane(__float_as_int(score[i]), idx));
                        wsum[i] += sc;
                        if (lane == idx) { key[i] = 0u; chosenm += 1u; }
                        if (lane == 8 * i + r) { myE = idx; myS = sc; }
                    }
                {
                    const int ti = lane >> 3; const float ws_ = (ti == 0) ? wsum[0] : (ti == 1) ? wsum[1] : (ti == 2) ? wsum[2] : wsum[3];
                    if (lane < 32) { const int o = (it * 32 + wid * 4) * 8 + lane; stE[o] = myE; stW[o] = myS / ws_ * 2.5f; }
                    if (chosenm) __hip_atomic_fetch_add(&hist[lane], chosenm, __ATOMIC_RELAXED, __HIP_MEMORY_SCOPE_WORKGROUP);
                }
                LDS_WAIT();
            }
            __syncthreads();
        }
        if (tail && !skip) {
        if (F.tid < 64) { const unsigned h_ = hist[F.tid]; blockoff[F.tid] = h_ ? __hip_atomic_fetch_add(CUR + F.tid, h_, __ATOMIC_RELAXED, __HIP_MEMORY_SCOPE_AGENT) : 0u; }
        if (F.tid < 128) selm[F.tid] = 0u;
        __syncthreads();
        { const int tok = F.tid >> 3, slot = F.tid & 7, gt = vb * 64 + tok; const int e = stE[F.tid];
          __hip_atomic_fetch_or(&selm[e * 2 + (tok >> 5)], 1u << (tok & 31), __ATOMIC_RELAXED, __HIP_MEMORY_SCOPE_WORKGROUP);
          __syncthreads();
          const unsigned lo = selm[e * 2], hi = selm[e * 2 + 1];
          const unsigned rank = (tok < 32) ? __popc(lo & ((1u << tok) - 1u)) : (__popc(lo) + __popc(hi & ((1u << (tok - 32)) - 1u)));
          const size_t pos = (size_t)e * RS_CAP + blockoff[e] + rank;
          *(GAS unsigned*)((unsigned*)wsp(F, WS_RSTOK) + pos) = (unsigned)gt; *(GAS float*)((float*)wsp(F, WS_RSW) + pos) = stW[F.tid]; *(GAS unsigned*)((unsigned*)wsp(F, WS_RSDST) + pos) = (unsigned)(gt * 8 + slot); }
        }
        __syncthreads();
    }
}

__device__ __forceinline__ int moe_layout(Frame& F, int l, LAS unsigned* tot, LAS unsigned* padv, LAS unsigned* base) {
    const unsigned* CUR = (const unsigned*)wsp(F, WS_CUR) + l * 64;
    if (F.tid < 64) { const unsigned T = *(const GAS unsigned*)(CUR + F.tid); tot[F.tid] = T; padv[F.tid] = (T + 255u) & ~255u; }
    __syncthreads();
    if (F.tid < 64) { unsigned b = 0; for (int e = 0; e < F.tid; ++e) b += padv[e]; base[F.tid] = b; }
    __syncthreads();
    return (int)((base[63] + padv[63]) >> 8);
}

__device__ __forceinline__ void phase_scatter(Frame& F) {
    LAS unsigned* red = (LAS unsigned*)(F.lds);
    LAS unsigned* tot = red + 1024; LAS unsigned* padv = tot + 64; LAS unsigned* bef = padv + 64; LAS unsigned* base = bef + 64; LAS unsigned* selm = base + 64;
    const unsigned* CNT = (const unsigned*)wsp(F, WS_CNT); const int* TOPE = (const int*)wsp(F, WS_TOPE); const float* TOPW = (const float*)wsp(F, WS_TOPW);
    unsigned* STOK = (unsigned*)wsp(F, WS_STOK); float* SW = (float*)wsp(F, WS_SW); unsigned* SDST = (unsigned*)wsp(F, WS_SDST); int* TILEE = (int*)wsp(F, WS_TILEE);
    const int tid = F.tid;
    for (int vb = F.c; vb < 256; vb += F.G) {
        { const int e = tid & 63, part = tid >> 6; unsigned t = 0, bfv = 0;
          unsigned cv[32];
#pragma unroll
          for (int q = 0; q < 32; ++q) cv[q] = *(const GAS unsigned*)(CNT + (32 * part + q) * 64 + e);
#pragma unroll
          for (int q = 0; q < 32; ++q) { t += cv[q]; if (32 * part + q < vb) bfv += cv[q]; }
          red[part * 64 + e] = t; red[512 + part * 64 + e] = bfv; }
        if (tid < 128) selm[tid] = 0u;
        __syncthreads();
        if (tid < 64) { unsigned T = 0, B = 0;
#pragma unroll
            for (int p = 0; p < 8; ++p) { T += red[p * 64 + tid]; B += red[512 + p * 64 + tid]; }
            tot[tid] = T; padv[tid] = (T + 255u) & ~255u; bef[tid] = B; }
        __syncthreads();
        if (tid < 64) { unsigned b = 0; for (int e = 0; e < tid; ++e) b += padv[e]; base[tid] = b; }
        const int tok = tid >> 3, slot = tid & 7, gt = vb * 64 + tok; const int e = TOPE[(size_t)gt * 8 + slot];
        __hip_atomic_fetch_or(&selm[e * 2 + (tok >> 5)], 1u << (tok & 31), __ATOMIC_RELAXED, __HIP_MEMORY_SCOPE_WORKGROUP);
        __syncthreads();
        { const unsigned lo = selm[e * 2], hi = selm[e * 2 + 1];
          const unsigned rank = (tok < 32) ? __popc(lo & ((1u << tok) - 1u)) : (__popc(lo) + __popc(hi & ((1u << (tok - 32)) - 1u)));
          const unsigned pos = base[e] + bef[e] + rank;
          STOK[pos] = (unsigned)gt; SW[pos] = TOPW[(size_t)gt * 8 + slot]; SDST[pos] = (unsigned)(gt * 8 + slot); }
        if (vb < 64) { const unsigned n = padv[vb] - tot[vb]; if ((unsigned)tid < n) { const unsigned pos = base[vb] + tot[vb] + tid; STOK[pos] = 0u; SW[pos] = 0.f; SDST[pos] = 0xffffffffu; } }
        if (vb == 0) { const int ntiles = (int)((base[63] + padv[63]) >> 8);
            for (int pm = tid; pm < ntiles; pm += 512) { int ee = 0; for (int q = 0; q < 64; ++q) if ((unsigned)(256 * pm) >= base[q] && (unsigned)(256 * pm) < base[q] + padv[q]) ee = q; TILEE[pm] = ee; }
            if (tid == 0) TILEE[1000] = ntiles; }
        __syncthreads();
    }
}

struct RoutedOrder {
    int ntiles, G, c; const LAS int* tabE; const LAS unsigned* tabTok; int wave;
    __device__ __forceinline__ bool next(int i, pg8::Unit& u) const { const int pm = i * G + c; if (pm >= ntiles) return false; u.pm = pm; u.pn = tabE[i]; return true; }
    __device__ __forceinline__ unsigned rowtok(int i, int row) const { return tabTok[i * 256 + row]; }
};
struct DownOrder {
    int nunits, G, v; const LAS int* tabE; int wave;
    __device__ __forceinline__ bool next(int i, pg8::Unit& u) const { const int L = i * G + v; if (L >= nunits) return false; u.pm = L >> 2; u.pn = tabE[i] * 4 + (L & 3); return true; }
    __device__ __forceinline__ unsigned rowtok(int, int) const { return 0u; }
};

__device__ __forceinline__ void phase_combine(Frame& F, int l, bool do_store) {
    const bf16* Y = (const bf16*)wsp(F, WS_R1); bf16* XN = (bf16*)wsp(F, WS_R2); float* GATES = (float*)wsp(F, WS_GATES);
    const bool last = (l == NLAYER - 1);
    for (int vb = F.c; vb < 256; vb += F.G) {
        const int b = vb >> 6;
        const float* g2 = (const float*)wsp(F, WS_MODF) + (size_t)(l * 4 + b) * 6144 + 5 * 1024;
        float gbl = 0.f;
        if (!last) { norm1_tables(F, l + 1, b, false); gbl = (F.lane < 4) ? inp(F, I_IGB)[(l + 1) * 4 + F.lane] : (F.lane < 8 ? inp(F, I_FGB)[(l + 1) * 4 + F.lane - 4] : 0.f); }
        __syncthreads();
        v2u yn[8][2];
        const bf16* SHO = (const bf16*)wsp(F, WS_R1 + 128 * MiB);
#define CB_LOAD(tt) do { const int t_ = (tt); \
            _Pragma("unroll") for (int s = 0; s < 8; ++s) _Pragma("unroll") for (int j = 0; j < 2; ++j) yn[s][j] = *(const GAS v2u*)((const unsigned char*)Y + ((size_t)t_ * 8 + s) * 1024 + 8 * F.lane + 512 * j); \
            } while (0)
        CB_LOAD(vb * 64 + F.wave * 8);
        for (int i = 0; i < 8; ++i) {
            const int t = vb * 64 + F.wave * 8 + i;
            v2u yc[8][2]; v4u xc[2]; v4u sc2[2]; bf16* xbr = xmid(F, l) + (size_t)t * 1024 + 8 * F.lane;
#pragma unroll
            for (int j = 0; j < 2; ++j) sc2[j] = *(const GAS v4u*)(SHO + (size_t)t * 1024 + 8 * F.lane + 512 * j);
#pragma unroll
            for (int s = 0; s < 8; ++s) { yc[s][0] = yn[s][0]; yc[s][1] = yn[s][1]; }
#pragma unroll
            for (int j = 0; j < 2; ++j) xc[j] = *(const GAS v4u*)(xbr + 512 * j);
            if (i + 1 < 8) CB_LOAD(t + 1);
            float acc[2][8];
#pragma unroll
            for (int j = 0; j < 2; ++j)
#pragma unroll
                for (int q = 0; q < 8; ++q) acc[j][q] = 0.f;
#pragma unroll
            for (int s = 0; s < 8; ++s)
#pragma unroll
                for (int j = 0; j < 2; ++j) { const v2u q = yc[s][j];
                    const f32x2_t a0 = __builtin_amdgcn_cvt_pk_f32_fp8((int)q.x, false), a1 = __builtin_amdgcn_cvt_pk_f32_fp8((int)q.x, true), a2 = __builtin_amdgcn_cvt_pk_f32_fp8((int)q.y, false), a3 = __builtin_amdgcn_cvt_pk_f32_fp8((int)q.y, true);
                    acc[j][0] += a0.x; acc[j][1] += a0.y; acc[j][2] += a1.x; acc[j][3] += a1.y; acc[j][4] += a2.x; acc[j][5] += a2.y; acc[j][6] += a3.x; acc[j][7] += a3.y; }
            float v[2][8]; float* xr = outp(F) + (size_t)t * 1024 + 8 * F.lane;
#pragma unroll
            for (int j = 0; j < 2; ++j) { const f32x4 a = {bflo(xc[j].x), bfhi(xc[j].x), bflo(xc[j].y), bfhi(xc[j].y)}, c2 = {bflo(xc[j].z), bfhi(xc[j].z), bflo(xc[j].w), bfhi(xc[j].w)};
                const f32x4 ga = *(const GAS f32x4*)(g2 + 8 * F.lane + 512 * j), gc = *(const GAS f32x4*)(g2 + 8 * F.lane + 512 * j + 4);
                const float sh[8] = {bflo(sc2[j].x), bfhi(sc2[j].x), bflo(sc2[j].y), bfhi(sc2[j].y), bflo(sc2[j].z), bfhi(sc2[j].z), bflo(sc2[j].w), bfhi(sc2[j].w)};
#pragma unroll
                for (int q = 0; q < 4; ++q) { v[j][q] = a[q] + ga[q] * (acc[j][q] * (1.f / YS_SCALE) + sh[q]); v[j][4 + q] = c2[q] + gc[q] * (acc[j][4 + q] * (1.f / YS_SCALE) + sh[4 + q]); } }
            if (last) {
                float ss = 0.f;
#pragma unroll
                for (int j = 0; j < 2; ++j)
#pragma unroll
                    for (int q = 0; q < 8; ++q) ss += v[j][q] * v[j][q];
                ss = wave_sum(ss, F.lane);
                const float r = 1.0f / sqrtf(ss * (1.f / 1024.f) + EPS);
#pragma unroll
                for (int j = 0; j < 2; ++j) { const float* fw = inp(F, I_FNW) + 8 * F.lane + 512 * j; const f32x4 w0 = *(const GAS f32x4*)fw, w1 = *(const GAS f32x4*)(fw + 4);
                    f32x4 o0, o1;
#pragma unroll
                    for (int q = 0; q < 4; ++q) { o0[q] = v[j][q] * r * w0[q]; o1[q] = v[j][4 + q] * r * w1[q]; }
                    if (do_store) { *(GAS f32x4*)(xr + 512 * j) = o0; *(GAS f32x4*)(xr + 512 * j + 4) = o1; } else asm volatile("" :: "v"(o0), "v"(o1)); }
            } else {
#pragma unroll
                for (int j = 0; j < 2; ++j) { v4u o; o.x = pk2(v[j][0], v[j][1]); o.y = pk2(v[j][2], v[j][3]); o.z = pk2(v[j][4], v[j][5]); o.w = pk2(v[j][6], v[j][7]);
                    if (do_store) { *(GAS v4u*)(xbr + 512 * j) = o; } else asm volatile("" :: "v"(o)); }
                if (do_store) norm_emit(F, v, (const LAS float*)(F.lds + LDS_TAB), (const LAS float*)(F.lds + LDS_TAB) + 1024, (const LAS float*)(F.lds), gbl, XN + (size_t)t * 1024, GATES + (size_t)t * 8);
            }
        }
#undef CB_LOAD
        __syncthreads();
    }
}

__device__ __forceinline__ void dbg_final(Frame& F, const float* src) {
    for (int vb = F.c; vb < 256; vb += F.G)
        for (int i = 0; i < 8; ++i) {
            const int t = vb * 64 + F.wave * 8 + i; const float* xr = src + (size_t)t * 1024 + 8 * F.lane; float* orow = outp(F) + (size_t)t * 1024 + 8 * F.lane;
            float v[2][8]; float ss = 0.f;
#pragma unroll
            for (int j = 0; j < 2; ++j) { const f32x4 a = *(const GAS f32x4*)(xr + 512 * j), c2 = *(const GAS f32x4*)(xr + 512 * j + 4);
#pragma unroll
                for (int q = 0; q < 4; ++q) { v[j][q] = a[q]; v[j][4 + q] = c2[q]; ss += a[q] * a[q] + c2[q] * c2[q]; } }
            ss = wave_sum(ss, F.lane);
            const float r = 1.0f / sqrtf(ss * (1.f / 1024.f) + EPS);
#pragma unroll
            for (int j = 0; j < 2; ++j) { const float* fw = inp(F, I_FNW) + 8 * F.lane + 512 * j; const f32x4 w0 = *(const GAS f32x4*)fw, w1 = *(const GAS f32x4*)(fw + 4);
                f32x4 o0, o1;
#pragma unroll
                for (int q = 0; q < 4; ++q) { o0[q] = v[j][q] * r * w0[q]; o1[q] = v[j][4 + q] * r * w1[q]; }
                *(GAS f32x4*)(orow + 512 * j) = o0; *(GAS f32x4*)(orow + 512 * j + 4) = o1; }
        }
}
struct Args { const float* in[24]; float* out; unsigned char* ws; };
#ifndef MK_EN_MASK
#define MK_EN_MASK 0xffffffffu
#endif
#define EN(k) (((MK_EN_MASK) >> (k)) & 1u)
#ifndef RP_G1
#define RP_G1 1
#endif
#ifndef RP_ATT
#define RP_ATT 1
#endif
#ifndef RP_ML
#define RP_ML 1
#endif
#ifndef RP_N2
#define RP_N2 1
#endif
#ifndef RP_CW
#define RP_CW 1
#endif
#ifndef RP_C
#define RP_C 1
#endif
#ifndef RP_D
#define RP_D 1
#endif
#ifndef RP_CV
#define RP_CV 1
#endif
#ifndef RP_PB
#define RP_PB 1
#endif
#ifndef RP_VT
#define RP_VT 1
#endif
#ifndef RP_PA
#define RP_PA 1
#endif
#ifndef RP_SC
#define RP_SC 1
#endif
#ifndef RP_SG
#define RP_SG 1
#endif
#ifndef ML_SKIP
#define ML_SKIP 0
#endif
#ifndef RP_X5
#define RP_X5 1
#endif
#ifndef RP_E
#define RP_E 1
#endif
#ifndef RP_HM
#define RP_HM 1
#endif
#ifndef RP_P1
#define RP_P1 1
#endif
#ifndef RP_SD
#define RP_SD 1
#endif
#ifndef N2_SKIP
#define N2_SKIP 0
#endif
#ifndef MK_LAST_PHASE
#define MK_LAST_PHASE 1000
#endif
__global__ void __launch_bounds__(512, 2) mk_fwd(Args args) {
    extern __shared__ __attribute__((aligned(16))) unsigned char lds_raw[];
    Frame F;
    F.lds = (LAS unsigned char*)lds_raw;
    const int wave0 = __builtin_amdgcn_readfirstlane((int)threadIdx.x >> 6);
#define RELOAD_IDS() do { int l_ = lane_now(); F.lane = l_; F.wave = wave0; F.tid = wave0 * 64 + l_; } while (0)
    RELOAD_IDS();
    F.G = gridDim.x; F.c = blockIdx.x;
    F.out = args.out; F.ws = args.ws;
    if (F.tid < 16) ((LAS unsigned*)(F.lds + LDS_CTL))[F.tid] = 0u;
#pragma unroll
    for (int i = 0; i < 24; ++i) if (F.tid == 64 + i) *(LAS unsigned long long*)(F.lds + LDS_CTL + 64 + 8 * i) = (unsigned long long)args.in[i];
    __syncthreads();
    XcdBarrier bar = xcd_barrier_post((unsigned*)wsp(F, WS_CTL) + CW_BAR, (volatile LAS unsigned*)(F.lds + LDS_CTL));
#define P6 ((bf16*)wsp(F, WS_P6))
#define VT ((bf16*)wsp(F, WS_VT))
#define R2 ((bf16*)wsp(F, WS_R2))
#define MODF ((const float*)wsp(F, WS_MODF))
#define GRID_BAR() do { XcdBarrier b_ = bar; asm volatile("" : "+s"(b_.bar), "+s"(b_.x)); xcd_barrier(b_); } while (0)
    int phase_no = 0;
#ifndef RP_BAR
#define RP_BAR 1
#endif
#define PHASE_END() do { for (int rb_ = 0; rb_ < RP_BAR; ++rb_) GRID_BAR(); RELOAD_IDS(); if (++phase_no >= MK_LAST_PHASE) goto finish; } while (0)

    if (EN(0)) { mod_partials(F);
    for (int rp = 0; rp < RP_CW; ++rp) { RELOAD_IDS(); conv_weights(F, 0); } }
    PHASE_END();
    for (int rp = 0; rp < RP_P1; ++rp) if (EN(1)) phase_norm1_first(F);
    PHASE_END();

#pragma unroll
    for (int l = 0; l < NLAYER; ++l) {
        if (EN(2)) { phase_mlstm_scalars(F); RELOAD_IDS(); }
        for (int rp = 0; rp < RP_G1; ++rp) if (EN(2)) {
            pg8::Gemm g{R2, (const bf16*)wsp(F, WS_BIN), 1024, 1024}; pg8::StaticOrder S; S.init(NTOK, P6W, F.G, F.c, F.wave);
            EpiPlain E{P6, P6W};
            pg8::gemm_phase<EpiPlain, pg8::StaticOrder, true, false>(F.lds, g, S, E);
        }
        for (int rp = 0; rp < RP_VT; ++rp) if (EN(3)) {
            pg8::Gemm g{(const bf16*)wsp(F, WS_AIN), R2, 1024, 1024}; pg8::StaticOrder S; S.init(2048, NTOK, F.G, F.c, F.wave);
            EpiPlain E{VT, NTOK};
            pg8::gemm_phase<EpiPlain, pg8::StaticOrder, true, false>(F.lds, g, S, E);
        }
        PHASE_END();
        for (int pass = 0; pass < 2; ++pass) {
            if (((pass ^ F.c) & 1) == 0) { for (int rp = 0; rp < RP_CV; ++rp) if (EN(4)) phase_cvp(F, l); }
            else { for (int rp = 1; rp < RP_ATT; ++rp) phase_attn(F, false); if (EN(5)) phase_attn(F, true); }
            RELOAD_IDS();
        }
        PHASE_END();
        for (int rp = 0; rp < RP_ML; ++rp) if (EN(6)) phase_mlstm(F, (RP_ML > 1 && rp == 0) ? ML_SKIP : 0);
        PHASE_END();
        for (int pass = 0; pass < 2; ++pass) {
            if (((pass ^ F.c) & 1) == 0) { for (int rp = 1; rp < RP_HM; ++rp) phase_hm_final(F, l, false); if (EN(7)) phase_hm_final(F, l, true); }
            else {
        for (int rp = 0; rp < RP_PB; ++rp) if (EN(8)) {
            pg8::Gemm g{P6 + P_SQ, (const bf16*)wsp(F, WS_BB), 1024, P6W}; pg8::StaticOrder S; S.init(NTOK, 1024, F.G, F.c, F.wave);
            EpiGateT1 E{P6 + P_GB, P6W, (bf16*)wsp(F, WS_VT)};
            pg8::gemm_phase<EpiGateT1, pg8::StaticOrder, true, false>(F.lds, g, S, E);
        }
            }
            RELOAD_IDS();
        }
        PHASE_END();
        for (int rp = 0; rp < RP_PA; ++rp) if (EN(9)) {
            pg8::Gemm g{P6 + P_MQK, (const bf16*)wsp(F, WS_BA), 1024, P6W}; pg8::StaticOrder S; S.init(NTOK, 1024, F.G, F.c, F.wave);
            EpiGateY E{P6 + P_GA, P6W, (const bf16*)wsp(F, WS_VT), R2};
            pg8::gemm_phase<EpiGateY, pg8::StaticOrder, true, false>(F.lds, g, S, E);
        }
        PHASE_END();
        for (int rp = 0; rp < RP_X5; ++rp) if (EN(10)) {
            pg8::Gemm g{R2, (const bf16*)wsp(F, WS_BO), 1024, 1024}; pg8::StaticOrder S; S.init(NTOK, 1024, F.G, F.c, F.wave);
            EpiRes E{(const bf16*)outp(F), xmid(F, l), MODF + (size_t)(l * 4) * 6144 + 2 * 1024, (RP_X5 > 1 && rp + 1 < RP_X5) ? 1 : 0};
            pg8::gemm_phase<EpiRes, pg8::StaticOrder, true, false>(F.lds, g, S, E);
        }
        PHASE_END();
        for (int rp = 0; rp < RP_N2; ++rp) if (EN(11)) phase_norm2_router(F, l, (RP_N2 > 1 && rp == 0) ? N2_SKIP : 0, rp == RP_N2 - 1);
        PHASE_END();
        {
            LAS int* tabE = (LAS int*)(F.lds + LDS_TAB); LAS unsigned* tabTok = (LAS unsigned*)(F.lds + LDS_TAB + 64);
            LAS float* tabW = (LAS float*)(F.lds + LDS_TAB + 64 + 3072);
            LAS unsigned* tot = (LAS unsigned*)(F.lds + LDS_TAB + 64 + 6144); LAS unsigned* padv = tot + 64; LAS unsigned* base = padv + 64;
            const int ntiles = moe_layout(F, l, tot, padv, base);
            const int v = (F.G % 8 == 0) ? (F.c % 8) * (F.G / 8) + F.c / 8 : F.c;
            const int cs = (F.G % 8 == 0) ? (v + F.G / 2) % F.G : F.G - 1 - F.c;
            if (F.tid < 64) {
#pragma unroll
                for (int i = 0; i < 3; ++i) { const unsigned r0 = 256u * (unsigned)(i * F.G + v); if (r0 >= base[F.tid] && r0 < base[F.tid] + padv[F.tid]) tabE[i] = F.tid; }
            }
            __syncthreads();
            if (F.tid < 256) {
                const unsigned* RT = (const unsigned*)wsp(F, WS_RSTOK); const float* RW = (const float*)wsp(F, WS_RSW);
                unsigned tt[3]; float tw[3]; bool ok[3];
#pragma unroll
                for (int i = 0; i < 3; ++i) { const int pm = i * F.G + v; ok[i] = false; tt[i] = 0u; tw[i] = 0.f;
                    if (pm < ntiles) { const int e = tabE[i]; const unsigned rel = 256u * (unsigned)pm - base[e] + (unsigned)F.tid; ok[i] = true;
                        if (rel < tot[e]) { tt[i] = *(const GAS unsigned*)(RT + (size_t)e * RS_CAP + rel); tw[i] = *(const GAS float*)(RW + (size_t)e * RS_CAP + rel); } } }
#pragma unroll
                for (int i = 0; i < 3; ++i) if (ok[i]) { tabTok[i * 256 + F.tid] = tt[i]; tabW[i * 256 + F.tid] = tw[i]; }
            }
            __syncthreads();
            for (int rp = 0; rp < RP_C; ++rp) if (EN(13)) {
                pg8::Gemm g{(const bf16*)wsp(F, WS_R1), (const bf16*)wsp(F, WS_BGU), 1024, 1024}; RoutedOrder S{ntiles, F.G, v, tabE, tabTok, F.wave};
                EpiHid E{R2, 128, tabW, v, F.G, 0};
                pg8::gemm_phase<EpiHid, RoutedOrder, true, true>(F.lds, g, S, E);
            }
            for (int rp = 0; rp < RP_SG; ++rp) if (EN(14)) {
                pg8::Gemm g{(const bf16*)wsp(F, WS_R1), (const bf16*)wsp(F, WS_BSGU), 1024, 1024}; pg8::StaticOrder S; S.init(NTOK, 512, F.G, cs, F.wave);
                EpiHid E{(bf16*)wsp(F, WS_R3), 256, nullptr, 0, 1, 1};
                pg8::gemm_phase<EpiHid, pg8::StaticOrder, true, false>(F.lds, g, S, E);
            }
        }
        PHASE_END();
        {
            LAS int* tabE = (LAS int*)(F.lds + LDS_TAB); LAS unsigned* tabD = (LAS unsigned*)(F.lds + LDS_TAB + 64);
            LAS unsigned* tot = (LAS unsigned*)(F.lds + LDS_TAB + 64 + 10240); LAS unsigned* padv = tot + 64; LAS unsigned* base = padv + 64;
            const int ntiles = moe_layout(F, l, tot, padv, base), nunits = 4 * ntiles;
            const int v = (F.G % 8 == 0) ? (F.c % 8) * (F.G / 8) + F.c / 8 : F.c;
            if (F.tid < 64) {
#pragma unroll
                for (int i = 0; i < 10; ++i) { const int Lu = i * F.G + v; const unsigned r0 = 256u * (unsigned)(Lu >> 2); if (Lu < nunits && r0 >= base[F.tid] && r0 < base[F.tid] + padv[F.tid]) tabE[i] = F.tid; }
            }
            __syncthreads();
            if (F.tid < 256) {
                const unsigned* RD = (const unsigned*)wsp(F, WS_RSDST);
                unsigned td[10]; bool ok[10];
#pragma unroll
                for (int i = 0; i < 10; ++i) { const int Lu = i * F.G + v; ok[i] = Lu < nunits; td[i] = 0xffffffffu;
                    if (ok[i]) { const int e = tabE[i]; const unsigned rel = 256u * (unsigned)(Lu >> 2) - base[e] + (unsigned)F.tid; if (rel < tot[e]) td[i] = *(const GAS unsigned*)(RD + (size_t)e * RS_CAP + rel); } }
#pragma unroll
                for (int i = 0; i < 10; ++i) if (ok[i]) tabD[i * 256 + F.tid] = td[i];
            }
            __syncthreads();
            for (int rp = 0; rp < RP_D; ++rp) if (EN(15)) {
                pg8::Gemm g{R2, (const bf16*)wsp(F, WS_BD), 128, 128}; DownOrder S{nunits, F.G, v, tabE, F.wave};
                EpiScatter E{(bf16*)wsp(F, WS_R1), tabD, v, F.G, (RP_D > 1 && rp > 0) ? 1 : 0};
                pg8::gemm_phase<EpiScatter, DownOrder, true, false>(F.lds, g, S, E);
            }
            for (int rp = 0; rp < RP_SD; ++rp) if (EN(16)) {
                pg8::Gemm g{(const bf16*)wsp(F, WS_R3), (const bf16*)wsp(F, WS_BSD), 256, 256}; pg8::StaticOrder S; S.init(NTOK, 1024, F.G, F.c, F.wave);
                EpiPlain E{(bf16*)wsp(F, WS_R1 + 128 * MiB), 1024};
                pg8::gemm_phase<EpiPlain, pg8::StaticOrder, true, false>(F.lds, g, S, E);
            }
        }
        PHASE_END();
        for (int rp = 1; rp < RP_E; ++rp) phase_combine(F, l, false);
        if (EN(17)) phase_combine(F, l, true);
        if (l + 1 < NLAYER) { RELOAD_IDS(); if (EN(18)) conv_weights(F, l + 1); PHASE_END(); }
    }
#undef P6
#undef VT
#undef R2
#undef MODF
finish:
    if (MK_LAST_PHASE < 1000) dbg_final(F, phase_no >= 8 ? (const float*)outp(F) : inp(F, I_X));
}

extern "C" void kernel_launch(void* const* d_in, const int* in_sizes, int n_in, void* d_out, int out_size, void* d_ws, size_t ws_size, hipStream_t stream) {
    static int grid = 0;
    if (grid == 0) {
        if (n_in != 24 || in_sizes[0] != NTOK * DM || out_size != NTOK * DM || ws_size < WS_END) {
            fprintf(stderr, "kernel_launch: unexpected shapes (n_in %d, in0 %d, out %d, ws %zu < %zu); nothing launched\n", n_in, n_in > 0 ? in_sizes[0] : -1, out_size, ws_size, (size_t)WS_END); grid = -1; return; }
        int dev = 0, cus = 0, per_cu = 0;
        if (hipGetDevice(&dev) != hipSuccess || hipDeviceGetAttribute(&cus, hipDeviceAttributeMultiprocessorCount, dev) != hipSuccess) { grid = -1; return; }
        if (hipFuncSetAttribute((const void*)mk_fwd, hipFuncAttributeMaxDynamicSharedMemorySize, LDS_BYTES) != hipSuccess) { fprintf(stderr, "kernel_launch: hipFuncSetAttribute failed\n"); grid = -1; return; }
        if (hipOccupancyMaxActiveBlocksPerMultiprocessor(&per_cu, (const void*)mk_fwd, 512, LDS_BYTES) != hipSuccess || per_cu < 1)
            fprintf(stderr, "kernel_launch: note: occupancy query reports %d workgroups per CU\n", per_cu);
        (void)hipGetLastError();
        grid = cus;
    }
    if (grid < 0) return;
    if (hipMemsetAsync((char*)d_ws + WS_CTL, 0, CTL_ZERO_BYTES, stream) != hipSuccess) return;
    Args a{};
    for (int i = 0; i < 24; ++i) a.in[i] = (const float*)d_in[i];
    a.out = (float*)d_out; a.ws = (unsigned char*)d_ws;
    hipLaunchKernelGGL(mk_fwd, dim3(grid), dim3(512), LDS_BYTES, stream, a);
}
```

```cpp
#include <hip/hip_runtime.h>
#include <cstdio>
#include <cstdint>
#include <cmath>
namespace pg8 {
#define PG8_LAS __attribute__((address_space(3)))
typedef unsigned short bf16_t;
typedef short bf16x8 __attribute__((ext_vector_type(8)));
typedef float f32x4 __attribute__((ext_vector_type(4)));
typedef unsigned u32x4 __attribute__((ext_vector_type(4)));
constexpr int BM = 256, BK = 64, HALF = 128, HTB = HALF * BK * 2  , STAGE_BYTES = 8 * HTB, NXCD = 8, WGM = 8;

__host__ __device__ __forceinline__ int lds_byte(int r, int c) { const int st = (r >> 4) * 2 + (c >> 5), rr = r & 15, cc = c & 31, ob = rr * 64 + cc * 2; return st * 1024 + (ob ^ (((ob >> 9) & 1) << 5)); }
__host__ __device__ __forceinline__ void stage_rc(int b, int& R, int& C) { const int st = b / 1024, sb = b % 1024, swz = sb ^ (((sb >> 9) & 1) << 5); R = (st >> 1) * 16 + swz / 64; C = (st & 1) * 32 + (swz % 64) / 2; }
__host__ __device__ __forceinline__ int perm32(int rho) { const int n = rho >> 4, i = rho & 15; return 8 * (i >> 2) + 4 * n + (i & 3); }

struct Unit { int pm, pn; };
struct Gemm { const bf16_t* A; const bf16_t* Bt; int K; int lda; };

struct StaticOrder {
    int nM, nN, nwg, G, c, wave;
    __device__ void init(int M, int N, int G_, int c_, int wave_) { nM = M / BM; nN = N / BM; nwg = nM * nN; G = G_; c = c_; wave = wave_; }
    __device__ bool next(int i, Unit& u) const {
        const long L = (long)i * G + c; if (L >= nwg) return false;
        int wgid = (int)L; { const int q = nwg / NXCD, r = nwg % NXCD, xcd = wgid % NXCD, off = wgid / NXCD; wgid = (xcd < r ? xcd * (q + 1) : r * (q + 1) + (xcd - r) * q) + off; }
        const int nig = WGM * nN, gid = wgid / nig, fm = gid * WGM, gsz = (nM - fm) < WGM ? (nM - fm) : WGM;
        u.pm = fm + ((wgid % nig) % gsz); u.pn = (wgid % nig) / gsz; return true;
    }
    __device__ __forceinline__ unsigned rowtok(int, int) const { return 0u; }
    __device__ __forceinline__ size_t aoff(const Unit&) const { return 0; }
};

template <class Epi, class Sched, bool ALIGN_EPI, bool GATHER>
__device__ __forceinline__ void gemm_phase(PG8_LAS unsigned char* lds, const Gemm g, const Sched& S, const Epi& E) {
    int lane_; asm volatile("v_mbcnt_lo_u32_b32 %0, -1, 0\n\tv_mbcnt_hi_u32_b32 %0, -1, %0" : "=v"(lane_));
    const int wid = S.wave, lane = lane_, tid = wid * 64 + lane, wr = wid >> 2, wc = wid & 3, fr = lane & 15, fq = lane >> 4;
    int K_ = g.K, lda_ = g.lda; asm volatile("" : "+s"(K_), "+s"(lda_));
    const int K = K_, nt = K / BK, lda = lda_;
    unsigned vA[2][2], voffB[2];
#pragma unroll
    for (int i = 0; i < 2; ++i) { int R, C; stage_rc(tid * 16 + i * 8192, R, C); const int Rb = Epi::PERM ? ((R & ~31) + perm32(R & 31)) : R;
        voffB[i] = (unsigned)(Rb * K + C) * 2u;
#pragma unroll
        for (int h = 0; h < 2; ++h) vA[h][i] = (unsigned)(((GATHER ? h * HALF : 0) + R) * lda + C) * 2u; }
    const size_t kstep = (size_t)(BK * 2);
    const size_t hstepB = (size_t)HALF * K * 2, tstepB = 2 * hstepB;
    const size_t tstepA = (size_t)BM * lda * 2, hstepA = (size_t)HALF * lda * 2;
    const unsigned ldsw = (unsigned)wid * 1024u;
    const int aoff = lds_byte(wr * 64 + fr, fq * 8), boff = lds_byte(wc * 32 + fr, fq * 8);
#define PG8_SA(b, h) (((b) * 2 + (h)) * HTB)
#define PG8_SB(b, h) ((4 + (b) * 2 + (h)) * HTB)
#define PG8_STAGE(bufoff, gbase, voff) do { _Pragma("unroll") for (int _i = 0; _i < 2; ++_i) \
        __builtin_amdgcn_global_load_lds((const unsigned*)((const char*)(gbase) + (voff)[_i]), (PG8_LAS unsigned*)(lds + (bufoff) + ldsw + _i * 8192), 16, 0, 0); } while (0)
#define PG8_GATHER_SET(ui_, h) do { int l2_; asm volatile("v_mbcnt_lo_u32_b32 %0, -1, 0\n\tv_mbcnt_hi_u32_b32 %0, -1, %0" : "=v"(l2_)); const int tid2_ = wid * 64 + l2_; _Pragma("unroll") for (int _i = 0; _i < 2; ++_i) { int R_, C_; stage_rc(tid2_ * 16 + _i * 8192, R_, C_); vA[h][_i] = (S.rowtok((ui_), (h) * HALF + R_) * (unsigned)lda + (unsigned)C_) * 2u; } } while (0)
#define PG8_STAGE_A(bufoff, gbase, h, NX) do { _Pragma("unroll") for (int _i = 0; _i < 2; ++_i) { const unsigned _v = GATHER ? vA[h][_i] : vA[0][_i]; \
        __builtin_amdgcn_global_load_lds((const unsigned*)((const char*)(gbase) + (GATHER ? (size_t)0 : (size_t)(h) * hstepA) + _v), (PG8_LAS unsigned*)(lds + (bufoff) + ldsw + _i * 8192), 16, 0, 0); } } while (0)
#define PG8_LDA(dst, b, h) do { _Pragma("unroll") for (int m = 0; m < 4; ++m) _Pragma("unroll") for (int k = 0; k < 2; ++k) dst[m][k] = *(const PG8_LAS bf16x8*)(lds + PG8_SA(b, h) + aoff + m * 2048 + k * 1024); } while (0)
#define PG8_LDB(dst, b, h) do { _Pragma("unroll") for (int n = 0; n < 2; ++n) _Pragma("unroll") for (int k = 0; k < 2; ++k) dst[n][k] = *(const PG8_LAS bf16x8*)(lds + PG8_SB(b, h) + boff + n * 2048 + k * 1024); } while (0)
#define PG8_MMA(ai, bj, At, Bt) do { __builtin_amdgcn_s_setprio(1); _Pragma("unroll") for (int m = 0; m < 4; ++m) _Pragma("unroll") for (int n = 0; n < 2; ++n) _Pragma("unroll") for (int k = 0; k < 2; ++k) \
        acc[ai][bj][m][n] = __builtin_amdgcn_mfma_f32_16x16x32_bf16(Bt[n][k], At[m][k], acc[ai][bj][m][n], 0, 0, 0); __builtin_amdgcn_s_setprio(0); } while (0)
#define PG8_WAIT_V(n) asm volatile("s_waitcnt vmcnt(" #n ")" ::: "memory")
#define PG8_WAIT_L(n) asm volatile("s_waitcnt lgkmcnt(" #n ")" ::: "memory")
#define PG8_BAR __builtin_amdgcn_s_barrier()
#define PG8_SCHED __builtin_amdgcn_sched_barrier(0)
    Unit cur, nxt; int ui = 0;
    if (!S.next(0, cur)) return;
    if constexpr (GATHER) { PG8_GATHER_SET(0, 0); PG8_GATHER_SET(0, 1); }
    f32x4 acc[2][2][4][2];
#pragma unroll
    for (int a = 0; a < 2; ++a)
#pragma unroll
        for (int b = 0; b < 2; ++b)
#pragma unroll
            for (int m = 0; m < 4; ++m)
#pragma unroll
                for (int n = 0; n < 2; ++n) acc[a][b][m][n] = (f32x4){0.f, 0.f, 0.f, 0.f};
    bf16x8 At[4][2], B0[2][2], B1[2][2];
    const char* cA = (const char*)g.A + (GATHER ? (size_t)0 : (size_t)cur.pm * tstepA + S.aoff(cur)); const char* cB = (const char*)g.Bt + (size_t)cur.pn * tstepB;
    PG8_STAGE(PG8_SB(0, 0), cB, voffB); PG8_STAGE(PG8_SB(0, 1), cB + hstepB, voffB); PG8_STAGE_A(PG8_SA(0, 0), cA, 0, false); PG8_STAGE_A(PG8_SA(0, 1), cA, 1, false);
    if (wr == 1) PG8_BAR;
    PG8_WAIT_V(2); PG8_BAR;
    PG8_STAGE(PG8_SB(1, 0), cB + kstep, voffB); PG8_STAGE_A(PG8_SA(1, 0), cA + kstep, 0, false); PG8_STAGE(PG8_SB(1, 1), cB + hstepB + kstep, voffB);
    PG8_WAIT_V(6); PG8_BAR;
    for (;;) {
        const bool has_next = S.next(ui + 1, nxt);
        const char* nA = (has_next && !GATHER) ? (const char*)g.A + (size_t)nxt.pm * tstepA + S.aoff(nxt) : (GATHER ? (const char*)g.A : cA);
        const char* nB = has_next ? (const char*)g.Bt + (size_t)nxt.pn * tstepB : cB;
        for (int t = 0; t < nt; t += 2) {
            const bool last = (t == nt - 2);
            const char* a1 = cA + (size_t)(t + 1) * kstep;
            const char* a2 = last ? nA : cA + (size_t)(t + 2) * kstep; const char* b2 = last ? nB : cB + (size_t)(t + 2) * kstep;
            const char* a3 = a2 + kstep; const char* b3 = b2 + kstep;
            if constexpr (GATHER) { if (last && has_next) PG8_GATHER_SET(ui + 1, 0); }
            PG8_LDB(B0, 0, 0); PG8_LDB(B1, 0, 1); PG8_SCHED; PG8_LDA(At, 0, 0); PG8_STAGE_A(PG8_SA(1, 1), a1, 1, false);
            if constexpr (GATHER) { if (last && has_next) PG8_GATHER_SET(ui + 1, 1); }
            PG8_WAIT_V(8); PG8_WAIT_L(0); PG8_BAR; PG8_MMA(0, 0, At, B0); PG8_MMA(0, 1, At, B1); PG8_BAR; PG8_SCHED;
            PG8_LDA(At, 0, 1); PG8_STAGE(PG8_SB(0, 0), b2, voffB); PG8_STAGE(PG8_SB(0, 1), b2 + hstepB, voffB); PG8_STAGE_A(PG8_SA(0, 0), a2, 0, last);
            PG8_WAIT_V(8); PG8_WAIT_L(0); PG8_BAR; PG8_MMA(1, 0, At, B0); PG8_MMA(1, 1, At, B1); PG8_BAR; PG8_SCHED;
            PG8_LDB(B0, 1, 0); PG8_LDB(B1, 1, 1); PG8_SCHED; PG8_LDA(At, 1, 0); PG8_STAGE_A(PG8_SA(0, 1), a2, 1, last);
            PG8_WAIT_V(8); PG8_WAIT_L(0); PG8_BAR; PG8_MMA(0, 0, At, B0); PG8_MMA(0, 1, At, B1); PG8_BAR; PG8_SCHED;
            PG8_LDA(At, 1, 1); PG8_STAGE(PG8_SB(1, 0), b3, voffB); PG8_STAGE(PG8_SB(1, 1), b3 + hstepB, voffB); PG8_STAGE_A(PG8_SA(1, 0), a3, 0, last);
            PG8_WAIT_V(8); PG8_WAIT_L(0); PG8_BAR; PG8_MMA(1, 0, At, B0); PG8_MMA(1, 1, At, B1); PG8_BAR; PG8_SCHED;
        }
        if constexpr (ALIGN_EPI) { if (wr == 0) PG8_BAR; }
        { Unit eu; eu.pm = __builtin_amdgcn_readfirstlane(cur.pm); eu.pn = __builtin_amdgcn_readfirstlane(cur.pn); int fr_ = fr, fq_ = fq; asm volatile("" : "+s"(eu.pm), "+s"(eu.pn), "+v"(fr_), "+v"(fq_));
          E(acc, eu, wr, wc, fr_, fq_); }
        if (!has_next) break;
#pragma unroll
        for (int a = 0; a < 2; ++a)
#pragma unroll
            for (int b = 0; b < 2; ++b)
#pragma unroll
                for (int m = 0; m < 4; ++m)
#pragma unroll
                    for (int n = 0; n < 2; ++n) acc[a][b][m][n] = (f32x4){0.f, 0.f, 0.f, 0.f};
        cur = nxt; cA = nA; cB = nB; ++ui;
        if constexpr (ALIGN_EPI) { if (wr == 1) PG8_BAR; }
    }
    PG8_WAIT_V(0);
    if constexpr (!ALIGN_EPI) { if (wr == 0) PG8_BAR; }
    PG8_BAR;
#undef PG8_SA
#undef PG8_SB
#undef PG8_STAGE
#undef PG8_STAGE_A
#undef PG8_GATHER_SET
#undef PG8_LDA
#undef PG8_LDB
#undef PG8_MMA
#undef PG8_WAIT_V
#undef PG8_WAIT_L
#undef PG8_BAR
#undef PG8_SCHED
}
}

constexpr int NTOK = 16384, DM = 1024, SEQ = 4096, NB = 4, NLAYER = 2;
constexpr int INW = 8200;
constexpr int C_MQK = 0, C_MV = 1024, C_MO = 2048, C_MI = 3072, C_MF = 3076, C_SQ = 3080, C_SK = 4104, C_SV = 5128, C_GA = 6152, C_GB = 7176;
constexpr int P6N = 6144;
constexpr int P6W = 1024;
constexpr int P_BLK = 16384 * 1024;
constexpr int P_MQK = 0, P_MO = 1 * P_BLK, P_SQ = 2 * P_BLK, P_SK = 3 * P_BLK, P_GA = 4 * P_BLK, P_GB = 5 * P_BLK;
constexpr int NEXP = 64, EFF = 128, SFF = 256, TOPK = 8;
constexpr int MAXROWS = NTOK * TOPK + NEXP * 256;
constexpr int MAXTILES = MAXROWS / 256;
constexpr float EPS = 1e-6f;
constexpr float LOG2E = 1.4426950408889634f;

constexpr size_t MiB = 1u << 20;
constexpr size_t WS_CTL = 0, CTL_BAR_BYTES = 3456 * 4, WS_CUR = CTL_BAR_BYTES, CTL_ZERO_BYTES = CTL_BAR_BYTES + 512;
constexpr size_t WS_MODP = 1 * MiB;
constexpr size_t WS_MODF = 4 * MiB;
constexpr size_t WS_GATES = WS_MODF + 256 * 1024;
constexpr size_t WS_TOPE = WS_GATES + 512 * 1024;
constexpr size_t WS_TOPW = WS_TOPE + 512 * 1024;
constexpr size_t WS_CNT = WS_TOPW + 512 * 1024;
constexpr size_t WS_STOK = WS_CNT + 64 * 1024;
constexpr size_t WS_SW = WS_STOK + 576 * 1024;
constexpr size_t WS_SDST = WS_SW + 576 * 1024;
constexpr size_t WS_TILEE = WS_SDST + 576 * 1024;
constexpr size_t WS_MISC_END = WS_TILEE + 4096;
static_assert(WS_MISC_END <= 8 * MiB, "misc region");
constexpr size_t WS_BIN = 8 * MiB;
constexpr size_t WS_AIN = WS_BIN + 12 * MiB;
constexpr size_t WS_BA = WS_AIN + 4 * MiB, WS_BB = WS_BA + 2 * MiB, WS_BO = WS_BB + 2 * MiB;
constexpr size_t WS_BGU = WS_BO + 2 * MiB;
constexpr size_t WS_BD = WS_BGU + 32 * MiB;
constexpr size_t WS_BSGU = WS_BD + 16 * MiB;
constexpr size_t WS_BSD = WS_BSGU + 1 * MiB;
constexpr size_t WS_W_END = WS_BSD + 1 * MiB;
constexpr size_t WS_R1 = 80 * MiB;
constexpr size_t WS_P6 = WS_R1, WS_VT = WS_R1 + 192 * MiB;
constexpr size_t WS_R2 = WS_R1 + 256 * MiB;
constexpr size_t WS_R3 = WS_R2 + 36 * MiB;
constexpr size_t WS_PT = WS_R3 + 8 * MiB;
constexpr size_t WS_END = WS_PT + 18 * MiB;
constexpr int RS_CAP = 16384;
constexpr size_t WS_RSTOK = WS_PT, WS_RSW = WS_PT + 4 * MiB, WS_RSDST = WS_PT + 8 * MiB;
static_assert(WS_W_END <= WS_R1, "weights region");
constexpr int CW_BAR = 0;

constexpr int LDS_BYTES = 147456;
constexpr int LDS_MAIN = 131072;
constexpr int LDS_TAB = 131072;
constexpr int LDS_CTL = LDS_BYTES - 512;

#define GAS __attribute__((address_space(1)))
#define LAS __attribute__((address_space(3)))
typedef unsigned short bf16;
typedef unsigned v4u __attribute__((ext_vector_type(4)));
typedef unsigned v2u __attribute__((ext_vector_type(2)));
typedef float f32x4 __attribute__((ext_vector_type(4)));
typedef float f32x16 __attribute__((ext_vector_type(16)));
typedef short bf16x8 __attribute__((ext_vector_type(8)));
typedef short s16x4 __attribute__((ext_vector_type(4)));
typedef GAS unsigned gu32;
#define RLX_AGENT __ATOMIC_RELAXED, __HIP_MEMORY_SCOPE_AGENT
#define LDS_WAIT() asm volatile("s_waitcnt lgkmcnt(0)" ::: "memory")
typedef float f32x2_t __attribute__((ext_vector_type(2))); typedef __bf16 bf16x2_t __attribute__((ext_vector_type(2)));
__device__ __forceinline__ unsigned pk2(float lo, float hi) { f32x2_t v = {lo, hi}; bf16x2_t b = __builtin_convertvector(v, bf16x2_t); return __builtin_bit_cast(unsigned, b); }
__device__ __forceinline__ unsigned short f2bf(float f) { return (unsigned short)(pk2(f, 0.f) & 0xffffu); }
__device__ __forceinline__ float bflo(unsigned w) { return __uint_as_float(w << 16); }
__device__ __forceinline__ float bfhi(unsigned w) { return __uint_as_float(w & 0xffff0000u); }
__device__ __forceinline__ float bf2f(unsigned short h) { return __uint_as_float((unsigned)h << 16); }
__device__ __forceinline__ float sigmoidf_(float x) { return __builtin_amdgcn_rcpf(1.f + __builtin_amdgcn_exp2f(-x * LOG2E)); }
__device__ __forceinline__ int crow(int r, int hi) { return (r & 3) + 8 * (r >> 2) + 4 * hi; }
__device__ __forceinline__ int lane_now() { int l; asm volatile("v_mbcnt_lo_u32_b32 %0, -1, 0\n\tv_mbcnt_hi_u32_b32 %0, -1, %0" : "=v"(l)); return l; }
__device__ __forceinline__ float shfl_xor_l(float v, int d, int lane) { return __int_as_float(__builtin_amdgcn_ds_bpermute((lane ^ d) << 2, __float_as_int(v))); }
__device__ __forceinline__ float shfl_up_l(float v, int d, int lane) { return __int_as_float(__builtin_amdgcn_ds_bpermute(((lane - d) & 63) << 2, __float_as_int(v))); }
__device__ __forceinline__ unsigned umax_(unsigned a, unsigned b) { return a > b ? a : b; }
__device__ __forceinline__ unsigned wave_umax_all(unsigned v) {
    v = umax_(v, (unsigned)__builtin_amdgcn_update_dpp(0, (int)v, 0x128, 0xf, 0xf, false));
    v = umax_(v, (unsigned)__builtin_amdgcn_update_dpp(0, (int)v, 0x124, 0xf, 0xf, false));
    v = umax_(v, (unsigned)__builtin_amdgcn_update_dpp(0, (int)v, 0x122, 0xf, 0xf, false));
    v = umax_(v, (unsigned)__builtin_amdgcn_update_dpp(0, (int)v, 0x121, 0xf, 0xf, false));
    { auto rr = __builtin_amdgcn_permlane16_swap(v, v, false, false); v = umax_(rr[0], rr[1]); }
    { auto rr = __builtin_amdgcn_permlane32_swap(v, v, false, false); v = umax_(rr[0], rr[1]); }
    return v;
}
__device__ __forceinline__ float half_sum32(float v) {
    v += __int_as_float(__builtin_amdgcn_update_dpp(0, __float_as_int(v), 0x128, 0xf, 0xf, false));
    v += __int_as_float(__builtin_amdgcn_update_dpp(0, __float_as_int(v), 0x124, 0xf, 0xf, false));
    v += __int_as_float(__builtin_amdgcn_update_dpp(0, __float_as_int(v), 0x122, 0xf, 0xf, false));
    v += __int_as_float(__builtin_amdgcn_update_dpp(0, __float_as_int(v), 0x121, 0xf, 0xf, false));
    { auto rr = __builtin_amdgcn_permlane16_swap(__float_as_uint(v), __float_as_uint(v), false, false); v = __uint_as_float(rr[0]) + __uint_as_float(rr[1]); }
    return v;
}
__device__ __forceinline__ float wave_sum(float v, int lane) {
#pragma unroll
    for (int o = 1; o < 64; o <<= 1) v += shfl_xor_l(v, o, lane);
    return v;
}

#define XB_TMO      128
#define XB_XCNT(j)  (256  + 64 * (j))
#define XB_XSUB(j)  (1280 + 64 * (j))
#define XB_XGEN(j)  (2304 + 64 * (j))
#define XB_TOP      3328
#define XB_TOPGEN   3392
#define XCD_BAR_WORDS 3456
#define XB_SPIN_CAP (1u << 18)
__device__ __forceinline__ unsigned xb_ld(unsigned* p)              { return __hip_atomic_load(p, __ATOMIC_RELAXED, __HIP_MEMORY_SCOPE_AGENT); }
__device__ __forceinline__ unsigned xb_add(unsigned* p, unsigned v) { return __hip_atomic_fetch_add(p, v, __ATOMIC_RELAXED, __HIP_MEMORY_SCOPE_AGENT); }
__device__ __forceinline__ unsigned xb_xcc_id() { return (unsigned)__builtin_amdgcn_s_getreg((3 << 11) | 20) & 0xFu; }
#define XB_SPIN(cond, bar) do { unsigned _sp = 0; while (cond) { __builtin_amdgcn_s_sleep(1); \
    if ((++_sp & 255u) == 0u) { if (xb_ld(&(bar)[XB_TMO])) break; if (_sp > XB_SPIN_CAP) { atomicAdd(&(bar)[XB_TMO], 1u); break; } } } } while (0)
struct XcdBarrier { unsigned* bar; unsigned x; volatile LAS unsigned* st; };
__device__ __forceinline__ XcdBarrier xcd_barrier_post(unsigned* bar, volatile LAS unsigned* st) {
    XcdBarrier b; b.bar = bar; b.x = xb_xcc_id(); b.st = st;
    if (threadIdx.x == 0) (void)xb_add(&bar[XB_XCNT(b.x)], 1u);
    return b;
}
__device__ __forceinline__ void xcd_barrier_complete(unsigned* bar, unsigned x, unsigned& nloc, unsigned& nx) {
    const unsigned G = gridDim.x * gridDim.y * gridDim.z;
    unsigned sum, cnt, mine, sp = 0u;
    for (;;) {
        sum = 0u; cnt = 0u; mine = 0u;
#pragma unroll
        for (unsigned j = 0; j < 16; ++j) { const unsigned c = xb_ld(&bar[XB_XCNT(j)]); sum += c; cnt += (c > 0u) ? 1u : 0u; mine = (j == x) ? c : mine; }
        if (sum == G) break;
        __builtin_amdgcn_s_sleep(1);
        if ((++sp & 255u) == 0u) { if (xb_ld(&bar[XB_TMO])) break; if (sp > XB_SPIN_CAP) { atomicAdd(&bar[XB_TMO], 1u); break; } }
    }
    nloc = mine > 0u ? mine : 1u; nx = cnt > 0u ? cnt : 1u;
}
__device__ __forceinline__ void xcd_barrier(const XcdBarrier& b) {
    asm volatile("s_waitcnt vmcnt(0)" ::: "memory");
    __syncthreads();
    if (threadIdx.x == 0) {
        unsigned* bar = b.bar;
        __builtin_amdgcn_s_waitcnt(0);
        unsigned nloc = b.st[0], nx = b.st[1];
        if (nloc == 0u) { xcd_barrier_complete(bar, b.x, nloc, nx); b.st[0] = nloc; b.st[1] = nx; }
        const unsigned old = xb_add(&bar[XB_XSUB(b.x)], 1u);
        const unsigned gen = old / nloc;
        if (old + 1u == (gen + 1u) * nloc) {
            __builtin_amdgcn_fence(__ATOMIC_RELEASE, "agent");
            asm volatile("s_waitcnt vmcnt(0)" ::: "memory");
            const unsigned og = xb_add(&bar[XB_TOP], 1u);
            const unsigned tg = og / nx;
            if (og + 1u == (tg + 1u) * nx) xb_add(&bar[XB_TOPGEN], 1u);
            else XB_SPIN(xb_ld(&bar[XB_TOPGEN]) == tg, bar);
            __builtin_amdgcn_fence(__ATOMIC_ACQUIRE, "agent");
            xb_add(&bar[XB_XGEN(b.x)], 1u);
            asm volatile("s_waitcnt vmcnt(0)" ::: "memory");
        } else {
            XB_SPIN(xb_ld(&bar[XB_XGEN(b.x)]) == gen, bar);
            __builtin_amdgcn_fence(__ATOMIC_ACQUIRE, "agent");
            asm volatile("s_waitcnt vmcnt(0)" ::: "memory");
        }
    }
    __syncthreads();
}

struct Frame {
    LAS unsigned char* lds;
    int tid, lane, wave, G, c;
    float* out; unsigned char* ws;
};
__device__ __forceinline__ unsigned char* wsp(const Frame& F, size_t off) { unsigned char* p = F.ws; asm volatile("" : "+s"(p)); return (unsigned char*)(GAS unsigned char*)(p + off); }
__device__ __forceinline__ float* outp(const Frame& F) { float* p = F.out; asm volatile("" : "+s"(p)); return (float*)(GAS float*)p; }
__device__ __forceinline__ const float* inp(const Frame& F, int i) {
    const LAS unsigned* p = (const LAS unsigned*)(F.lds + LDS_CTL + 64) + 2 * i;
    const unsigned lo = __builtin_amdgcn_readfirstlane(p[0]), hi = __builtin_amdgcn_readfirstlane(p[1]);
    return (const float*)(const GAS float*)(((unsigned long long)hi << 32) | lo);
}
__device__ __forceinline__ bf16* xmid(const Frame& F, int l) { return (l == NLAYER - 1) ? (bf16*)wsp(F, WS_VT) : (bf16*)outp(F); }
enum { I_X = 0, I_C, I_ADAW, I_ADAB, I_N1W, I_WIN, I_CONVW, I_CONVB, I_IGB, I_FGB, I_MNW, I_WPA, I_WPB, I_WOUT, I_N2W, I_RW, I_RB, I_WG, I_WU, I_WD, I_SG, I_SU, I_SD, I_FNW };

#define EPI_LOOP_BEGIN \
    _Pragma("unroll") for (int ai = 0; ai < 2; ++ai) _Pragma("unroll") for (int m = 0; m < 4; ++m) { const int rl = ai * 128 + wr * 64 + m * 16 + fr; (void)rl; \
    _Pragma("unroll") for (int bj = 0; bj < 2; ++bj) { const int cl = bj * 128 + wc * 32 + 8 * fq; (void)cl; const pg8::f32x4 v0 = acc[ai][bj][m][0], v1 = acc[ai][bj][m][1];
#define EPI_LOOP_END } }

struct EpiP6 {
    static constexpr bool PERM = true;
    bf16* O;
    __device__ __forceinline__ void operator()(const pg8::f32x4 (&acc)[2][2][4][2], const pg8::Unit& u, int wr, int wc, int fr, int fq) const {
        bf16* Ob = O + (size_t)(u.pn >> 2) * P_BLK + (u.pn & 3) * 256;
        EPI_LOOP_BEGIN
            v4u w; w.x = pk2(v0[0], v0[1]); w.y = pk2(v0[2], v0[3]); w.z = pk2(v1[0], v1[1]); w.w = pk2(v1[2], v1[3]);
            *(GAS v4u*)(Ob + (size_t)(u.pm * 256 + rl) * P6W + cl) = w;
        EPI_LOOP_END
    }
};
struct EpiPlain {
    static constexpr bool PERM = true;
    bf16* O; int ldc;
    __device__ __forceinline__ void operator()(const pg8::f32x4 (&acc)[2][2][4][2], const pg8::Unit& u, int wr, int wc, int fr, int fq) const {
        EPI_LOOP_BEGIN
            v4u w; w.x = pk2(v0[0], v0[1]); w.y = pk2(v0[2], v0[3]); w.z = pk2(v1[0], v1[1]); w.w = pk2(v1[2], v1[3]);
            *(GAS v4u*)(O + (size_t)(u.pm * 256 + rl) * ldc + u.pn * 256 + cl) = w;
        EPI_LOOP_END
    }
};
#define SG8(q_, v0_, v1_, o0_, o1_, OP) do { \
        o0_[0] = OP(sigmoidf_(bflo(q_.x)) * v0_[0], 0); o0_[1] = OP(sigmoidf_(bfhi(q_.x)) * v0_[1], 1); o0_[2] = OP(sigmoidf_(bflo(q_.y)) * v0_[2], 2); o0_[3] = OP(sigmoidf_(bfhi(q_.y)) * v0_[3], 3); \
        o1_[0] = OP(sigmoidf_(bflo(q_.z)) * v1_[0], 4); o1_[1] = OP(sigmoidf_(bfhi(q_.z)) * v1_[1], 5); o1_[2] = OP(sigmoidf_(bflo(q_.w)) * v1_[2], 6); o1_[3] = OP(sigmoidf_(bfhi(q_.w)) * v1_[3], 7); } while (0)
struct EpiGateT1 {
    static constexpr bool PERM = true;
    const bf16* Gt; int gld; bf16* T1;
    __device__ __forceinline__ void operator()(const pg8::f32x4 (&acc)[2][2][4][2], const pg8::Unit& u, int wr, int wc, int fr, int fq) const {
#pragma unroll
        for (int ai = 0; ai < 2; ++ai) {
            v4u gq[4][2];
#pragma unroll
            for (int m = 0; m < 4; ++m)
#pragma unroll
                for (int bj = 0; bj < 2; ++bj) { const size_t row = (size_t)(u.pm * 256 + ai * 128 + wr * 64 + m * 16 + fr); const int col = u.pn * 256 + bj * 128 + wc * 32 + 8 * fq; gq[m][bj] = *(const GAS v4u*)(Gt + row * gld + col); }
#pragma unroll
            for (int m = 0; m < 4; ++m)
#pragma unroll
                for (int bj = 0; bj < 2; ++bj) { const size_t row = (size_t)(u.pm * 256 + ai * 128 + wr * 64 + m * 16 + fr); const int col = u.pn * 256 + bj * 128 + wc * 32 + 8 * fq;
                    const pg8::f32x4 v0 = acc[ai][bj][m][0], v1 = acc[ai][bj][m][1]; f32x4 o0, o1;
#define OPN(x_, i_) (x_)
                    SG8(gq[m][bj], v0, v1, o0, o1, OPN);
#undef OPN
                    v4u tw; tw.x = pk2(o0[0], o0[1]); tw.y = pk2(o0[2], o0[3]); tw.z = pk2(o1[0], o1[1]); tw.w = pk2(o1[2], o1[3]);
                    *(GAS v4u*)(T1 + row * 1024 + col) = tw; }
        }
    }
};
struct EpiGateY {
    static constexpr bool PERM = true;
    const bf16* Gt; int gld; const bf16* T1; bf16* Y;
    __device__ __forceinline__ void operator()(const pg8::f32x4 (&acc)[2][2][4][2], const pg8::Unit& u, int wr, int wc, int fr, int fq) const {
#pragma unroll
        for (int ai = 0; ai < 2; ++ai) {
            v4u gq[4][2], tq[4][2];
#pragma unroll
            for (int m = 0; m < 4; ++m)
#pragma unroll
                for (int bj = 0; bj < 2; ++bj) { const size_t row = (size_t)(u.pm * 256 + ai * 128 + wr * 64 + m * 16 + fr); const int col = u.pn * 256 + bj * 128 + wc * 32 + 8 * fq;
                    gq[m][bj] = *(const GAS v4u*)(Gt + row * gld + col); tq[m][bj] = *(const GAS v4u*)(T1 + row * 1024 + col); }
#pragma unroll
            for (int m = 0; m < 4; ++m)
#pragma unroll
                for (int bj = 0; bj < 2; ++bj) { const size_t row = (size_t)(u.pm * 256 + ai * 128 + wr * 64 + m * 16 + fr); const int col = u.pn * 256 + bj * 128 + wc * 32 + 8 * fq;
                    const pg8::f32x4 v0 = acc[ai][bj][m][0], v1 = acc[ai][bj][m][1]; f32x4 o0, o1;
                    const v4u t4 = tq[m][bj]; const float tt[8] = {bflo(t4.x), bfhi(t4.x), bflo(t4.y), bfhi(t4.y), bflo(t4.z), bfhi(t4.z), bflo(t4.w), bfhi(t4.w)};
#define OPT(x_, i_) (tt[i_] + (x_))
                    SG8(gq[m][bj], v0, v1, o0, o1, OPT);
#undef OPT
                    v4u w; w.x = pk2(o0[0], o0[1]); w.y = pk2(o0[2], o0[3]); w.z = pk2(o1[0], o1[1]); w.w = pk2(o1[2], o1[3]);
                    *(GAS v4u*)(Y + row * 1024 + col) = w; }
        }
    }
};
#undef SG8
struct PairOrder {
    pg8::StaticOrder so; size_t acol_b; int wave;
    __device__ __forceinline__ bool next(int i, pg8::Unit& u) const { pg8::Unit t; if (!so.next(i >> 1, t)) return false; u.pm = t.pm; u.pn = t.pn + ((i & 1) ? 0 : 4); return true; }
    __device__ __forceinline__ unsigned rowtok(int, int) const { return 0u; }
    __device__ __forceinline__ size_t aoff(const pg8::Unit& u) const { return u.pn >= 4 ? acol_b : (size_t)0; }
};
struct EpiPair {
    static constexpr bool PERM = true;
    EpiGateT1 e1; EpiGateY e2;
    __device__ __forceinline__ void operator()(const pg8::f32x4 (&acc)[2][2][4][2], const pg8::Unit& u, int wr, int wc, int fr, int fq) const {
        if (u.pn >= 4) { pg8::Unit t; t.pm = u.pm; t.pn = u.pn - 4; e1(acc, t, wr, wc, fr, fq); }
        else { asm volatile("s_waitcnt vmcnt(0)" ::: "memory"); e2(acc, u, wr, wc, fr, fq); }
    }
};
struct EpiRes {
    static constexpr bool PERM = true;
    const bf16* xin; bf16* out; const float* gv; int nostore;
    __device__ __forceinline__ void operator()(const pg8::f32x4 (&acc)[2][2][4][2], const pg8::Unit& u, int wr, int wc, int fr, int fq) const {
        const float* gb = gv + (size_t)(u.pm >> 4) * 6144;
        f32x4 g0[2], g1[2];
#pragma unroll
        for (int bj = 0; bj < 2; ++bj) { const int col = u.pn * 256 + bj * 128 + wc * 32 + 8 * fq; g0[bj] = *(const GAS f32x4*)(gb + col); g1[bj] = *(const GAS f32x4*)(gb + col + 4); }
#pragma unroll
        for (int ai = 0; ai < 2; ++ai)
#pragma unroll
            for (int mh = 0; mh < 2; ++mh) {
                v4u xb[2][2];
#pragma unroll
                for (int mm = 0; mm < 2; ++mm)
#pragma unroll
                    for (int bj = 0; bj < 2; ++bj) { const size_t row = (size_t)(u.pm * 256 + ai * 128 + wr * 64 + (2 * mh + mm) * 16 + fr); const int col = u.pn * 256 + bj * 128 + wc * 32 + 8 * fq;
                        xb[mm][bj] = *(const GAS v4u*)(xin + row * 1024 + col); }
#pragma unroll
                for (int mm = 0; mm < 2; ++mm)
#pragma unroll
                    for (int bj = 0; bj < 2; ++bj) { const int m = 2 * mh + mm; const size_t row = (size_t)(u.pm * 256 + ai * 128 + wr * 64 + m * 16 + fr); const int col = u.pn * 256 + bj * 128 + wc * 32 + 8 * fq;
                        const v4u x = xb[mm][bj]; const f32x4 a0 = acc[ai][bj][m][0], a1 = acc[ai][bj][m][1];
                        v4u o;
                        o.x = pk2(bflo(x.x) + g0[bj][0] * a0[0], bfhi(x.x) + g0[bj][1] * a0[1]); o.y = pk2(bflo(x.y) + g0[bj][2] * a0[2], bfhi(x.y) + g0[bj][3] * a0[3]);
                        o.z = pk2(bflo(x.z) + g1[bj][0] * a1[0], bfhi(x.z) + g1[bj][1] * a1[1]); o.w = pk2(bflo(x.w) + g1[bj][2] * a1[2], bfhi(x.w) + g1[bj][3] * a1[3]);
                        if (nostore) { asm volatile("" :: "v"(o)); } else { *(GAS v4u*)(out + row * 1024 + col) = o; } }
            }
    }
};
struct EpiHid {
    static constexpr bool PERM = true;
    bf16* O; int ldo; const LAS float* roww; int ubase; int ustride; int shared;
    __device__ __forceinline__ void operator()(const pg8::f32x4 (&acc)[2][2][4][2], const pg8::Unit& u, int wr, int wc, int fr, int fq) const {
#pragma unroll
        for (int ai = 0; ai < 2; ++ai)
#pragma unroll
            for (int m = 0; m < 4; ++m) {
                const int rl = ai * 128 + wr * 64 + m * 16 + fr; const size_t pos = (size_t)u.pm * 256 + rl;
                const float w = shared ? 1.f : roww[((u.pm - ubase) / ustride) * 256 + rl];
                const int col = (shared ? 128 * u.pn : 0) + wc * 32 + 8 * fq;
                float h[8];
#pragma unroll
                for (int n = 0; n < 2; ++n)
#pragma unroll
                    for (int j = 0; j < 4; ++j) { const float gt = acc[ai][0][m][n][j], up = acc[ai][1][m][n][j]; h[n * 4 + j] = gt * sigmoidf_(gt) * up * w; }
                v4u o; o.x = pk2(h[0], h[1]); o.y = pk2(h[2], h[3]); o.z = pk2(h[4], h[5]); o.w = pk2(h[6], h[7]);
                *(GAS v4u*)(O + pos * ldo + col) = o;
                asm volatile("" ::: "memory");
            }
    }
};
constexpr float YS_SCALE = 4.0f;
struct EpiScatter {
    static constexpr bool PERM = true;
    bf16* Y; const LAS unsigned* dst; int v; int G; int nostore;
    __device__ __forceinline__ void operator()(const pg8::f32x4 (&acc)[2][2][4][2], const pg8::Unit& u, int wr, int wc, int fr, int fq) const {
        const int q = u.pn & 3;
#pragma unroll
        for (int ai = 0; ai < 2; ++ai)
#pragma unroll
            for (int m = 0; m < 4; ++m) {
                const int rl = ai * 128 + wr * 64 + m * 16 + fr; const unsigned d = dst[((4 * u.pm + q - v) / G) * 256 + rl];
                if (nostore) { asm volatile("" :: "v"(acc[ai][0][m][0]), "v"(acc[ai][0][m][1]), "v"(acc[ai][1][m][0]), "v"(acc[ai][1][m][1])); } else if (d != 0xffffffffu) {
#pragma unroll
                    for (int bj = 0; bj < 2; ++bj) { const pg8::f32x4 v0 = acc[ai][bj][m][0] * YS_SCALE, v1 = acc[ai][bj][m][1] * YS_SCALE;
                        int w0 = 0, w1 = 0;
#define YS_CL(x_) __builtin_amdgcn_fmed3f((x_), -440.f, 440.f)
                        w0 = __builtin_amdgcn_cvt_pk_fp8_f32(YS_CL(v0[0]), YS_CL(v0[1]), w0, false); w0 = __builtin_amdgcn_cvt_pk_fp8_f32(YS_CL(v0[2]), YS_CL(v0[3]), w0, true);
                        w1 = __builtin_amdgcn_cvt_pk_fp8_f32(YS_CL(v1[0]), YS_CL(v1[1]), w1, false); w1 = __builtin_amdgcn_cvt_pk_fp8_f32(YS_CL(v1[2]), YS_CL(v1[3]), w1, true);
#undef YS_CL
                        v2u w; w.x = (unsigned)w0; w.y = (unsigned)w1;
                        *(GAS v2u*)((unsigned char*)Y + (size_t)d * 1024 + q * 256 + bj * 128 + wc * 32 + 8 * fq) = w; }
                }
            }
    }
};

struct TrDesc { const float* sp; bf16* dp; int ldw, ldt; float scale; };
__device__ __forceinline__ void tr_load(const TrDesc& d, float (&tv)[32]) {
    const GAS float* sp = (const GAS float*)d.sp;
#pragma unroll
    for (int i = 0; i < 32; ++i) tv[i] = sp[(size_t)(2 * i) * d.ldw];
}
__device__ __forceinline__ void tr_store(const TrDesc& d, const float (&tv)[32], LAS float* scr, int lane) {
#pragma unroll
    for (int i = 0; i < 32; ++i) { const int kk = 2 * i + (lane >> 5); scr[kk * 33 + (lane & 31)] = tv[i]; }
    LDS_WAIT();
    const int c = lane & 7; const float scale = d.scale;
#pragma unroll
    for (int j = 0; j < 4; ++j) { const int n = (lane >> 3) + 8 * j; const LAS float* s = scr + (8 * c) * 33 + n;
        v4u o; o.x = pk2(s[0 * 33] * scale, s[1 * 33] * scale); o.y = pk2(s[2 * 33] * scale, s[3 * 33] * scale); o.z = pk2(s[4 * 33] * scale, s[5 * 33] * scale); o.w = pk2(s[6 * 33] * scale, s[7 * 33] * scale);
        *(GAS v4u*)(d.dp + (size_t)n * d.ldt + 8 * c) = o; }
    LDS_WAIT();
}
constexpr int CW_N_IN = 8 * 512, CW_N_P = 3 * 512, CW_N_E = 4096, CW_N_S = 4 * 64, CW_N_SD = 128;
constexpr int CW_TOTAL = CW_N_IN + CW_N_P + 3 * CW_N_E + CW_N_S + CW_N_SD;
__device__ __forceinline__ TrDesc tr_decode(Frame& F, int l, int it) {
    const float* src; int ldw; bf16* dst; int ldt; int kb, nb; float sc = 1.f;
    int r = it;
    if (r < CW_N_IN) { const int job = r >> 9, rr = r & 511; kb = rr >> 5; nb = rr & 31;
        int col; bf16* BIN = (bf16*)wsp(F, WS_BIN); bf16* AIN = (bf16*)wsp(F, WS_AIN);
        switch (job) {
            case 0: col = C_MQK; dst = BIN; break;
            case 1: col = C_MO; dst = BIN + (size_t)1024 * 1024; break;
            case 2: col = C_SQ; dst = BIN + (size_t)2048 * 1024; sc = LOG2E * 0.125f; break;
            case 3: col = C_SK; dst = BIN + (size_t)3072 * 1024; break;
            case 4: col = C_GA; dst = BIN + (size_t)4096 * 1024; break;
            case 5: col = C_GB; dst = BIN + (size_t)5120 * 1024; break;
            case 6: col = C_MV; dst = AIN; break;
            default: col = C_SV; dst = AIN + (size_t)1024 * 1024; break;
        }
        src = inp(F, I_WIN) + (size_t)l * DM * INW + col; ldw = INW; ldt = 1024; }
    else if ((r -= CW_N_IN) < CW_N_P) { const int job = r >> 9, rr = r & 511; kb = rr >> 5; nb = rr & 31;
        src = inp(F, job == 0 ? I_WPA : (job == 1 ? I_WPB : I_WOUT)) + (size_t)l * DM * DM; ldw = 1024;
        dst = (bf16*)wsp(F, job == 0 ? WS_BA : (job == 1 ? WS_BB : WS_BO)); ldt = 1024; }
    else if ((r -= CW_N_P) < 2 * CW_N_E) { const int up = r >= CW_N_E; if (up) r -= CW_N_E; const int e = r >> 6, rr = r & 63; kb = rr >> 2; nb = rr & 3;
        src = inp(F, up ? I_WU : I_WG) + ((size_t)l * NEXP + e) * DM * EFF; ldw = EFF;
        dst = (bf16*)wsp(F, WS_BGU) + ((size_t)e * 256 + (up ? 128 : 0)) * 1024; ldt = 1024; }
    else if ((r -= 2 * CW_N_E) < CW_N_E) { const int e = r >> 6, rr = r & 63; kb = rr >> 5; nb = rr & 31;
        src = inp(F, I_WD) + ((size_t)l * NEXP + e) * EFF * DM; ldw = DM;
        dst = (bf16*)wsp(F, WS_BD) + (size_t)e * 1024 * 128; ldt = 128; }
    else if ((r -= CW_N_E) < CW_N_S) { const int job = r >> 6, rr = r & 63; kb = rr >> 2; nb = rr & 3;
        const int up = job >> 1, hi = job & 1;
        src = inp(F, up ? I_SU : I_SG) + (size_t)l * DM * SFF + hi * 128; ldw = SFF;
        dst = (bf16*)wsp(F, WS_BSGU) + (size_t)(hi * 256 + up * 128) * 1024; ldt = 1024; }
    else { r -= CW_N_S; kb = r >> 5; nb = r & 31;
        src = inp(F, I_SD) + (size_t)l * SFF * DM; ldw = DM; dst = (bf16*)wsp(F, WS_BSD); ldt = 256; }
    TrDesc d; const int k0 = 64 * kb, n0 = 32 * nb; const int ln = lane_now();
    d.sp = src + (size_t)(k0 + (ln >> 5)) * ldw + n0 + (ln & 31); d.dp = dst + (size_t)n0 * ldt + k0; d.ldw = ldw; d.ldt = ldt; d.scale = sc;
    return d;
}
__device__ __forceinline__ void conv_weights(Frame& F, int l) {
    LAS float* scr = (LAS float*)(F.lds + F.wave * 16384);
    int gw = F.c * 8 + F.wave; asm volatile("" : "+s"(gw)); const int NGW = F.G * 8;
    int it = gw;
    if (it >= CW_TOTAL) return;
    TrDesc dc = tr_decode(F, l, it); float tc[32]; tr_load(dc, tc);
    for (;;) {
        const int itn = it + NGW; const bool more = itn < CW_TOTAL;
        TrDesc dn = dc; float tn[32];
        if (more) { dn = tr_decode(F, l, itn); tr_load(dn, tn); }
        tr_store(dc, tc, scr, F.lane);
        if (!more) break;
        it = itn; dc = dn;
#pragma unroll
        for (int i = 0; i < 32; ++i) tc[i] = tn[i];
    }
}
__device__ __forceinline__ void mod_partials(Frame& F) {
    LAS float* sc = (LAS float*)(F.lds);
    for (int i = F.tid; i < 4096; i += 512) { const float v = inp(F, I_C)[i]; sc[i] = v / (1.f + __expf(-v)); }
    __syncthreads();
    float* MODP = (float*)wsp(F, WS_MODP);
    for (int it = F.c; it < 384; it += F.G) {
        const int l = it / 192, rem = it % 192, g = rem >> 4, kp = rem & 15, j = g * 512 + F.tid;
        const float* w = inp(F, I_ADAW) + ((size_t)l * DM + 64 * kp) * 6144 + j;
        float a0 = 0.f, a1 = 0.f, a2 = 0.f, a3 = 0.f;
#pragma unroll 16
        for (int k = 0; k < 64; ++k) { const float wv = w[(size_t)k * 6144]; const int kk = 64 * kp + k;
            a0 += sc[kk] * wv; a1 += sc[1024 + kk] * wv; a2 += sc[2048 + kk] * wv; a3 += sc[3072 + kk] * wv; }
        float* o = MODP + ((size_t)(kp * 2 + l) * 4) * 6144 + j;
        o[0] = a0; o[6144] = a1; o[2 * 6144] = a2; o[3 * 6144] = a3;
    }
    __syncthreads();
}
__device__ __forceinline__ float modv(const Frame& F, int l, int b, int j) {
    const float* MODP = (const float*)wsp(F, WS_MODP);
    float s = inp(F, I_ADAB)[l * 6144 + j];
#pragma unroll
    for (int kp = 0; kp < 16; ++kp) s += MODP[((size_t)(kp * 2 + l) * 4 + b) * 6144 + j];
    return s;
}

__device__ __forceinline__ void norm_emit(Frame& F, const float (&v)[2][8], const LAS float* cA, const LAS float* cB, const LAS float* Wg, const float gbias_lane  , bf16* xn_row, float* gate_row) {
    float ss = 0.f;
#pragma unroll
    for (int j = 0; j < 2; ++j)
#pragma unroll
        for (int i = 0; i < 8; ++i) ss += v[j][i] * v[j][i];
    ss = wave_sum(ss, F.lane);
    const float r = 1.0f / sqrtf(ss * (1.f / 1024.f) + EPS);
    float h[2][8];
#pragma unroll
    for (int j = 0; j < 2; ++j) { const int k = 8 * F.lane + 512 * j;
        const f32x4 a0 = *(const LAS f32x4*)(cA + k), a1 = *(const LAS f32x4*)(cA + k + 4), b0 = *(const LAS f32x4*)(cB + k), b1 = *(const LAS f32x4*)(cB + k + 4);
#pragma unroll
        for (int i = 0; i < 4; ++i) { h[j][i] = v[j][i] * r * a0[i] + b0[i]; h[j][4 + i] = v[j][4 + i] * r * a1[i] + b1[i]; }
        v4u o; o.x = pk2(h[j][0], h[j][1]); o.y = pk2(h[j][2], h[j][3]); o.z = pk2(h[j][4], h[j][5]); o.w = pk2(h[j][6], h[j][7]);
        *(GAS v4u*)(xn_row + k) = o; }
    float mine = 0.f;
#pragma unroll
    for (int g = 0; g < 8; ++g) { float p = 0.f;
#pragma unroll
        for (int j = 0; j < 2; ++j) { const int k = 8 * F.lane + 512 * j; const f32x4 w0 = *(const LAS f32x4*)(Wg + g * 1024 + k), w1 = *(const LAS f32x4*)(Wg + g * 1024 + k + 4);
#pragma unroll
            for (int i = 0; i < 4; ++i) { p += h[j][i] * w0[i]; p += h[j][4 + i] * w1[i]; } }
        p = wave_sum(p, F.lane);
        if (F.lane == g) mine = p; }
    if (F.lane < 8) { float z = mine + gbias_lane; if (F.lane >= 4) z = fminf(z, 0.f) - __logf(1.f + __expf(-fabsf(z))); gate_row[F.lane] = z; }
}
__device__ __forceinline__ void norm1_tables(Frame& F, int l, int b, bool from_modp) {
    LAS float* cA = (LAS float*)(F.lds + LDS_TAB); LAS float* cB = cA + 1024; LAS float* Wg = (LAS float*)(F.lds);
    const float* MODF = (const float*)wsp(F, WS_MODF) + (size_t)(l * 4 + b) * 6144;
    for (int k = F.tid; k < 1024; k += 512) {
        const float sh = from_modp ? modv(F, l, b, k) : MODF[k], sc = from_modp ? modv(F, l, b, 1024 + k) : MODF[1024 + k];
        cA[k] = inp(F, I_N1W)[l * 1024 + k] * (1.f + sc); cB[k] = sh; }
    const float* w_in = inp(F, I_WIN) + (size_t)l * DM * INW;
    for (int idx = F.tid; idx < 8192; idx += 512) { const int k = idx >> 3, g = idx & 7; Wg[g * 1024 + k] = w_in[(size_t)k * INW + C_MI + g]; }
}
__device__ __forceinline__ void phase_norm1_first(Frame& F) {
    float* MODF = (float*)wsp(F, WS_MODF);
    for (int idx = F.c * 512 + F.tid; idx < 2 * 4 * 6144; idx += F.G * 512) { const int l = idx / 24576, rem = idx % 24576, b = rem / 6144, j = rem % 6144; MODF[idx] = modv(F, l, b, j); }
    bf16* XN = (bf16*)wsp(F, WS_R2); float* GATES = (float*)wsp(F, WS_GATES); bf16* XB = (bf16*)outp(F);
    for (int vb = F.c; vb < 256; vb += F.G) {
        norm1_tables(F, 0, vb >> 6, true);
        __syncthreads();
        const float gbl = (F.lane < 4) ? inp(F, I_IGB)[F.lane] : (F.lane < 8 ? inp(F, I_FGB)[F.lane - 4] : 0.f);
        f32x4 xn_[2][2];
#define N1_LOAD(tt) do { const float* xr_ = inp(F, I_X) + (size_t)(tt) * 1024 + 8 * F.lane; \
            _Pragma("unroll") for (int j = 0; j < 2; ++j) { xn_[j][0] = *(const GAS f32x4*)(xr_ + 512 * j); xn_[j][1] = *(const GAS f32x4*)(xr_ + 512 * j + 4); } } while (0)
        N1_LOAD(vb * 64 + F.wave * 8);
        for (int i = 0; i < 8; ++i) {
            const int t = vb * 64 + F.wave * 8 + i;
            float v[2][8];
#pragma unroll
            for (int j = 0; j < 2; ++j) { const f32x4 a = xn_[j][0], b2 = xn_[j][1];
#pragma unroll
                for (int q = 0; q < 4; ++q) { v[j][q] = a[q]; v[j][4 + q] = b2[q]; } }
            if (i + 1 < 8) N1_LOAD(t + 1);
#pragma unroll
            for (int j = 0; j < 2; ++j) { v4u o; o.x = pk2(v[j][0], v[j][1]); o.y = pk2(v[j][2], v[j][3]); o.z = pk2(v[j][4], v[j][5]); o.w = pk2(v[j][6], v[j][7]);
                *(GAS v4u*)(XB + (size_t)t * 1024 + 8 * F.lane + 512 * j) = o; }
            norm_emit(F, v, (const LAS float*)(F.lds + LDS_TAB), (const LAS float*)(F.lds + LDS_TAB) + 1024, (const LAS float*)(F.lds), gbl, XN + (size_t)t * 1024, GATES + (size_t)t * 8);
        }
        __syncthreads();
    }
}

__device__ __forceinline__ void phase_conv(Frame& F, int l) {
    const bf16* P6 = (const bf16*)wsp(F, WS_P6); bf16* MQK = (bf16*)wsp(F, WS_R2);
    const int cg = F.tid & 127, tq = F.tid >> 7, ch = cg * 8;
    float w[4][8], bias[8];
#pragma unroll
    for (int j = 0; j < 4; ++j) { const float* p = inp(F, I_CONVW) + ((size_t)l * 4 + j) * 1024 + ch; const f32x4 a = *(const GAS f32x4*)p, b = *(const GAS f32x4*)(p + 4);
#pragma unroll
        for (int i = 0; i < 4; ++i) { w[j][i] = a[i]; w[j][4 + i] = b[i]; } }
    { const float* p = inp(F, I_CONVB) + (size_t)l * 1024 + ch; const f32x4 a = *(const GAS f32x4*)p, b = *(const GAS f32x4*)(p + 4);
#pragma unroll
      for (int i = 0; i < 4; ++i) { bias[i] = a[i]; bias[4 + i] = b[i]; } }
    const float osc = (ch < 512) ? 0.08838834764831845f : 1.0f;
    for (int vb = F.c; vb < 256; vb += F.G) {
        const int tbeg = vb * 64 + tq * 16;
        float u0[8], u1[8], u2[8];
#define CV_LOAD(dst, tt) do { const int t_ = (tt); if (t_ >= 0 && (t_ >> 12) == (tbeg >> 12)) { const v4u q = *(const GAS v4u*)(P6 + (size_t)t_ * P6W + ch); \
            dst[0] = bflo(q.x); dst[1] = bfhi(q.x); dst[2] = bflo(q.y); dst[3] = bfhi(q.y); dst[4] = bflo(q.z); dst[5] = bfhi(q.z); dst[6] = bflo(q.w); dst[7] = bfhi(q.w); } \
            else { _Pragma("unroll") for (int i_ = 0; i_ < 8; ++i_) dst[i_] = 0.f; } } while (0)
        CV_LOAD(u0, tbeg - 3); CV_LOAD(u1, tbeg - 2); CV_LOAD(u2, tbeg - 1);
        for (int tt = 0; tt < 16; ++tt) {
            const int t = tbeg + tt; float u3[8]; CV_LOAD(u3, t);
            float o[8];
#pragma unroll
            for (int i = 0; i < 8; ++i) { const float a = bias[i] + w[0][i] * u0[i] + w[1][i] * u1[i] + w[2][i] * u2[i] + w[3][i] * u3[i]; o[i] = a * sigmoidf_(a) * osc; }
            v4u q; q.x = pk2(o[0], o[1]); q.y = pk2(o[2], o[3]); q.z = pk2(o[4], o[5]); q.w = pk2(o[6], o[7]);
            *(GAS v4u*)(MQK + (size_t)t * 1024 + ch) = q;
#pragma unroll
            for (int i = 0; i < 8; ++i) { u0[i] = u1[i]; u1[i] = u2[i]; u2[i] = u3[i]; }
        }
#undef CV_LOAD
    }
}

constexpr float SB_EXIT = -80.0f;
constexpr int AT_NSLOT = 12, AT_SLOTB = 8192, AT_FLAGS = AT_NSLOT * AT_SLOTB;
__device__ __forceinline__ void at_dma(const void* gsrc, LAS unsigned char* ldst) { __builtin_amdgcn_global_load_lds((const GAS unsigned*)gsrc, (LAS unsigned*)ldst, 16, 0, 0); }
__device__ __forceinline__ void attn_unit(Frame& F, int b, int h, int qb, bool do_store) {
    bf16* P6 = (bf16*)wsp(F, WS_P6); const bf16* VT = (const bf16*)wsp(F, WS_VT);
    LAS unsigned char* L = F.lds;
    const int lane = F.lane, r32 = lane & 31, hh = lane >> 5, wid = F.wave;
    const int tb = b * SEQ, t0 = qb * 256 + wid * 32;
    const int D0 = 8 * qb, Dw = D0 + wid;
    const bf16* dsrc; int dtile_stride; int doff;
    if (wid < 4) { const int row = 8 * wid + (lane >> 3), pos = lane & 7; dsrc = P6 + (size_t)(tb + row) * P6W + P_SK + h * 64 + ((pos ^ (row & 7)) * 8); dtile_stride = 32 * P6W; doff = wid * 1024; }
    else { const int d = 16 * (wid - 4) + (lane >> 2), pos = lane & 3; dsrc = VT + (size_t)(1024 + h * 64 + d) * NTOK + tb + ((pos ^ ((d >> 2) & 3)) * 8); dtile_stride = 32; doff = 4096 + (wid - 4) * 1024; }
#define AT_DMA(T_) do { const int T__ = (T_); if (T__ >= 0) at_dma(dsrc + (size_t)T__ * dtile_stride, L + (T__ % AT_NSLOT) * AT_SLOTB + doff); } while (0)
    for (int T = D0 + 7; T >= D0 - 1; --T) AT_DMA(T);
    bf16x8 qf[4];
#pragma unroll
    for (int kk = 0; kk < 4; ++kk) qf[kk] = *(const GAS bf16x8*)(P6 + (size_t)(tb + t0 + r32) * P6W + P_SQ + h * 64 + 16 * kk + 8 * hh);
    f32x16 o0 = {}, o1 = {};
    float Rrun = 0.f;
    bool done = false;
    LAS unsigned* flags = (LAS unsigned*)(L + AT_FLAGS);
    asm volatile("s_waitcnt vmcnt(0)" ::: "memory");
    if (lane == 0) flags[wid] = 1u;
    __syncthreads();
    int koff[4], vlo[2][2], vhi[2][2];
#pragma unroll
    for (int kk = 0; kk < 4; ++kk) koff[kk] = r32 * 128 + (((2 * kk + hh) ^ (r32 & 7)) * 16);
#pragma unroll
    for (int dt = 0; dt < 2; ++dt)
#pragma unroll
        for (int s = 0; s < 2; ++s) { const int d = 32 * dt + r32, sw = (d >> 2) & 3; vlo[dt][s] = 4096 + d * 64 + (((2 * s) ^ sw) * 16) + 8 * hh; vhi[dt][s] = 4096 + d * 64 + (((2 * s + 1) ^ sw) * 16) + 8 * hh; }
#define AT_TILE(DIAG_) do { \
            const LAS unsigned char* S = L + (T % AT_NSLOT) * AT_SLOTB; \
            f32x16 p = {}; \
            _Pragma("unroll") \
            for (int kk = 0; kk < 4; ++kk) { const bf16x8 kf = *(const LAS bf16x8*)(S + koff[kk]); p = __builtin_amdgcn_mfma_f32_32x32x16_bf16(kf, qf[kk], p, 0, 0, 0); } \
            bf16x8 vf[2][2]; \
            _Pragma("unroll") \
            for (int dt = 0; dt < 2; ++dt) \
            _Pragma("unroll") \
                for (int s = 0; s < 2; ++s) { const v2u lo = *(const LAS v2u*)(S + vlo[dt][s]), hi = *(const LAS v2u*)(S + vhi[dt][s]); v4u t; t.x = lo.x; t.y = lo.y; t.z = hi.x; t.w = hi.y; vf[dt][s] = __builtin_bit_cast(bf16x8, t); } \
            float lf[16]; \
            _Pragma("unroll") \
            for (int r = 0; r < 16; ++r) { const float z = p[r]; const float e = __builtin_amdgcn_exp2f(-fabsf(z)); const float lg = __builtin_amdgcn_logf(1.f + e); \
                float v = -(fmaxf(z, 0.f) + lg); if (DIAG_ && crow(r, hh) >= r32) v = 0.f; lf[r] = v; } \
 \
            float own[4], pair[4]; \
            _Pragma("unroll") \
            for (int g = 0; g < 4; ++g) { own[g] = (lf[4 * g] + lf[4 * g + 1]) + (lf[4 * g + 2] + lf[4 * g + 3]); \
                auto rr = __builtin_amdgcn_permlane32_swap(__float_as_uint(own[g]), __float_as_uint(own[g]), false, false); \
                pair[g] = __uint_as_float(rr[0]) + __uint_as_float(rr[1]); } \
            float sfx[4]; sfx[3] = Rrun; sfx[2] = sfx[3] + pair[3]; sfx[1] = sfx[2] + pair[2]; sfx[0] = sfx[1] + pair[1]; \
            const float nh = hh ? 0.f : 1.f; \
            float att[16]; \
            _Pragma("unroll") \
            for (int g = 0; g < 4; ++g) { float run = sfx[g] + nh * (pair[g] - own[g]); \
            _Pragma("unroll") \
                for (int i = 3; i >= 0; --i) { const int r = 4 * g + i; run += lf[r]; float a = __builtin_amdgcn_exp2f(p[r] + run); if (DIAG_ && crow(r, hh) >= r32) a = 0.f; att[r] = a; } } \
            Rrun = sfx[0] + pair[0]; \
            v4u pb0, pb1; \
            pb0.x = pk2(att[0], att[1]); pb0.y = pk2(att[2], att[3]); pb0.z = pk2(att[4], att[5]); pb0.w = pk2(att[6], att[7]); \
            pb1.x = pk2(att[8], att[9]); pb1.y = pk2(att[10], att[11]); pb1.z = pk2(att[12], att[13]); pb1.w = pk2(att[14], att[15]); \
            const bf16x8 b0 = __builtin_bit_cast(bf16x8, pb0), b1 = __builtin_bit_cast(bf16x8, pb1); \
            o0 = __builtin_amdgcn_mfma_f32_32x32x16_bf16(vf[0][0], b0, o0, 0, 0, 0); o0 = __builtin_amdgcn_mfma_f32_32x32x16_bf16(vf[0][1], b1, o0, 0, 0, 0); \
            o1 = __builtin_amdgcn_mfma_f32_32x32x16_bf16(vf[1][0], b0, o1, 0, 0, 0); o1 = __builtin_amdgcn_mfma_f32_32x32x16_bf16(vf[1][1], b1, o1, 0, 0, 0); \
            if (__all(Rrun < SB_EXIT)) done = true; \
        } while (0)
    for (int j = 0; ; ++j) {
        const int T = Dw - j;
        const bool active = !done && T >= 0;
        AT_DMA(D0 - j - 2);
        if (active) { if (j == 0) AT_TILE(true); else AT_TILE(false); }
        const bool more = !done && (Dw - (j + 1)) >= 0;
        if (lane == 0) flags[8 * ((j + 1) & 1) + wid] = more ? 1u : 0u;
        asm volatile("s_waitcnt vmcnt(0) lgkmcnt(0)" ::: "memory");
        __builtin_amdgcn_s_barrier();
        asm volatile("" ::: "memory");
        const LAS unsigned* fl = flags + 8 * ((j + 1) & 1);
        const unsigned any = fl[0] | fl[1] | fl[2] | fl[3] | fl[4] | fl[5] | fl[6] | fl[7];
        if (any == 0u) break;
    }
#undef AT_DMA
#undef AT_TILE
    if (do_store) {
        bf16* orow = P6 + (size_t)(tb + t0 + r32) * P6W + P_SQ + h * 64 + 4 * hh;
#pragma unroll
        for (int g = 0; g < 4; ++g) {
            v2u a; a.x = pk2(o0[4 * g], o0[4 * g + 1]); a.y = pk2(o0[4 * g + 2], o0[4 * g + 3]); *(GAS v2u*)(orow + 8 * g) = a;
            v2u c; c.x = pk2(o1[4 * g], o1[4 * g + 1]); c.y = pk2(o1[4 * g + 2], o1[4 * g + 3]); *(GAS v2u*)(orow + 32 + 8 * g) = c;
        }
    } else { asm volatile("" :: "v"(o0), "v"(o1)); }
    __syncthreads();
}
__device__ __forceinline__ void phase_attn(Frame& F, bool do_store) {
    const int v = (F.G % 8 == 0) ? (F.c % 8) * (F.G / 8) + F.c / 8 : F.c;
    for (int u = v; u < 1024; u += F.G) { const int bh = u >> 4, qb = u & 15; attn_unit(F, bh >> 4, bh & 15, qb, do_store); }
}

constexpr size_t MLS_U = 0, MLS_PM = 16 * 4096 * 4, MLS_BL = 2 * 16 * 4096 * 4, MLS_SUM = 3 * 16 * 4096 * 4;
__device__ __forceinline__ void phase_mlstm_scalars(Frame& F) {
    const float* GATES = (const float*)wsp(F, WS_GATES); unsigned char* R3 = wsp(F, WS_R3);
    const int lane = F.lane;
    for (int vb = F.c; vb < 256; vb += F.G) {
        if (F.wave != 0) continue;
        const int bh = vb >> 4, ch = vb & 15, b = bh >> 2, h = bh & 3, t0 = b * SEQ + 256 * ch;
        float carry_b = 0.f, carry_pm = -INFINITY;
#pragma unroll
        for (int sg = 0; sg < 4; ++sg) {
            const int tok = t0 + 64 * sg + lane;
            const float ig = *(const GAS float*)(GATES + (size_t)tok * 8 + h), lfv = *(const GAS float*)(GATES + (size_t)tok * 8 + 4 + h);
            float bc = lfv;
#pragma unroll
            for (int o = 1; o < 64; o <<= 1) { const float t = shfl_up_l(bc, o, lane); if (lane >= o) bc += t; }
            bc += carry_b;
            const float u = ig - bc;
            float pm = u;
#pragma unroll
            for (int o = 1; o < 64; o <<= 1) { const float t = shfl_up_l(pm, o, lane); if (lane >= o) pm = fmaxf(pm, t); }
            pm = fmaxf(pm, carry_pm);
            const size_t idx = (size_t)bh * 4096 + 256 * ch + 64 * sg + lane;
            *(GAS float*)(R3 + MLS_U + idx * 4) = u; *(GAS float*)(R3 + MLS_PM + idx * 4) = pm; *(GAS float*)(R3 + MLS_BL + idx * 4) = bc;
            carry_b = __int_as_float(__builtin_amdgcn_readlane(__float_as_int(bc), 63)); carry_pm = __int_as_float(__builtin_amdgcn_readlane(__float_as_int(pm), 63));
        }
        if (lane == 0) { *(GAS float*)(R3 + MLS_SUM + (size_t)(bh * 16 + ch) * 8) = carry_b; *(GAS float*)(R3 + MLS_SUM + (size_t)(bh * 16 + ch) * 8 + 4) = carry_pm; }
    }
}

constexpr int CVP_QS = 0, CVP_KS = 69632, CVP_U = 139264;
__device__ __forceinline__ void cvp_job(Frame& F, int l, int bh, int c) {
    LAS unsigned char* L = F.lds;
    const int b = bh >> 2, h = bh & 3, T0 = b * SEQ + 256 * c;
    const bf16* P6 = (const bf16*)wsp(F, WS_P6); const unsigned char* R3 = wsp(F, WS_R3);
    {
        const int cg = F.tid & 31, tr = F.tid >> 5, ch8 = 8 * cg;
        const int cq = (ch8 < 128) ? h * 128 + ch8 : 512 + h * 128 + (ch8 - 128);
        float w[4][8], bias[8];
#pragma unroll
        for (int j = 0; j < 4; ++j) { const float* p = inp(F, I_CONVW) + ((size_t)l * 4 + j) * 1024 + cq; const f32x4 a = *(const GAS f32x4*)p, bb = *(const GAS f32x4*)(p + 4);
#pragma unroll
            for (int i = 0; i < 4; ++i) { w[j][i] = a[i]; w[j][4 + i] = bb[i]; } }
        { const float* p = inp(F, I_CONVB) + (size_t)l * 1024 + cq; const f32x4 a = *(const GAS f32x4*)p, bb = *(const GAS f32x4*)(p + 4);
#pragma unroll
          for (int i = 0; i < 4; ++i) { bias[i] = a[i]; bias[4 + i] = bb[i]; } }
        const float osc = (ch8 < 128) ? 0.08838834764831845f : 1.0f;
        const int sbeg = 256 * c + 16 * tr;
        float u0[8], u1[8], u2[8];
#define CVP_RAW(ss) ((ss) >= 0 ? *(const GAS v4u*)(P6 + (size_t)(b * SEQ + (ss)) * P6W + cq) : (v4u){0u, 0u, 0u, 0u})
#define CVP_DEC(dst, q) do { dst[0] = bflo(q.x); dst[1] = bfhi(q.x); dst[2] = bflo(q.y); dst[3] = bfhi(q.y); dst[4] = bflo(q.z); dst[5] = bfhi(q.z); dst[6] = bflo(q.w); dst[7] = bfhi(q.w); } while (0)
        LAS unsigned char* tile = L + ((ch8 < 128) ? CVP_QS : CVP_KS) + ((ch8 & 127) * 2);
        {
            v4u ra[11];
#pragma unroll
            for (int i = 0; i < 11; ++i) ra[i] = CVP_RAW(sbeg - 3 + i);
            v4u rb[8];
#pragma unroll
            for (int i = 0; i < 8; ++i) rb[i] = CVP_RAW(sbeg + 8 + i);
            CVP_DEC(u0, ra[0]); CVP_DEC(u1, ra[1]); CVP_DEC(u2, ra[2]);
#pragma unroll
            for (int tt = 0; tt < 16; ++tt) {
                float u3[8]; if (tt < 8) CVP_DEC(u3, ra[3 + tt]); else CVP_DEC(u3, rb[tt - 8]);
                float o[8];
#pragma unroll
                for (int i = 0; i < 8; ++i) { const float a = bias[i] + w[0][i] * u0[i] + w[1][i] * u1[i] + w[2][i] * u2[i] + w[3][i] * u3[i]; o[i] = a * sigmoidf_(a) * osc; }
                v4u q; q.x = pk2(o[0], o[1]); q.y = pk2(o[2], o[3]); q.z = pk2(o[4], o[5]); q.w = pk2(o[6], o[7]);
                *(LAS v4u*)(tile + (16 * tr + tt) * 272) = q;
#pragma unroll
                for (int i = 0; i < 8; ++i) { u0[i] = u1[i]; u1[i] = u2[i]; u2[i] = u3[i]; }
            }
        }
#undef CVP_RAW
#undef CVP_DEC
        if (F.tid < 256) *(LAS float*)(L + CVP_U + F.tid * 4) = *(const GAS float*)(R3 + MLS_U + ((size_t)bh * 4096 + 256 * c + F.tid) * 4) * LOG2E;
    }
    __syncthreads();
    {
        const int lane = F.lane, wid = F.wave, r32 = lane & 31, hh = lane >> 5;
        const int qblk = (wid < 4) ? 7 - wid : wid - 4;
        float Mc = 0.f;
        { const float a_l = *(const GAS float*)(R3 + MLS_SUM + (size_t)(bh * 16 + (lane & 15)) * 8), p_l = *(const GAS float*)(R3 + MLS_SUM + (size_t)(bh * 16 + (lane & 15)) * 8 + 4);
#pragma unroll
          for (int cc = 0; cc < 16; ++cc) if (cc < c) { const float a = __int_as_float(__builtin_amdgcn_readlane(__float_as_int(a_l), cc)), pmx = __int_as_float(__builtin_amdgcn_readlane(__float_as_int(p_l), cc)); Mc = a + fmaxf(Mc, pmx); } }
        const float pmq = *(const GAS float*)(R3 + MLS_PM + ((size_t)bh * 4096 + 256 * c + 32 * qblk + r32) * 4);
        const float myMM2 = fmaxf(Mc, pmq) * LOG2E;
        bf16x8 qf[8];
#pragma unroll
        for (int kk = 0; kk < 8; ++kk) qf[kk] = *(const LAS bf16x8*)(L + CVP_QS + (32 * qblk + r32) * 272 + (16 * kk + 8 * hh) * 2);
        { unsigned char* QF = wsp(F, WS_R2) + (((size_t)(bh * 16 + c) * 8 + qblk) * 8) * 1024 + lane * 16;
#pragma unroll
          for (int kk = 0; kk < 8; ++kk) *(GAS bf16x8*)(QF + (size_t)kk * 1024) = qf[kk]; }
        unsigned char* PT = wsp(F, WS_PT) + ((size_t)(bh * 16 + c) * 36 + (qblk * (qblk + 1)) / 2) * 2048;
        const LAS float* U2 = (const LAS float*)(L + CVP_U);
        for (int kt = 0; kt <= qblk; ++kt) {
            f32x16 p = {};
#pragma unroll
            for (int kk = 0; kk < 8; ++kk) { const bf16x8 a = *(const LAS bf16x8*)(L + CVP_KS + (32 * kt + r32) * 272 + (16 * kk + 8 * hh) * 2); p = __builtin_amdgcn_mfma_f32_32x32x16_bf16(a, qf[kk], p, 0, 0, 0); }
            const bool diag = (kt == qblk);
            float pw[16];
#pragma unroll
            for (int g = 0; g < 4; ++g) { const f32x4 u2 = *(const LAS f32x4*)(U2 + 32 * kt + 8 * g + 4 * hh);
#pragma unroll
                for (int i = 0; i < 4; ++i) { const int r = 4 * g + i; float v = p[r] * __builtin_amdgcn_exp2f(u2[i] - myMM2); if (diag && (8 * g + 4 * hh + i) > r32) v = 0.f; pw[r] = v; } }
            v4u pb0, pb1;
            pb0.x = pk2(pw[0], pw[1]); pb0.y = pk2(pw[2], pw[3]); pb0.z = pk2(pw[4], pw[5]); pb0.w = pk2(pw[6], pw[7]);
            pb1.x = pk2(pw[8], pw[9]); pb1.y = pk2(pw[10], pw[11]); pb1.z = pk2(pw[12], pw[13]); pb1.w = pk2(pw[14], pw[15]);
            *(GAS v4u*)(PT + (size_t)kt * 2048 + lane * 16) = pb0; *(GAS v4u*)(PT + (size_t)kt * 2048 + 1024 + lane * 16) = pb1;
        }
        { const int dkt = wid & 3, kh = wid >> 2;
          unsigned char* KF = wsp(F, WS_R2) + 16 * MiB + (((size_t)(bh * 16 + c) * 8 + (dkt * 2 + kh)) * 8) * 1024 + lane * 16;
#pragma unroll
          for (int ks = 0; ks < 8; ++ks) { const int s0 = 128 * kh + 16 * ks + 8 * hh; bf16x8 bb;
#pragma unroll
              for (int j = 0; j < 8; ++j) bb[j] = *(const LAS short*)(L + CVP_KS + (s0 + j) * 272 + (32 * dkt + r32) * 2);
              *(GAS bf16x8*)(KF + (size_t)ks * 1024) = bb; } }
    }
    __syncthreads();
}
__device__ __forceinline__ void phase_cvp(Frame& F, int l) {
    const int v = (F.G % 8 == 0) ? (F.c % 8) * (F.G / 8) + F.c / 8 : F.c;
    for (int u = v; u < 256; u += F.G) cvp_job(F, l, u >> 4, u & 15);
}

constexpr int M2_KS = 0, M2_VT = 69632, M2_CT = 86528, M2_G = 95232, M2_U2 = 97280, M2_WC = 105472, M2_PART = 113664;
constexpr int M2_KP = 272, M2_VP = 528, M2_CP = 272;
__device__ __forceinline__ void mlstm_unit(Frame& F, int b, int h, int ds, int skip) {
    LAS unsigned char* L = F.lds;
    const int wid = F.wave;
    const int qblk = (wid < 4) ? 7 - wid : wid - 4;
    const int dkt = wid & 3, kh = wid >> 2;
#define M2_IDS() int lane_ = F.lane; asm volatile("" : "+v"(lane_)); const int lane = lane_, tid = wid * 64 + lane, r32 = lane & 31, hh = lane >> 5
    const bf16* VTg = (const bf16*)wsp(F, WS_VT);
    bf16* P6 = (bf16*)wsp(F, WS_P6);
    const int tb = b * SEQ, bh = b * 4 + h;
    { M2_IDS();
    for (int i = tid; i < 16 * 264; i += 512) { const int row = 16 + i / 264, col = i % 264; *(LAS bf16*)(L + M2_VT + row * M2_VP + col * 2) = (row == 16 && col < 256) ? (bf16)0x3F80 : (bf16)0; }
    for (int i = tid; i < 32 * 136; i += 512) *(LAS bf16*)(L + M2_CT + i * 2) = (bf16)0; }
    f32x16 st = {};
    float Mst = 0.f;
    v4u pv; float pu[4], ppm, pbl, psa, psm;
    bf16x8 qf[8];
    v4u kfr[8];
    v4u pbuf[8][2];
    const unsigned char* R3 = wsp(F, WS_R3);
#define M2_FETCH(cc) do { const int t0_ = tb + 256 * (cc); \
        { const int dvl_ = tid >> 5, seg_ = tid & 31; pv = *(const GAS v4u*)(VTg + (size_t)(h * 256 + ds * 16 + dvl_) * NTOK + t0_ + seg_ * 8); } \
        { const size_t ib_ = (size_t)bh * 4096 + 256 * (cc); \
          _Pragma("unroll") for (int i = 0; i < 4; ++i) pu[i] = *(const GAS float*)(R3 + MLS_U + (ib_ + 64 * i + lane) * 4); \
          ppm = *(const GAS float*)(R3 + MLS_PM + (ib_ + 32 * qblk + r32) * 4); pbl = *(const GAS float*)(R3 + MLS_BL + (ib_ + 32 * qblk + r32) * 4); \
          psa = *(const GAS float*)(R3 + MLS_SUM + (size_t)(bh * 16 + (cc)) * 8); psm = *(const GAS float*)(R3 + MLS_SUM + (size_t)(bh * 16 + (cc)) * 8 + 4); } } while (0)
#define M2_QFETCH(cc) do { const unsigned char* qf_ = wsp(F, WS_R2) + (((size_t)(bh * 16 + (cc)) * 8 + qblk) * 8) * 1024 + lane * 16; _Pragma("unroll") for (int kk = 0; kk < 8; ++kk) qf[kk] = *(const GAS bf16x8*)(qf_ + (size_t)kk * 1024); } while (0)
#define M2_KFETCH(cc) do { const unsigned char* kf_ = wsp(F, WS_R2) + 16 * MiB + (((size_t)(bh * 16 + (cc)) * 8 + (dkt * 2 + kh)) * 8) * 1024 + lane * 16; \
        _Pragma("unroll") for (int ks = 0; ks < 8; ++ks) kfr[ks] = *(const GAS v4u*)(kf_ + (size_t)ks * 1024); } while (0)
#define M2_PTQ(cc) (wsp(F, WS_PT) + ((size_t)(bh * 16 + (cc)) * 36 + (qblk * (qblk + 1)) / 2) * 2048 + lane * 16)
    { M2_IDS(); M2_FETCH(0); M2_QFETCH(0); M2_KFETCH(0);
      const unsigned char* pt_ = M2_PTQ(0);
#pragma unroll
      for (int kt = 0; kt < 8; ++kt) if (kt <= qblk) { pbuf[kt][0] = *(const GAS v4u*)(pt_ + (size_t)kt * 2048); pbuf[kt][1] = *(const GAS v4u*)(pt_ + (size_t)kt * 2048 + 1024); } }
    LAS float* WCw = (LAS float*)(L + M2_WC + wid * 1024);
    for (int c = 0; c < 16; ++c) {
        M2_IDS();
        const int t0 = tb + 256 * c;
        const bool more = (c + 1 < 16);
        { const int dvl_ = tid >> 5, seg_ = tid & 31; *(LAS v4u*)(L + M2_VT + dvl_ * M2_VP + seg_ * 16) = pv; }
        float cu[4]; const float cpm = ppm, cbl = pbl, csa = psa, csm = psm;
#pragma unroll
        for (int i = 0; i < 4; ++i) cu[i] = pu[i];
        if (more) M2_FETCH(c + 1);
        float myWIN, myEFLO, decay;
        {
            const float mml = fmaxf(Mst, csm);
#pragma unroll
            for (int i = 0; i < 4; ++i) WCw[64 * i + lane] = __expf(cu[i] - mml);
            const float mm = fmaxf(Mst, cpm);
            myWIN = __expf(Mst - mm); myEFLO = __expf(-(cbl + mm));
            decay = __expf(Mst - mml);
            Mst = csa + mml;
        }
        __syncthreads();
        f32x16 hT = {};
        if (!(skip & 4))
#pragma unroll
        for (int kk = 0; kk < 8; ++kk) { const bf16x8 a = *(const LAS bf16x8*)(L + M2_CT + r32 * M2_CP + (16 * kk + 8 * hh) * 2); hT = __builtin_amdgcn_mfma_f32_32x32x16_bf16(a, qf[kk], hT, 0, 0, 0); }
        if (more && !(skip & 32)) M2_QFETCH(c + 1);
#pragma unroll
        for (int r = 0; r < 16; ++r) hT[r] *= myWIN;
        {
            const unsigned char* ptn = M2_PTQ(c + 1);
#pragma unroll
            for (int kt = 0; kt < 8; ++kt) if (kt <= qblk) {
#pragma unroll
                for (int s = 0; s < 2; ++s) if (!(skip & 1)) { const LAS unsigned char* vp = L + M2_VT + r32 * M2_VP + (32 * kt + 16 * s + 4 * hh) * 2;
                    const v2u lo = *(const LAS v2u*)vp, hi = *(const LAS v2u*)(vp + 16);
                    v4u t; t.x = lo.x; t.y = lo.y; t.z = hi.x; t.w = hi.y;
                    hT = __builtin_amdgcn_mfma_f32_32x32x16_bf16(__builtin_bit_cast(bf16x8, t), __builtin_bit_cast(bf16x8, pbuf[kt][s]), hT, 0, 0, 0); }
                if (more && !(skip & 16)) { pbuf[kt][0] = *(const GAS v4u*)(ptn + (size_t)kt * 2048); pbuf[kt][1] = *(const GAS v4u*)(ptn + (size_t)kt * 2048 + 1024); }
            }
        }
        {
            const float dn = hT[8];
            auto rr = __builtin_amdgcn_permlane32_swap(__float_as_uint(dn), __float_as_uint(dn), false, false);
            const float den = __uint_as_float(rr[0]);
            const float inv = 1.0f / fmaxf(fabsf(den), myEFLO);
            bf16* orow = P6 + (size_t)(t0 + 32 * qblk + r32) * P6W + P_MQK + h * 256 + ds * 16 + 4 * hh;
            v2u o0, o1; o0.x = pk2(hT[0] * inv, hT[1] * inv); o0.y = pk2(hT[2] * inv, hT[3] * inv); o1.x = pk2(hT[4] * inv, hT[5] * inv); o1.y = pk2(hT[6] * inv, hT[7] * inv);
            if (!(skip & 8)) { *(GAS v2u*)orow = o0; *(GAS v2u*)(orow + 8) = o1; } else { asm volatile("" :: "v"(o0), "v"(o1)); }
        }
        f32x16 part = {};
#pragma unroll
        for (int ks = 0; ks < 8; ++ks) if (!(skip & 2)) {
            const int s0 = 128 * kh + 16 * ks + 8 * hh;
            const v4u raw = *(const LAS v4u*)(L + M2_VT + r32 * M2_VP + s0 * 2);
            const f32x4 w0 = *(const LAS f32x4*)(WCw + s0), w1 = *(const LAS f32x4*)(WCw + s0 + 4);
            v4u aw; aw.x = pk2(bflo(raw.x) * w0[0], bfhi(raw.x) * w0[1]); aw.y = pk2(bflo(raw.y) * w0[2], bfhi(raw.y) * w0[3]);
            aw.z = pk2(bflo(raw.z) * w1[0], bfhi(raw.z) * w1[1]); aw.w = pk2(bflo(raw.w) * w1[2], bfhi(raw.w) * w1[3]);
            part = __builtin_amdgcn_mfma_f32_32x32x16_bf16(__builtin_bit_cast(bf16x8, aw), __builtin_bit_cast(bf16x8, kfr[ks]), part, 0, 0, 0);
        }
        if (more && !(skip & 64)) M2_KFETCH(c + 1);
        if (kh == 1) {
#pragma unroll
            for (int r = 0; r < 16; ++r) *(LAS float*)(L + M2_PART + dkt * 4096 + r * 256 + lane * 4) = part[r];
        }
        __syncthreads();
        if (kh == 0) {
#pragma unroll
            for (int r = 0; r < 16; ++r) { st[r] = st[r] * decay + part[r] + *(LAS float*)(L + M2_PART + dkt * 4096 + r * 256 + lane * 4);
                *(LAS bf16*)(L + M2_CT + crow(r, hh) * M2_CP + (32 * dkt + r32) * 2) = f2bf(st[r]); }
        }
    }
#undef M2_FETCH
#undef M2_QFETCH
#undef M2_KFETCH
#undef M2_PTQ
#undef M2_IDS
}
__device__ __forceinline__ void phase_mlstm(Frame& F, int skip) {
    const int v = (F.G % 8 == 0) ? (F.c % 8) * (F.G / 8) + F.c / 8 : F.c;
    for (int u = v; u < 256; u += F.G) { const int bh = u >> 4, ds = u & 15; mlstm_unit(F, bh >> 2, bh & 3, ds, skip); __syncthreads(); }
}

__device__ __forceinline__ void phase_hm_final(Frame& F, int l, bool do_store) {
    bf16* P6 = (bf16*)wsp(F, WS_P6);
    const float* mw = inp(F, I_MNW) + (size_t)l * 1024;
    for (int vb = F.c; vb < 256; vb += F.G) {
        v4u hn[2], mn[2];
#define HM_LOAD(tt) do { const bf16* r_ = P6 + (size_t)(tt) * P6W + 8 * F.lane; \
            _Pragma("unroll") for (int j = 0; j < 2; ++j) { hn[j] = *(const GAS v4u*)(r_ + P_MQK + 512 * j); mn[j] = *(const GAS v4u*)(r_ + P_MO + 512 * j); } } while (0)
        HM_LOAD(vb * 64 + F.wave * 8);
        for (int i = 0; i < 8; ++i) {
            const int t = vb * 64 + F.wave * 8 + i; bf16* row = P6 + (size_t)t * P6W + 8 * F.lane;
            v4u hc[2], mc[2];
#pragma unroll
            for (int j = 0; j < 2; ++j) { hc[j] = hn[j]; mc[j] = mn[j]; }
            if (i + 1 < 8) HM_LOAD(t + 1);
#pragma unroll
            for (int j = 0; j < 2; ++j) {
                const float x[8] = {bflo(hc[j].x), bfhi(hc[j].x), bflo(hc[j].y), bfhi(hc[j].y), bflo(hc[j].z), bfhi(hc[j].z), bflo(hc[j].w), bfhi(hc[j].w)};
                const float mo[8] = {bflo(mc[j].x), bfhi(mc[j].x), bflo(mc[j].y), bfhi(mc[j].y), bflo(mc[j].z), bfhi(mc[j].z), bflo(mc[j].w), bfhi(mc[j].w)};
                float ss = 0.f;
#pragma unroll
                for (int q = 0; q < 8; ++q) ss += x[q] * x[q];
                ss = half_sum32(ss);
                const float r = 1.0f / sqrtf(ss * (1.f / 256.f) + EPS);
                const f32x4 w0 = *(const GAS f32x4*)(mw + 512 * j + 8 * F.lane), w1 = *(const GAS f32x4*)(mw + 512 * j + 8 * F.lane + 4);
                float y[8];
#pragma unroll
                for (int q = 0; q < 4; ++q) { y[q] = x[q] * r * w0[q] * sigmoidf_(mo[q]); y[4 + q] = x[4 + q] * r * w1[q] * sigmoidf_(mo[4 + q]); }
                v4u o; o.x = pk2(y[0], y[1]); o.y = pk2(y[2], y[3]); o.z = pk2(y[4], y[5]); o.w = pk2(y[6], y[7]);
                if (do_store) *(GAS v4u*)(row + P_MQK + 512 * j) = o; else asm volatile("" :: "v"(o));
            }
        }
#undef HM_LOAD
    }
}

#define N2_LD0(dst, k0) do { const GAS float* bq_ = bp + (size_t)(2 * (k0)) * 64; asm volatile("" : "+v"(bq_)); _Pragma("unroll") for (int q_ = 0; q_ < 32; ++q_) dst[q_] = bq_[(size_t)(2 * q_) * 64]; } while (0)
constexpr int N2_H2 = 0, N2_CA = 131328, N2_CB = N2_CA + 4096, N2_HIST = N2_CB + 4096, N2_ST = N2_HIST + 256;
static_assert(N2_ST + 4864 <= LDS_CTL, "N2 LDS");
__device__ __forceinline__ void phase_norm2_router(Frame& F, int l, int skip, bool tail) {
    LAS unsigned char* L = F.lds;
    LAS float* H2 = (LAS float*)(L + N2_H2); LAS float* cA = (LAS float*)(L + N2_CA); LAS float* cB = (LAS float*)(L + N2_CB); LAS unsigned* hist = (LAS unsigned*)(L + N2_HIST);
    const int lane = F.lane, wid = F.wave, r32 = lane & 31, hh = lane >> 5;
    bf16* XN2 = (bf16*)wsp(F, WS_R1); unsigned* CUR = (unsigned*)wsp(F, WS_CUR) + l * 64;
    LAS int* stE = (LAS int*)(L + N2_ST); LAS float* stW = (LAS float*)(L + N2_ST + 2048); LAS unsigned* blockoff = (LAS unsigned*)(L + N2_ST + 4096); LAS unsigned* selm = (LAS unsigned*)(L + N2_ST + 4352);
    const float* Wr = inp(F, I_RW) + (size_t)l * 1024 * 64;
    const float rb = inp(F, I_RB)[l * 64 + lane];
    for (int vb = F.c; vb < 256; vb += F.G) {
        const int b = vb >> 6;
        const float* MODF = (const float*)wsp(F, WS_MODF) + (size_t)(l * 4 + b) * 6144;
        for (int k = F.tid; k < 1024; k += 512) { cA[k] = inp(F, I_N2W)[l * 1024 + k] * (1.f + MODF[4 * 1024 + k]); cB[k] = MODF[3 * 1024 + k]; }
        if (F.tid < 64) hist[F.tid] = 0u;
        const int eh = wid & 1, kq = wid >> 1;
        const GAS float* bp = (const GAS float*)(Wr + (size_t)(256 * kq + hh) * 64 + 32 * eh + r32);
        __syncthreads();
        for (int it = 0; it < 2; ++it) {
            const int T0 = vb * 64 + it * 32;
            float wA[32], wB[32];
            N2_LD0(wA, 0); N2_LD0(wB, 32);
            v4u xr4[4][2];
            if (!(skip & 4))
#pragma unroll
            for (int i = 0; i < 4; ++i) { const bf16* xr = xmid(F, l) + (size_t)(T0 + wid * 4 + i) * 1024 + 8 * lane;
#pragma unroll
                for (int j = 0; j < 2; ++j) xr4[i][j] = *(const GAS v4u*)(xr + 512 * j); }
#pragma unroll
            for (int i = 0; i < 4; ++i) if (!(skip & 4)) {
                const int tl = wid * 4 + i, t = T0 + tl;
                float v[2][8]; float ss = 0.f;
#pragma unroll
                for (int j = 0; j < 2; ++j) { const v4u a = xr4[i][j];
                    v[j][0] = bflo(a.x); v[j][1] = bfhi(a.x); v[j][2] = bflo(a.y); v[j][3] = bfhi(a.y); v[j][4] = bflo(a.z); v[j][5] = bfhi(a.z); v[j][6] = bflo(a.w); v[j][7] = bfhi(a.w);
#pragma unroll
                    for (int q = 0; q < 8; ++q) ss += v[j][q] * v[j][q]; }
                ss = wave_sum(ss, F.lane);
                const float r = 1.0f / sqrtf(ss * (1.f / 1024.f) + EPS);
#pragma unroll
                for (int j = 0; j < 2; ++j) { const int k = 8 * lane + 512 * j; float h[8];
                    const f32x4 a0 = *(const LAS f32x4*)(cA + k), a1 = *(const LAS f32x4*)(cA + k + 4), b0 = *(const LAS f32x4*)(cB + k), b1 = *(const LAS f32x4*)(cB + k + 4);
                    LAS float* hp = H2 + tl * 1025 + k;
#pragma unroll
                    for (int q = 0; q < 4; ++q) { h[q] = v[j][q] * r * a0[q] + b0[q]; h[4 + q] = v[j][4 + q] * r * a1[q] + b1[q]; }
#pragma unroll
                    for (int q = 0; q < 8; ++q) hp[q] = h[q];
                    v4u o; o.x = pk2(h[0], h[1]); o.y = pk2(h[2], h[3]); o.z = pk2(h[4], h[5]); o.w = pk2(h[6], h[7]);
                    *(GAS v4u*)(XN2 + (size_t)t * 1024 + k) = o; }
            }
            __syncthreads();
            f32x16 acc = {};
            {
                const LAS float* ap = H2 + r32 * 1025 + 256 * kq + hh;
#define N2_LD(dst, k0) N2_LD0(dst, k0)
#define N2_MM(src, k0) do { _Pragma("unroll") for (int q_ = 0; q_ < 32; ++q_) { if ((q_ & 7) == 0) asm volatile("" ::: "memory"); acc = __builtin_amdgcn_mfma_f32_32x32x2f32(ap[2 * ((k0) + q_)], src[q_], acc, 0, 0, 0); } } while (0)
                if (!(skip & 1)) { N2_MM(wA, 0); N2_LD(wA, 64); N2_MM(wB, 32); N2_LD(wB, 96); N2_MM(wA, 64); N2_MM(wB, 96); }
            }
            __syncthreads();
            LAS float* PART = (LAS float*)(L);
#pragma unroll
            for (int r = 0; r < 16; ++r) PART[(kq * 32 + crow(r, hh)) * 64 + 32 * eh + r32] = acc[r];
            __syncthreads();
            if (!(skip & 2))
            {
                LAS float* rowb = (LAS float*)(L + 32768 + wid * 4096);
                int lane_t = F.lane; asm volatile("" : "+v"(lane_t)); const int lane = lane_t;
                const int g = lane >> 3;
                float score[4], sel[4]; unsigned key[4];
#pragma unroll
                for (int i = 0; i < 4; ++i) { const int tl = wid * 4 + i;
                    const float x = (PART[(0 * 32 + tl) * 64 + lane] + PART[(1 * 32 + tl) * 64 + lane]) + (PART[(2 * 32 + tl) * 64 + lane] + PART[(3 * 32 + tl) * 64 + lane]);
                    score[i] = 1.f / (1.f + expf(-x)); sel[i] = score[i] + rb; rowb[i * 256 + lane] = sel[i]; }
                LDS_WAIT();
#pragma unroll
                for (int i = 0; i < 4; ++i) { const LAS float* row = rowb + i * 256;
                    const f32x4 a = *(const LAS f32x4*)(row + 8 * g), c2 = *(const LAS f32x4*)(row + 8 * g + 4);
                    float m1 = fmaxf(a[0], a[1]), m2 = fminf(a[0], a[1]);
#define TK_INS(v_) do { const float v__ = (v_); m2 = fmaxf(m2, fminf(m1, v__)); m1 = fmaxf(m1, v__); } while (0)
                    TK_INS(a[2]); TK_INS(a[3]); TK_INS(c2[0]); TK_INS(c2[1]); TK_INS(c2[2]); TK_INS(c2[3]);
#undef TK_INS
                    if ((lane & 7) == 0) rowb[i * 256 + 64 + g] = m1 + m2; }
                LDS_WAIT();
#pragma unroll
                for (int i = 0; i < 4; ++i) { const LAS float* row = rowb + i * 256;
                    const f32x4 a = *(const LAS f32x4*)(row + 64), c2 = *(const LAS f32x4*)(row + 68);
                    const float gsv[8] = {a[0], a[1], a[2], a[3], c2[0], c2[1], c2[2], c2[3]};
                    float mine = 0.f;
#pragma unroll
                    for (int q = 0; q < 8; ++q) if (q == g) mine = gsv[q];
                    int gr = 0;
#pragma unroll
                    for (int q = 0; q < 8; ++q) gr += ((gsv[q] > mine) || (gsv[q] == mine && q < g)) ? 1 : 0;
                    const unsigned sb = __float_as_uint(sel[i]); key[i] = (gr < 4) ? (sb ^ ((unsigned)((int)sb >> 31) | 0x80000000u)) : 0u; }
                unsigned chosenm = 0u; float wsum[4] = {0.f, 0.f, 0.f, 0.f}; int myE = 0; float myS = 0.f;
#pragma unroll
                for (int r = 0; r < 8; ++r)
#pragma unroll
                    for (int i = 0; i < 4; ++i) {
                        const unsigned m = wave_umax_all(key[i]);
                        const int idx = __builtin_ctzll(__builtin_amdgcn_ballot_w64(key[i] == m));
                        const float sc = __int_as_float(__builtin_amdgcn_readlane(__float_as_int(score[i]), idx));
                        wsum[i] += sc;
                        if (lane == idx) { key[i] = 0u; chosenm += 1u; }
                        if (lane == 8 * i + r) { myE = idx; myS = sc; }
                    }
                {
                    const int ti = lane >> 3; const float ws_ = (ti == 0) ? wsum[0] : (ti == 1) ? wsum[1] : (ti == 2) ? wsum[2] : wsum[3];
                    if (lane < 32) { const int o = (it * 32 + wid * 4) * 8 + lane; stE[o] = myE; stW[o] = myS / ws_ * 2.5f; }
                    if (chosenm) __hip_atomic_fetch_add(&hist[lane], chosenm, __ATOMIC_RELAXED, __HIP_MEMORY_SCOPE_WORKGROUP);
                }
                LDS_WAIT();
            }
            __syncthreads();
        }
        if (tail && !skip) {
        if (F.tid < 64) { const unsigned h_ = hist[F.tid]; blockoff[F.tid] = h_ ? __hip_atomic_fetch_add(CUR + F.tid, h_, __ATOMIC_RELAXED, __HIP_MEMORY_SCOPE_AGENT) : 0u; }
        if (F.tid < 128) selm[F.tid] = 0u;
        __syncthreads();
        { const int tok = F.tid >> 3, slot = F.tid & 7, gt = vb * 64 + tok; const int e = stE[F.tid];
          __hip_atomic_fetch_or(&selm[e * 2 + (tok >> 5)], 1u << (tok & 31), __ATOMIC_RELAXED, __HIP_MEMORY_SCOPE_WORKGROUP);
          __syncthreads();
          const unsigned lo = selm[e * 2], hi = selm[e * 2 + 1];
          const unsigned rank = (tok < 32) ? __popc(lo & ((1u << tok) - 1u)) : (__popc(lo) + __popc(hi & ((1u << (tok - 32)) - 1u)));
          const size_t pos = (size_t)e * RS_CAP + blockoff[e] + rank;
          *(GAS unsigned*)((unsigned*)wsp(F, WS_RSTOK) + pos) = (unsigned)gt; *(GAS float*)((float*)wsp(F, WS_RSW) + pos) = stW[F.tid]; *(GAS unsigned*)((unsigned*)wsp(F, WS_RSDST) + pos) = (unsigned)(gt * 8 + slot); }
        }
        __syncthreads();
    }
}

__device__ __forceinline__ int moe_layout(Frame& F, int l, LAS unsigned* tot, LAS unsigned* padv, LAS unsigned* base) {
    const unsigned* CUR = (const unsigned*)wsp(F, WS_CUR) + l * 64;
    if (F.tid < 64) { const unsigned T = *(const GAS unsigned*)(CUR + F.tid); tot[F.tid] = T; padv[F.tid] = (T + 255u) & ~255u; }
    __syncthreads();
    if (F.tid < 64) { unsigned b = 0; for (int e = 0; e < F.tid; ++e) b += padv[e]; base[F.tid] = b; }
    __syncthreads();
    return (int)((base[63] + padv[63]) >> 8);
}

__device__ __forceinline__ void phase_scatter(Frame& F) {
    LAS unsigned* red = (LAS unsigned*)(F.lds);
    LAS unsigned* tot = red + 1024; LAS unsigned* padv = tot + 64; LAS unsigned* bef = padv + 64; LAS unsigned* base = bef + 64; LAS unsigned* selm = base + 64;
    const unsigned* CNT = (const unsigned*)wsp(F, WS_CNT); const int* TOPE = (const int*)wsp(F, WS_TOPE); const float* TOPW = (const float*)wsp(F, WS_TOPW);
    unsigned* STOK = (unsigned*)wsp(F, WS_STOK); float* SW = (float*)wsp(F, WS_SW); unsigned* SDST = (unsigned*)wsp(F, WS_SDST); int* TILEE = (int*)wsp(F, WS_TILEE);
    const int tid = F.tid;
    for (int vb = F.c; vb < 256; vb += F.G) {
        { const int e = tid & 63, part = tid >> 6; unsigned t = 0, bfv = 0;
          unsigned cv[32];
#pragma unroll
          for (int q = 0; q < 32; ++q) cv[q] = *(const GAS unsigned*)(CNT + (32 * part + q) * 64 + e);
#pragma unroll
          for (int q = 0; q < 32; ++q) { t += cv[q]; if (32 * part + q < vb) bfv += cv[q]; }
          red[part * 64 + e] = t; red[512 + part * 64 + e] = bfv; }
        if (tid < 128) selm[tid] = 0u;
        __syncthreads();
        if (tid < 64) { unsigned T = 0, B = 0;
#pragma unroll
            for (int p = 0; p < 8; ++p) { T += red[p * 64 + tid]; B += red[512 + p * 64 + tid]; }
            tot[tid] = T; padv[tid] = (T + 255u) & ~255u; bef[tid] = B; }
        __syncthreads();
        if (tid < 64) { unsigned b = 0; for (int e = 0; e < tid; ++e) b += padv[e]; base[tid] = b; }
        const int tok = tid >> 3, slot = tid & 7, gt = vb * 64 + tok; const int e = TOPE[(size_t)gt * 8 + slot];
        __hip_atomic_fetch_or(&selm[e * 2 + (tok >> 5)], 1u << (tok & 31), __ATOMIC_RELAXED, __HIP_MEMORY_SCOPE_WORKGROUP);
        __syncthreads();
        { const unsigned lo = selm[e * 2], hi = selm[e * 2 + 1];
          const unsigned rank = (tok < 32) ? __popc(lo & ((1u << tok) - 1u)) : (__popc(lo) + __popc(hi & ((1u << (tok - 32)) - 1u)));
          const unsigned pos = base[e] + bef[e] + rank;
          STOK[pos] = (unsigned)gt; SW[pos] = TOPW[(size_t)gt * 8 + slot]; SDST[pos] = (unsigned)(gt * 8 + slot); }
        if (vb < 64) { const unsigned n = padv[vb] - tot[vb]; if ((unsigned)tid < n) { const unsigned pos = base[vb] + tot[vb] + tid; STOK[pos] = 0u; SW[pos] = 0.f; SDST[pos] = 0xffffffffu; } }
        if (vb == 0) { const int ntiles = (int)((base[63] + padv[63]) >> 8);
            for (int pm = tid; pm < ntiles; pm += 512) { int ee = 0; for (int q = 0; q < 64; ++q) if ((unsigned)(256 * pm) >= base[q] && (unsigned)(256 * pm) < base[q] + padv[q]) ee = q; TILEE[pm] = ee; }
            if (tid == 0) TILEE[1000] = ntiles; }
        __syncthreads();
    }
}

struct RoutedOrder {
    int ntiles, G, c; const LAS int* tabE; const LAS unsigned* tabTok; int wave;
    __device__ __forceinline__ bool next(int i, pg8::Unit& u) const { const int pm = i * G + c; if (pm >= ntiles) return false; u.pm = pm; u.pn = tabE[i]; return true; }
    __device__ __forceinline__ unsigned rowtok(int i, int row) const { return tabTok[i * 256 + row]; }
    __device__ __forceinline__ size_t aoff(const pg8::Unit&) const { return 0; }
};
struct DownOrder {
    int nunits, G, v; const LAS int* tabE; int wave;
    __device__ __forceinline__ bool next(int i, pg8::Unit& u) const { const int L = i * G + v; if (L >= nunits) return false; u.pm = L >> 2; u.pn = tabE[i] * 4 + (L & 3); return true; }
    __device__ __forceinline__ unsigned rowtok(int, int) const { return 0u; }
    __device__ __forceinline__ size_t aoff(const pg8::Unit&) const { return 0; }
};

__device__ __forceinline__ void phase_combine(Frame& F, int l, bool do_store) {
    const bf16* Y = (const bf16*)wsp(F, WS_R1); bf16* XN = (bf16*)wsp(F, WS_R2); float* GATES = (float*)wsp(F, WS_GATES);
    const bool last = (l == NLAYER - 1);
    for (int vb = F.c; vb < 256; vb += F.G) {
        const int b = vb >> 6;
        const float* g2 = (const float*)wsp(F, WS_MODF) + (size_t)(l * 4 + b) * 6144 + 5 * 1024;
        float gbl = 0.f;
        if (!last) { norm1_tables(F, l + 1, b, false); gbl = (F.lane < 4) ? inp(F, I_IGB)[(l + 1) * 4 + F.lane] : (F.lane < 8 ? inp(F, I_FGB)[(l + 1) * 4 + F.lane - 4] : 0.f); }
        __syncthreads();
        v2u yn[8][2];
        const bf16* SHO = (const bf16*)wsp(F, WS_R1 + 128 * MiB);
#define CB_LOAD(tt) do { const int t_ = (tt); \
            _Pragma("unroll") for (int s = 0; s < 8; ++s) _Pragma("unroll") for (int j = 0; j < 2; ++j) yn[s][j] = *(const GAS v2u*)((const unsigned char*)Y + ((size_t)t_ * 8 + s) * 1024 + 8 * F.lane + 512 * j); \
            } while (0)
        CB_LOAD(vb * 64 + F.wave * 8);
        for (int i = 0; i < 8; ++i) {
            const int t = vb * 64 + F.wave * 8 + i;
            v2u yc[8][2]; v4u xc[2]; v4u sc2[2]; bf16* xbr = xmid(F, l) + (size_t)t * 1024 + 8 * F.lane;
#pragma unroll
            for (int j = 0; j < 2; ++j) sc2[j] = *(const GAS v4u*)(SHO + (size_t)t * 1024 + 8 * F.lane + 512 * j);
#pragma unroll
            for (int s = 0; s < 8; ++s) { yc[s][0] = yn[s][0]; yc[s][1] = yn[s][1]; }
#pragma unroll
            for (int j = 0; j < 2; ++j) xc[j] = *(const GAS v4u*)(xbr + 512 * j);
            if (i + 1 < 8) CB_LOAD(t + 1);
            float acc[2][8];
#pragma unroll
            for (int j = 0; j < 2; ++j)
#pragma unroll
                for (int q = 0; q < 8; ++q) acc[j][q] = 0.f;
#pragma unroll
            for (int s = 0; s < 8; ++s)
#pragma unroll
                for (int j = 0; j < 2; ++j) { const v2u q = yc[s][j];
                    const f32x2_t a0 = __builtin_amdgcn_cvt_pk_f32_fp8((int)q.x, false), a1 = __builtin_amdgcn_cvt_pk_f32_fp8((int)q.x, true), a2 = __builtin_amdgcn_cvt_pk_f32_fp8((int)q.y, false), a3 = __builtin_amdgcn_cvt_pk_f32_fp8((int)q.y, true);
                    acc[j][0] += a0.x; acc[j][1] += a0.y; acc[j][2] += a1.x; acc[j][3] += a1.y; acc[j][4] += a2.x; acc[j][5] += a2.y; acc[j][6] += a3.x; acc[j][7] += a3.y; }
            float v[2][8]; float* xr = outp(F) + (size_t)t * 1024 + 8 * F.lane;
#pragma unroll
            for (int j = 0; j < 2; ++j) { const f32x4 a = {bflo(xc[j].x), bfhi(xc[j].x), bflo(xc[j].y), bfhi(xc[j].y)}, c2 = {bflo(xc[j].z), bfhi(xc[j].z), bflo(xc[j].w), bfhi(xc[j].w)};
                const f32x4 ga = *(const GAS f32x4*)(g2 + 8 * F.lane + 512 * j), gc = *(const GAS f32x4*)(g2 + 8 * F.lane + 512 * j + 4);
                const float sh[8] = {bflo(sc2[j].x), bfhi(sc2[j].x), bflo(sc2[j].y), bfhi(sc2[j].y), bflo(sc2[j].z), bfhi(sc2[j].z), bflo(sc2[j].w), bfhi(sc2[j].w)};
#pragma unroll
                for (int q = 0; q < 4; ++q) { v[j][q] = a[q] + ga[q] * (acc[j][q] * (1.f / YS_SCALE) + sh[q]); v[j][4 + q] = c2[q] + gc[q] * (acc[j][4 + q] * (1.f / YS_SCALE) + sh[4 + q]); } }
            if (last) {
                float ss = 0.f;
#pragma unroll
                for (int j = 0; j < 2; ++j)
#pragma unroll
                    for (int q = 0; q < 8; ++q) ss += v[j][q] * v[j][q];
                ss = wave_sum(ss, F.lane);
                const float r = 1.0f / sqrtf(ss * (1.f / 1024.f) + EPS);
#pragma unroll
                for (int j = 0; j < 2; ++j) { const float* fw = inp(F, I_FNW) + 8 * F.lane + 512 * j; const f32x4 w0 = *(const GAS f32x4*)fw, w1 = *(const GAS f32x4*)(fw + 4);
                    f32x4 o0, o1;
#pragma unroll
                    for (int q = 0; q < 4; ++q) { o0[q] = v[j][q] * r * w0[q]; o1[q] = v[j][4 + q] * r * w1[q]; }
                    if (do_store) { *(GAS f32x4*)(xr + 512 * j) = o0; *(GAS f32x4*)(xr + 512 * j + 4) = o1; } else asm volatile("" :: "v"(o0), "v"(o1)); }
            } else {
#pragma unroll
                for (int j = 0; j < 2; ++j) { v4u o; o.x = pk2(v[j][0], v[j][1]); o.y = pk2(v[j][2], v[j][3]); o.z = pk2(v[j][4], v[j][5]); o.w = pk2(v[j][6], v[j][7]);
                    if (do_store) { *(GAS v4u*)(xbr + 512 * j) = o; } else asm volatile("" :: "v"(o)); }
                if (do_store) norm_emit(F, v, (const LAS float*)(F.lds + LDS_TAB), (const LAS float*)(F.lds + LDS_TAB) + 1024, (const LAS float*)(F.lds), gbl, XN + (size_t)t * 1024, GATES + (size_t)t * 8);
            }
        }
#undef CB_LOAD
        __syncthreads();
    }
}

__device__ __forceinline__ void dbg_final(Frame& F, const float* src) {
    for (int vb = F.c; vb < 256; vb += F.G)
        for (int i = 0; i < 8; ++i) {
            const int t = vb * 64 + F.wave * 8 + i; const float* xr = src + (size_t)t * 1024 + 8 * F.lane; float* orow = outp(F) + (size_t)t * 1024 + 8 * F.lane;
            float v[2][8]; float ss = 0.f;
#pragma unroll
            for (int j = 0; j < 2; ++j) { const f32x4 a = *(const GAS f32x4*)(xr + 512 * j), c2 = *(const GAS f32x4*)(xr + 512 * j + 4);
#pragma unroll
                for (int q = 0; q < 4; ++q) { v[j][q] = a[q]; v[j][4 + q] = c2[q]; ss += a[q] * a[q] + c2[q] * c2[q]; } }
            ss = wave_sum(ss, F.lane);
            const float r = 1.0f / sqrtf(ss * (1.f / 1024.f) + EPS);
#pragma unroll
            for (int j = 0; j < 2; ++j) { const float* fw = inp(F, I_FNW) + 8 * F.lane + 512 * j; const f32x4 w0 = *(const GAS f32x4*)fw, w1 = *(const GAS f32x4*)(fw + 4);
                f32x4 o0, o1;
#pragma unroll
                for (int q = 0; q < 4; ++q) { o0[q] = v[j][q] * r * w0[q]; o1[q] = v[j][4 + q] * r * w1[q]; }
                *(GAS f32x4*)(orow + 512 * j) = o0; *(GAS f32x4*)(orow + 512 * j + 4) = o1; }
        }
}
struct Args { const float* in[24]; float* out; unsigned char* ws; };
#ifndef MK_EN_MASK
#define MK_EN_MASK 0xffffffffu
#endif
#define EN(k) (((MK_EN_MASK) >> (k)) & 1u)
#ifndef RP_G1
#define RP_G1 1
#endif
#ifndef RP_ATT
#define RP_ATT 1
#endif
#ifndef RP_ML
#define RP_ML 1
#endif
#ifndef RP_N2
#define RP_N2 1
#endif
#ifndef RP_CW
#define RP_CW 1
#endif
#ifndef RP_C
#define RP_C 1
#endif
#ifndef RP_D
#define RP_D 1
#endif
#ifndef RP_CV
#define RP_CV 1
#endif
#ifndef RP_PB
#define RP_PB 1
#endif
#ifndef RP_VT
#define RP_VT 1
#endif
#ifndef RP_PA
#define RP_PA 1
#endif
#ifndef RP_SC
#define RP_SC 1
#endif
#ifndef RP_SG
#define RP_SG 1
#endif
#ifndef ML_SKIP
#define ML_SKIP 0
#endif
#ifndef RP_X5
#define RP_X5 1
#endif
#ifndef RP_E
#define RP_E 1
#endif
#ifndef RP_HM
#define RP_HM 1
#endif
#ifndef RP_P1
#define RP_P1 1
#endif
#ifndef RP_SD
#define RP_SD 1
#endif
#ifndef N2_SKIP
#define N2_SKIP 0
#endif
#ifndef MK_LAST_PHASE
#define MK_LAST_PHASE 1000
#endif
__global__ void __launch_bounds__(512, 2) mk_fwd(Args args) {
    extern __shared__ __attribute__((aligned(16))) unsigned char lds_raw[];
    Frame F;
    F.lds = (LAS unsigned char*)lds_raw;
    const int wave0 = __builtin_amdgcn_readfirstlane((int)threadIdx.x >> 6);
#define RELOAD_IDS() do { int l_ = lane_now(); F.lane = l_; F.wave = wave0; F.tid = wave0 * 64 + l_; } while (0)
    RELOAD_IDS();
    F.G = gridDim.x; F.c = blockIdx.x;
    F.out = args.out; F.ws = args.ws;
    if (F.tid < 16) ((LAS unsigned*)(F.lds + LDS_CTL))[F.tid] = 0u;
#pragma unroll
    for (int i = 0; i < 24; ++i) if (F.tid == 64 + i) *(LAS unsigned long long*)(F.lds + LDS_CTL + 64 + 8 * i) = (unsigned long long)args.in[i];
    __syncthreads();
    XcdBarrier bar = xcd_barrier_post((unsigned*)wsp(F, WS_CTL) + CW_BAR, (volatile LAS unsigned*)(F.lds + LDS_CTL));
#define P6 ((bf16*)wsp(F, WS_P6))
#define VT ((bf16*)wsp(F, WS_VT))
#define R2 ((bf16*)wsp(F, WS_R2))
#define MODF ((const float*)wsp(F, WS_MODF))
#define GRID_BAR() do { XcdBarrier b_ = bar; asm volatile("" : "+s"(b_.bar), "+s"(b_.x)); xcd_barrier(b_); } while (0)
    int phase_no = 0;
#ifndef RP_BAR
#define RP_BAR 1
#endif
#ifdef TP_K
#define TP_SEL() ((TP_K) < 0 ? (phase_no == -(TP_K) - 1) : (phase_no >= 2 && (phase_no - 2) % 10 == (TP_K)))
#define TP_BEFORE() do { __syncthreads(); if (threadIdx.x == 0 && TP_SEL()) { const unsigned long long t1_ = wall_clock64(), t0_ = *(volatile LAS unsigned long long*)(F.lds + LDS_CTL + 16); \
        const unsigned long long te_ = t1_ + (unsigned long long)(TP_MULT) * (t1_ - t0_); while (wall_clock64() < te_) __builtin_amdgcn_s_sleep(8); } } while (0)
#define TP_AFTER() do { if (threadIdx.x == 0) *(volatile LAS unsigned long long*)(F.lds + LDS_CTL + 16) = wall_clock64(); } while (0)
#else
#define TP_BEFORE() do { } while (0)
#define TP_AFTER() do { } while (0)
#endif
#define PHASE_END() do { TP_BEFORE(); for (int rb_ = 0; rb_ < RP_BAR; ++rb_) GRID_BAR(); TP_AFTER(); RELOAD_IDS(); if (++phase_no >= MK_LAST_PHASE) goto finish; } while (0)
    TP_AFTER();

    if (EN(0)) { mod_partials(F);
    for (int rp = 0; rp < RP_CW; ++rp) { RELOAD_IDS(); conv_weights(F, 0); } }
    PHASE_END();
    for (int rp = 0; rp < RP_P1; ++rp) if (EN(1)) phase_norm1_first(F);
    PHASE_END();

#pragma unroll
    for (int l = 0; l < NLAYER; ++l) {
        if (EN(2)) { phase_mlstm_scalars(F); RELOAD_IDS(); }
        for (int rp = 0; rp < RP_G1; ++rp) if (EN(2)) {
            pg8::Gemm g{R2, (const bf16*)wsp(F, WS_BIN), 1024, 1024}; pg8::StaticOrder S; S.init(NTOK, P6N, F.G, F.c, F.wave);
            EpiP6 E{P6};
            pg8::gemm_phase<EpiP6, pg8::StaticOrder, true, false>(F.lds, g, S, E);
        }
        for (int rp = 0; rp < RP_VT; ++rp) if (EN(3)) {
            pg8::Gemm g{(const bf16*)wsp(F, WS_AIN), R2, 1024, 1024}; pg8::StaticOrder S; S.init(2048, NTOK, F.G, F.c, F.wave);
            EpiPlain E{VT, NTOK};
            pg8::gemm_phase<EpiPlain, pg8::StaticOrder, true, false>(F.lds, g, S, E);
        }
        PHASE_END();
        for (int pass = 0; pass < 2; ++pass) {
            if (((pass ^ F.c) & 1) == 0) { for (int rp = 0; rp < RP_CV; ++rp) if (EN(4)) phase_cvp(F, l); }
            else { for (int rp = 1; rp < RP_ATT; ++rp) phase_attn(F, false); if (EN(5)) phase_attn(F, true); }
            RELOAD_IDS();
        }
        PHASE_END();
        for (int rp = 0; rp < RP_ML; ++rp) if (EN(6)) phase_mlstm(F, (RP_ML > 1 && rp == 0) ? ML_SKIP : 0);
        PHASE_END();
        for (int rp = 1; rp < RP_HM; ++rp) phase_hm_final(F, l, false);
        if (EN(7)) phase_hm_final(F, l, true);
        PHASE_END();
        for (int rp = 0; rp < RP_PA; ++rp) if (EN(9)) {
            pg8::Gemm g{P6 + P_MQK, (const bf16*)wsp(F, WS_BA), 1024, P6W};
            PairOrder S; S.so.init(NTOK, 1024, F.G, F.c, F.wave); S.acol_b = (size_t)(P_SQ - P_MQK) * 2; S.wave = F.wave;
            EpiPair E{EpiGateT1{P6 + P_GB, P6W, (bf16*)wsp(F, WS_VT)}, EpiGateY{P6 + P_GA, P6W, (const bf16*)wsp(F, WS_VT), R2}};
            pg8::gemm_phase<EpiPair, PairOrder, true, false>(F.lds, g, S, E);
        }
        PHASE_END();
        for (int rp = 0; rp < RP_X5; ++rp) if (EN(10)) {
            pg8::Gemm g{R2, (const bf16*)wsp(F, WS_BO), 1024, 1024}; pg8::StaticOrder S; S.init(NTOK, 1024, F.G, F.c, F.wave);
            EpiRes E{(const bf16*)outp(F), xmid(F, l), MODF + (size_t)(l * 4) * 6144 + 2 * 1024, (RP_X5 > 1 && rp + 1 < RP_X5) ? 1 : 0};
            pg8::gemm_phase<EpiRes, pg8::StaticOrder, true, false>(F.lds, g, S, E);
        }
        PHASE_END();
        for (int rp = 0; rp < RP_N2; ++rp) if (EN(11)) phase_norm2_router(F, l, (RP_N2 > 1 && rp == 0) ? N2_SKIP : 0, rp == RP_N2 - 1);
        PHASE_END();
        {
            LAS int* tabE = (LAS int*)(F.lds + LDS_TAB); LAS unsigned* tabTok = (LAS unsigned*)(F.lds + LDS_TAB + 64);
            LAS float* tabW = (LAS float*)(F.lds + LDS_TAB + 64 + 3072);
            LAS unsigned* tot = (LAS unsigned*)(F.lds + LDS_TAB + 64 + 6144); LAS unsigned* padv = tot + 64; LAS unsigned* base = padv + 64;
            const int ntiles = moe_layout(F, l, tot, padv, base);
            const int v = (F.G % 8 == 0) ? (F.c % 8) * (F.G / 8) + F.c / 8 : F.c;
            const int cs = (F.G % 8 == 0) ? (v + F.G / 2) % F.G : F.G - 1 - F.c;
            if (F.tid < 64) {
#pragma unroll
                for (int i = 0; i < 3; ++i) { const unsigned r0 = 256u * (unsigned)(i * F.G + v); if (r0 >= base[F.tid] && r0 < base[F.tid] + padv[F.tid]) tabE[i] = F.tid; }
            }
            __syncthreads();
            if (F.tid < 256) {
                const unsigned* RT = (const unsigned*)wsp(F, WS_RSTOK); const float* RW = (const float*)wsp(F, WS_RSW);
                unsigned tt[3]; float tw[3]; bool ok[3];
#pragma unroll
                for (int i = 0; i < 3; ++i) { const int pm = i * F.G + v; ok[i] = false; tt[i] = 0u; tw[i] = 0.f;
                    if (pm < ntiles) { const int e = tabE[i]; const unsigned rel = 256u * (unsigned)pm - base[e] + (unsigned)F.tid; ok[i] = true;
                        if (rel < tot[e]) { tt[i] = *(const GAS unsigned*)(RT + (size_t)e * RS_CAP + rel); tw[i] = *(const GAS float*)(RW + (size_t)e * RS_CAP + rel); } } }
#pragma unroll
                for (int i = 0; i < 3; ++i) if (ok[i]) { tabTok[i * 256 + F.tid] = tt[i]; tabW[i * 256 + F.tid] = tw[i]; }
            }
            __syncthreads();
            for (int rp = 0; rp < RP_C; ++rp) if (EN(13)) {
                pg8::Gemm g{(const bf16*)wsp(F, WS_R1), (const bf16*)wsp(F, WS_BGU), 1024, 1024}; RoutedOrder S{ntiles, F.G, v, tabE, tabTok, F.wave};
                EpiHid E{R2, 128, tabW, v, F.G, 0};
                pg8::gemm_phase<EpiHid, RoutedOrder, true, true>(F.lds, g, S, E);
            }
            for (int rp = 0; rp < RP_SG; ++rp) if (EN(14)) {
                pg8::Gemm g{(const bf16*)wsp(F, WS_R1), (const bf16*)wsp(F, WS_BSGU), 1024, 1024}; pg8::StaticOrder S; S.init(NTOK, 512, F.G, cs, F.wave);
                EpiHid E{(bf16*)wsp(F, WS_R3), 256, nullptr, 0, 1, 1};
                pg8::gemm_phase<EpiHid, pg8::StaticOrder, true, false>(F.lds, g, S, E);
            }
        }
        PHASE_END();
        {
            LAS int* tabE = (LAS int*)(F.lds + LDS_TAB); LAS unsigned* tabD = (LAS unsigned*)(F.lds + LDS_TAB + 64);
            LAS unsigned* tot = (LAS unsigned*)(F.lds + LDS_TAB + 64 + 10240); LAS unsigned* padv = tot + 64; LAS unsigned* base = padv + 64;
            const int ntiles = moe_layout(F, l, tot, padv, base), nunits = 4 * ntiles;
            const int v = (F.G % 8 == 0) ? (F.c % 8) * (F.G / 8) + F.c / 8 : F.c;
            if (F.tid < 64) {
#pragma unroll
                for (int i = 0; i < 10; ++i) { const int Lu = i * F.G + v; const unsigned r0 = 256u * (unsigned)(Lu >> 2); if (Lu < nunits && r0 >= base[F.tid] && r0 < base[F.tid] + padv[F.tid]) tabE[i] = F.tid; }
            }
            __syncthreads();
            if (F.tid < 256) {
                const unsigned* RD = (const unsigned*)wsp(F, WS_RSDST);
                unsigned td[10]; bool ok[10];
#pragma unroll
                for (int i = 0; i < 10; ++i) { const int Lu = i * F.G + v; ok[i] = Lu < nunits; td[i] = 0xffffffffu;
                    if (ok[i]) { const int e = tabE[i]; const unsigned rel = 256u * (unsigned)(Lu >> 2) - base[e] + (unsigned)F.tid; if (rel < tot[e]) td[i] = *(const GAS unsigned*)(RD + (size_t)e * RS_CAP + rel); } }
#pragma unroll
                for (int i = 0; i < 10; ++i) if (ok[i]) tabD[i * 256 + F.tid] = td[i];
            }
            __syncthreads();
            for (int rp = 0; rp < RP_D; ++rp) if (EN(15)) {
                pg8::Gemm g{R2, (const bf16*)wsp(F, WS_BD), 128, 128}; DownOrder S{nunits, F.G, v, tabE, F.wave};
                EpiScatter E{(bf16*)wsp(F, WS_R1), tabD, v, F.G, (RP_D > 1 && rp > 0) ? 1 : 0};
                pg8::gemm_phase<EpiScatter, DownOrder, true, false>(F.lds, g, S, E);
            }
            for (int rp = 0; rp < RP_SD; ++rp) if (EN(16)) {
                pg8::Gemm g{(const bf16*)wsp(F, WS_R3), (const bf16*)wsp(F, WS_BSD), 256, 256}; pg8::StaticOrder S; S.init(NTOK, 1024, F.G, F.c, F.wave);
                EpiPlain E{(bf16*)wsp(F, WS_R1 + 128 * MiB), 1024};
                pg8::gemm_phase<EpiPlain, pg8::StaticOrder, true, false>(F.lds, g, S, E);
            }
        }
        PHASE_END();
        for (int rp = 1; rp < RP_E; ++rp) phase_combine(F, l, false);
        if (EN(17)) phase_combine(F, l, true);
        if (l + 1 < NLAYER) { RELOAD_IDS(); if (EN(18)) conv_weights(F, l + 1); PHASE_END(); }
    }
#undef P6
#undef VT
#undef R2
#undef MODF
finish:
    if (MK_LAST_PHASE < 1000) dbg_final(F, phase_no >= 8 ? (const float*)outp(F) : inp(F, I_X));
}

extern "C" void kernel_launch(void* const* d_in, const int* in_sizes, int n_in, void* d_out, int out_size, void* d_ws, size_t ws_size, hipStream_t stream) {
    static int grid = 0;
    if (grid == 0) {
        if (n_in != 24 || in_sizes[0] != NTOK * DM || out_size != NTOK * DM || ws_size < WS_END) {
            fprintf(stderr, "kernel_launch: unexpected shapes (n_in %d, in0 %d, out %d, ws %zu < %zu); nothing launched\n", n_in, n_in > 0 ? in_sizes[0] : -1, out_size, ws_size, (size_t)WS_END); grid = -1; return; }
        int dev = 0, cus = 0, per_cu = 0;
        if (hipGetDevice(&dev) != hipSuccess || hipDeviceGetAttribute(&cus, hipDeviceAttributeMultiprocessorCount, dev) != hipSuccess) { grid = -1; return; }
        if (hipFuncSetAttribute((const void*)mk_fwd, hipFuncAttributeMaxDynamicSharedMemorySize, LDS_BYTES) != hipSuccess) { fprintf(stderr, "kernel_launch: hipFuncSetAttribute failed\n"); grid = -1; return; }
        if (hipOccupancyMaxActiveBlocksPerMultiprocessor(&per_cu, (const void*)mk_fwd, 512, LDS_BYTES) != hipSuccess || per_cu < 1)
            fprintf(stderr, "kernel_launch: note: occupancy query reports %d workgroups per CU\n", per_cu);
        (void)hipGetLastError();
        grid = cus;
    }
    if (grid < 0) return;
    if (hipMemsetAsync((char*)d_ws + WS_CTL, 0, CTL_ZERO_BYTES, stream) != hipSuccess) return;
    Args a{};
    for (int i = 0; i < 24; ++i) a.in[i] = (const float*)d_in[i];
    a.out = (float*)d_out; a.ws = (unsigned char*)d_ws;
    hipLaunchKernelGGL(mk_fwd, dim3(grid), dim3(512), LDS_BYTES, stream, a);
}
```

```cpp
#include <hip/hip_runtime.h>
#include <cstdio>
#include <cstdint>
#include <cmath>
namespace pg8 {
#define PG8_LAS __attribute__((address_space(3)))
typedef unsigned short bf16_t;
typedef short bf16x8 __attribute__((ext_vector_type(8)));
typedef float f32x4 __attribute__((ext_vector_type(4)));
typedef unsigned u32x4 __attribute__((ext_vector_type(4)));
constexpr int BM = 256, BK = 64, HALF = 128, HTB = HALF * BK * 2  , STAGE_BYTES = 8 * HTB, NXCD = 8, WGM = 8;

__host__ __device__ __forceinline__ int lds_byte(int r, int c) { const int st = (r >> 4) * 2 + (c >> 5), rr = r & 15, cc = c & 31, ob = rr * 64 + cc * 2; return st * 1024 + (ob ^ (((ob >> 9) & 1) << 5)); }
__host__ __device__ __forceinline__ void stage_rc(int b, int& R, int& C) { const int st = b / 1024, sb = b % 1024, swz = sb ^ (((sb >> 9) & 1) << 5); R = (st >> 1) * 16 + swz / 64; C = (st & 1) * 32 + (swz % 64) / 2; }
__host__ __device__ __forceinline__ int perm32(int rho) { const int n = rho >> 4, i = rho & 15; return 8 * (i >> 2) + 4 * n + (i & 3); }

struct Unit { int pm, pn; };
struct Gemm { const bf16_t* A; const bf16_t* Bt; int K; int lda; };

struct StaticOrder {
    int nM, nN, nwg, G, c, wave;
    __device__ void init(int M, int N, int G_, int c_, int wave_) { nM = M / BM; nN = N / BM; nwg = nM * nN; G = G_; c = c_; wave = wave_; }
    __device__ bool next(int i, Unit& u) const {
        const long L = (long)i * G + c; if (L >= nwg) return false;
        int wgid = (int)L; { const int q = nwg / NXCD, r = nwg % NXCD, xcd = wgid % NXCD, off = wgid / NXCD; wgid = (xcd < r ? xcd * (q + 1) : r * (q + 1) + (xcd - r) * q) + off; }
        const int nig = WGM * nN, gid = wgid / nig, fm = gid * WGM, gsz = (nM - fm) < WGM ? (nM - fm) : WGM;
        u.pm = fm + ((wgid % nig) % gsz); u.pn = (wgid % nig) / gsz; return true;
    }
    __device__ __forceinline__ unsigned rowtok(int, int) const { return 0u; }
    __device__ __forceinline__ size_t aoff(const Unit&) const { return 0; }
};

template <class Epi, class Sched, bool ALIGN_EPI, bool GATHER>
__device__ __forceinline__ void gemm_phase(PG8_LAS unsigned char* lds, const Gemm g, const Sched& S, const Epi& E) {
    int lane_; asm volatile("v_mbcnt_lo_u32_b32 %0, -1, 0\n\tv_mbcnt_hi_u32_b32 %0, -1, %0" : "=v"(lane_));
    const int wid = S.wave, lane = lane_, tid = wid * 64 + lane, wr = wid >> 2, wc = wid & 3, fr = lane & 15, fq = lane >> 4;
    int K_ = g.K, lda_ = g.lda; asm volatile("" : "+s"(K_), "+s"(lda_));
    const int K = K_, nt = K / BK, lda = lda_;
    unsigned vA[2][2], voffB[2];
#pragma unroll
    for (int i = 0; i < 2; ++i) { int R, C; stage_rc(tid * 16 + i * 8192, R, C); const int Rb = Epi::PERM ? ((R & ~31) + perm32(R & 31)) : R;
        voffB[i] = (unsigned)(Rb * K + C) * 2u;
#pragma unroll
        for (int h = 0; h < 2; ++h) vA[h][i] = (unsigned)(((GATHER ? h * HALF : 0) + R) * lda + C) * 2u; }
    const size_t kstep = (size_t)(BK * 2);
    const size_t hstepB = (size_t)HALF * K * 2, tstepB = 2 * hstepB;
    const size_t tstepA = (size_t)BM * lda * 2, hstepA = (size_t)HALF * lda * 2;
    const unsigned ldsw = (unsigned)wid * 1024u;
    const int aoff = lds_byte(wr * 64 + fr, fq * 8), boff = lds_byte(wc * 32 + fr, fq * 8);
#define PG8_SA(b, h) (((b) * 2 + (h)) * HTB)
#define PG8_SB(b, h) ((4 + (b) * 2 + (h)) * HTB)
#define PG8_STAGE(bufoff, gbase, voff) do { _Pragma("unroll") for (int _i = 0; _i < 2; ++_i) \
        __builtin_amdgcn_global_load_lds((const unsigned*)((const char*)(gbase) + (voff)[_i]), (PG8_LAS unsigned*)(lds + (bufoff) + ldsw + _i * 8192), 16, 0, 0); } while (0)
#define PG8_GATHER_SET(ui_, h) do { int l2_; asm volatile("v_mbcnt_lo_u32_b32 %0, -1, 0\n\tv_mbcnt_hi_u32_b32 %0, -1, %0" : "=v"(l2_)); const int tid2_ = wid * 64 + l2_; _Pragma("unroll") for (int _i = 0; _i < 2; ++_i) { int R_, C_; stage_rc(tid2_ * 16 + _i * 8192, R_, C_); vA[h][_i] = (S.rowtok((ui_), (h) * HALF + R_) * (unsigned)lda + (unsigned)C_) * 2u; } } while (0)
#define PG8_STAGE_A(bufoff, gbase, h, NX) do { _Pragma("unroll") for (int _i = 0; _i < 2; ++_i) { const unsigned _v = GATHER ? vA[h][_i] : vA[0][_i]; \
        __builtin_amdgcn_global_load_lds((const unsigned*)((const char*)(gbase) + (GATHER ? (size_t)0 : (size_t)(h) * hstepA) + _v), (PG8_LAS unsigned*)(lds + (bufoff) + ldsw + _i * 8192), 16, 0, 0); } } while (0)
#define PG8_LDA(dst, b, h) do { _Pragma("unroll") for (int m = 0; m < 4; ++m) _Pragma("unroll") for (int k = 0; k < 2; ++k) dst[m][k] = *(const PG8_LAS bf16x8*)(lds + PG8_SA(b, h) + aoff + m * 2048 + k * 1024); } while (0)
#define PG8_LDB(dst, b, h) do { _Pragma("unroll") for (int n = 0; n < 2; ++n) _Pragma("unroll") for (int k = 0; k < 2; ++k) dst[n][k] = *(const PG8_LAS bf16x8*)(lds + PG8_SB(b, h) + boff + n * 2048 + k * 1024); } while (0)
#define PG8_MMA(ai, bj, At, Bt) do { __builtin_amdgcn_s_setprio(1); _Pragma("unroll") for (int m = 0; m < 4; ++m) _Pragma("unroll") for (int n = 0; n < 2; ++n) _Pragma("unroll") for (int k = 0; k < 2; ++k) \
        acc[ai][bj][m][n] = __builtin_amdgcn_mfma_f32_16x16x32_bf16(Bt[n][k], At[m][k], acc[ai][bj][m][n], 0, 0, 0); __builtin_amdgcn_s_setprio(0); } while (0)
#define PG8_WAIT_V(n) asm volatile("s_waitcnt vmcnt(" #n ")" ::: "memory")
#define PG8_WAIT_L(n) asm volatile("s_waitcnt lgkmcnt(" #n ")" ::: "memory")
#define PG8_BAR __builtin_amdgcn_s_barrier()
#define PG8_SCHED __builtin_amdgcn_sched_barrier(0)
    Unit cur, nxt; int ui = 0;
    if (!S.next(0, cur)) return;
    if constexpr (GATHER) { PG8_GATHER_SET(0, 0); PG8_GATHER_SET(0, 1); }
    f32x4 acc[2][2][4][2];
#pragma unroll
    for (int a = 0; a < 2; ++a)
#pragma unroll
        for (int b = 0; b < 2; ++b)
#pragma unroll
            for (int m = 0; m < 4; ++m)
#pragma unroll
                for (int n = 0; n < 2; ++n) acc[a][b][m][n] = (f32x4){0.f, 0.f, 0.f, 0.f};
    bf16x8 At[4][2], B0[2][2], B1[2][2];
    const char* cA = (const char*)g.A + (GATHER ? (size_t)0 : (size_t)cur.pm * tstepA + S.aoff(cur)); const char* cB = (const char*)g.Bt + (size_t)cur.pn * tstepB;
    PG8_STAGE(PG8_SB(0, 0), cB, voffB); PG8_STAGE(PG8_SB(0, 1), cB + hstepB, voffB); PG8_STAGE_A(PG8_SA(0, 0), cA, 0, false); PG8_STAGE_A(PG8_SA(0, 1), cA, 1, false);
    if (wr == 1) PG8_BAR;
    PG8_WAIT_V(2); PG8_BAR;
    PG8_STAGE(PG8_SB(1, 0), cB + kstep, voffB); PG8_STAGE_A(PG8_SA(1, 0), cA + kstep, 0, false); PG8_STAGE(PG8_SB(1, 1), cB + hstepB + kstep, voffB);
    PG8_WAIT_V(6); PG8_BAR;
    for (;;) {
        const bool has_next = S.next(ui + 1, nxt);
        const char* nA = (has_next && !GATHER) ? (const char*)g.A + (size_t)nxt.pm * tstepA + S.aoff(nxt) : (GATHER ? (const char*)g.A : cA);
        const char* nB = has_next ? (const char*)g.Bt + (size_t)nxt.pn * tstepB : cB;
        for (int t = 0; t < nt; t += 2) {
            const bool last = (t == nt - 2);
            const char* a1 = cA + (size_t)(t + 1) * kstep;
            const char* a2 = last ? nA : cA + (size_t)(t + 2) * kstep; const char* b2 = last ? nB : cB + (size_t)(t + 2) * kstep;
            const char* a3 = a2 + kstep; const char* b3 = b2 + kstep;
            if constexpr (GATHER) { if (last && has_next) PG8_GATHER_SET(ui + 1, 0); }
            PG8_LDB(B0, 0, 0); PG8_LDB(B1, 0, 1); PG8_SCHED; PG8_LDA(At, 0, 0); PG8_STAGE_A(PG8_SA(1, 1), a1, 1, false);
            if constexpr (GATHER) { if (last && has_next) PG8_GATHER_SET(ui + 1, 1); }
            PG8_WAIT_V(8); PG8_WAIT_L(0); PG8_BAR; PG8_MMA(0, 0, At, B0); PG8_MMA(0, 1, At, B1); PG8_BAR; PG8_SCHED;
            PG8_LDA(At, 0, 1); PG8_STAGE(PG8_SB(0, 0), b2, voffB); PG8_STAGE(PG8_SB(0, 1), b2 + hstepB, voffB); PG8_STAGE_A(PG8_SA(0, 0), a2, 0, last);
            PG8_WAIT_V(8); PG8_WAIT_L(0); PG8_BAR; PG8_MMA(1, 0, At, B0); PG8_MMA(1, 1, At, B1); PG8_BAR; PG8_SCHED;
            PG8_LDB(B0, 1, 0); PG8_LDB(B1, 1, 1); PG8_SCHED; PG8_LDA(At, 1, 0); PG8_STAGE_A(PG8_SA(0, 1), a2, 1, last);
            PG8_WAIT_V(8); PG8_WAIT_L(0); PG8_BAR; PG8_MMA(0, 0, At, B0); PG8_MMA(0, 1, At, B1); PG8_BAR; PG8_SCHED;
            PG8_LDA(At, 1, 1); PG8_STAGE(PG8_SB(1, 0), b3, voffB); PG8_STAGE(PG8_SB(1, 1), b3 + hstepB, voffB); PG8_STAGE_A(PG8_SA(1, 0), a3, 0, last);
            PG8_WAIT_V(8); PG8_WAIT_L(0); PG8_BAR; PG8_MMA(1, 0, At, B0); PG8_MMA(1, 1, At, B1); PG8_BAR; PG8_SCHED;
        }
        if constexpr (ALIGN_EPI) { if (wr == 0) PG8_BAR; }
        { Unit eu; eu.pm = __builtin_amdgcn_readfirstlane(cur.pm); eu.pn = __builtin_amdgcn_readfirstlane(cur.pn); int fr_ = fr, fq_ = fq; asm volatile("" : "+s"(eu.pm), "+s"(eu.pn), "+v"(fr_), "+v"(fq_));
          E(acc, eu, wr, wc, fr_, fq_); }
        if (!has_next) break;
#pragma unroll
        for (int a = 0; a < 2; ++a)
#pragma unroll
            for (int b = 0; b < 2; ++b)
#pragma unroll
                for (int m = 0; m < 4; ++m)
#pragma unroll
                    for (int n = 0; n < 2; ++n) acc[a][b][m][n] = (f32x4){0.f, 0.f, 0.f, 0.f};
        cur = nxt; cA = nA; cB = nB; ++ui;
        if constexpr (ALIGN_EPI) { if (wr == 1) PG8_BAR; }
    }
    PG8_WAIT_V(0);
    if constexpr (!ALIGN_EPI) { if (wr == 0) PG8_BAR; }
    PG8_BAR;
#undef PG8_SA
#undef PG8_SB
#undef PG8_STAGE
#undef PG8_STAGE_A
#undef PG8_GATHER_SET
#undef PG8_LDA
#undef PG8_LDB
#undef PG8_MMA
#undef PG8_WAIT_V
#undef PG8_WAIT_L
#undef PG8_BAR
#undef PG8_SCHED
}
}

constexpr int NTOK = 16384, DM = 1024, SEQ = 4096, NB = 4, NLAYER = 2;
constexpr int INW = 8200;
constexpr int C_MQK = 0, C_MV = 1024, C_MO = 2048, C_MI = 3072, C_MF = 3076, C_SQ = 3080, C_SK = 4104, C_SV = 5128, C_GA = 6152, C_GB = 7176;
constexpr int P6N = 6144;
constexpr int P6W = 1024;
constexpr int P_BLK = 16384 * 1024;
constexpr int P_MQK = 0, P_MO = 1 * P_BLK, P_SQ = 2 * P_BLK, P_SK = 3 * P_BLK, P_GA = 4 * P_BLK, P_GB = 5 * P_BLK;
constexpr int NEXP = 64, EFF = 128, SFF = 256, TOPK = 8;
constexpr int MAXROWS = NTOK * TOPK + NEXP * 256;
constexpr int MAXTILES = MAXROWS / 256;
constexpr float EPS = 1e-6f;
constexpr float LOG2E = 1.4426950408889634f;

constexpr size_t MiB = 1u << 20;
constexpr size_t WS_CTL = 0, CTL_BAR_BYTES = 3456 * 4, WS_CUR = CTL_BAR_BYTES, CTL_ZERO_BYTES = CTL_BAR_BYTES + 512;
constexpr size_t WS_MODP = 1 * MiB;
constexpr size_t WS_MODF = 4 * MiB;
constexpr size_t WS_GATES = WS_MODF + 256 * 1024;
constexpr size_t WS_TOPE = WS_GATES + 512 * 1024;
constexpr size_t WS_TOPW = WS_TOPE + 512 * 1024;
constexpr size_t WS_CNT = WS_TOPW + 512 * 1024;
constexpr size_t WS_STOK = WS_CNT + 64 * 1024;
constexpr size_t WS_SW = WS_STOK + 576 * 1024;
constexpr size_t WS_SDST = WS_SW + 576 * 1024;
constexpr size_t WS_TILEE = WS_SDST + 576 * 1024;
constexpr size_t WS_MISC_END = WS_TILEE + 4096;
static_assert(WS_MISC_END <= 8 * MiB, "misc region");
constexpr size_t WS_BIN = 8 * MiB;
constexpr size_t WS_AIN = WS_BIN + 12 * MiB;
constexpr size_t WS_BA = WS_AIN + 4 * MiB, WS_BB = WS_BA + 2 * MiB, WS_BO = WS_BB + 2 * MiB;
constexpr size_t WS_BGU = WS_BO + 2 * MiB;
constexpr size_t WS_BD = WS_BGU + 32 * MiB;
constexpr size_t WS_BSGU = WS_BD + 16 * MiB;
constexpr size_t WS_BSD = WS_BSGU + 1 * MiB;
constexpr size_t WS_W_END = WS_BSD + 1 * MiB;
constexpr size_t WS_R1 = 80 * MiB;
constexpr size_t WS_P6 = WS_R1, WS_VT = WS_R1 + 192 * MiB;
constexpr size_t WS_R2 = WS_R1 + 256 * MiB;
constexpr size_t WS_R3 = WS_R2 + 36 * MiB;
constexpr size_t WS_PT = WS_R3 + 8 * MiB;
constexpr size_t WS_END = WS_PT + 18 * MiB;
constexpr int RS_CAP = 16384;
constexpr size_t WS_RSTOK = WS_PT, WS_RSW = WS_PT + 4 * MiB;
constexpr size_t WS_RSPOS = WS_TOPE;
constexpr size_t WS_YSLOT = WS_R1, WS_SHO = WS_R1 + 144 * MiB;
static_assert(WS_W_END <= WS_R1, "weights region");
constexpr int CW_BAR = 0;

constexpr int LDS_BYTES = 163840;
constexpr int LDS_MAIN = 131072;
constexpr int LDS_TAB = 131072;
constexpr int LDS_CTL = LDS_BYTES - 512;

#define GAS __attribute__((address_space(1)))
#define LAS __attribute__((address_space(3)))
typedef unsigned short bf16;
typedef unsigned v4u __attribute__((ext_vector_type(4)));
typedef unsigned v2u __attribute__((ext_vector_type(2)));
typedef float f32x4 __attribute__((ext_vector_type(4)));
typedef float f32x16 __attribute__((ext_vector_type(16)));
typedef short bf16x8 __attribute__((ext_vector_type(8)));
typedef short s16x4 __attribute__((ext_vector_type(4)));
typedef GAS unsigned gu32;
#define RLX_AGENT __ATOMIC_RELAXED, __HIP_MEMORY_SCOPE_AGENT
#define LDS_WAIT() asm volatile("s_waitcnt lgkmcnt(0)" ::: "memory")
typedef float f32x2_t __attribute__((ext_vector_type(2))); typedef __bf16 bf16x2_t __attribute__((ext_vector_type(2)));
__device__ __forceinline__ unsigned pk2(float lo, float hi) { f32x2_t v = {lo, hi}; bf16x2_t b = __builtin_convertvector(v, bf16x2_t); return __builtin_bit_cast(unsigned, b); }
__device__ __forceinline__ unsigned short f2bf(float f) { return (unsigned short)(pk2(f, 0.f) & 0xffffu); }
__device__ __forceinline__ float bflo(unsigned w) { return __uint_as_float(w << 16); }
__device__ __forceinline__ float bfhi(unsigned w) { return __uint_as_float(w & 0xffff0000u); }
__device__ __forceinline__ float bf2f(unsigned short h) { return __uint_as_float((unsigned)h << 16); }
__device__ __forceinline__ float sigmoidf_(float x) { return __builtin_amdgcn_rcpf(1.f + __builtin_amdgcn_exp2f(-x * LOG2E)); }
__device__ __forceinline__ int crow(int r, int hi) { return (r & 3) + 8 * (r >> 2) + 4 * hi; }
__device__ __forceinline__ int lane_now() { int l; asm volatile("v_mbcnt_lo_u32_b32 %0, -1, 0\n\tv_mbcnt_hi_u32_b32 %0, -1, %0" : "=v"(l)); return l; }
__device__ __forceinline__ float shfl_xor_l(float v, int d, int lane) { return __int_as_float(__builtin_amdgcn_ds_bpermute((lane ^ d) << 2, __float_as_int(v))); }
__device__ __forceinline__ float shfl_up_l(float v, int d, int lane) { return __int_as_float(__builtin_amdgcn_ds_bpermute(((lane - d) & 63) << 2, __float_as_int(v))); }
__device__ __forceinline__ unsigned umax_(unsigned a, unsigned b) { return a > b ? a : b; }
__device__ __forceinline__ unsigned wave_umax_all(unsigned v) {
    v = umax_(v, (unsigned)__builtin_amdgcn_update_dpp(0, (int)v, 0x128, 0xf, 0xf, false));
    v = umax_(v, (unsigned)__builtin_amdgcn_update_dpp(0, (int)v, 0x124, 0xf, 0xf, false));
    v = umax_(v, (unsigned)__builtin_amdgcn_update_dpp(0, (int)v, 0x122, 0xf, 0xf, false));
    v = umax_(v, (unsigned)__builtin_amdgcn_update_dpp(0, (int)v, 0x121, 0xf, 0xf, false));
    { auto rr = __builtin_amdgcn_permlane16_swap(v, v, false, false); v = umax_(rr[0], rr[1]); }
    { auto rr = __builtin_amdgcn_permlane32_swap(v, v, false, false); v = umax_(rr[0], rr[1]); }
    return v;
}
__device__ __forceinline__ float half_sum32(float v) {
    v += __int_as_float(__builtin_amdgcn_update_dpp(0, __float_as_int(v), 0x128, 0xf, 0xf, false));
    v += __int_as_float(__builtin_amdgcn_update_dpp(0, __float_as_int(v), 0x124, 0xf, 0xf, false));
    v += __int_as_float(__builtin_amdgcn_update_dpp(0, __float_as_int(v), 0x122, 0xf, 0xf, false));
    v += __int_as_float(__builtin_amdgcn_update_dpp(0, __float_as_int(v), 0x121, 0xf, 0xf, false));
    { auto rr = __builtin_amdgcn_permlane16_swap(__float_as_uint(v), __float_as_uint(v), false, false); v = __uint_as_float(rr[0]) + __uint_as_float(rr[1]); }
    return v;
}
__device__ __forceinline__ float wave_sum(float v, int lane) {
#pragma unroll
    for (int o = 1; o < 64; o <<= 1) v += shfl_xor_l(v, o, lane);
    return v;
}

#define XB_TMO      128
#define XB_XCNT(j)  (256  + 64 * (j))
#define XB_XSUB(j)  (1280 + 64 * (j))
#define XB_XGEN(j)  (2304 + 64 * (j))
#define XB_TOP      3328
#define XB_TOPGEN   3392
#define XCD_BAR_WORDS 3456
#define XB_SPIN_CAP (1u << 18)
__device__ __forceinline__ unsigned xb_ld(unsigned* p)              { return __hip_atomic_load(p, __ATOMIC_RELAXED, __HIP_MEMORY_SCOPE_AGENT); }
__device__ __forceinline__ unsigned xb_add(unsigned* p, unsigned v) { return __hip_atomic_fetch_add(p, v, __ATOMIC_RELAXED, __HIP_MEMORY_SCOPE_AGENT); }
__device__ __forceinline__ unsigned xb_xcc_id() { return (unsigned)__builtin_amdgcn_s_getreg((3 << 11) | 20) & 0xFu; }
#define XB_SPIN(cond, bar) do { unsigned _sp = 0; while (cond) { __builtin_amdgcn_s_sleep(1); \
    if ((++_sp & 255u) == 0u) { if (xb_ld(&(bar)[XB_TMO])) break; if (_sp > XB_SPIN_CAP) { atomicAdd(&(bar)[XB_TMO], 1u); break; } } } } while (0)
struct XcdBarrier { unsigned* bar; unsigned x; volatile LAS unsigned* st; };
__device__ __forceinline__ XcdBarrier xcd_barrier_post(unsigned* bar, volatile LAS unsigned* st) {
    XcdBarrier b; b.bar = bar; b.x = xb_xcc_id(); b.st = st;
    if (threadIdx.x == 0) (void)xb_add(&bar[XB_XCNT(b.x)], 1u);
    return b;
}
__device__ __forceinline__ void xcd_barrier_complete(unsigned* bar, unsigned x, unsigned& nloc, unsigned& nx) {
    const unsigned G = gridDim.x * gridDim.y * gridDim.z;
    unsigned sum, cnt, mine, sp = 0u;
    for (;;) {
        sum = 0u; cnt = 0u; mine = 0u;
#pragma unroll
        for (unsigned j = 0; j < 16; ++j) { const unsigned c = xb_ld(&bar[XB_XCNT(j)]); sum += c; cnt += (c > 0u) ? 1u : 0u; mine = (j == x) ? c : mine; }
        if (sum == G) break;
        __builtin_amdgcn_s_sleep(1);
        if ((++sp & 255u) == 0u) { if (xb_ld(&bar[XB_TMO])) break; if (sp > XB_SPIN_CAP) { atomicAdd(&bar[XB_TMO], 1u); break; } }
    }
    nloc = mine > 0u ? mine : 1u; nx = cnt > 0u ? cnt : 1u;
}
__device__ __forceinline__ void xcd_barrier(const XcdBarrier& b) {
    asm volatile("s_waitcnt vmcnt(0)" ::: "memory");
    __syncthreads();
    if (threadIdx.x == 0) {
        unsigned* bar = b.bar;
        __builtin_amdgcn_s_waitcnt(0);
        unsigned nloc = b.st[0], nx = b.st[1];
        if (nloc == 0u) { xcd_barrier_complete(bar, b.x, nloc, nx); b.st[0] = nloc; b.st[1] = nx; }
        const unsigned old = xb_add(&bar[XB_XSUB(b.x)], 1u);
        const unsigned gen = old / nloc;
        if (old + 1u == (gen + 1u) * nloc) {
            __builtin_amdgcn_fence(__ATOMIC_RELEASE, "agent");
            asm volatile("s_waitcnt vmcnt(0)" ::: "memory");
            const unsigned og = xb_add(&bar[XB_TOP], 1u);
            const unsigned tg = og / nx;
            if (og + 1u == (tg + 1u) * nx) xb_add(&bar[XB_TOPGEN], 1u);
            else XB_SPIN(xb_ld(&bar[XB_TOPGEN]) == tg, bar);
            __builtin_amdgcn_fence(__ATOMIC_ACQUIRE, "agent");
            xb_add(&bar[XB_XGEN(b.x)], 1u);
            asm volatile("s_waitcnt vmcnt(0)" ::: "memory");
        } else {
            XB_SPIN(xb_ld(&bar[XB_XGEN(b.x)]) == gen, bar);
            __builtin_amdgcn_fence(__ATOMIC_ACQUIRE, "agent");
            asm volatile("s_waitcnt vmcnt(0)" ::: "memory");
        }
    }
    __syncthreads();
}

struct Frame {
    LAS unsigned char* lds;
    int tid, lane, wave, G, c;
    float* out; unsigned char* ws;
};
__device__ __forceinline__ unsigned char* wsp(const Frame& F, size_t off) { unsigned char* p = F.ws; asm volatile("" : "+s"(p)); return (unsigned char*)(GAS unsigned char*)(p + off); }
__device__ __forceinline__ float* outp(const Frame& F) { float* p = F.out; asm volatile("" : "+s"(p)); return (float*)(GAS float*)p; }
__device__ __forceinline__ const float* inp(const Frame& F, int i) {
    const LAS unsigned* p = (const LAS unsigned*)(F.lds + LDS_CTL + 64) + 2 * i;
    const unsigned lo = __builtin_amdgcn_readfirstlane(p[0]), hi = __builtin_amdgcn_readfirstlane(p[1]);
    return (const float*)(const GAS float*)(((unsigned long long)hi << 32) | lo);
}
__device__ __forceinline__ bf16* xmid(const Frame& F, int l) { return (l == NLAYER - 1) ? (bf16*)wsp(F, WS_VT) : (bf16*)outp(F); }
enum { I_X = 0, I_C, I_ADAW, I_ADAB, I_N1W, I_WIN, I_CONVW, I_CONVB, I_IGB, I_FGB, I_MNW, I_WPA, I_WPB, I_WOUT, I_N2W, I_RW, I_RB, I_WG, I_WU, I_WD, I_SG, I_SU, I_SD, I_FNW };

#define EPI_LOOP_BEGIN \
    _Pragma("unroll") for (int ai = 0; ai < 2; ++ai) _Pragma("unroll") for (int m = 0; m < 4; ++m) { const int rl = ai * 128 + wr * 64 + m * 16 + fr; (void)rl; \
    _Pragma("unroll") for (int bj = 0; bj < 2; ++bj) { const int cl = bj * 128 + wc * 32 + 8 * fq; (void)cl; const pg8::f32x4 v0 = acc[ai][bj][m][0], v1 = acc[ai][bj][m][1];
#define EPI_LOOP_END } }

struct EpiP6 {
    static constexpr bool PERM = true; static constexpr int NST = 16;
    bf16* O;
    __device__ __forceinline__ void operator()(const pg8::f32x4 (&acc)[2][2][4][2], const pg8::Unit& u, int wr, int wc, int fr, int fq) const {
        bf16* Ob = O + (size_t)(u.pn >> 2) * P_BLK + (u.pn & 3) * 256;
        EPI_LOOP_BEGIN
            v4u w; w.x = pk2(v0[0], v0[1]); w.y = pk2(v0[2], v0[3]); w.z = pk2(v1[0], v1[1]); w.w = pk2(v1[2], v1[3]);
            *(GAS v4u*)(Ob + (size_t)(u.pm * 256 + rl) * P6W + cl) = w;
        EPI_LOOP_END
    }
};
struct EpiPlain {
    static constexpr bool PERM = true; static constexpr int NST = 16;
    bf16* O; int ldc;
    __device__ __forceinline__ void operator()(const pg8::f32x4 (&acc)[2][2][4][2], const pg8::Unit& u, int wr, int wc, int fr, int fq) const {
        EPI_LOOP_BEGIN
            v4u w; w.x = pk2(v0[0], v0[1]); w.y = pk2(v0[2], v0[3]); w.z = pk2(v1[0], v1[1]); w.w = pk2(v1[2], v1[3]);
            *(GAS v4u*)(O + (size_t)(u.pm * 256 + rl) * ldc + u.pn * 256 + cl) = w;
        EPI_LOOP_END
    }
};
#define SG8(q_, v0_, v1_, o0_, o1_, OP) do { \
        o0_[0] = OP(sigmoidf_(bflo(q_.x)) * v0_[0], 0); o0_[1] = OP(sigmoidf_(bfhi(q_.x)) * v0_[1], 1); o0_[2] = OP(sigmoidf_(bflo(q_.y)) * v0_[2], 2); o0_[3] = OP(sigmoidf_(bfhi(q_.y)) * v0_[3], 3); \
        o1_[0] = OP(sigmoidf_(bflo(q_.z)) * v1_[0], 4); o1_[1] = OP(sigmoidf_(bfhi(q_.z)) * v1_[1], 5); o1_[2] = OP(sigmoidf_(bflo(q_.w)) * v1_[2], 6); o1_[3] = OP(sigmoidf_(bfhi(q_.w)) * v1_[3], 7); } while (0)
struct EpiGateT1 {
    static constexpr bool PERM = true; static constexpr int NST = 16;
    const bf16* Gt; int gld; bf16* T1;
    __device__ __forceinline__ void operator()(const pg8::f32x4 (&acc)[2][2][4][2], const pg8::Unit& u, int wr, int wc, int fr, int fq) const {
#pragma unroll
        for (int ai = 0; ai < 2; ++ai) {
            v4u gq[4][2];
#pragma unroll
            for (int m = 0; m < 4; ++m)
#pragma unroll
                for (int bj = 0; bj < 2; ++bj) { const size_t row = (size_t)(u.pm * 256 + ai * 128 + wr * 64 + m * 16 + fr); const int col = u.pn * 256 + bj * 128 + wc * 32 + 8 * fq; gq[m][bj] = *(const GAS v4u*)(Gt + row * gld + col); }
#pragma unroll
            for (int m = 0; m < 4; ++m)
#pragma unroll
                for (int bj = 0; bj < 2; ++bj) { const size_t row = (size_t)(u.pm * 256 + ai * 128 + wr * 64 + m * 16 + fr); const int col = u.pn * 256 + bj * 128 + wc * 32 + 8 * fq;
                    const pg8::f32x4 v0 = acc[ai][bj][m][0], v1 = acc[ai][bj][m][1]; f32x4 o0, o1;
#define OPN(x_, i_) (x_)
                    SG8(gq[m][bj], v0, v1, o0, o1, OPN);
#undef OPN
                    v4u tw; tw.x = pk2(o0[0], o0[1]); tw.y = pk2(o0[2], o0[3]); tw.z = pk2(o1[0], o1[1]); tw.w = pk2(o1[2], o1[3]);
                    *(GAS v4u*)(T1 + row * 1024 + col) = tw; }
        }
    }
};
struct EpiGateY {
    static constexpr bool PERM = true; static constexpr int NST = 16;
    const bf16* Gt; int gld; const bf16* T1; bf16* Y;
    __device__ __forceinline__ void operator()(const pg8::f32x4 (&acc)[2][2][4][2], const pg8::Unit& u, int wr, int wc, int fr, int fq) const {
#pragma unroll
        for (int ai = 0; ai < 2; ++ai) {
            v4u gq[4][2], tq[4][2];
#pragma unroll
            for (int m = 0; m < 4; ++m)
#pragma unroll
                for (int bj = 0; bj < 2; ++bj) { const size_t row = (size_t)(u.pm * 256 + ai * 128 + wr * 64 + m * 16 + fr); const int col = u.pn * 256 + bj * 128 + wc * 32 + 8 * fq;
                    gq[m][bj] = *(const GAS v4u*)(Gt + row * gld + col); tq[m][bj] = *(const GAS v4u*)(T1 + row * 1024 + col); }
#pragma unroll
            for (int m = 0; m < 4; ++m)
#pragma unroll
                for (int bj = 0; bj < 2; ++bj) { const size_t row = (size_t)(u.pm * 256 + ai * 128 + wr * 64 + m * 16 + fr); const int col = u.pn * 256 + bj * 128 + wc * 32 + 8 * fq;
                    const pg8::f32x4 v0 = acc[ai][bj][m][0], v1 = acc[ai][bj][m][1]; f32x4 o0, o1;
                    const v4u t4 = tq[m][bj]; const float tt[8] = {bflo(t4.x), bfhi(t4.x), bflo(t4.y), bfhi(t4.y), bflo(t4.z), bfhi(t4.z), bflo(t4.w), bfhi(t4.w)};
#define OPT(x_, i_) (tt[i_] + (x_))
                    SG8(gq[m][bj], v0, v1, o0, o1, OPT);
#undef OPT
                    v4u w; w.x = pk2(o0[0], o0[1]); w.y = pk2(o0[2], o0[3]); w.z = pk2(o1[0], o1[1]); w.w = pk2(o1[2], o1[3]);
                    *(GAS v4u*)(Y + row * 1024 + col) = w; }
        }
    }
};
#undef SG8
struct PairOrder {
    pg8::StaticOrder so; size_t acol_b; int wave;
    __device__ __forceinline__ bool next(int i, pg8::Unit& u) const { pg8::Unit t; if (!so.next(i >> 1, t)) return false; u.pm = t.pm; u.pn = t.pn + ((i & 1) ? 0 : 4); return true; }
    __device__ __forceinline__ unsigned rowtok(int, int) const { return 0u; }
    __device__ __forceinline__ size_t aoff(const pg8::Unit& u) const { return u.pn >= 4 ? acol_b : (size_t)0; }
};
struct EpiPair {
    static constexpr bool PERM = true; static constexpr int NST = 16;
    EpiGateT1 e1; EpiGateY e2;
    __device__ __forceinline__ void operator()(const pg8::f32x4 (&acc)[2][2][4][2], const pg8::Unit& u, int wr, int wc, int fr, int fq) const {
        if (u.pn >= 4) { pg8::Unit t; t.pm = u.pm; t.pn = u.pn - 4; e1(acc, t, wr, wc, fr, fq); }
        else { asm volatile("s_waitcnt vmcnt(0)" ::: "memory"); e2(acc, u, wr, wc, fr, fq); }
    }
};
struct EpiRes {
    static constexpr bool PERM = true; static constexpr int NST = 0;
    const bf16* xin; bf16* out; const float* gv; int nostore;
    __device__ __forceinline__ void operator()(const pg8::f32x4 (&acc)[2][2][4][2], const pg8::Unit& u, int wr, int wc, int fr, int fq) const {
        const float* gb = gv + (size_t)(u.pm >> 4) * 6144;
        f32x4 g0[2], g1[2];
#pragma unroll
        for (int bj = 0; bj < 2; ++bj) { const int col = u.pn * 256 + bj * 128 + wc * 32 + 8 * fq; g0[bj] = *(const GAS f32x4*)(gb + col); g1[bj] = *(const GAS f32x4*)(gb + col + 4); }
#pragma unroll
        for (int ai = 0; ai < 2; ++ai)
#pragma unroll
            for (int mh = 0; mh < 2; ++mh) {
                v4u xb[2][2];
#pragma unroll
                for (int mm = 0; mm < 2; ++mm)
#pragma unroll
                    for (int bj = 0; bj < 2; ++bj) { const size_t row = (size_t)(u.pm * 256 + ai * 128 + wr * 64 + (2 * mh + mm) * 16 + fr); const int col = u.pn * 256 + bj * 128 + wc * 32 + 8 * fq;
                        xb[mm][bj] = *(const GAS v4u*)(xin + row * 1024 + col); }
#pragma unroll
                for (int mm = 0; mm < 2; ++mm)
#pragma unroll
                    for (int bj = 0; bj < 2; ++bj) { const int m = 2 * mh + mm; const size_t row = (size_t)(u.pm * 256 + ai * 128 + wr * 64 + m * 16 + fr); const int col = u.pn * 256 + bj * 128 + wc * 32 + 8 * fq;
                        const v4u x = xb[mm][bj]; const f32x4 a0 = acc[ai][bj][m][0], a1 = acc[ai][bj][m][1];
                        v4u o;
                        o.x = pk2(bflo(x.x) + g0[bj][0] * a0[0], bfhi(x.x) + g0[bj][1] * a0[1]); o.y = pk2(bflo(x.y) + g0[bj][2] * a0[2], bfhi(x.y) + g0[bj][3] * a0[3]);
                        o.z = pk2(bflo(x.z) + g1[bj][0] * a1[0], bfhi(x.z) + g1[bj][1] * a1[1]); o.w = pk2(bflo(x.w) + g1[bj][2] * a1[2], bfhi(x.w) + g1[bj][3] * a1[3]);
                        if (nostore) { asm volatile("" :: "v"(o)); } else { *(GAS v4u*)(out + row * 1024 + col) = o; } }
            }
    }
};
struct EpiHid {
    static constexpr bool PERM = true; static constexpr int NST = 8;
    bf16* O; int ldo; const LAS float* roww; int ubase; int ustride; int shared;
    __device__ __forceinline__ void operator()(const pg8::f32x4 (&acc)[2][2][4][2], const pg8::Unit& u, int wr, int wc, int fr, int fq) const {
#pragma unroll
        for (int ai = 0; ai < 2; ++ai)
#pragma unroll
            for (int m = 0; m < 4; ++m) {
                const int rl = ai * 128 + wr * 64 + m * 16 + fr; const size_t pos = (size_t)u.pm * 256 + rl;
                const float w = shared ? 1.f : roww[((u.pm - ubase) / ustride) * 256 + rl];
                const int col = (shared ? 128 * u.pn : 0) + wc * 32 + 8 * fq;
                float h[8];
#pragma unroll
                for (int n = 0; n < 2; ++n)
#pragma unroll
                    for (int j = 0; j < 4; ++j) { const float gt = acc[ai][0][m][n][j], up = acc[ai][1][m][n][j]; h[n * 4 + j] = gt * sigmoidf_(gt) * up * w; }
                v4u o; o.x = pk2(h[0], h[1]); o.y = pk2(h[2], h[3]); o.z = pk2(h[4], h[5]); o.w = pk2(h[6], h[7]);
                *(GAS v4u*)(O + pos * ldo + col) = o;
                asm volatile("" ::: "memory");
            }
    }
};
constexpr float YS_SCALE = 4.0f;
struct EpiScatter {
    static constexpr bool PERM = true; static constexpr int NST = 16;
    bf16* Y;
    __device__ __forceinline__ void operator()(const pg8::f32x4 (&acc)[2][2][4][2], const pg8::Unit& u, int wr, int wc, int fr, int fq) const {
        const int q = u.pn & 3;
#pragma unroll
        for (int ai = 0; ai < 2; ++ai)
#pragma unroll
            for (int m = 0; m < 4; ++m) {
                const int rl = ai * 128 + wr * 64 + m * 16 + fr;
                {
#pragma unroll
                    for (int bj = 0; bj < 2; ++bj) { const pg8::f32x4 v0 = acc[ai][bj][m][0] * YS_SCALE, v1 = acc[ai][bj][m][1] * YS_SCALE;
                        int w0 = 0, w1 = 0;
#define YS_CL(x_) __builtin_amdgcn_fmed3f((x_), -440.f, 440.f)
                        w0 = __builtin_amdgcn_cvt_pk_fp8_f32(YS_CL(v0[0]), YS_CL(v0[1]), w0, false); w0 = __builtin_amdgcn_cvt_pk_fp8_f32(YS_CL(v0[2]), YS_CL(v0[3]), w0, true);
                        w1 = __builtin_amdgcn_cvt_pk_fp8_f32(YS_CL(v1[0]), YS_CL(v1[1]), w1, false); w1 = __builtin_amdgcn_cvt_pk_fp8_f32(YS_CL(v1[2]), YS_CL(v1[3]), w1, true);
#undef YS_CL
                        v2u w; w.x = (unsigned)w0; w.y = (unsigned)w1;
                        *(GAS v2u*)((unsigned char*)Y + (size_t)(u.pm * 256 + rl) * 1024 + q * 256 + bj * 128 + wc * 32 + 8 * fq) = w; }
                }
            }
    }
};

struct TrDesc { const float* sp; bf16* dp; int ldw, ldt; float scale; };
__device__ __forceinline__ void tr_load(const TrDesc& d, float (&tv)[32]) {
    const GAS float* sp = (const GAS float*)d.sp;
#pragma unroll
    for (int i = 0; i < 32; ++i) tv[i] = sp[(size_t)(2 * i) * d.ldw];
}
__device__ __forceinline__ void tr_store(const TrDesc& d, const float (&tv)[32], LAS float* scr, int lane) {
#pragma unroll
    for (int i = 0; i < 32; ++i) { const int kk = 2 * i + (lane >> 5); scr[kk * 33 + (lane & 31)] = tv[i]; }
    LDS_WAIT();
    const int c = lane & 7; const float scale = d.scale;
#pragma unroll
    for (int j = 0; j < 4; ++j) { const int n = (lane >> 3) + 8 * j; const LAS float* s = scr + (8 * c) * 33 + n;
        v4u o; o.x = pk2(s[0 * 33] * scale, s[1 * 33] * scale); o.y = pk2(s[2 * 33] * scale, s[3 * 33] * scale); o.z = pk2(s[4 * 33] * scale, s[5 * 33] * scale); o.w = pk2(s[6 * 33] * scale, s[7 * 33] * scale);
        *(GAS v4u*)(d.dp + (size_t)n * d.ldt + 8 * c) = o; }
    LDS_WAIT();
}
constexpr int CW_N_IN = 8 * 512, CW_N_P = 3 * 512, CW_N_E = 4096, CW_N_S = 4 * 64, CW_N_SD = 128;
constexpr int CW_TOTAL = CW_N_IN + CW_N_P + 3 * CW_N_E + CW_N_S + CW_N_SD;
__device__ __forceinline__ TrDesc tr_decode(Frame& F, int l, int it) {
    const float* src; int ldw; bf16* dst; int ldt; int kb, nb; float sc = 1.f;
    int r = it;
    if (r < CW_N_IN) { const int job = r >> 9, rr = r & 511; kb = rr >> 5; nb = rr & 31;
        int col; bf16* BIN = (bf16*)wsp(F, WS_BIN); bf16* AIN = (bf16*)wsp(F, WS_AIN);
        switch (job) {
            case 0: col = C_MQK; dst = BIN; break;
            case 1: col = C_MO; dst = BIN + (size_t)1024 * 1024; break;
            case 2: col = C_SQ; dst = BIN + (size_t)2048 * 1024; sc = LOG2E * 0.125f; break;
            case 3: col = C_SK; dst = BIN + (size_t)3072 * 1024; break;
            case 4: col = C_GA; dst = BIN + (size_t)4096 * 1024; break;
            case 5: col = C_GB; dst = BIN + (size_t)5120 * 1024; break;
            case 6: col = C_MV; dst = AIN; break;
            default: col = C_SV; dst = AIN + (size_t)1024 * 1024; break;
        }
        src = inp(F, I_WIN) + (size_t)l * DM * INW + col; ldw = INW; ldt = 1024; }
    else if ((r -= CW_N_IN) < CW_N_P) { const int job = r >> 9, rr = r & 511; kb = rr >> 5; nb = rr & 31;
        src = inp(F, job == 0 ? I_WPA : (job == 1 ? I_WPB : I_WOUT)) + (size_t)l * DM * DM; ldw = 1024;
        dst = (bf16*)wsp(F, job == 0 ? WS_BA : (job == 1 ? WS_BB : WS_BO)); ldt = 1024; }
    else if ((r -= CW_N_P) < 2 * CW_N_E) { const int up = r >= CW_N_E; if (up) r -= CW_N_E; const int e = r >> 6, rr = r & 63; kb = rr >> 2; nb = rr & 3;
        src = inp(F, up ? I_WU : I_WG) + ((size_t)l * NEXP + e) * DM * EFF; ldw = EFF;
        dst = (bf16*)wsp(F, WS_BGU) + ((size_t)e * 256 + (up ? 128 : 0)) * 1024; ldt = 1024; }
    else if ((r -= 2 * CW_N_E) < CW_N_E) { const int e = r >> 6, rr = r & 63; kb = rr >> 5; nb = rr & 31;
        src = inp(F, I_WD) + ((size_t)l * NEXP + e) * EFF * DM; ldw = DM;
        dst = (bf16*)wsp(F, WS_BD) + (size_t)e * 1024 * 128; ldt = 128; }
    else if ((r -= CW_N_E) < CW_N_S) { const int job = r >> 6, rr = r & 63; kb = rr >> 2; nb = rr & 3;
        const int up = job >> 1, hi = job & 1;
        src = inp(F, up ? I_SU : I_SG) + (size_t)l * DM * SFF + hi * 128; ldw = SFF;
        dst = (bf16*)wsp(F, WS_BSGU) + (size_t)(hi * 256 + up * 128) * 1024; ldt = 1024; }
    else { r -= CW_N_S; kb = r >> 5; nb = r & 31;
        src = inp(F, I_SD) + (size_t)l * SFF * DM; ldw = DM; dst = (bf16*)wsp(F, WS_BSD); ldt = 256; }
    TrDesc d; const int k0 = 64 * kb, n0 = 32 * nb; const int ln = lane_now();
    d.sp = src + (size_t)(k0 + (ln >> 5)) * ldw + n0 + (ln & 31); d.dp = dst + (size_t)n0 * ldt + k0; d.ldw = ldw; d.ldt = ldt; d.scale = sc;
    return d;
}
__device__ __forceinline__ void conv_weights(Frame& F, int l) {
    LAS float* scr = (LAS float*)(F.lds + F.wave * 16384);
    int gw = F.c * 8 + F.wave; asm volatile("" : "+s"(gw)); const int NGW = F.G * 8;
    int it = gw;
    if (it >= CW_TOTAL) return;
    TrDesc dc = tr_decode(F, l, it); float tc[32]; tr_load(dc, tc);
    for (;;) {
        const int itn = it + NGW; const bool more = itn < CW_TOTAL;
        TrDesc dn = dc; float tn[32];
        if (more) { dn = tr_decode(F, l, itn); tr_load(dn, tn); }
        tr_store(dc, tc, scr, F.lane);
        if (!more) break;
        it = itn; dc = dn;
#pragma unroll
        for (int i = 0; i < 32; ++i) tc[i] = tn[i];
    }
}
__device__ __forceinline__ void mod_partials(Frame& F) {
    LAS float* sc = (LAS float*)(F.lds);
    for (int i = F.tid; i < 4096; i += 512) { const float v = inp(F, I_C)[i]; sc[i] = v / (1.f + __expf(-v)); }
    __syncthreads();
    float* MODP = (float*)wsp(F, WS_MODP);
    for (int it = F.c; it < 384; it += F.G) {
        const int l = it / 192, rem = it % 192, g = rem >> 4, kp = rem & 15, j = g * 512 + F.tid;
        const float* w = inp(F, I_ADAW) + ((size_t)l * DM + 64 * kp) * 6144 + j;
        float a0 = 0.f, a1 = 0.f, a2 = 0.f, a3 = 0.f;
#pragma unroll 16
        for (int k = 0; k < 64; ++k) { const float wv = w[(size_t)k * 6144]; const int kk = 64 * kp + k;
            a0 += sc[kk] * wv; a1 += sc[1024 + kk] * wv; a2 += sc[2048 + kk] * wv; a3 += sc[3072 + kk] * wv; }
        float* o = MODP + ((size_t)(kp * 2 + l) * 4) * 6144 + j;
        o[0] = a0; o[6144] = a1; o[2 * 6144] = a2; o[3 * 6144] = a3;
    }
    __syncthreads();
}
__device__ __forceinline__ float modv(const Frame& F, int l, int b, int j) {
    const float* MODP = (const float*)wsp(F, WS_MODP);
    float s = inp(F, I_ADAB)[l * 6144 + j];
#pragma unroll
    for (int kp = 0; kp < 16; ++kp) s += MODP[((size_t)(kp * 2 + l) * 4 + b) * 6144 + j];
    return s;
}

__device__ __forceinline__ void norm_emit(Frame& F, const float (&v)[2][8], const LAS float* cA, const LAS float* cB, const LAS float* Wg, const float gbias_lane  , bf16* xn_row, float* gate_row) {
    float ss = 0.f;
#pragma unroll
    for (int j = 0; j < 2; ++j)
#pragma unroll
        for (int i = 0; i < 8; ++i) ss += v[j][i] * v[j][i];
    ss = wave_sum(ss, F.lane);
    const float r = 1.0f / sqrtf(ss * (1.f / 1024.f) + EPS);
    float h[2][8];
#pragma unroll
    for (int j = 0; j < 2; ++j) { const int k = 8 * F.lane + 512 * j;
        const f32x4 a0 = *(const LAS f32x4*)(cA + k), a1 = *(const LAS f32x4*)(cA + k + 4), b0 = *(const LAS f32x4*)(cB + k), b1 = *(const LAS f32x4*)(cB + k + 4);
#pragma unroll
        for (int i = 0; i < 4; ++i) { h[j][i] = v[j][i] * r * a0[i] + b0[i]; h[j][4 + i] = v[j][4 + i] * r * a1[i] + b1[i]; }
        v4u o; o.x = pk2(h[j][0], h[j][1]); o.y = pk2(h[j][2], h[j][3]); o.z = pk2(h[j][4], h[j][5]); o.w = pk2(h[j][6], h[j][7]);
        *(GAS v4u*)(xn_row + k) = o; }
    float mine = 0.f;
#pragma unroll
    for (int g = 0; g < 8; ++g) { float p = 0.f;
#pragma unroll
        for (int j = 0; j < 2; ++j) { const int k = 8 * F.lane + 512 * j; const f32x4 w0 = *(const LAS f32x4*)(Wg + g * 1024 + k), w1 = *(const LAS f32x4*)(Wg + g * 1024 + k + 4);
#pragma unroll
            for (int i = 0; i < 4; ++i) { p += h[j][i] * w0[i]; p += h[j][4 + i] * w1[i]; } }
        p = wave_sum(p, F.lane);
        if (F.lane == g) mine = p; }
    if (F.lane < 8) { float z = mine + gbias_lane; if (F.lane >= 4) z = fminf(z, 0.f) - __logf(1.f + __expf(-fabsf(z))); gate_row[F.lane] = z; }
}
__device__ __forceinline__ void norm1_tables(Frame& F, int l, int b, bool from_modp) {
    LAS float* cA = (LAS float*)(F.lds + LDS_TAB); LAS float* cB = cA + 1024; LAS float* Wg = (LAS float*)(F.lds);
    const float* MODF = (const float*)wsp(F, WS_MODF) + (size_t)(l * 4 + b) * 6144;
    for (int k = F.tid; k < 1024; k += 512) {
        const float sh = from_modp ? modv(F, l, b, k) : MODF[k], sc = from_modp ? modv(F, l, b, 1024 + k) : MODF[1024 + k];
        cA[k] = inp(F, I_N1W)[l * 1024 + k] * (1.f + sc); cB[k] = sh; }
    const float* w_in = inp(F, I_WIN) + (size_t)l * DM * INW;
    for (int idx = F.tid; idx < 8192; idx += 512) { const int k = idx >> 3, g = idx & 7; Wg[g * 1024 + k] = w_in[(size_t)k * INW + C_MI + g]; }
}
__device__ __forceinline__ void phase_norm1_first(Frame& F) {
    float* MODF = (float*)wsp(F, WS_MODF);
    for (int idx = F.c * 512 + F.tid; idx < 2 * 4 * 6144; idx += F.G * 512) { const int l = idx / 24576, rem = idx % 24576, b = rem / 6144, j = rem % 6144; MODF[idx] = modv(F, l, b, j); }
    bf16* XN = (bf16*)wsp(F, WS_R2); float* GATES = (float*)wsp(F, WS_GATES); bf16* XB = (bf16*)outp(F);
    for (int vb = F.c; vb < 256; vb += F.G) {
        norm1_tables(F, 0, vb >> 6, true);
        __syncthreads();
        const float gbl = (F.lane < 4) ? inp(F, I_IGB)[F.lane] : (F.lane < 8 ? inp(F, I_FGB)[F.lane - 4] : 0.f);
        f32x4 xn_[2][2];
#define N1_LOAD(tt) do { const float* xr_ = inp(F, I_X) + (size_t)(tt) * 1024 + 8 * F.lane; \
            _Pragma("unroll") for (int j = 0; j < 2; ++j) { xn_[j][0] = *(const GAS f32x4*)(xr_ + 512 * j); xn_[j][1] = *(const GAS f32x4*)(xr_ + 512 * j + 4); } } while (0)
        N1_LOAD(vb * 64 + F.wave * 8);
        for (int i = 0; i < 8; ++i) {
            const int t = vb * 64 + F.wave * 8 + i;
            float v[2][8];
#pragma unroll
            for (int j = 0; j < 2; ++j) { const f32x4 a = xn_[j][0], b2 = xn_[j][1];
#pragma unroll
                for (int q = 0; q < 4; ++q) { v[j][q] = a[q]; v[j][4 + q] = b2[q]; } }
            if (i + 1 < 8) N1_LOAD(t + 1);
#pragma unroll
            for (int j = 0; j < 2; ++j) { v4u o; o.x = pk2(v[j][0], v[j][1]); o.y = pk2(v[j][2], v[j][3]); o.z = pk2(v[j][4], v[j][5]); o.w = pk2(v[j][6], v[j][7]);
                *(GAS v4u*)(XB + (size_t)t * 1024 + 8 * F.lane + 512 * j) = o; }
            norm_emit(F, v, (const LAS float*)(F.lds + LDS_TAB), (const LAS float*)(F.lds + LDS_TAB) + 1024, (const LAS float*)(F.lds), gbl, XN + (size_t)t * 1024, GATES + (size_t)t * 8);
        }
        __syncthreads();
    }
}

__device__ __forceinline__ void phase_conv(Frame& F, int l) {
    const bf16* P6 = (const bf16*)wsp(F, WS_P6); bf16* MQK = (bf16*)wsp(F, WS_R2);
    const int cg = F.tid & 127, tq = F.tid >> 7, ch = cg * 8;
    float w[4][8], bias[8];
#pragma unroll
    for (int j = 0; j < 4; ++j) { const float* p = inp(F, I_CONVW) + ((size_t)l * 4 + j) * 1024 + ch; const f32x4 a = *(const GAS f32x4*)p, b = *(const GAS f32x4*)(p + 4);
#pragma unroll
        for (int i = 0; i < 4; ++i) { w[j][i] = a[i]; w[j][4 + i] = b[i]; } }
    { const float* p = inp(F, I_CONVB) + (size_t)l * 1024 + ch; const f32x4 a = *(const GAS f32x4*)p, b = *(const GAS f32x4*)(p + 4);
#pragma unroll
      for (int i = 0; i < 4; ++i) { bias[i] = a[i]; bias[4 + i] = b[i]; } }
    const float osc = (ch < 512) ? 0.08838834764831845f : 1.0f;
    for (int vb = F.c; vb < 256; vb += F.G) {
        const int tbeg = vb * 64 + tq * 16;
        float u0[8], u1[8], u2[8];
#define CV_LOAD(dst, tt) do { const int t_ = (tt); if (t_ >= 0 && (t_ >> 12) == (tbeg >> 12)) { const v4u q = *(const GAS v4u*)(P6 + (size_t)t_ * P6W + ch); \
            dst[0] = bflo(q.x); dst[1] = bfhi(q.x); dst[2] = bflo(q.y); dst[3] = bfhi(q.y); dst[4] = bflo(q.z); dst[5] = bfhi(q.z); dst[6] = bflo(q.w); dst[7] = bfhi(q.w); } \
            else { _Pragma("unroll") for (int i_ = 0; i_ < 8; ++i_) dst[i_] = 0.f; } } while (0)
        CV_LOAD(u0, tbeg - 3); CV_LOAD(u1, tbeg - 2); CV_LOAD(u2, tbeg - 1);
        for (int tt = 0; tt < 16; ++tt) {
            const int t = tbeg + tt; float u3[8]; CV_LOAD(u3, t);
            float o[8];
#pragma unroll
            for (int i = 0; i < 8; ++i) { const float a = bias[i] + w[0][i] * u0[i] + w[1][i] * u1[i] + w[2][i] * u2[i] + w[3][i] * u3[i]; o[i] = a * sigmoidf_(a) * osc; }
            v4u q; q.x = pk2(o[0], o[1]); q.y = pk2(o[2], o[3]); q.z = pk2(o[4], o[5]); q.w = pk2(o[6], o[7]);
            *(GAS v4u*)(MQK + (size_t)t * 1024 + ch) = q;
#pragma unroll
            for (int i = 0; i < 8; ++i) { u0[i] = u1[i]; u1[i] = u2[i]; u2[i] = u3[i]; }
        }
#undef CV_LOAD
    }
}

constexpr float SB_EXIT = -80.0f;
constexpr int AT_NSLOT = 12, AT_SLOTB = 8192, AT_FLAGS = AT_NSLOT * AT_SLOTB;
__device__ __forceinline__ void at_dma(const void* gsrc, LAS unsigned char* ldst) { __builtin_amdgcn_global_load_lds((const GAS unsigned*)gsrc, (LAS unsigned*)ldst, 16, 0, 0); }
__device__ __forceinline__ void attn_unit(Frame& F, int b, int h, int qb, bool do_store) {
    bf16* P6 = (bf16*)wsp(F, WS_P6); const bf16* VT = (const bf16*)wsp(F, WS_VT);
    LAS unsigned char* L = F.lds;
    const int lane = F.lane, r32 = lane & 31, hh = lane >> 5, wid = F.wave;
    const int tb = b * SEQ, t0 = qb * 256 + wid * 32;
    const int D0 = 8 * qb, Dw = D0 + wid;
    const bf16* dsrc; int dtile_stride; int doff;
    if (wid < 4) { const int row = 8 * wid + (lane >> 3), pos = lane & 7; dsrc = P6 + (size_t)(tb + row) * P6W + P_SK + h * 64 + ((pos ^ (row & 7)) * 8); dtile_stride = 32 * P6W; doff = wid * 1024; }
    else { const int d = 16 * (wid - 4) + (lane >> 2), pos = lane & 3; dsrc = VT + (size_t)(1024 + h * 64 + d) * NTOK + tb + ((pos ^ ((d >> 2) & 3)) * 8); dtile_stride = 32; doff = 4096 + (wid - 4) * 1024; }
#define AT_DMA(T_) do { const int T__ = (T_); if (T__ >= 0) at_dma(dsrc + (size_t)T__ * dtile_stride, L + (T__ % AT_NSLOT) * AT_SLOTB + doff); } while (0)
    for (int T = D0 + 7; T >= D0 - 1; --T) AT_DMA(T);
    bf16x8 qf[4];
#pragma unroll
    for (int kk = 0; kk < 4; ++kk) qf[kk] = *(const GAS bf16x8*)(P6 + (size_t)(tb + t0 + r32) * P6W + P_SQ + h * 64 + 16 * kk + 8 * hh);
    f32x16 o0 = {}, o1 = {};
    float Rrun = 0.f;
    bool done = false;
    LAS unsigned* flags = (LAS unsigned*)(L + AT_FLAGS);
    asm volatile("s_waitcnt vmcnt(0)" ::: "memory");
    if (lane == 0) flags[wid] = 1u;
    __syncthreads();
    int koff[4], vlo[2][2], vhi[2][2];
#pragma unroll
    for (int kk = 0; kk < 4; ++kk) koff[kk] = r32 * 128 + (((2 * kk + hh) ^ (r32 & 7)) * 16);
#pragma unroll
    for (int dt = 0; dt < 2; ++dt)
#pragma unroll
        for (int s = 0; s < 2; ++s) { const int d = 32 * dt + r32, sw = (d >> 2) & 3; vlo[dt][s] = 4096 + d * 64 + (((2 * s) ^ sw) * 16) + 8 * hh; vhi[dt][s] = 4096 + d * 64 + (((2 * s + 1) ^ sw) * 16) + 8 * hh; }
#define AT_TILE(DIAG_) do { \
            const LAS unsigned char* S = L + (T % AT_NSLOT) * AT_SLOTB; \
            f32x16 p = {}; \
            _Pragma("unroll") \
            for (int kk = 0; kk < 4; ++kk) { const bf16x8 kf = *(const LAS bf16x8*)(S + koff[kk]); p = __builtin_amdgcn_mfma_f32_32x32x16_bf16(kf, qf[kk], p, 0, 0, 0); } \
            bf16x8 vf[2][2]; \
            _Pragma("unroll") \
            for (int dt = 0; dt < 2; ++dt) \
            _Pragma("unroll") \
                for (int s = 0; s < 2; ++s) { const v2u lo = *(const LAS v2u*)(S + vlo[dt][s]), hi = *(const LAS v2u*)(S + vhi[dt][s]); v4u t; t.x = lo.x; t.y = lo.y; t.z = hi.x; t.w = hi.y; vf[dt][s] = __builtin_bit_cast(bf16x8, t); } \
            float lf[16]; \
            _Pragma("unroll") \
            for (int r = 0; r < 16; ++r) { const float z = p[r]; const float e = __builtin_amdgcn_exp2f(-fabsf(z)); const float lg = __builtin_amdgcn_logf(1.f + e); \
                float v = -(fmaxf(z, 0.f) + lg); if (DIAG_ && crow(r, hh) >= r32) v = 0.f; lf[r] = v; } \
 \
            float own[4], pair[4]; \
            _Pragma("unroll") \
            for (int g = 0; g < 4; ++g) { own[g] = (lf[4 * g] + lf[4 * g + 1]) + (lf[4 * g + 2] + lf[4 * g + 3]); \
                auto rr = __builtin_amdgcn_permlane32_swap(__float_as_uint(own[g]), __float_as_uint(own[g]), false, false); \
                pair[g] = __uint_as_float(rr[0]) + __uint_as_float(rr[1]); } \
            float sfx[4]; sfx[3] = Rrun; sfx[2] = sfx[3] + pair[3]; sfx[1] = sfx[2] + pair[2]; sfx[0] = sfx[1] + pair[1]; \
            const float nh = hh ? 0.f : 1.f; \
            float att[16]; \
            _Pragma("unroll") \
            for (int g = 0; g < 4; ++g) { float run = sfx[g] + nh * (pair[g] - own[g]); \
            _Pragma("unroll") \
                for (int i = 3; i >= 0; --i) { const int r = 4 * g + i; run += lf[r]; float a = __builtin_amdgcn_exp2f(p[r] + run); if (DIAG_ && crow(r, hh) >= r32) a = 0.f; att[r] = a; } } \
            Rrun = sfx[0] + pair[0]; \
            v4u pb0, pb1; \
            pb0.x = pk2(att[0], att[1]); pb0.y = pk2(att[2], att[3]); pb0.z = pk2(att[4], att[5]); pb0.w = pk2(att[6], att[7]); \
            pb1.x = pk2(att[8], att[9]); pb1.y = pk2(att[10], att[11]); pb1.z = pk2(att[12], att[13]); pb1.w = pk2(att[14], att[15]); \
            const bf16x8 b0 = __builtin_bit_cast(bf16x8, pb0), b1 = __builtin_bit_cast(bf16x8, pb1); \
            o0 = __builtin_amdgcn_mfma_f32_32x32x16_bf16(vf[0][0], b0, o0, 0, 0, 0); o0 = __builtin_amdgcn_mfma_f32_32x32x16_bf16(vf[0][1], b1, o0, 0, 0, 0); \
            o1 = __builtin_amdgcn_mfma_f32_32x32x16_bf16(vf[1][0], b0, o1, 0, 0, 0); o1 = __builtin_amdgcn_mfma_f32_32x32x16_bf16(vf[1][1], b1, o1, 0, 0, 0); \
            if (__all(Rrun < SB_EXIT)) done = true; \
        } while (0)
    for (int j = 0; ; ++j) {
        const int T = Dw - j;
        const bool active = !done && T >= 0;
        AT_DMA(D0 - j - 2);
        if (active) { if (j == 0) AT_TILE(true); else AT_TILE(false); }
        const bool more = !done && (Dw - (j + 1)) >= 0;
        if (lane == 0) flags[8 * ((j + 1) & 1) + wid] = more ? 1u : 0u;
        asm volatile("s_waitcnt vmcnt(0) lgkmcnt(0)" ::: "memory");
        __builtin_amdgcn_s_barrier();
        asm volatile("" ::: "memory");
        const LAS unsigned* fl = flags + 8 * ((j + 1) & 1);
        const unsigned any = fl[0] | fl[1] | fl[2] | fl[3] | fl[4] | fl[5] | fl[6] | fl[7];
        if (any == 0u) break;
    }
#undef AT_DMA
#undef AT_TILE
    if (do_store) {
        bf16* orow = P6 + (size_t)(tb + t0 + r32) * P6W + P_SQ + h * 64 + 4 * hh;
#pragma unroll
        for (int g = 0; g < 4; ++g) {
            v2u a; a.x = pk2(o0[4 * g], o0[4 * g + 1]); a.y = pk2(o0[4 * g + 2], o0[4 * g + 3]); *(GAS v2u*)(orow + 8 * g) = a;
            v2u c; c.x = pk2(o1[4 * g], o1[4 * g + 1]); c.y = pk2(o1[4 * g + 2], o1[4 * g + 3]); *(GAS v2u*)(orow + 32 + 8 * g) = c;
        }
    } else { asm volatile("" :: "v"(o0), "v"(o1)); }
    __syncthreads();
}
__device__ __forceinline__ void phase_attn(Frame& F, bool do_store) {
    const int v = (F.G % 8 == 0) ? (F.c % 8) * (F.G / 8) + F.c / 8 : F.c;
    for (int u = v; u < 1024; u += F.G) { const int bh = u >> 4, qb = u & 15; attn_unit(F, bh >> 4, bh & 15, qb, do_store); }
}

constexpr size_t MLS_U = 0, MLS_PM = 16 * 4096 * 4, MLS_BL = 2 * 16 * 4096 * 4, MLS_SUM = 3 * 16 * 4096 * 4;
__device__ __forceinline__ void phase_mlstm_scalars(Frame& F) {
    const float* GATES = (const float*)wsp(F, WS_GATES); unsigned char* R3 = wsp(F, WS_R3);
    const int lane = F.lane;
    for (int vb = F.c; vb < 256; vb += F.G) {
        if (F.wave != 0) continue;
        const int bh = vb >> 4, ch = vb & 15, b = bh >> 2, h = bh & 3, t0 = b * SEQ + 256 * ch;
        float carry_b = 0.f, carry_pm = -INFINITY;
#pragma unroll
        for (int sg = 0; sg < 4; ++sg) {
            const int tok = t0 + 64 * sg + lane;
            const float ig = *(const GAS float*)(GATES + (size_t)tok * 8 + h), lfv = *(const GAS float*)(GATES + (size_t)tok * 8 + 4 + h);
            float bc = lfv;
#pragma unroll
            for (int o = 1; o < 64; o <<= 1) { const float t = shfl_up_l(bc, o, lane); if (lane >= o) bc += t; }
            bc += carry_b;
            const float u = ig - bc;
            float pm = u;
#pragma unroll
            for (int o = 1; o < 64; o <<= 1) { const float t = shfl_up_l(pm, o, lane); if (lane >= o) pm = fmaxf(pm, t); }
            pm = fmaxf(pm, carry_pm);
            const size_t idx = (size_t)bh * 4096 + 256 * ch + 64 * sg + lane;
            *(GAS float*)(R3 + MLS_U + idx * 4) = u; *(GAS float*)(R3 + MLS_PM + idx * 4) = pm; *(GAS float*)(R3 + MLS_BL + idx * 4) = bc;
            carry_b = __int_as_float(__builtin_amdgcn_readlane(__float_as_int(bc), 63)); carry_pm = __int_as_float(__builtin_amdgcn_readlane(__float_as_int(pm), 63));
        }
        if (lane == 0) { *(GAS float*)(R3 + MLS_SUM + (size_t)(bh * 16 + ch) * 8) = carry_b; *(GAS float*)(R3 + MLS_SUM + (size_t)(bh * 16 + ch) * 8 + 4) = carry_pm; }
    }
}

constexpr int CVP_QS = 0, CVP_KS = 69632, CVP_U = 139264;
__device__ __forceinline__ void cvp_job(Frame& F, int l, int bh, int c) {
    LAS unsigned char* L = F.lds;
    const int b = bh >> 2, h = bh & 3, T0 = b * SEQ + 256 * c;
    const bf16* P6 = (const bf16*)wsp(F, WS_P6); const unsigned char* R3 = wsp(F, WS_R3);
    {
        const int cg = F.tid & 31, tr = F.tid >> 5, ch8 = 8 * cg;
        const int cq = (ch8 < 128) ? h * 128 + ch8 : 512 + h * 128 + (ch8 - 128);
        float w[4][8], bias[8];
#pragma unroll
        for (int j = 0; j < 4; ++j) { const float* p = inp(F, I_CONVW) + ((size_t)l * 4 + j) * 1024 + cq; const f32x4 a = *(const GAS f32x4*)p, bb = *(const GAS f32x4*)(p + 4);
#pragma unroll
            for (int i = 0; i < 4; ++i) { w[j][i] = a[i]; w[j][4 + i] = bb[i]; } }
        { const float* p = inp(F, I_CONVB) + (size_t)l * 1024 + cq; const f32x4 a = *(const GAS f32x4*)p, bb = *(const GAS f32x4*)(p + 4);
#pragma unroll
          for (int i = 0; i < 4; ++i) { bias[i] = a[i]; bias[4 + i] = bb[i]; } }
        const float osc = (ch8 < 128) ? 0.08838834764831845f : 1.0f;
        const int sbeg = 256 * c + 16 * tr;
        float u0[8], u1[8], u2[8];
#define CVP_RAW(ss) ((ss) >= 0 ? *(const GAS v4u*)(P6 + (size_t)(b * SEQ + (ss)) * P6W + cq) : (v4u){0u, 0u, 0u, 0u})
#define CVP_DEC(dst, q) do { dst[0] = bflo(q.x); dst[1] = bfhi(q.x); dst[2] = bflo(q.y); dst[3] = bfhi(q.y); dst[4] = bflo(q.z); dst[5] = bfhi(q.z); dst[6] = bflo(q.w); dst[7] = bfhi(q.w); } while (0)
        LAS unsigned char* tile = L + ((ch8 < 128) ? CVP_QS : CVP_KS) + ((ch8 & 127) * 2);
        {
            v4u ra[11];
#pragma unroll
            for (int i = 0; i < 11; ++i) ra[i] = CVP_RAW(sbeg - 3 + i);
            v4u rb[8];
#pragma unroll
            for (int i = 0; i < 8; ++i) rb[i] = CVP_RAW(sbeg + 8 + i);
            CVP_DEC(u0, ra[0]); CVP_DEC(u1, ra[1]); CVP_DEC(u2, ra[2]);
#pragma unroll
            for (int tt = 0; tt < 16; ++tt) {
                float u3[8]; if (tt < 8) CVP_DEC(u3, ra[3 + tt]); else CVP_DEC(u3, rb[tt - 8]);
                float o[8];
#pragma unroll
                for (int i = 0; i < 8; ++i) { const float a = bias[i] + w[0][i] * u0[i] + w[1][i] * u1[i] + w[2][i] * u2[i] + w[3][i] * u3[i]; o[i] = a * sigmoidf_(a) * osc; }
                v4u q; q.x = pk2(o[0], o[1]); q.y = pk2(o[2], o[3]); q.z = pk2(o[4], o[5]); q.w = pk2(o[6], o[7]);
                *(LAS v4u*)(tile + (16 * tr + tt) * 272) = q;
#pragma unroll
                for (int i = 0; i < 8; ++i) { u0[i] = u1[i]; u1[i] = u2[i]; u2[i] = u3[i]; }
            }
        }
#undef CVP_RAW
#undef CVP_DEC
        if (F.tid < 256) *(LAS float*)(L + CVP_U + F.tid * 4) = *(const GAS float*)(R3 + MLS_U + ((size_t)bh * 4096 + 256 * c + F.tid) * 4) * LOG2E;
    }
    __syncthreads();
    {
        const int lane = F.lane, wid = F.wave, r32 = lane & 31, hh = lane >> 5;
        const int qblk = (wid < 4) ? 7 - wid : wid - 4;
        float Mc = 0.f;
        { const float a_l = *(const GAS float*)(R3 + MLS_SUM + (size_t)(bh * 16 + (lane & 15)) * 8), p_l = *(const GAS float*)(R3 + MLS_SUM + (size_t)(bh * 16 + (lane & 15)) * 8 + 4);
#pragma unroll
          for (int cc = 0; cc < 16; ++cc) if (cc < c) { const float a = __int_as_float(__builtin_amdgcn_readlane(__float_as_int(a_l), cc)), pmx = __int_as_float(__builtin_amdgcn_readlane(__float_as_int(p_l), cc)); Mc = a + fmaxf(Mc, pmx); } }
        const float pmq = *(const GAS float*)(R3 + MLS_PM + ((size_t)bh * 4096 + 256 * c + 32 * qblk + r32) * 4);
        const float myMM2 = fmaxf(Mc, pmq) * LOG2E;
        bf16x8 qf[8];
#pragma unroll
        for (int kk = 0; kk < 8; ++kk) qf[kk] = *(const LAS bf16x8*)(L + CVP_QS + (32 * qblk + r32) * 272 + (16 * kk + 8 * hh) * 2);
        { unsigned char* QF = wsp(F, WS_R2) + (((size_t)(bh * 16 + c) * 8 + qblk) * 8) * 1024 + lane * 16;
#pragma unroll
          for (int kk = 0; kk < 8; ++kk) *(GAS bf16x8*)(QF + (size_t)kk * 1024) = qf[kk]; }
        unsigned char* PT = wsp(F, WS_PT) + ((size_t)(bh * 16 + c) * 36 + (qblk * (qblk + 1)) / 2) * 2048;
        const LAS float* U2 = (const LAS float*)(L + CVP_U);
        for (int kt = 0; kt <= qblk; ++kt) {
            f32x16 p = {};
#pragma unroll
            for (int kk = 0; kk < 8; ++kk) { const bf16x8 a = *(const LAS bf16x8*)(L + CVP_KS + (32 * kt + r32) * 272 + (16 * kk + 8 * hh) * 2); p = __builtin_amdgcn_mfma_f32_32x32x16_bf16(a, qf[kk], p, 0, 0, 0); }
            const bool diag = (kt == qblk);
            float pw[16];
#pragma unroll
            for (int g = 0; g < 4; ++g) { const f32x4 u2 = *(const LAS f32x4*)(U2 + 32 * kt + 8 * g + 4 * hh);
#pragma unroll
                for (int i = 0; i < 4; ++i) { const int r = 4 * g + i; float v = p[r] * __builtin_amdgcn_exp2f(u2[i] - myMM2); if (diag && (8 * g + 4 * hh + i) > r32) v = 0.f; pw[r] = v; } }
            v4u pb0, pb1;
            pb0.x = pk2(pw[0], pw[1]); pb0.y = pk2(pw[2], pw[3]); pb0.z = pk2(pw[4], pw[5]); pb0.w = pk2(pw[6], pw[7]);
            pb1.x = pk2(pw[8], pw[9]); pb1.y = pk2(pw[10], pw[11]); pb1.z = pk2(pw[12], pw[13]); pb1.w = pk2(pw[14], pw[15]);
            *(GAS v4u*)(PT + (size_t)kt * 2048 + lane * 16) = pb0; *(GAS v4u*)(PT + (size_t)kt * 2048 + 1024 + lane * 16) = pb1;
        }
        { const int dkt = wid & 3, kh = wid >> 2;
          unsigned char* KF = wsp(F, WS_R2) + 16 * MiB + (((size_t)(bh * 16 + c) * 8 + (dkt * 2 + kh)) * 8) * 1024 + lane * 16;
#pragma unroll
          for (int ks = 0; ks < 8; ++ks) { const int s0 = 128 * kh + 16 * ks + 8 * hh; bf16x8 bb;
#pragma unroll
              for (int j = 0; j < 8; ++j) bb[j] = *(const LAS short*)(L + CVP_KS + (s0 + j) * 272 + (32 * dkt + r32) * 2);
              *(GAS bf16x8*)(KF + (size_t)ks * 1024) = bb; } }
    }
    __syncthreads();
}
__device__ __forceinline__ void phase_cvp(Frame& F, int l) {
    const int v = (F.G % 8 == 0) ? (F.c % 8) * (F.G / 8) + F.c / 8 : F.c;
    for (int u = v; u < 256; u += F.G) cvp_job(F, l, u >> 4, u & 15);
}

constexpr int M2_KS = 0, M2_VT = 69632, M2_CT = 86528, M2_G = 95232, M2_U2 = 97280, M2_WC = 105472, M2_PART = 113664;
constexpr int M2_KP = 272, M2_VP = 528, M2_CP = 272;
__device__ __forceinline__ void mlstm_unit(Frame& F, int b, int h, int ds, int skip) {
    LAS unsigned char* L = F.lds;
    const int wid = F.wave;
    const int qblk = (wid < 4) ? 7 - wid : wid - 4;
    const int dkt = wid & 3, kh = wid >> 2;
#define M2_IDS() int lane_ = F.lane; asm volatile("" : "+v"(lane_)); const int lane = lane_, tid = wid * 64 + lane, r32 = lane & 31, hh = lane >> 5
    const bf16* VTg = (const bf16*)wsp(F, WS_VT);
    bf16* P6 = (bf16*)wsp(F, WS_P6);
    const int tb = b * SEQ, bh = b * 4 + h;
    { M2_IDS();
    for (int i = tid; i < 16 * 264; i += 512) { const int row = 16 + i / 264, col = i % 264; *(LAS bf16*)(L + M2_VT + row * M2_VP + col * 2) = (row == 16 && col < 256) ? (bf16)0x3F80 : (bf16)0; }
    for (int i = tid; i < 32 * 136; i += 512) *(LAS bf16*)(L + M2_CT + i * 2) = (bf16)0; }
    f32x16 st = {};
    float Mst = 0.f;
    v4u pv; float pu[4], ppm, pbl, psa, psm;
    bf16x8 qf[8];
    v4u kfr[8];
    v4u pbuf[8][2];
    const unsigned char* R3 = wsp(F, WS_R3);
#define M2_FETCH(cc) do { const int t0_ = tb + 256 * (cc); \
        { const int dvl_ = tid >> 5, seg_ = tid & 31; pv = *(const GAS v4u*)(VTg + (size_t)(h * 256 + ds * 16 + dvl_) * NTOK + t0_ + seg_ * 8); } \
        { const size_t ib_ = (size_t)bh * 4096 + 256 * (cc); \
          _Pragma("unroll") for (int i = 0; i < 4; ++i) pu[i] = *(const GAS float*)(R3 + MLS_U + (ib_ + 64 * i + lane) * 4); \
          ppm = *(const GAS float*)(R3 + MLS_PM + (ib_ + 32 * qblk + r32) * 4); pbl = *(const GAS float*)(R3 + MLS_BL + (ib_ + 32 * qblk + r32) * 4); \
          psa = *(const GAS float*)(R3 + MLS_SUM + (size_t)(bh * 16 + (cc)) * 8); psm = *(const GAS float*)(R3 + MLS_SUM + (size_t)(bh * 16 + (cc)) * 8 + 4); } } while (0)
#define M2_QFETCH(cc) do { const unsigned char* qf_ = wsp(F, WS_R2) + (((size_t)(bh * 16 + (cc)) * 8 + qblk) * 8) * 1024 + lane * 16; _Pragma("unroll") for (int kk = 0; kk < 8; ++kk) qf[kk] = *(const GAS bf16x8*)(qf_ + (size_t)kk * 1024); } while (0)
#define M2_KFETCH(cc) do { const unsigned char* kf_ = wsp(F, WS_R2) + 16 * MiB + (((size_t)(bh * 16 + (cc)) * 8 + (dkt * 2 + kh)) * 8) * 1024 + lane * 16; \
        _Pragma("unroll") for (int ks = 0; ks < 8; ++ks) kfr[ks] = *(const GAS v4u*)(kf_ + (size_t)ks * 1024); } while (0)
#define M2_PTQ(cc) (wsp(F, WS_PT) + ((size_t)(bh * 16 + (cc)) * 36 + (qblk * (qblk + 1)) / 2) * 2048 + lane * 16)
    { M2_IDS(); M2_FETCH(0); M2_QFETCH(0); M2_KFETCH(0);
      const unsigned char* pt_ = M2_PTQ(0);
#pragma unroll
      for (int kt = 0; kt < 8; ++kt) if (kt <= qblk) { pbuf[kt][0] = *(const GAS v4u*)(pt_ + (size_t)kt * 2048); pbuf[kt][1] = *(const GAS v4u*)(pt_ + (size_t)kt * 2048 + 1024); } }
    LAS float* WCw = (LAS float*)(L + M2_WC + wid * 1024);
    for (int c = 0; c < 16; ++c) {
        M2_IDS();
        const int t0 = tb + 256 * c;
        const bool more = (c + 1 < 16);
        { const int dvl_ = tid >> 5, seg_ = tid & 31; *(LAS v4u*)(L + M2_VT + dvl_ * M2_VP + seg_ * 16) = pv; }
        float cu[4]; const float cpm = ppm, cbl = pbl, csa = psa, csm = psm;
#pragma unroll
        for (int i = 0; i < 4; ++i) cu[i] = pu[i];
        if (more) M2_FETCH(c + 1);
        float myWIN, myEFLO, decay;
        {
            const float mml = fmaxf(Mst, csm);
#pragma unroll
            for (int i = 0; i < 4; ++i) WCw[64 * i + lane] = __expf(cu[i] - mml);
            const float mm = fmaxf(Mst, cpm);
            myWIN = __expf(Mst - mm); myEFLO = __expf(-(cbl + mm));
            decay = __expf(Mst - mml);
            Mst = csa + mml;
        }
        __syncthreads();
        f32x16 hT = {};
        if (!(skip & 4))
#pragma unroll
        for (int kk = 0; kk < 8; ++kk) { const bf16x8 a = *(const LAS bf16x8*)(L + M2_CT + r32 * M2_CP + (16 * kk + 8 * hh) * 2); hT = __builtin_amdgcn_mfma_f32_32x32x16_bf16(a, qf[kk], hT, 0, 0, 0); }
        if (more && !(skip & 32)) M2_QFETCH(c + 1);
#pragma unroll
        for (int r = 0; r < 16; ++r) hT[r] *= myWIN;
        {
            const unsigned char* ptn = M2_PTQ(c + 1);
#pragma unroll
            for (int kt = 0; kt < 8; ++kt) if (kt <= qblk) {
#pragma unroll
                for (int s = 0; s < 2; ++s) if (!(skip & 1)) { const LAS unsigned char* vp = L + M2_VT + r32 * M2_VP + (32 * kt + 16 * s + 4 * hh) * 2;
                    const v2u lo = *(const LAS v2u*)vp, hi = *(const LAS v2u*)(vp + 16);
                    v4u t; t.x = lo.x; t.y = lo.y; t.z = hi.x; t.w = hi.y;
                    hT = __builtin_amdgcn_mfma_f32_32x32x16_bf16(__builtin_bit_cast(bf16x8, t), __builtin_bit_cast(bf16x8, pbuf[kt][s]), hT, 0, 0, 0); }
                if (more && !(skip & 16)) { pbuf[kt][0] = *(const GAS v4u*)(ptn + (size_t)kt * 2048); pbuf[kt][1] = *(const GAS v4u*)(ptn + (size_t)kt * 2048 + 1024); }
            }
        }
        {
            const float dn = hT[8];
            auto rr = __builtin_amdgcn_permlane32_swap(__float_as_uint(dn), __float_as_uint(dn), false, false);
            const float den = __uint_as_float(rr[0]);
            const float inv = 1.0f / fmaxf(fabsf(den), myEFLO);
            bf16* orow = P6 + (size_t)(t0 + 32 * qblk + r32) * P6W + P_MQK + h * 256 + ds * 16 + 4 * hh;
            v2u o0, o1; o0.x = pk2(hT[0] * inv, hT[1] * inv); o0.y = pk2(hT[2] * inv, hT[3] * inv); o1.x = pk2(hT[4] * inv, hT[5] * inv); o1.y = pk2(hT[6] * inv, hT[7] * inv);
            if (!(skip & 8)) { *(GAS v2u*)orow = o0; *(GAS v2u*)(orow + 8) = o1; } else { asm volatile("" :: "v"(o0), "v"(o1)); }
        }
        f32x16 part = {};
#pragma unroll
        for (int ks = 0; ks < 8; ++ks) if (!(skip & 2)) {
            const int s0 = 128 * kh + 16 * ks + 8 * hh;
            const v4u raw = *(const LAS v4u*)(L + M2_VT + r32 * M2_VP + s0 * 2);
            const f32x4 w0 = *(const LAS f32x4*)(WCw + s0), w1 = *(const LAS f32x4*)(WCw + s0 + 4);
            v4u aw; aw.x = pk2(bflo(raw.x) * w0[0], bfhi(raw.x) * w0[1]); aw.y = pk2(bflo(raw.y) * w0[2], bfhi(raw.y) * w0[3]);
            aw.z = pk2(bflo(raw.z) * w1[0], bfhi(raw.z) * w1[1]); aw.w = pk2(bflo(raw.w) * w1[2], bfhi(raw.w) * w1[3]);
            part = __builtin_amdgcn_mfma_f32_32x32x16_bf16(__builtin_bit_cast(bf16x8, aw), __builtin_bit_cast(bf16x8, kfr[ks]), part, 0, 0, 0);
        }
        if (more && !(skip & 64)) M2_KFETCH(c + 1);
        if (kh == 1) {
#pragma unroll
            for (int r = 0; r < 16; ++r) *(LAS float*)(L + M2_PART + dkt * 4096 + r * 256 + lane * 4) = part[r];
        }
        __syncthreads();
        if (kh == 0) {
#pragma unroll
            for (int r = 0; r < 16; ++r) { st[r] = st[r] * decay + part[r] + *(LAS float*)(L + M2_PART + dkt * 4096 + r * 256 + lane * 4);
                *(LAS bf16*)(L + M2_CT + crow(r, hh) * M2_CP + (32 * dkt + r32) * 2) = f2bf(st[r]); }
        }
    }
#undef M2_FETCH
#undef M2_QFETCH
#undef M2_KFETCH
#undef M2_PTQ
#undef M2_IDS
}
__device__ __forceinline__ void phase_mlstm(Frame& F, int skip) {
    const int v = (F.G % 8 == 0) ? (F.c % 8) * (F.G / 8) + F.c / 8 : F.c;
    for (int u = v; u < 256; u += F.G) { const int bh = u >> 4, ds = u & 15; mlstm_unit(F, bh >> 2, bh & 3, ds, skip); __syncthreads(); }
}

__device__ __forceinline__ void phase_hm_final(Frame& F, int l, bool do_store) {
    bf16* P6 = (bf16*)wsp(F, WS_P6);
    const float* mw = inp(F, I_MNW) + (size_t)l * 1024;
    for (int vb = F.c; vb < 256; vb += F.G) {
        v4u hn[2], mn[2];
#define HM_LOAD(tt) do { const bf16* r_ = P6 + (size_t)(tt) * P6W + 8 * F.lane; \
            _Pragma("unroll") for (int j = 0; j < 2; ++j) { hn[j] = *(const GAS v4u*)(r_ + P_MQK + 512 * j); mn[j] = *(const GAS v4u*)(r_ + P_MO + 512 * j); } } while (0)
        HM_LOAD(vb * 64 + F.wave * 8);
        for (int i = 0; i < 8; ++i) {
            const int t = vb * 64 + F.wave * 8 + i; bf16* row = P6 + (size_t)t * P6W + 8 * F.lane;
            v4u hc[2], mc[2];
#pragma unroll
            for (int j = 0; j < 2; ++j) { hc[j] = hn[j]; mc[j] = mn[j]; }
            if (i + 1 < 8) HM_LOAD(t + 1);
#pragma unroll
            for (int j = 0; j < 2; ++j) {
                const float x[8] = {bflo(hc[j].x), bfhi(hc[j].x), bflo(hc[j].y), bfhi(hc[j].y), bflo(hc[j].z), bfhi(hc[j].z), bflo(hc[j].w), bfhi(hc[j].w)};
                const float mo[8] = {bflo(mc[j].x), bfhi(mc[j].x), bflo(mc[j].y), bfhi(mc[j].y), bflo(mc[j].z), bfhi(mc[j].z), bflo(mc[j].w), bfhi(mc[j].w)};
                float ss = 0.f;
#pragma unroll
                for (int q = 0; q < 8; ++q) ss += x[q] * x[q];
                ss = half_sum32(ss);
                const float r = 1.0f / sqrtf(ss * (1.f / 256.f) + EPS);
                const f32x4 w0 = *(const GAS f32x4*)(mw + 512 * j + 8 * F.lane), w1 = *(const GAS f32x4*)(mw + 512 * j + 8 * F.lane + 4);
                float y[8];
#pragma unroll
                for (int q = 0; q < 4; ++q) { y[q] = x[q] * r * w0[q] * sigmoidf_(mo[q]); y[4 + q] = x[4 + q] * r * w1[q] * sigmoidf_(mo[4 + q]); }
                v4u o; o.x = pk2(y[0], y[1]); o.y = pk2(y[2], y[3]); o.z = pk2(y[4], y[5]); o.w = pk2(y[6], y[7]);
                if (do_store) *(GAS v4u*)(row + P_MQK + 512 * j) = o; else asm volatile("" :: "v"(o));
            }
        }
#undef HM_LOAD
    }
}

#define N2_LD0(dst, k0) do { const GAS float* bq_ = bp + (size_t)(2 * (k0)) * 64; asm volatile("" : "+v"(bq_)); _Pragma("unroll") for (int q_ = 0; q_ < 32; ++q_) dst[q_] = bq_[(size_t)(2 * q_) * 64]; } while (0)
constexpr int N2_H2 = 0, N2_CA = 131328, N2_CB = N2_CA + 4096, N2_HIST = N2_CB + 4096, N2_ST = N2_HIST + 256;
static_assert(N2_ST + 4864 <= LDS_CTL, "N2 LDS");
__device__ __forceinline__ void phase_norm2_router(Frame& F, int l, int skip, bool tail) {
    LAS unsigned char* L = F.lds;
    LAS float* H2 = (LAS float*)(L + N2_H2); LAS float* cA = (LAS float*)(L + N2_CA); LAS float* cB = (LAS float*)(L + N2_CB); LAS unsigned* hist = (LAS unsigned*)(L + N2_HIST);
    const int lane = F.lane, wid = F.wave, r32 = lane & 31, hh = lane >> 5;
    bf16* XN2 = (bf16*)wsp(F, WS_R1); unsigned* CUR = (unsigned*)wsp(F, WS_CUR) + l * 64;
    LAS int* stE = (LAS int*)(L + N2_ST); LAS float* stW = (LAS float*)(L + N2_ST + 2048); LAS unsigned* blockoff = (LAS unsigned*)(L + N2_ST + 4096); LAS unsigned* selm = (LAS unsigned*)(L + N2_ST + 4352);
    const float* Wr = inp(F, I_RW) + (size_t)l * 1024 * 64;
    const float rb = inp(F, I_RB)[l * 64 + lane];
    for (int vb = F.c; vb < 256; vb += F.G) {
        const int b = vb >> 6;
        const float* MODF = (const float*)wsp(F, WS_MODF) + (size_t)(l * 4 + b) * 6144;
        for (int k = F.tid; k < 1024; k += 512) { cA[k] = inp(F, I_N2W)[l * 1024 + k] * (1.f + MODF[4 * 1024 + k]); cB[k] = MODF[3 * 1024 + k]; }
        if (F.tid < 64) hist[F.tid] = 0u;
        const int eh = wid & 1, kq = wid >> 1;
        const GAS float* bp = (const GAS float*)(Wr + (size_t)(256 * kq + hh) * 64 + 32 * eh + r32);
        __syncthreads();
        for (int it = 0; it < 2; ++it) {
            const int T0 = vb * 64 + it * 32;
            float wA[32], wB[32];
            N2_LD0(wA, 0); N2_LD0(wB, 32);
            v4u xr4[4][2];
            if (!(skip & 4))
#pragma unroll
            for (int i = 0; i < 4; ++i) { const bf16* xr = xmid(F, l) + (size_t)(T0 + wid * 4 + i) * 1024 + 8 * lane;
#pragma unroll
                for (int j = 0; j < 2; ++j) xr4[i][j] = *(const GAS v4u*)(xr + 512 * j); }
#pragma unroll
            for (int i = 0; i < 4; ++i) if (!(skip & 4)) {
                const int tl = wid * 4 + i, t = T0 + tl;
                float v[2][8]; float ss = 0.f;
#pragma unroll
                for (int j = 0; j < 2; ++j) { const v4u a = xr4[i][j];
                    v[j][0] = bflo(a.x); v[j][1] = bfhi(a.x); v[j][2] = bflo(a.y); v[j][3] = bfhi(a.y); v[j][4] = bflo(a.z); v[j][5] = bfhi(a.z); v[j][6] = bflo(a.w); v[j][7] = bfhi(a.w);
#pragma unroll
                    for (int q = 0; q < 8; ++q) ss += v[j][q] * v[j][q]; }
                ss = wave_sum(ss, F.lane);
                const float r = 1.0f / sqrtf(ss * (1.f / 1024.f) + EPS);
#pragma unroll
                for (int j = 0; j < 2; ++j) { const int k = 8 * lane + 512 * j; float h[8];
                    const f32x4 a0 = *(const LAS f32x4*)(cA + k), a1 = *(const LAS f32x4*)(cA + k + 4), b0 = *(const LAS f32x4*)(cB + k), b1 = *(const LAS f32x4*)(cB + k + 4);
                    LAS float* hp = H2 + tl * 1025 + k;
#pragma unroll
                    for (int q = 0; q < 4; ++q) { h[q] = v[j][q] * r * a0[q] + b0[q]; h[4 + q] = v[j][4 + q] * r * a1[q] + b1[q]; }
#pragma unroll
                    for (int q = 0; q < 8; ++q) hp[q] = h[q];
                    v4u o; o.x = pk2(h[0], h[1]); o.y = pk2(h[2], h[3]); o.z = pk2(h[4], h[5]); o.w = pk2(h[6], h[7]);
                    *(GAS v4u*)(XN2 + (size_t)t * 1024 + k) = o; }
            }
            __syncthreads();
            f32x16 acc = {};
            {
                const LAS float* ap = H2 + r32 * 1025 + 256 * kq + hh;
#define N2_LD(dst, k0) N2_LD0(dst, k0)
#define N2_MM(src, k0) do { _Pragma("unroll") for (int q_ = 0; q_ < 32; ++q_) { if ((q_ & 7) == 0) asm volatile("" ::: "memory"); acc = __builtin_amdgcn_mfma_f32_32x32x2f32(ap[2 * ((k0) + q_)], src[q_], acc, 0, 0, 0); } } while (0)
                if (!(skip & 1)) { N2_MM(wA, 0); N2_LD(wA, 64); N2_MM(wB, 32); N2_LD(wB, 96); N2_MM(wA, 64); N2_MM(wB, 96); }
            }
            __syncthreads();
            LAS float* PART = (LAS float*)(L);
#pragma unroll
            for (int r = 0; r < 16; ++r) PART[(kq * 32 + crow(r, hh)) * 64 + 32 * eh + r32] = acc[r];
            __syncthreads();
            if (!(skip & 2))
            {
                LAS float* rowb = (LAS float*)(L + 32768 + wid * 4096);
                int lane_t = F.lane; asm volatile("" : "+v"(lane_t)); const int lane = lane_t;
                const int g = lane >> 3;
                float score[4], sel[4]; unsigned key[4];
#pragma unroll
                for (int i = 0; i < 4; ++i) { const int tl = wid * 4 + i;
                    const float x = (PART[(0 * 32 + tl) * 64 + lane] + PART[(1 * 32 + tl) * 64 + lane]) + (PART[(2 * 32 + tl) * 64 + lane] + PART[(3 * 32 + tl) * 64 + lane]);
                    score[i] = 1.f / (1.f + expf(-x)); sel[i] = score[i] + rb; rowb[i * 256 + lane] = sel[i]; }
                LDS_WAIT();
#pragma unroll
                for (int i = 0; i < 4; ++i) { const LAS float* row = rowb + i * 256;
                    const f32x4 a = *(const LAS f32x4*)(row + 8 * g), c2 = *(const LAS f32x4*)(row + 8 * g + 4);
                    float m1 = fmaxf(a[0], a[1]), m2 = fminf(a[0], a[1]);
#define TK_INS(v_) do { const float v__ = (v_); m2 = fmaxf(m2, fminf(m1, v__)); m1 = fmaxf(m1, v__); } while (0)
                    TK_INS(a[2]); TK_INS(a[3]); TK_INS(c2[0]); TK_INS(c2[1]); TK_INS(c2[2]); TK_INS(c2[3]);
#undef TK_INS
                    if ((lane & 7) == 0) rowb[i * 256 + 64 + g] = m1 + m2; }
                LDS_WAIT();
#pragma unroll
                for (int i = 0; i < 4; ++i) { const LAS float* row = rowb + i * 256;
                    const f32x4 a = *(const LAS f32x4*)(row + 64), c2 = *(const LAS f32x4*)(row + 68);
                    const float gsv[8] = {a[0], a[1], a[2], a[3], c2[0], c2[1], c2[2], c2[3]};
                    float mine = 0.f;
#pragma unroll
                    for (int q = 0; q < 8; ++q) if (q == g) mine = gsv[q];
                    int gr = 0;
#pragma unroll
                    for (int q = 0; q < 8; ++q) gr += ((gsv[q] > mine) || (gsv[q] == mine && q < g)) ? 1 : 0;
                    const unsigned sb = __float_as_uint(sel[i]); key[i] = (gr < 4) ? (sb ^ ((unsigned)((int)sb >> 31) | 0x80000000u)) : 0u; }
                unsigned chosenm = 0u; float wsum[4] = {0.f, 0.f, 0.f, 0.f}; int myE = 0; float myS = 0.f;
#pragma unroll
                for (int r = 0; r < 8; ++r)
#pragma unroll
                    for (int i = 0; i < 4; ++i) {
                        const unsigned m = wave_umax_all(key[i]);
                        const int idx = __builtin_ctzll(__builtin_amdgcn_ballot_w64(key[i] == m));
                        const float sc = __int_as_float(__builtin_amdgcn_readlane(__float_as_int(score[i]), idx));
                        wsum[i] += sc;
                        if (lane == idx) { key[i] = 0u; chosenm += 1u; }
                        if (lane == 8 * i + r) { myE = idx; myS = sc; }
                    }
                {
                    const int ti = lane >> 3; const float ws_ = (ti == 0) ? wsum[0] : (ti == 1) ? wsum[1] : (ti == 2) ? wsum[2] : wsum[3];
                    if (lane < 32) { const int o = (it * 32 + wid * 4) * 8 + lane; stE[o] = myE; stW[o] = myS / ws_ * 2.5f; }
                    if (chosenm) __hip_atomic_fetch_add(&hist[lane], chosenm, __ATOMIC_RELAXED, __HIP_MEMORY_SCOPE_WORKGROUP);
                }
                LDS_WAIT();
            }
            __syncthreads();
        }
        if (tail && !skip) {
        if (F.tid < 64) { const unsigned h_ = hist[F.tid]; blockoff[F.tid] = h_ ? __hip_atomic_fetch_add(CUR + F.tid, h_, __ATOMIC_RELAXED, __HIP_MEMORY_SCOPE_AGENT) : 0u; }
        if (F.tid < 128) selm[F.tid] = 0u;
        __syncthreads();
        { const int tok = F.tid >> 3, slot = F.tid & 7, gt = vb * 64 + tok; const int e = stE[F.tid];
          __hip_atomic_fetch_or(&selm[e * 2 + (tok >> 5)], 1u << (tok & 31), __ATOMIC_RELAXED, __HIP_MEMORY_SCOPE_WORKGROUP);
          __syncthreads();
          const unsigned lo = selm[e * 2], hi = selm[e * 2 + 1];
          const unsigned rank = (tok < 32) ? __popc(lo & ((1u << tok) - 1u)) : (__popc(lo) + __popc(hi & ((1u << (tok - 32)) - 1u)));
          const size_t pos = (size_t)e * RS_CAP + blockoff[e] + rank;
          *(GAS unsigned*)((unsigned*)wsp(F, WS_RSTOK) + pos) = (unsigned)gt; *(GAS float*)((float*)wsp(F, WS_RSW) + pos) = stW[F.tid]; *(GAS unsigned*)((unsigned*)wsp(F, WS_RSPOS) + (size_t)gt * 8 + slot) = (unsigned)pos; }
        }
        __syncthreads();
    }
}

__device__ __forceinline__ int moe_layout(Frame& F, int l, LAS unsigned* tot, LAS unsigned* padv, LAS unsigned* base) {
    const unsigned* CUR = (const unsigned*)wsp(F, WS_CUR) + l * 64;
    if (F.tid < 64) { const unsigned T = *(const GAS unsigned*)(CUR + F.tid); tot[F.tid] = T; padv[F.tid] = (T + 255u) & ~255u; }
    __syncthreads();
    if (F.tid < 64) { unsigned b = 0; for (int e = 0; e < F.tid; ++e) b += padv[e]; base[F.tid] = b; }
    __syncthreads();
    return (int)((base[63] + padv[63]) >> 8);
}

__device__ __forceinline__ void phase_scatter(Frame& F) {
    LAS unsigned* red = (LAS unsigned*)(F.lds);
    LAS unsigned* tot = red + 1024; LAS unsigned* padv = tot + 64; LAS unsigned* bef = padv + 64; LAS unsigned* base = bef + 64; LAS unsigned* selm = base + 64;
    const unsigned* CNT = (const unsigned*)wsp(F, WS_CNT); const int* TOPE = (const int*)wsp(F, WS_TOPE); const float* TOPW = (const float*)wsp(F, WS_TOPW);
    unsigned* STOK = (unsigned*)wsp(F, WS_STOK); float* SW = (float*)wsp(F, WS_SW); unsigned* SDST = (unsigned*)wsp(F, WS_SDST); int* TILEE = (int*)wsp(F, WS_TILEE);
    const int tid = F.tid;
    for (int vb = F.c; vb < 256; vb += F.G) {
        { const int e = tid & 63, part = tid >> 6; unsigned t = 0, bfv = 0;
          unsigned cv[32];
#pragma unroll
          for (int q = 0; q < 32; ++q) cv[q] = *(const GAS unsigned*)(CNT + (32 * part + q) * 64 + e);
#pragma unroll
          for (int q = 0; q < 32; ++q) { t += cv[q]; if (32 * part + q < vb) bfv += cv[q]; }
          red[part * 64 + e] = t; red[512 + part * 64 + e] = bfv; }
        if (tid < 128) selm[tid] = 0u;
        __syncthreads();
        if (tid < 64) { unsigned T = 0, B = 0;
#pragma unroll
            for (int p = 0; p < 8; ++p) { T += red[p * 64 + tid]; B += red[512 + p * 64 + tid]; }
            tot[tid] = T; padv[tid] = (T + 255u) & ~255u; bef[tid] = B; }
        __syncthreads();
        if (tid < 64) { unsigned b = 0; for (int e = 0; e < tid; ++e) b += padv[e]; base[tid] = b; }
        const int tok = tid >> 3, slot = tid & 7, gt = vb * 64 + tok; const int e = TOPE[(size_t)gt * 8 + slot];
        __hip_atomic_fetch_or(&selm[e * 2 + (tok >> 5)], 1u << (tok & 31), __ATOMIC_RELAXED, __HIP_MEMORY_SCOPE_WORKGROUP);
        __syncthreads();
        { const unsigned lo = selm[e * 2], hi = selm[e * 2 + 1];
          const unsigned rank = (tok < 32) ? __popc(lo & ((1u << tok) - 1u)) : (__popc(lo) + __popc(hi & ((1u << (tok - 32)) - 1u)));
          const unsigned pos = base[e] + bef[e] + rank;
          STOK[pos] = (unsigned)gt; SW[pos] = TOPW[(size_t)gt * 8 + slot]; SDST[pos] = (unsigned)(gt * 8 + slot); }
        if (vb < 64) { const unsigned n = padv[vb] - tot[vb]; if ((unsigned)tid < n) { const unsigned pos = base[vb] + tot[vb] + tid; STOK[pos] = 0u; SW[pos] = 0.f; SDST[pos] = 0xffffffffu; } }
        if (vb == 0) { const int ntiles = (int)((base[63] + padv[63]) >> 8);
            for (int pm = tid; pm < ntiles; pm += 512) { int ee = 0; for (int q = 0; q < 64; ++q) if ((unsigned)(256 * pm) >= base[q] && (unsigned)(256 * pm) < base[q] + padv[q]) ee = q; TILEE[pm] = ee; }
            if (tid == 0) TILEE[1000] = ntiles; }
        __syncthreads();
    }
}

struct RoutedOrder {
    int ntiles, G, c; const LAS int* tabE; const LAS unsigned* tabTok; int wave;
    __device__ __forceinline__ bool next(int i, pg8::Unit& u) const { const int pm = i * G + c; if (pm >= ntiles) return false; u.pm = pm; u.pn = tabE[i]; return true; }
    __device__ __forceinline__ unsigned rowtok(int i, int row) const { return tabTok[i * 256 + row]; }
    __device__ __forceinline__ size_t aoff(const pg8::Unit&) const { return 0; }
};
struct DownOrder {
    int nunits, G, v; const LAS int* tabE; int wave;
    __device__ __forceinline__ bool next(int i, pg8::Unit& u) const { const int L = i * G + v; if (L >= nunits) return false; u.pm = L >> 2; u.pn = tabE[i] * 4 + (L & 3); return true; }
    __device__ __forceinline__ unsigned rowtok(int, int) const { return 0u; }
    __device__ __forceinline__ size_t aoff(const pg8::Unit&) const { return 0; }
};

constexpr int DK_A = 0, DK_B = 65536, DK_CH = 32768;
static_assert(DK_B + 3 * DK_CH == LDS_BYTES, "down-projection LDS map");
__device__ __forceinline__ void phase_down_routed(Frame& F, int nunits, int v, const LAS int* tabE) {
    LAS unsigned char* L = F.lds;
    const int w = F.wave;
    int lane_t = lane_now(); const int lane = lane_t, fr = lane & 15, fq = lane >> 4;
    const int rg = w & 3, cg = w >> 2;
    const unsigned char* HID = (const unsigned char*)wsp(F, WS_R2);
    const unsigned char* BD = (const unsigned char*)wsp(F, WS_BD);
    unsigned char* Y = (unsigned char*)wsp(F, WS_YSLOT);
    const int myE = tabE[lane & 15];
    v2u ctl = {0u, 0u}; if (w == 0) ctl = *(const LAS v2u*)(L + LDS_CTL + lane * 8);
    asm volatile("s_waitcnt lgkmcnt(0)" ::: "memory");
    __builtin_amdgcn_s_barrier();
    const int nU = (v < nunits) ? (nunits - v + F.G - 1) / F.G : 0;
#define DK_ISSUE_A(i_) do { const int Lu_ = (i_) * F.G + v; const unsigned char* s_ = HID + (size_t)(Lu_ >> 2) * 65536; \
        _Pragma("unroll") for (int dd = 0; dd < 8; ++dd) { const int rho_ = 32 * w + 4 * dd + fq, c_ = fr ^ (rho_ & 15); \
            __builtin_amdgcn_global_load_lds((const GAS unsigned*)(s_ + rho_ * 256 + c_ * 16), (LAS unsigned*)(L + DK_A + (8 * w + dd) * 1024), 16, 0, 0); } } while (0)
#define DK_ISSUE_B(i_, cc_, bo_) do { const int Lu_ = (i_) * F.G + v; const unsigned char* s_ = BD + ((size_t)__builtin_amdgcn_readlane(myE, (i_)) * 1024 + (Lu_ & 3) * 256 + (cc_) * 128) * 256; \
        _Pragma("unroll") for (int dd = 0; dd < 4; ++dd) { const int i4_ = 4 * dd + fq, col_ = 64 * (w >> 2) + 16 * dd + 4 * (w & 3) + fq, c_ = fr ^ i4_; \
            __builtin_amdgcn_global_load_lds((const GAS unsigned*)(s_ + col_ * 256 + c_ * 16), (LAS unsigned*)(L + (bo_) + (4 * w + dd) * 1024), 16, 0, 0); } } while (0)
#define DK_CHUNK(i_, cc_, bo_) do { \
        f32x4 acc[4][4]; \
        _Pragma("unroll") for (int m = 0; m < 4; ++m) _Pragma("unroll") for (int n = 0; n < 4; ++n) acc[m][n] = (f32x4){0.f, 0.f, 0.f, 0.f}; \
        const LAS unsigned char* bb_ = L + (bo_) + (64 * cg + fr) * 256; \
        _Pragma("unroll") for (int kk = 0; kk < 4; ++kk) { bf16x8 bfr[4]; \
            _Pragma("unroll") for (int n = 0; n < 4; ++n) bfr[n] = *(const LAS bf16x8*)(bb_ + (16 * n) * 256 + (((4 * kk + fq) ^ fr) * 16)); \
            _Pragma("unroll") for (int m = 0; m < 4; ++m) _Pragma("unroll") for (int n = 0; n < 4; ++n) acc[m][n] = __builtin_amdgcn_mfma_f32_16x16x32_bf16(bfr[n], afr[m][kk], acc[m][n], 0, 0, 0); } \
        const int Lu_ = (i_) * F.G + v; unsigned char* yb_ = Y + (size_t)((Lu_ >> 2) * 256 + 64 * rg + fr) * 1024 + (Lu_ & 3) * 256 + (cc_) * 128 + 64 * cg + 16 * fq; \
        _Pragma("unroll") for (int m = 0; m < 4; ++m) { v4u o_; \
            _Pragma("unroll") for (int n = 0; n < 4; ++n) { const f32x4 x_ = acc[m][n] * YS_SCALE; int w_ = 0; \
                w_ = __builtin_amdgcn_cvt_pk_fp8_f32(__builtin_amdgcn_fmed3f(x_[0], -440.f, 440.f), __builtin_amdgcn_fmed3f(x_[1], -440.f, 440.f), w_, false); \
                w_ = __builtin_amdgcn_cvt_pk_fp8_f32(__builtin_amdgcn_fmed3f(x_[2], -440.f, 440.f), __builtin_amdgcn_fmed3f(x_[3], -440.f, 440.f), w_, true); \
                o_[n] = (unsigned)w_; } \
            *(GAS v4u*)(yb_ + (size_t)(16 * m) * 1024) = o_; } } while (0)
    if (nU > 0) {
        int b0 = DK_B, b1 = DK_B + DK_CH, b2 = DK_B + 2 * DK_CH;
        DK_ISSUE_A(0); DK_ISSUE_B(0, 0, b0); DK_ISSUE_B(0, 1, b1);
        for (int i = 0; i < nU; ++i) {
            const int in = (i + 1 < nU) ? i + 1 : i;
            if (i == 0) asm volatile("s_waitcnt vmcnt(4)" ::: "memory"); else asm volatile("s_waitcnt vmcnt(12)" ::: "memory");
            __builtin_amdgcn_s_barrier();
            DK_ISSUE_B(in, 0, b2);
            bf16x8 afr[4][4];
#pragma unroll
            for (int m = 0; m < 4; ++m)
#pragma unroll
                for (int kk = 0; kk < 4; ++kk) afr[m][kk] = *(const LAS bf16x8*)(L + DK_A + (64 * rg + 16 * m + fr) * 256 + (((4 * kk + fq) ^ fr) * 16));
            asm volatile("s_waitcnt lgkmcnt(0)" ::: "memory");
            __builtin_amdgcn_s_barrier();
            DK_ISSUE_A(in);
            DK_CHUNK(i, 0, b0);
            asm volatile("s_waitcnt vmcnt(16)" ::: "memory");
            __builtin_amdgcn_s_barrier();
            DK_ISSUE_B(in, 1, b0);
            DK_CHUNK(i, 1, b1);
            { const int t_ = b0; b0 = b2; b2 = b1; b1 = t_; }
        }
        asm volatile("s_waitcnt vmcnt(0)" ::: "memory");
    }
    __builtin_amdgcn_s_barrier();
    if (w == 0) *(LAS v2u*)(L + LDS_CTL + lane * 8) = ctl;
    asm volatile("s_waitcnt lgkmcnt(0)" ::: "memory");
    __builtin_amdgcn_s_barrier();
#undef DK_ISSUE_A
#undef DK_ISSUE_B
#undef DK_CHUNK
}

__device__ __forceinline__ void phase_combine(Frame& F, int l, bool do_store) {
    const bf16* Y = (const bf16*)wsp(F, WS_YSLOT); bf16* XN = (bf16*)wsp(F, WS_R2); float* GATES = (float*)wsp(F, WS_GATES);
    const bool last = (l == NLAYER - 1);
    LAS unsigned* tot = (LAS unsigned*)(F.lds + LDS_TAB + 8192); LAS unsigned* padv = tot + 64; LAS unsigned* base = padv + 64;
    moe_layout(F, l, tot, padv, base);
    for (int vb = F.c; vb < 256; vb += F.G) {
        const int b = vb >> 6;
        const float* g2 = (const float*)wsp(F, WS_MODF) + (size_t)(l * 4 + b) * 6144 + 5 * 1024;
        float gbl = 0.f;
        if (!last) { norm1_tables(F, l + 1, b, false); gbl = (F.lane < 4) ? inp(F, I_IGB)[(l + 1) * 4 + F.lane] : (F.lane < 8 ? inp(F, I_FGB)[(l + 1) * 4 + F.lane - 4] : 0.f); }
        __syncthreads();
        v2u yn[8][2];
        const bf16* SHO = (const bf16*)wsp(F, WS_SHO);
        int mypos; { const unsigned p_ = *(const GAS unsigned*)((const unsigned*)wsp(F, WS_RSPOS) + (size_t)(vb * 64 + F.wave * 8) * 8 + F.lane); mypos = (int)(base[p_ >> 14] + (p_ & (RS_CAP - 1))); }
#define CB_LOAD(ii) do { const int i_ = (ii); \
            _Pragma("unroll") for (int s = 0; s < 8; ++s) { const int rp_ = __builtin_amdgcn_readlane(mypos, i_ * 8 + s); \
                _Pragma("unroll") for (int j = 0; j < 2; ++j) yn[s][j] = *(const GAS v2u*)((const unsigned char*)Y + (size_t)rp_ * 1024 + 8 * F.lane + 512 * j); } \
            } while (0)
        CB_LOAD(0);
        for (int i = 0; i < 8; ++i) {
            const int t = vb * 64 + F.wave * 8 + i;
            v2u yc[8][2]; v4u xc[2]; v4u sc2[2]; bf16* xbr = xmid(F, l) + (size_t)t * 1024 + 8 * F.lane;
#pragma unroll
            for (int j = 0; j < 2; ++j) sc2[j] = *(const GAS v4u*)(SHO + (size_t)t * 1024 + 8 * F.lane + 512 * j);
#pragma unroll
            for (int s = 0; s < 8; ++s) { yc[s][0] = yn[s][0]; yc[s][1] = yn[s][1]; }
#pragma unroll
            for (int j = 0; j < 2; ++j) xc[j] = *(const GAS v4u*)(xbr + 512 * j);
            if (i + 1 < 8) CB_LOAD(i + 1);
            float acc[2][8];
#pragma unroll
            for (int j = 0; j < 2; ++j)
#pragma unroll
                for (int q = 0; q < 8; ++q) acc[j][q] = 0.f;
#pragma unroll
            for (int s = 0; s < 8; ++s)
#pragma unroll
                for (int j = 0; j < 2; ++j) { const v2u q = yc[s][j];
                    const f32x2_t a0 = __builtin_amdgcn_cvt_pk_f32_fp8((int)q.x, false), a1 = __builtin_amdgcn_cvt_pk_f32_fp8((int)q.x, true), a2 = __builtin_amdgcn_cvt_pk_f32_fp8((int)q.y, false), a3 = __builtin_amdgcn_cvt_pk_f32_fp8((int)q.y, true);
                    acc[j][0] += a0.x; acc[j][1] += a0.y; acc[j][2] += a1.x; acc[j][3] += a1.y; acc[j][4] += a2.x; acc[j][5] += a2.y; acc[j][6] += a3.x; acc[j][7] += a3.y; }
            float v[2][8]; float* xr = outp(F) + (size_t)t * 1024 + 8 * F.lane;
#pragma unroll
            for (int j = 0; j < 2; ++j) { const f32x4 a = {bflo(xc[j].x), bfhi(xc[j].x), bflo(xc[j].y), bfhi(xc[j].y)}, c2 = {bflo(xc[j].z), bfhi(xc[j].z), bflo(xc[j].w), bfhi(xc[j].w)};
                const f32x4 ga = *(const GAS f32x4*)(g2 + 8 * F.lane + 512 * j), gc = *(const GAS f32x4*)(g2 + 8 * F.lane + 512 * j + 4);
                const float sh[8] = {bflo(sc2[j].x), bfhi(sc2[j].x), bflo(sc2[j].y), bfhi(sc2[j].y), bflo(sc2[j].z), bfhi(sc2[j].z), bflo(sc2[j].w), bfhi(sc2[j].w)};
#pragma unroll
                for (int q = 0; q < 4; ++q) { v[j][q] = a[q] + ga[q] * (acc[j][q] * (1.f / YS_SCALE) + sh[q]); v[j][4 + q] = c2[q] + gc[q] * (acc[j][4 + q] * (1.f / YS_SCALE) + sh[4 + q]); } }
            if (last) {
                float ss = 0.f;
#pragma unroll
                for (int j = 0; j < 2; ++j)
#pragma unroll
                    for (int q = 0; q < 8; ++q) ss += v[j][q] * v[j][q];
                ss = wave_sum(ss, F.lane);
                const float r = 1.0f / sqrtf(ss * (1.f / 1024.f) + EPS);
#pragma unroll
                for (int j = 0; j < 2; ++j) { const float* fw = inp(F, I_FNW) + 8 * F.lane + 512 * j; const f32x4 w0 = *(const GAS f32x4*)fw, w1 = *(const GAS f32x4*)(fw + 4);
                    f32x4 o0, o1;
#pragma unroll
                    for (int q = 0; q < 4; ++q) { o0[q] = v[j][q] * r * w0[q]; o1[q] = v[j][4 + q] * r * w1[q]; }
                    if (do_store) { *(GAS f32x4*)(xr + 512 * j) = o0; *(GAS f32x4*)(xr + 512 * j + 4) = o1; } else asm volatile("" :: "v"(o0), "v"(o1)); }
            } else {
#pragma unroll
                for (int j = 0; j < 2; ++j) { v4u o; o.x = pk2(v[j][0], v[j][1]); o.y = pk2(v[j][2], v[j][3]); o.z = pk2(v[j][4], v[j][5]); o.w = pk2(v[j][6], v[j][7]);
                    if (do_store) { *(GAS v4u*)(xbr + 512 * j) = o; } else asm volatile("" :: "v"(o)); }
                if (do_store) norm_emit(F, v, (const LAS float*)(F.lds + LDS_TAB), (const LAS float*)(F.lds + LDS_TAB) + 1024, (const LAS float*)(F.lds), gbl, XN + (size_t)t * 1024, GATES + (size_t)t * 8);
            }
        }
#undef CB_LOAD
        __syncthreads();
    }
}

__device__ __forceinline__ void dbg_final(Frame& F, const float* src) {
    for (int vb = F.c; vb < 256; vb += F.G)
        for (int i = 0; i < 8; ++i) {
            const int t = vb * 64 + F.wave * 8 + i; const float* xr = src + (size_t)t * 1024 + 8 * F.lane; float* orow = outp(F) + (size_t)t * 1024 + 8 * F.lane;
            float v[2][8]; float ss = 0.f;
#pragma unroll
            for (int j = 0; j < 2; ++j) { const f32x4 a = *(const GAS f32x4*)(xr + 512 * j), c2 = *(const GAS f32x4*)(xr + 512 * j + 4);
#pragma unroll
                for (int q = 0; q < 4; ++q) { v[j][q] = a[q]; v[j][4 + q] = c2[q]; ss += a[q] * a[q] + c2[q] * c2[q]; } }
            ss = wave_sum(ss, F.lane);
            const float r = 1.0f / sqrtf(ss * (1.f / 1024.f) + EPS);
#pragma unroll
            for (int j = 0; j < 2; ++j) { const float* fw = inp(F, I_FNW) + 8 * F.lane + 512 * j; const f32x4 w0 = *(const GAS f32x4*)fw, w1 = *(const GAS f32x4*)(fw + 4);
                f32x4 o0, o1;
#pragma unroll
                for (int q = 0; q < 4; ++q) { o0[q] = v[j][q] * r * w0[q]; o1[q] = v[j][4 + q] * r * w1[q]; }
                *(GAS f32x4*)(orow + 512 * j) = o0; *(GAS f32x4*)(orow + 512 * j + 4) = o1; }
        }
}
struct Args { const float* in[24]; float* out; unsigned char* ws; };
#ifndef MK_EN_MASK
#define MK_EN_MASK 0xffffffffu
#endif
#define EN(k) (((MK_EN_MASK) >> (k)) & 1u)
#ifndef RP_G1
#define RP_G1 1
#endif
#ifndef RP_ATT
#define RP_ATT 1
#endif
#ifndef RP_ML
#define RP_ML 1
#endif
#ifndef RP_N2
#define RP_N2 1
#endif
#ifndef RP_CW
#define RP_CW 1
#endif
#ifndef RP_C
#define RP_C 1
#endif
#ifndef RP_D
#define RP_D 1
#endif
#ifndef RP_CV
#define RP_CV 1
#endif
#ifndef RP_PB
#define RP_PB 1
#endif
#ifndef RP_VT
#define RP_VT 1
#endif
#ifndef RP_PA
#define RP_PA 1
#endif
#ifndef RP_SC
#define RP_SC 1
#endif
#ifndef RP_SG
#define RP_SG 1
#endif
#ifndef ML_SKIP
#define ML_SKIP 0
#endif
#ifndef RP_X5
#define RP_X5 1
#endif
#ifndef RP_E
#define RP_E 1
#endif
#ifndef RP_HM
#define RP_HM 1
#endif
#ifndef RP_P1
#define RP_P1 1
#endif
#ifndef RP_SD
#define RP_SD 1
#endif
#ifndef N2_SKIP
#define N2_SKIP 0
#endif
#ifndef MK_LAST_PHASE
#define MK_LAST_PHASE 1000
#endif
__global__ void __launch_bounds__(512, 2) mk_fwd(Args args) {
    extern __shared__ __attribute__((aligned(16))) unsigned char lds_raw[];
    Frame F;
    F.lds = (LAS unsigned char*)lds_raw;
    const int wave0 = __builtin_amdgcn_readfirstlane((int)threadIdx.x >> 6);
#define RELOAD_IDS() do { int l_ = lane_now(); F.lane = l_; F.wave = wave0; F.tid = wave0 * 64 + l_; } while (0)
    RELOAD_IDS();
    F.G = gridDim.x; F.c = blockIdx.x;
    F.out = args.out; F.ws = args.ws;
    if (F.tid < 16) ((LAS unsigned*)(F.lds + LDS_CTL))[F.tid] = 0u;
#pragma unroll
    for (int i = 0; i < 24; ++i) if (F.tid == 64 + i) *(LAS unsigned long long*)(F.lds + LDS_CTL + 64 + 8 * i) = (unsigned long long)args.in[i];
    __syncthreads();
    XcdBarrier bar = xcd_barrier_post((unsigned*)wsp(F, WS_CTL) + CW_BAR, (volatile LAS unsigned*)(F.lds + LDS_CTL));
#define P6 ((bf16*)wsp(F, WS_P6))
#define VT ((bf16*)wsp(F, WS_VT))
#define R2 ((bf16*)wsp(F, WS_R2))
#define MODF ((const float*)wsp(F, WS_MODF))
#define GRID_BAR() do { XcdBarrier b_ = bar; asm volatile("" : "+s"(b_.bar), "+s"(b_.x)); xcd_barrier(b_); } while (0)
    int phase_no = 0;
#ifndef RP_BAR
#define RP_BAR 1
#endif
#ifdef TP_K
#define TP_SEL() ((TP_K) < 0 ? (phase_no == -(TP_K) - 1) : (phase_no >= 2 && (phase_no - 2) % 10 == (TP_K)))
#define TP_BEFORE() do { __syncthreads(); if (threadIdx.x == 0 && TP_SEL()) { const unsigned long long t1_ = wall_clock64(), t0_ = *(volatile LAS unsigned long long*)(F.lds + LDS_CTL + 16); \
        const unsigned long long te_ = t1_ + (unsigned long long)(TP_MULT) * (t1_ - t0_); while (wall_clock64() < te_) __builtin_amdgcn_s_sleep(8); } } while (0)
#define TP_AFTER() do { if (threadIdx.x == 0) *(volatile LAS unsigned long long*)(F.lds + LDS_CTL + 16) = wall_clock64(); } while (0)
#else
#define TP_BEFORE() do { } while (0)
#define TP_AFTER() do { } while (0)
#endif
#define PHASE_END() do { TP_BEFORE(); for (int rb_ = 0; rb_ < RP_BAR; ++rb_) GRID_BAR(); TP_AFTER(); RELOAD_IDS(); if (++phase_no >= MK_LAST_PHASE) goto finish; } while (0)
    TP_AFTER();

    if (EN(0)) { mod_partials(F);
    for (int rp = 0; rp < RP_CW; ++rp) { RELOAD_IDS(); conv_weights(F, 0); } }
    PHASE_END();
    for (int rp = 0; rp < RP_P1; ++rp) if (EN(1)) phase_norm1_first(F);
    PHASE_END();

#pragma unroll
    for (int l = 0; l < NLAYER; ++l) {
        if (EN(2)) { phase_mlstm_scalars(F); RELOAD_IDS(); }
        for (int rp = 0; rp < RP_G1; ++rp) if (EN(2)) {
            pg8::Gemm g{R2, (const bf16*)wsp(F, WS_BIN), 1024, 1024}; pg8::StaticOrder S; S.init(NTOK, P6N, F.G, F.c, F.wave);
            EpiP6 E{P6};
            pg8::gemm_phase<EpiP6, pg8::StaticOrder, true, false>(F.lds, g, S, E);
        }
        for (int rp = 0; rp < RP_VT; ++rp) if (EN(3)) {
            pg8::Gemm g{(const bf16*)wsp(F, WS_AIN), R2, 1024, 1024}; pg8::StaticOrder S; S.init(2048, NTOK, F.G, F.c, F.wave);
            EpiPlain E{VT, NTOK};
            pg8::gemm_phase<EpiPlain, pg8::StaticOrder, true, false>(F.lds, g, S, E);
        }
        PHASE_END();
        for (int pass = 0; pass < 2; ++pass) {
            if (((pass ^ F.c) & 1) == 0) { for (int rp = 0; rp < RP_CV; ++rp) if (EN(4)) phase_cvp(F, l); }
            else { for (int rp = 1; rp < RP_ATT; ++rp) phase_attn(F, false); if (EN(5)) phase_attn(F, true); }
            RELOAD_IDS();
        }
        PHASE_END();
        for (int rp = 0; rp < RP_ML; ++rp) if (EN(6)) phase_mlstm(F, (RP_ML > 1 && rp == 0) ? ML_SKIP : 0);
        PHASE_END();
        for (int rp = 1; rp < RP_HM; ++rp) phase_hm_final(F, l, false);
        if (EN(7)) phase_hm_final(F, l, true);
        PHASE_END();
        for (int rp = 0; rp < RP_PA; ++rp) if (EN(9)) {
            pg8::Gemm g{P6 + P_MQK, (const bf16*)wsp(F, WS_BA), 1024, P6W};
            PairOrder S; S.so.init(NTOK, 1024, F.G, F.c, F.wave); S.acol_b = (size_t)(P_SQ - P_MQK) * 2; S.wave = F.wave;
            EpiPair E{EpiGateT1{P6 + P_GB, P6W, (bf16*)wsp(F, WS_VT)}, EpiGateY{P6 + P_GA, P6W, (const bf16*)wsp(F, WS_VT), R2}};
            pg8::gemm_phase<EpiPair, PairOrder, true, false>(F.lds, g, S, E);
        }
        PHASE_END();
        for (int rp = 0; rp < RP_X5; ++rp) if (EN(10)) {
            pg8::Gemm g{R2, (const bf16*)wsp(F, WS_BO), 1024, 1024}; pg8::StaticOrder S; S.init(NTOK, 1024, F.G, F.c, F.wave);
            EpiRes E{(const bf16*)outp(F), xmid(F, l), MODF + (size_t)(l * 4) * 6144 + 2 * 1024, (RP_X5 > 1 && rp + 1 < RP_X5) ? 1 : 0};
            pg8::gemm_phase<EpiRes, pg8::StaticOrder, true, false>(F.lds, g, S, E);
        }
        PHASE_END();
        for (int rp = 0; rp < RP_N2; ++rp) if (EN(11)) phase_norm2_router(F, l, (RP_N2 > 1 && rp == 0) ? N2_SKIP : 0, rp == RP_N2 - 1);
        PHASE_END();
        {
            LAS int* tabE = (LAS int*)(F.lds + LDS_TAB); LAS unsigned* tabTok = (LAS unsigned*)(F.lds + LDS_TAB + 64);
            LAS float* tabW = (LAS float*)(F.lds + LDS_TAB + 64 + 3072);
            LAS unsigned* tot = (LAS unsigned*)(F.lds + LDS_TAB + 64 + 6144); LAS unsigned* padv = tot + 64; LAS unsigned* base = padv + 64;
            const int ntiles = moe_layout(F, l, tot, padv, base);
            const int v = (F.G % 8 == 0) ? (F.c % 8) * (F.G / 8) + F.c / 8 : F.c;
            const int cs = (F.G % 8 == 0) ? (v + F.G / 2) % F.G : F.G - 1 - F.c;
            if (F.tid < 64) {
#pragma unroll
                for (int i = 0; i < 3; ++i) { const unsigned r0 = 256u * (unsigned)(i * F.G + v); if (r0 >= base[F.tid] && r0 < base[F.tid] + padv[F.tid]) tabE[i] = F.tid; }
            }
            __syncthreads();
            if (F.tid < 256) {
                const unsigned* RT = (const unsigned*)wsp(F, WS_RSTOK); const float* RW = (const float*)wsp(F, WS_RSW);
                unsigned tt[3]; float tw[3]; bool ok[3];
#pragma unroll
                for (int i = 0; i < 3; ++i) { const int pm = i * F.G + v; ok[i] = false; tt[i] = 0u; tw[i] = 0.f;
                    if (pm < ntiles) { const int e = tabE[i]; const unsigned rel = 256u * (unsigned)pm - base[e] + (unsigned)F.tid; ok[i] = true;
                        if (rel < tot[e]) { tt[i] = *(const GAS unsigned*)(RT + (size_t)e * RS_CAP + rel); tw[i] = *(const GAS float*)(RW + (size_t)e * RS_CAP + rel); } } }
#pragma unroll
                for (int i = 0; i < 3; ++i) if (ok[i]) { tabTok[i * 256 + F.tid] = tt[i]; tabW[i * 256 + F.tid] = tw[i]; }
            }
            __syncthreads();
            for (int rp = 0; rp < RP_C; ++rp) if (EN(13)) {
                pg8::Gemm g{(const bf16*)wsp(F, WS_R1), (const bf16*)wsp(F, WS_BGU), 1024, 1024}; RoutedOrder S{ntiles, F.G, v, tabE, tabTok, F.wave};
                EpiHid E{R2, 128, tabW, v, F.G, 0};
                pg8::gemm_phase<EpiHid, RoutedOrder, true, true>(F.lds, g, S, E);
            }
            for (int rp = 0; rp < RP_SG; ++rp) if (EN(14)) {
                pg8::Gemm g{(const bf16*)wsp(F, WS_R1), (const bf16*)wsp(F, WS_BSGU), 1024, 1024}; pg8::StaticOrder S; S.init(NTOK, 512, F.G, cs, F.wave);
                EpiHid E{(bf16*)wsp(F, WS_R3), 256, nullptr, 0, 1, 1};
                pg8::gemm_phase<EpiHid, pg8::StaticOrder, true, false>(F.lds, g, S, E);
            }
        }
        PHASE_END();
        {
            LAS int* tabE = (LAS int*)(F.lds + LDS_TAB);
            LAS unsigned* tot = (LAS unsigned*)(F.lds + LDS_TAB + 64); LAS unsigned* padv = tot + 64; LAS unsigned* base = padv + 64;
            const int ntiles = moe_layout(F, l, tot, padv, base), nunits = 4 * ntiles;
            const int v = (F.G % 8 == 0) ? (F.c % 8) * (F.G / 8) + F.c / 8 : F.c;
            if (F.tid < 64) {
#pragma unroll
                for (int i = 0; i < 10; ++i) { const int Lu = i * F.G + v; const unsigned r0 = 256u * (unsigned)(Lu >> 2); if (Lu < nunits && r0 >= base[F.tid] && r0 < base[F.tid] + padv[F.tid]) tabE[i] = F.tid; }
            }
            __syncthreads();
            for (int rp = 0; rp < RP_D; ++rp) if (EN(15)) phase_down_routed(F, nunits, v, tabE);
            RELOAD_IDS();
            for (int rp = 0; rp < RP_SD; ++rp) if (EN(16)) {
                pg8::Gemm g{(const bf16*)wsp(F, WS_R3), (const bf16*)wsp(F, WS_BSD), 256, 256}; pg8::StaticOrder S; S.init(NTOK, 1024, F.G, F.c, F.wave);
                EpiPlain E{(bf16*)wsp(F, WS_SHO), 1024};
                pg8::gemm_phase<EpiPlain, pg8::StaticOrder, true, false>(F.lds, g, S, E);
            }
        }
        PHASE_END();
        for (int rp = 1; rp < RP_E; ++rp) phase_combine(F, l, false);
        if (EN(17)) phase_combine(F, l, true);
        if (l + 1 < NLAYER) { RELOAD_IDS(); if (EN(18)) conv_weights(F, l + 1); PHASE_END(); }
    }
#undef P6
#undef VT
#undef R2
#undef MODF
finish:
    if (MK_LAST_PHASE < 1000) dbg_final(F, phase_no >= 8 ? (const float*)outp(F) : inp(F, I_X));
}

extern "C" void kernel_launch(void* const* d_in, const int* in_sizes, int n_in, void* d_out, int out_size, void* d_ws, size_t ws_size, hipStream_t stream) {
    static int grid = 0;
    if (grid == 0) {
        if (n_in != 24 || in_sizes[0] != NTOK * DM || out_size != NTOK * DM || ws_size < WS_END) {
            fprintf(stderr, "kernel_launch: unexpected shapes (n_in %d, in0 %d, out %d, ws %zu < %zu); nothing launched\n", n_in, n_in > 0 ? in_sizes[0] : -1, out_size, ws_size, (size_t)WS_END); grid = -1; return; }
        int dev = 0, cus = 0, per_cu = 0;
        if (hipGetDevice(&dev) != hipSuccess || hipDeviceGetAttribute(&cus, hipDeviceAttributeMultiprocessorCount, dev) != hipSuccess) { grid = -1; return; }
        if (hipFuncSetAttribute((const void*)mk_fwd, hipFuncAttributeMaxDynamicSharedMemorySize, LDS_BYTES) != hipSuccess) { fprintf(stderr, "kernel_launch: hipFuncSetAttribute failed\n"); grid = -1; return; }
        if (hipOccupancyMaxActiveBlocksPerMultiprocessor(&per_cu, (const void*)mk_fwd, 512, LDS_BYTES) != hipSuccess || per_cu < 1)
            fprintf(stderr, "kernel_launch: note: occupancy query reports %d workgroups per CU\n", per_cu);
        (void)hipGetLastError();
        grid = cus;
    }
    if (grid < 0) return;
    if (hipMemsetAsync((char*)d_ws + WS_CTL, 0, CTL_ZERO_BYTES, stream) != hipSuccess) return;
    Args a{};
    for (int i = 0; i < 24; ++i) a.in[i] = (const float*)d_in[i];
    a.out = (float*)d_out; a.ws = (unsigned char*)d_ws;
    hipLaunchKernelGGL(mk_fwd, dim3(grid), dim3(512), LDS_BYTES, stream, a);
}
```
